# Optimizing an MI355X kernel written in HIP

```python
import math
import jax
import jax.numpy as jnp
from jax import lax
import numpy as np

D_MODEL = 2048
BATCH = 1
SEQ = 16384
DEPTH = 1

MIX_WIDTH = D_MODEL
ATTN_WIDTH = MIX_WIDTH // 2
SSM_WIDTH = MIX_WIDTH - ATTN_WIDTH
HEAD_DIM = 64
N_HEADS = ATTN_WIDTH // HEAD_DIM
ATTN_BRANCHES = ((128, 1), (512, 4), (2048, 16))
SSM_GROUP_CH = 16
N_SSM_GROUPS = SSM_WIDTH // SSM_GROUP_CH
SSM_STATE = 64
DT_MIN = 0.001
DT_MAX = 0.1
IN_WIDTH = 3 * ATTN_WIDTH + SSM_WIDTH
N_EXPERTS = 32
TOP_K = 4
D_FF_EXPERT = D_MODEL
SWIGLU_LIMIT = 7.0
SWIGLU_ALPHA = 1.702
EXPERT_BLOCK = 128
NORM_EPS = 1e-6

kernel_name = 'hymba_s5_longnet_moe_block'


def rmsnorm(x, g):
    xf = x.astype(jnp.float32)
    y = xf * lax.rsqrt(jnp.mean(xf * xf, axis=-1, keepdims=True) + NORM_EPS)
    return (y * g.astype(jnp.float32)).astype(x.dtype)


def dilated_branch(q, k, v, window, dil):
    Bb, S, H, Dh = q.shape
    blk = window // dil
    span = blk * dil
    nb = -(-S // span)
    Sp = nb * span
    padw = ((0, 0), (0, Sp - S), (0, 0), (0, 0))

    def split_stride(t):
        return jnp.pad(t, padw).reshape(Bb, nb, blk, dil, H, Dh)

    def with_prev(t):
        prev = jnp.pad(t[:, :-1], ((0, 0), (1, 0), (0, 0), (0, 0), (0, 0), (0, 0)))
        return jnp.concatenate([prev, t], axis=2)

    qb = split_stride(q)
    kc = with_prev(split_stride(k))
    vc = with_prev(split_stride(v))
    s = jnp.einsum('bnqrhd,bnkrhd->bnrhqk', qb, kc,
                   preferred_element_type=jnp.float32) * (Dh ** -0.5)
    qi = jnp.arange(blk)[:, None]
    kj = jnp.arange(2 * blk)[None, :]
    dist = qi + blk - kj
    band = (dist >= 0) & (dist <= blk)
    first = (jnp.arange(nb)[:, None, None] > 0) | (kj[None] >= blk)
    mask = (band[None] & first)[None, :, None, None]
    s = jnp.where(mask, s, -jnp.inf)
    m = jnp.max(s, axis=-1, keepdims=True)
    p = jnp.exp(s - m)
    den = jnp.sum(p, axis=-1, keepdims=True)
    o = jnp.einsum('bnrhqk,bnkrhd->bnrhqd', p, vc.astype(jnp.float32)) / den
    lse = (m + jnp.log(den))[..., 0]
    o = jnp.transpose(o, (0, 1, 4, 2, 3, 5)).reshape(Bb, Sp, H, Dh)[:, :S]
    lse = jnp.transpose(lse, (0, 1, 4, 2, 3)).reshape(Bb, Sp, H)[:, :S]
    return o, lse


def dilated_mixture_attention(q, k, v):
    outs = []
    lses = []
    for window, dil in ATTN_BRANCHES:
        o, lse = dilated_branch(q, k, v, window, dil)
        outs.append(o)
        lses.append(lse)
    wts = jax.nn.softmax(jnp.stack(lses, axis=0), axis=0)[..., None]
    o = jnp.sum(wts * jnp.stack(outs, axis=0), axis=0)
    return o.astype(q.dtype)


def s5_mixer(u, lam_re, lam_im, b_re, b_im, c_re, c_im, d_skip, log_dt, w_glu, b_glu):
    Bb, S, W = u.shape
    f32 = jnp.float32
    uf = u.astype(f32).reshape(Bb, S, N_SSM_GROUPS, SSM_GROUP_CH)
    dt = jnp.exp(log_dt.astype(f32))[:, None]
    lr = lam_re.astype(f32)
    li = lam_im.astype(f32)
    mag = jnp.exp(lr * dt)
    ab_re = mag * jnp.cos(li * dt)
    ab_im = mag * jnp.sin(li * dt)
    den = lr * lr + li * li
    nr = ab_re - 1.0
    ni = ab_im
    f_re = (nr * lr + ni * li) / den
    f_im = (ni * lr - nr * li) / den
    br = b_re.astype(f32)
    bi = b_im.astype(f32)
    bb_re = f_re[..., None] * br - f_im[..., None] * bi
    bb_im = f_re[..., None] * bi + f_im[..., None] * br
    bu_re = jnp.einsum('gnp,bsgp->bsgn', bb_re, uf)
    bu_im = jnp.einsum('gnp,bsgp->bsgn', bb_im, uf)
    a_re = jnp.broadcast_to(ab_re, bu_re.shape)
    a_im = jnp.broadcast_to(ab_im, bu_im.shape)

    def combine(e1, e2):
        a1r, a1i, b1r, b1i = e1
        a2r, a2i, b2r, b2i = e2
        return (a2r * a1r - a2i * a1i,
                a2r * a1i + a2i * a1r,
                a2r * b1r - a2i * b1i + b2r,
                a2r * b1i + a2i * b1r + b2i)

    _, _, xr, xi = lax.associative_scan(combine, (a_re, a_im, bu_re, bu_im), axis=1)
    y = (jnp.einsum('gpn,bsgn->bsgp', c_re.astype(f32), xr)
         - jnp.einsum('gpn,bsgn->bsgp', c_im.astype(f32), xi)
         + d_skip.astype(f32) * uf)
    y = jax.nn.gelu(y.reshape(Bb, S, W))
    y = y * jax.nn.sigmoid(y @ w_glu.astype(f32) + b_glu.astype(f32))
    return y.astype(u.dtype)


def clamped_swiglu(gu):
    x_glu = jnp.minimum(gu[..., ::2], SWIGLU_LIMIT)
    x_lin = jnp.clip(gu[..., 1::2], -SWIGLU_LIMIT, SWIGLU_LIMIT)
    return x_glu * jax.nn.sigmoid(SWIGLU_ALPHA * x_glu) * (x_lin + 1.0)


def moe_ffn(h, l, w_router, b_router, w_gate_up, b_gate_up, w_down, b_down):
    Bb, S, D = h.shape
    T = Bb * S
    hf = h.reshape(T, D)
    logits = (hf @ w_router[l] + b_router[l]).astype(jnp.float32)
    top_vals, top_idx = lax.top_k(logits, TOP_K)
    gates = jax.nn.softmax(top_vals, axis=-1)
    n_assign = T * TOP_K
    flat_e = top_idx.reshape(-1).astype(jnp.int32)
    flat_tok = jnp.arange(n_assign, dtype=jnp.int32) // TOP_K
    flat_gate = gates.reshape(-1)
    order = jnp.argsort(flat_e)
    sorted_e = flat_e[order]
    sorted_tok = flat_tok[order]
    sorted_gate = flat_gate[order]
    counts = jnp.bincount(flat_e, length=N_EXPERTS).astype(jnp.int32)
    start = jnp.cumsum(counts) - counts
    padded = (counts + EXPERT_BLOCK - 1) // EXPERT_BLOCK * EXPERT_BLOCK
    pad_end = jnp.cumsum(padded)
    pad_start = pad_end - padded
    rank = jnp.arange(n_assign, dtype=jnp.int32) - start[sorted_e]
    dest = pad_start[sorted_e] + rank
    m_pad = n_assign + N_EXPERTS * EXPERT_BLOCK
    n_blocks = m_pad // EXPERT_BLOCK
    row_tok = jnp.full((m_pad,), T, jnp.int32).at[dest].set(sorted_tok)
    row_gate = jnp.zeros((m_pad,), jnp.float32).at[dest].set(sorted_gate)
    block_e = jnp.minimum(
        jnp.searchsorted(pad_end, jnp.arange(n_blocks, dtype=jnp.int32) * EXPERT_BLOCK,
                         side='right'), N_EXPERTS - 1).astype(jnp.int32)
    h_pad = jnp.concatenate([hf, jnp.zeros((1, D), hf.dtype)], axis=0)

    def expert_block(args):
        e, tok, g = args
        xb = h_pad[tok]
        gu = xb @ w_gate_up[l, e] + b_gate_up[l, e]
        yb = clamped_swiglu(gu) @ w_down[l, e] + b_down[l, e]
        return yb * g[:, None].astype(yb.dtype)

    out = lax.map(expert_block, (block_e,
                                 row_tok.reshape(n_blocks, EXPERT_BLOCK),
                                 row_gate.reshape(n_blocks, EXPERT_BLOCK)))
    y = jax.ops.segment_sum(out.reshape(m_pad, D), row_tok, num_segments=T + 1)[:T]
    return y.reshape(Bb, S, D).astype(h.dtype)


def setup_inputs(seed: int = 0) -> dict:
    key = jax.random.key(seed)
    ks = jax.random.split(key, 30)
    f32 = jnp.float32
    L, D, A, W = DEPTH, D_MODEL, ATTN_WIDTH, SSM_WIDTH
    G, N, P = N_SSM_GROUPS, SSM_STATE, SSM_GROUP_CH
    E, F = N_EXPERTS, D_FF_EXPERT

    def nrm(k, shape, scale):
        return jax.random.normal(k, shape, f32) * scale

    n_idx = jnp.arange(N, dtype=f32)[None, None, :]
    return {
        'x': nrm(ks[0], (BATCH, SEQ, D), 1.0),
        'c': nrm(ks[1], (BATCH, D), 1.0),
        'w_ada': nrm(ks[2], (L, D, 6 * D), D ** -0.5),
        'b_ada': nrm(ks[3], (L, 6 * D), 0.02),
        'norm1_g': 1.0 + nrm(ks[4], (L, D), 0.02),
        'w_in': nrm(ks[5], (L, D, IN_WIDTH), D ** -0.5),
        'lambda_re': -0.5 + nrm(ks[6], (L, G, N), 0.01),
        'lambda_im': jnp.pi * n_idx + nrm(ks[7], (L, G, N), 0.01),
        'ssm_b_re': nrm(ks[8], (L, G, N, P), (2 * P) ** -0.5),
        'ssm_b_im': nrm(ks[9], (L, G, N, P), (2 * P) ** -0.5),
        'ssm_c_re': nrm(ks[10], (L, G, P, N), (2 * N) ** -0.5),
        'ssm_c_im': nrm(ks[11], (L, G, P, N), (2 * N) ** -0.5),
        'ssm_d': nrm(ks[12], (L, G, P), 1.0),
        'ssm_log_dt': jax.random.uniform(ks[13], (L, G), f32, math.log(DT_MIN), math.log(DT_MAX)),
        'w_glu': nrm(ks[14], (L, W, W), W ** -0.5),
        'b_glu': nrm(ks[15], (L, W), 0.02),
        'attn_out_g': 1.0 + nrm(ks[16], (L, A), 0.02),
        'ssm_out_g': 1.0 + nrm(ks[17], (L, W), 0.02),
        'w_out': nrm(ks[18], (L, MIX_WIDTH, D), MIX_WIDTH ** -0.5),
        'norm2_g': 1.0 + nrm(ks[19], (L, D), 0.02),
        'w_router': nrm(ks[20], (L, D, E), D ** -0.5),
        'b_router': nrm(ks[21], (L, E), 0.01),
        'w_gate_up': nrm(ks[22], (L, E, D, 2 * F), D ** -0.5),
        'b_gate_up': nrm(ks[23], (L, E, 2 * F), 0.02),
        'w_down': nrm(ks[24], (L, E, F, D), F ** -0.5),
        'b_down': nrm(ks[25], (L, E, D), 0.02),
        'final_g': 1.0 + nrm(ks[26], (D,), 0.02),
    }


def reference(x, c, w_ada, b_ada, norm1_g, w_in, lambda_re, lambda_im, ssm_b_re, ssm_b_im,
              ssm_c_re, ssm_c_im, ssm_d, ssm_log_dt, w_glu, b_glu, attn_out_g, ssm_out_g,
              w_out, norm2_g, w_router, b_router, w_gate_up, b_gate_up, w_down, b_down,
              final_g):
    Bb, S, _ = x.shape
    c_act = jax.nn.silu(c)
    for l in range(DEPTH):
        mod = c_act @ w_ada[l] + b_ada[l]
        sh1, sc1, g1, sh2, sc2, g2 = [m[:, None, :] for m in jnp.split(mod, 6, axis=-1)]
        h = rmsnorm(x, norm1_g[l]) * (1.0 + sc1) + sh1
        proj = h @ w_in[l]
        q, k, v, u = jnp.split(proj, [ATTN_WIDTH, 2 * ATTN_WIDTH, 3 * ATTN_WIDTH], axis=-1)
        q = q.reshape(Bb, S, N_HEADS, HEAD_DIM)
        k = k.reshape(Bb, S, N_HEADS, HEAD_DIM)
        v = v.reshape(Bb, S, N_HEADS, HEAD_DIM)
        y_attn = dilated_mixture_attention(q, k, v).reshape(Bb, S, ATTN_WIDTH)
        y_ssm = s5_mixer(u, lambda_re[l], lambda_im[l], ssm_b_re[l], ssm_b_im[l],
                         ssm_c_re[l], ssm_c_im[l], ssm_d[l], ssm_log_dt[l], w_glu[l], b_glu[l])
        y_mix = jnp.concatenate([rmsnorm(y_attn, attn_out_g[l]),
                                 rmsnorm(y_ssm, ssm_out_g[l])], axis=-1)
        x = x + g1 * (y_mix @ w_out[l])
        h2 = rmsnorm(x, norm2_g[l]) * (1.0 + sc2) + sh2
        x = x + g2 * moe_ffn(h2, l, w_router, b_router, w_gate_up, b_gate_up, w_down, b_down)
    return rmsnorm(x, final_g)
```

```cpp
#include <hip/hip_runtime.h>
#include <cstdio>
#include <cstdint>

constexpr int S = 16384, D = 2048, AW = 1024, SW = 1024, INW = 4096, NH = 16, HD = 64;
constexpr int G = 64, NS = 64, PC = 16;
constexpr int NE = 32, TOPK = 4, FF = 2048;
constexpr int LCH = 128, NCH = S / LCH;
constexpr int NASSIGN = S * TOPK;
constexpr int PADROWS = NASSIGN + NE * 256;
constexpr float EPS = 1e-6f;

constexpr size_t MiB = 1ull << 20;
constexpr size_t WS_CTL = 0;
constexpr size_t WS_MOD = 1 * MiB;
constexpr size_t WS_S5P = 2 * MiB;
constexpr size_t WS_IDX = 4 * MiB;
constexpr size_t WS_GATE = 5 * MiB;
constexpr size_t WS_SLOT = 6 * MiB;
constexpr size_t WS_LIST = 8 * MiB;
constexpr size_t WS_ECH = 12 * MiB;
constexpr size_t WS_X0 = 16 * MiB;
constexpr size_t WS_H = 32 * MiB;
constexpr size_t WS_PROJ = WS_H + 128 * MiB;
constexpr size_t WS_YATT = WS_PROJ + 256 * MiB;
constexpr size_t WS_YG = WS_YATT + 64 * MiB;
constexpr size_t WS_Z = WS_YG + 64 * MiB;
constexpr size_t WS_YMIX = WS_Z + 64 * MiB;
constexpr size_t WS_X1 = WS_YMIX + 128 * MiB;
constexpr size_t WS_H2 = WS_X1 + 128 * MiB;
constexpr size_t WS_ACT = WS_H2 + 128 * MiB;
constexpr size_t WS_YA = WS_ACT + 576 * MiB;
constexpr size_t WS_END = WS_YA + 576 * MiB;

struct P {
    const float *x, *c, *w_ada, *b_ada, *norm1_g, *w_in, *lam_re, *lam_im, *b_re, *b_im, *c_re, *c_im, *d_skip, *log_dt,
        *w_glu, *b_glu, *attn_g, *ssm_g, *w_out, *norm2_g, *w_router, *b_router, *w_gu, *b_gu, *w_down, *b_down, *final_g;
    float* out;
    unsigned char* ws;
};

__device__ __forceinline__ float wave_sum(float v) {
#pragma unroll
    for (int o = 1; o < 64; o <<= 1) v += __shfl_xor(v, o);
    return v;
}
__device__ __forceinline__ float block_sum256(float v, float* red) {
    v = wave_sum(v);
    __syncthreads();
    if ((threadIdx.x & 63) == 0) red[threadIdx.x >> 6] = v;
    __syncthreads();
    return red[0] + red[1] + red[2] + red[3];
}
__device__ __forceinline__ float sigmoidf_(float x) { return 1.0f / (1.0f + expf(-x)); }

__global__ void k_mod(P p) {
    const int j = blockIdx.x * blockDim.x + threadIdx.x;
    if (j >= 6 * D) return;
    float acc = p.b_ada[j];
    for (int i = 0; i < D; ++i) { const float cv = p.c[i]; const float s = cv / (1.0f + expf(-cv)); acc += s * p.w_ada[(size_t)i * 6 * D + j]; }
    ((float*)(p.ws + WS_MOD))[j] = acc;
}
__global__ void k_s5params(P p) {
    const int i = blockIdx.x * blockDim.x + threadIdx.x;
    if (i >= G * NS) return;
    const int g = i / NS;
    float* sp = (float*)(p.ws + WS_S5P);
    float *abr = sp, *abi = sp + 4096, *bbr = sp + 8192, *bbi = sp + 8192 + 65536;
    const float dt = expf(p.log_dt[g]), lr = p.lam_re[i], li = p.lam_im[i];
    const float mag = expf(lr * dt), ar = mag * cosf(li * dt), ai = mag * sinf(li * dt);
    const float den = lr * lr + li * li, nr = ar - 1.0f, ni = ai;
    const float fr = (nr * lr + ni * li) / den, fi = (ni * lr - nr * li) / den;
    abr[i] = ar; abi[i] = ai;
    for (int q = 0; q < PC; ++q) { const float br = p.b_re[(size_t)i * PC + q], bi = p.b_im[(size_t)i * PC + q];
        bbr[(size_t)i * PC + q] = fr * br - fi * bi; bbi[(size_t)i * PC + q] = fr * bi + fi * br; }
}
template <int WHICH>
__global__ __launch_bounds__(256) void k_norm_mod(P p) {
    __shared__ float red[4];
    const float* mod = (const float*)(p.ws + WS_MOD);
    const float* xin = (WHICH == 1) ? p.x : (const float*)(p.ws + WS_X1);
    const float* gain = (WHICH == 1) ? p.norm1_g : p.norm2_g;
    const float* mod_sc = (WHICH == 1) ? mod + 1 * D : mod + 4 * D;
    const float* mod_sh = (WHICH == 1) ? mod + 0 * D : mod + 3 * D;
    float* hout = (float*)(p.ws + ((WHICH == 1) ? WS_H : WS_H2));
    const int t = blockIdx.x;
    const float* xr = xin + (size_t)t * D;
    float v[8]; float ss = 0.f;
#pragma unroll
    for (int j = 0; j < 8; ++j) { v[j] = xr[threadIdx.x + 256 * j]; ss += v[j] * v[j]; }
    const float tot = block_sum256(ss, red);
    const float rs = 1.0f / sqrtf(tot * (1.0f / D) + EPS);
#pragma unroll
    for (int j = 0; j < 8; ++j) { const int cidx = threadIdx.x + 256 * j; hout[(size_t)t * D + cidx] = v[j] * rs * gain[cidx] * (1.0f + mod_sc[cidx]) + mod_sh[cidx]; }
}

struct EpiStore { float* C; int ldc; __device__ void operator()(int r, int cidx, const float (&v)[4]) const { float4 o = make_float4(v[0], v[1], v[2], v[3]); *(float4*)(C + (size_t)r * ldc + cidx) = o; } };
struct EpiGlu { const float* yg; const float* bias; float* Z; __device__ void operator()(int r, int cidx, const float (&v)[4]) const {
    float o[4];
#pragma unroll
    for (int j = 0; j < 4; ++j) { const float y = yg[(size_t)r * SW + cidx + j]; o[j] = y * sigmoidf_(v[j] + bias[cidx + j]); }
    *(float4*)(Z + (size_t)r * SW + cidx) = make_float4(o[0], o[1], o[2], o[3]); } };
struct EpiResid { const float* x; const float* gate; float* X1; __device__ void operator()(int r, int cidx, const float (&v)[4]) const {
    float o[4];
#pragma unroll
    for (int j = 0; j < 4; ++j) o[j] = x[(size_t)r * D + cidx + j] + gate[cidx + j] * v[j];
    *(float4*)(X1 + (size_t)r * D + cidx) = make_float4(o[0], o[1], o[2], o[3]); } };

template <int MODE>
__global__ __launch_bounds__(256) void k_gemm_dense(P p) {
    const float* mod = (const float*)(p.ws + WS_MOD);
    const float* A = (const float*)(p.ws + (MODE == 0 ? WS_H : (MODE == 1 ? WS_YG : WS_YMIX)));
    const float* B = MODE == 0 ? p.w_in : (MODE == 1 ? p.w_glu : p.w_out);
    constexpr int K = MODE == 0 ? D : (MODE == 1 ? SW : D);
    constexpr int lda = K;
    constexpr int ldb = MODE == 0 ? INW : (MODE == 1 ? SW : D);
    __shared__ float As[16][65];
    __shared__ __attribute__((aligned(16))) float Bs[16][64];
    const int tid = threadIdx.x, tx = tid & 15, ty = tid >> 4;
    const int row0 = blockIdx.y * 64, col0 = blockIdx.x * 64;
    float acc[4][4];
#pragma unroll
    for (int i = 0; i < 4; ++i)
#pragma unroll
        for (int j = 0; j < 4; ++j) acc[i][j] = 0.f;
    const int ar = tid >> 2, ak = (tid & 3) * 4;
    const int bk = tid >> 4, bc = (tid & 15) * 4;
    for (int k0 = 0; k0 < K; k0 += 16) {
        const float4 av = *(const float4*)(A + (size_t)(row0 + ar) * lda + k0 + ak);
        const float4 bv = *(const float4*)(B + (size_t)(k0 + bk) * ldb + col0 + bc);
        __syncthreads();
        As[ak + 0][ar] = av.x; As[ak + 1][ar] = av.y; As[ak + 2][ar] = av.z; As[ak + 3][ar] = av.w;
        *(float4*)&Bs[bk][bc] = bv;
        __syncthreads();
#pragma unroll
        for (int kk = 0; kk < 16; ++kk) {
            float a[4], b[4];
#pragma unroll
            for (int i = 0; i < 4; ++i) a[i] = As[kk][ty * 4 + i];
            const float4 b4 = *(const float4*)&Bs[kk][tx * 4]; b[0] = b4.x; b[1] = b4.y; b[2] = b4.z; b[3] = b4.w;
#pragma unroll
            for (int i = 0; i < 4; ++i)
#pragma unroll
                for (int j = 0; j < 4; ++j) acc[i][j] += a[i] * b[j];
        }
    }
#pragma unroll
    for (int i = 0; i < 4; ++i) {
        if (MODE == 0) { EpiStore epi{(float*)(p.ws + WS_PROJ), INW}; epi(row0 + ty * 4 + i, col0 + tx * 4, acc[i]); }
        if (MODE == 1) { EpiGlu epi{(const float*)(p.ws + WS_YG), p.b_glu, (float*)(p.ws + WS_Z)}; epi(row0 + ty * 4 + i, col0 + tx * 4, acc[i]); }
        if (MODE == 2) { EpiResid epi{p.x, mod + 2 * D, (float*)(p.ws + WS_X1)}; epi(row0 + ty * 4 + i, col0 + tx * 4, acc[i]); }
    }
}

__global__ __launch_bounds__(256) void k_attn_naive(P p) {
    const float* proj = (const float*)(p.ws + WS_PROJ); float* yatt = (float*)(p.ws + WS_YATT);
    const int w = (blockIdx.x * 256 + threadIdx.x) >> 6, lane = threadIdx.x & 63;
    if (w >= S * NH) return;
    const int t = w / NH, h = w % NH;
    const float q = proj[(size_t)t * INW + h * HD + lane] * 0.125f;
    float m = -INFINITY, l = 0.f, o = 0.f;
    for (int br = 0; br < 3; ++br) {
        const int d = (br == 0) ? 1 : (br == 1 ? 4 : 16);
        for (int j = 0; j <= 128; ++j) {
            const int pos = t - j * d;
            if (pos < 0) break;
            const float kv = proj[(size_t)pos * INW + AW + h * HD + lane];
            const float vv = proj[(size_t)pos * INW + 2 * AW + h * HD + lane];
            const float s = wave_sum(q * kv);
            const float mn = fmaxf(m, s), corr = expf(m - mn), pe = expf(s - mn);
            l = l * corr + pe; o = o * corr + pe * vv; m = mn;
        }
    }
    yatt[(size_t)t * AW + h * HD + lane] = o / l;
}

__global__ __launch_bounds__(256) void k_s5_passA(P p) {
    const int w = (blockIdx.x * 256 + threadIdx.x) >> 6, n = threadIdx.x & 63;
    if (w >= NCH * G) return;
    const int c = w / G, g = w % G;
    const float* sp = (const float*)(p.ws + WS_S5P);
    const float ar = sp[g * NS + n], ai = sp[4096 + g * NS + n];
    float br[PC], bi[PC];
#pragma unroll
    for (int q = 0; q < PC; ++q) { br[q] = sp[8192 + (size_t)(g * NS + n) * PC + q]; bi[q] = sp[8192 + 65536 + (size_t)(g * NS + n) * PC + q]; }
    const float* proj = (const float*)(p.ws + WS_PROJ);
    float xr = 0.f, xi = 0.f;
    for (int t = c * LCH; t < (c + 1) * LCH; ++t) {
        const float* u = proj + (size_t)t * INW + 3 * AW + g * PC;
        float bur = 0.f, bui = 0.f;
#pragma unroll
        for (int q = 0; q < PC; ++q) { const float uv = u[q]; bur += br[q] * uv; bui += bi[q] * uv; }
        const float nr = ar * xr - ai * xi + bur, ni = ar * xi + ai * xr + bui;
        xr = nr; xi = ni;
    }
    float* E = (float*)(p.ws + WS_ECH);
    E[((size_t)(c * G + g) * NS + n) * 2 + 0] = xr; E[((size_t)(c * G + g) * NS + n) * 2 + 1] = xi;
}
__global__ void k_s5_carry(P p) {
    const int i = blockIdx.x * blockDim.x + threadIdx.x;
    if (i >= G * NS) return;
    const float* sp = (const float*)(p.ws + WS_S5P);
    float pr = sp[i], pi = sp[4096 + i];
    for (int s = 0; s < 7; ++s) { const float nr = pr * pr - pi * pi, ni = 2.f * pr * pi; pr = nr; pi = ni; }
    const float* E = (const float*)(p.ws + WS_ECH);
    float* X0 = (float*)(p.ws + WS_X0);
    float xr = 0.f, xi = 0.f;
    for (int c = 0; c < NCH; ++c) {
        X0[((size_t)c * G * NS + i) * 2 + 0] = xr; X0[((size_t)c * G * NS + i) * 2 + 1] = xi;
        const float er = E[((size_t)c * G * NS + i) * 2 + 0], ei = E[((size_t)c * G * NS + i) * 2 + 1];
        const float nr = pr * xr - pi * xi + er, ni = pr * xi + pi * xr + ei;
        xr = nr; xi = ni;
    }
}
__device__ __forceinline__ float gelu_tanh(float y) { const float u = 0.7978845608028654f * (y + 0.044715f * y * y * y); return 0.5f * y * (1.0f + tanhf(u)); }
__global__ __launch_bounds__(256) void k_s5_passB(P p) {
    const int w = (blockIdx.x * 256 + threadIdx.x) >> 6, n = threadIdx.x & 63;
    if (w >= NCH * G) return;
    const int c = w / G, g = w % G;
    const float* sp = (const float*)(p.ws + WS_S5P);
    const float ar = sp[g * NS + n], ai = sp[4096 + g * NS + n];
    float br[PC], bi[PC], cr[PC], ci[PC];
#pragma unroll
    for (int q = 0; q < PC; ++q) { br[q] = sp[8192 + (size_t)(g * NS + n) * PC + q]; bi[q] = sp[8192 + 65536 + (size_t)(g * NS + n) * PC + q];
        cr[q] = p.c_re[((size_t)g * PC + q) * NS + n]; ci[q] = p.c_im[((size_t)g * PC + q) * NS + n]; }
    const float dsk = (n < PC) ? p.d_skip[g * PC + n] : 0.f;
    const float* proj = (const float*)(p.ws + WS_PROJ);
    const float* X0 = (const float*)(p.ws + WS_X0);
    float* YG = (float*)(p.ws + WS_YG);
    float xr = X0[((size_t)(c * G + g) * NS + n) * 2 + 0], xi = X0[((size_t)(c * G + g) * NS + n) * 2 + 1];
    for (int t = c * LCH; t < (c + 1) * LCH; ++t) {
        const float* u = proj + (size_t)t * INW + 3 * AW + g * PC;
        float bur = 0.f, bui = 0.f;
#pragma unroll
        for (int q = 0; q < PC; ++q) { const float uv = u[q]; bur += br[q] * uv; bui += bi[q] * uv; }
        const float nr = ar * xr - ai * xi + bur, ni = ar * xi + ai * xr + bui;
        xr = nr; xi = ni;
        float mine = 0.f;
#pragma unroll
        for (int q = 0; q < PC; ++q) { const float s = wave_sum(cr[q] * xr - ci[q] * xi); mine = (n == q) ? s : mine; }
        if (n < PC) { const float y = mine + dsk * u[n]; YG[(size_t)t * SW + g * PC + n] = gelu_tanh(y); }
    }
}

__global__ __launch_bounds__(256) void k_mix(P p) {
    __shared__ float red[4];
    const int t = blockIdx.x;
    const float* ya = (const float*)(p.ws + WS_YATT) + (size_t)t * AW;
    const float* z = (const float*)(p.ws + WS_Z) + (size_t)t * SW;
    float* ym = (float*)(p.ws + WS_YMIX) + (size_t)t * D;
    float a[4], b[4]; float sa = 0.f, sb = 0.f;
#pragma unroll
    for (int j = 0; j < 4; ++j) { a[j] = ya[threadIdx.x + 256 * j]; b[j] = z[threadIdx.x + 256 * j]; sa += a[j] * a[j]; sb += b[j] * b[j]; }
    const float ta = block_sum256(sa, red);
    const float tb = block_sum256(sb, red);
    const float ra = 1.0f / sqrtf(ta * (1.0f / AW) + EPS), rb = 1.0f / sqrtf(tb * (1.0f / SW) + EPS);
#pragma unroll
    for (int j = 0; j < 4; ++j) { const int cidx = threadIdx.x + 256 * j; ym[cidx] = a[j] * ra * p.attn_g[cidx]; ym[AW + cidx] = b[j] * rb * p.ssm_g[cidx]; }
}

__global__ __launch_bounds__(256) void k_router(P p) {
    __shared__ float hrow[D];
    __shared__ float part[8][NE];
    __shared__ float logit[NE];
    const int t = blockIdx.x;
    const float* h2 = (const float*)(p.ws + WS_H2) + (size_t)t * D;
    for (int j = threadIdx.x; j < D; j += 256) hrow[j] = h2[j];
    __syncthreads();
    const int e = threadIdx.x & 31, part_id = threadIdx.x >> 5;
    float acc = 0.f;
    for (int k = part_id * 256; k < (part_id + 1) * 256; ++k) acc += hrow[k] * p.w_router[(size_t)k * NE + e];
    part[part_id][e] = acc;
    __syncthreads();
    if (threadIdx.x < NE) { float s = p.b_router[threadIdx.x];
#pragma unroll
        for (int q = 0; q < 8; ++q) s += part[q][threadIdx.x];
        logit[threadIdx.x] = s; }
    __syncthreads();
    if (threadIdx.x == 0) {
        unsigned used = 0u; float tv[TOPK]; int ti[TOPK];
#pragma unroll
        for (int k = 0; k < TOPK; ++k) { float best = -INFINITY; int bi = 0;
            for (int j = 0; j < NE; ++j) { const float v = logit[j]; if (!((used >> j) & 1u) && v > best) { best = v; bi = j; } }
            used |= 1u << bi; tv[k] = best; ti[k] = bi; }
        const float mx = tv[0]; float ex[TOPK], sum = 0.f;
#pragma unroll
        for (int k = 0; k < TOPK; ++k) { ex[k] = expf(tv[k] - mx); sum += ex[k]; }
        int* idx = (int*)(p.ws + WS_IDX); float* gate = (float*)(p.ws + WS_GATE); int* slot = (int*)(p.ws + WS_SLOT);
        int* cnt = (int*)(p.ws + WS_CTL); int* list = (int*)(p.ws + WS_LIST);
#pragma unroll
        for (int k = 0; k < TOPK; ++k) { const int sl = atomicAdd(&cnt[ti[k]], 1);
            idx[t * TOPK + k] = ti[k]; gate[t * TOPK + k] = ex[k] / sum; slot[t * TOPK + k] = sl; list[ti[k] * S + sl] = t * TOPK + k; }
    }
}

__device__ __forceinline__ bool moe_tile(const int* cnt, int tile, int& e, int& r0, int& prow0) {
    int acc_t = 0, prow = 0;
    for (int j = 0; j < NE; ++j) { const int cj = cnt[j], nt = (cj + 63) >> 6;
        if (tile < acc_t + nt) { e = j; r0 = (tile - acc_t) * 64; prow0 = prow + r0; return true; }
        acc_t += nt; prow += (cj + 255) & ~255; }
    return false;
}
template <int STAGE>
__global__ __launch_bounds__(256) void k_gemm_moe(P p) {
    __shared__ float As[16][65];
    __shared__ __attribute__((aligned(16))) float Bs[16][64];
    const int* cnt = (const int*)(p.ws + WS_CTL);
    int e, r0, prow0;
    if (!moe_tile(cnt, blockIdx.y, e, r0, prow0)) return;
    const int ce = cnt[e];
    const int* list = (const int*)(p.ws + WS_LIST) + (size_t)e * S;
    const int tid = threadIdx.x, tx = tid & 15, ty = tid >> 4;
    const int col0 = blockIdx.x * 64;
    constexpr int K = (STAGE == 1) ? D : FF;
    constexpr int N = (STAGE == 1) ? 2 * FF : D;
    const float* B = (STAGE == 1) ? p.w_gu + (size_t)e * D * 2 * FF : p.w_down + (size_t)e * FF * D;
    const int ar = tid >> 2, ak = (tid & 3) * 4;
    const int bk = tid >> 4, bc = (tid & 15) * 4;
    const bool avalid = (r0 + ar) < ce;
    const float* arow;
    if (STAGE == 1) { const int a = avalid ? list[r0 + ar] : 0; arow = (const float*)(p.ws + WS_H2) + (size_t)(a >> 2) * D; }
    else arow = (const float*)(p.ws + WS_ACT) + (size_t)(prow0 + ar) * FF;
    float acc[4][4];
#pragma unroll
    for (int i = 0; i < 4; ++i)
#pragma unroll
        for (int j = 0; j < 4; ++j) acc[i][j] = 0.f;
    for (int k0 = 0; k0 < K; k0 += 16) {
        float4 av = make_float4(0.f, 0.f, 0.f, 0.f);
        if (avalid) av = *(const float4*)(arow + k0 + ak);
        const float4 bv = *(const float4*)(B + (size_t)(k0 + bk) * N + col0 + bc);
        __syncthreads();
        As[ak + 0][ar] = av.x; As[ak + 1][ar] = av.y; As[ak + 2][ar] = av.z; As[ak + 3][ar] = av.w;
        *(float4*)&Bs[bk][bc] = bv;
        __syncthreads();
#pragma unroll
        for (int kk = 0; kk < 16; ++kk) {
            float a[4], b[4];
#pragma unroll
            for (int i = 0; i < 4; ++i) a[i] = As[kk][ty * 4 + i];
            const float4 b4 = *(const float4*)&Bs[kk][tx * 4]; b[0] = b4.x; b[1] = b4.y; b[2] = b4.z; b[3] = b4.w;
#pragma unroll
            for (int i = 0; i < 4; ++i)
#pragma unroll
                for (int j = 0; j < 4; ++j) acc[i][j] += a[i] * b[j];
        }
    }
#pragma unroll
    for (int i = 0; i < 4; ++i) {
        const int lr = r0 + ty * 4 + i;
        if (lr >= ce) continue;
        const int prow = prow0 + ty * 4 + i, cidx = col0 + tx * 4;
        if (STAGE == 1) {
            const float* bias = p.b_gu + (size_t)e * 2 * FF + cidx;
            float o[2];
#pragma unroll
            for (int j = 0; j < 2; ++j) { const float gl = fminf(acc[i][2 * j] + bias[2 * j], 7.0f); const float ln = fminf(fmaxf(acc[i][2 * j + 1] + bias[2 * j + 1], -7.0f), 7.0f);
                o[j] = gl * sigmoidf_(1.702f * gl) * (ln + 1.0f); }
            float* act = (float*)(p.ws + WS_ACT) + (size_t)prow * FF + (cidx >> 1);
            act[0] = o[0]; act[1] = o[1];
        } else {
            const float* bias = p.b_down + (size_t)e * D + cidx;
            const float gt = ((const float*)(p.ws + WS_GATE))[list[lr]];
            float* ya = (float*)(p.ws + WS_YA) + (size_t)prow * D + cidx;
#pragma unroll
            for (int j = 0; j < 4; ++j) ya[j] = (acc[i][j] + bias[j]) * gt;
        }
    }
}

__global__ __launch_bounds__(256) void k_final(P p) {
    __shared__ float red[4];
    __shared__ int poff[NE];
    const int t = blockIdx.x;
    const int* cnt = (const int*)(p.ws + WS_CTL);
    if (threadIdx.x == 0) { int acc = 0; for (int j = 0; j < NE; ++j) { poff[j] = acc; acc += (cnt[j] + 255) & ~255; } }
    __syncthreads();
    const int* idx = (const int*)(p.ws + WS_IDX); const int* slot = (const int*)(p.ws + WS_SLOT);
    const float* mod = (const float*)(p.ws + WS_MOD);
    const float* x1 = (const float*)(p.ws + WS_X1) + (size_t)t * D;
    const float* YA = (const float*)(p.ws + WS_YA);
    int prow[TOPK];
#pragma unroll
    for (int k = 0; k < TOPK; ++k) prow[k] = poff[idx[t * TOPK + k]] + slot[t * TOPK + k];
    float v[8]; float ss = 0.f;
#pragma unroll
    for (int j = 0; j < 8; ++j) { const int cidx = threadIdx.x + 256 * j; float m = 0.f;
#pragma unroll
        for (int k = 0; k < TOPK; ++k) m += YA[(size_t)prow[k] * D + cidx];
        v[j] = x1[cidx] + mod[5 * D + cidx] * m; ss += v[j] * v[j]; }
    const float tot = block_sum256(ss, red);
    const float rs = 1.0f / sqrtf(tot * (1.0f / D) + EPS);
#pragma unroll
    for (int j = 0; j < 8; ++j) { const int cidx = threadIdx.x + 256 * j; p.out[(size_t)t * D + cidx] = v[j] * rs * p.final_g[cidx]; }
}

extern "C" void kernel_launch(void* const* d_in, const int* in_sizes, int n_in, void* d_out, int out_size, void* d_ws, size_t ws_size, hipStream_t stream) {
    if (n_in != 27 || ws_size < WS_END) { fprintf(stderr, "kernel_launch: unexpected n_in %d or ws_size %zu (< %zu)\n", n_in, ws_size, (size_t)WS_END); return; }
    P p{};
    const float** f = (const float**)&p;
    for (int i = 0; i < 27; ++i) f[i] = (const float*)d_in[i];
    p.out = (float*)d_out; p.ws = (unsigned char*)d_ws;
    unsigned char* ws = p.ws;
    (void)hipMemsetAsync(ws + WS_CTL, 0, 1 * MiB, stream);
    k_mod<<<(6 * D + 255) / 256, 256, 0, stream>>>(p);
    k_s5params<<<(G * NS + 255) / 256, 256, 0, stream>>>(p);
    k_norm_mod<1><<<S, 256, 0, stream>>>(p);
    k_gemm_dense<0><<<dim3(INW / 64, S / 64), 256, 0, stream>>>(p);
    k_attn_naive<<<(S * NH * 64) / 256, 256, 0, stream>>>(p);
    k_s5_passA<<<(NCH * G * 64) / 256, 256, 0, stream>>>(p);
    k_s5_carry<<<(G * NS + 255) / 256, 256, 0, stream>>>(p);
    k_s5_passB<<<(NCH * G * 64) / 256, 256, 0, stream>>>(p);
    k_gemm_dense<1><<<dim3(SW / 64, S / 64), 256, 0, stream>>>(p);
    k_mix<<<S, 256, 0, stream>>>(p);
    k_gemm_dense<2><<<dim3(D / 64, S / 64), 256, 0, stream>>>(p);
    k_norm_mod<2><<<S, 256, 0, stream>>>(p);
    k_router<<<S, 256, 0, stream>>>(p);
    k_gemm_moe<1><<<dim3(2 * FF / 64, NASSIGN / 64 + NE), 256, 0, stream>>>(p);
    k_gemm_moe<2><<<dim3(D / 64, NASSIGN / 64 + NE), 256, 0, stream>>>(p);
    k_final<<<S, 256, 0, stream>>>(p);
}
```

```cpp
#include <hip/hip_runtime.h>
#include <cstdio>
#include <cstdint>

constexpr int S = 16384, D = 2048, AW = 1024, SW = 1024, INW = 4096, NH = 16, HD = 64;
constexpr int G = 64, NS = 64, PC = 16;
constexpr int NE = 32, TOPK = 4, FF = 2048;
constexpr int LCH = 128, NCH = S / LCH;
constexpr int NASSIGN = S * TOPK;
constexpr int PADROWS = NASSIGN + NE * 256;
constexpr float EPS = 1e-6f;

constexpr size_t MiB = 1ull << 20;
constexpr size_t WS_CTL = 0;
constexpr size_t WS_MOD = 1 * MiB;
constexpr size_t WS_S5P = 2 * MiB;
constexpr size_t WS_IDX = 4 * MiB;
constexpr size_t WS_GATE = 5 * MiB;
constexpr size_t WS_SLOT = 6 * MiB;
constexpr size_t WS_LIST = 8 * MiB;
constexpr size_t WS_ECH = 12 * MiB;
constexpr size_t WS_X0 = 16 * MiB;
constexpr size_t WS_WIN = 32 * MiB;
constexpr size_t WS_WGLU = 48 * MiB;
constexpr size_t WS_WOUT = 50 * MiB;
constexpr size_t WS_HB = 64 * MiB;
constexpr size_t WS_PROJ = 128 * MiB;
constexpr size_t WS_YATT = WS_PROJ + 256 * MiB;
constexpr size_t WS_YG = WS_YATT + 64 * MiB;
constexpr size_t WS_YGB = WS_YG + 64 * MiB;
constexpr size_t WS_Z = WS_YGB + 32 * MiB;
constexpr size_t WS_YMIXB = WS_Z + 64 * MiB;
constexpr size_t WS_X1 = WS_YMIXB + 64 * MiB;
constexpr size_t WS_H2 = WS_X1 + 128 * MiB;
constexpr size_t WS_ACT = WS_H2 + 128 * MiB;
constexpr size_t WS_YA = WS_ACT + 288 * MiB;
constexpr size_t WS_WGU = WS_YA + 288 * MiB;
constexpr size_t WS_WDN = WS_WGU + 512 * MiB;
constexpr size_t WS_END = WS_WDN + 256 * MiB;

struct P {
    const float *x, *c, *w_ada, *b_ada, *norm1_g, *w_in, *lam_re, *lam_im, *b_re, *b_im, *c_re, *c_im, *d_skip, *log_dt,
        *w_glu, *b_glu, *attn_g, *ssm_g, *w_out, *norm2_g, *w_router, *b_router, *w_gu, *b_gu, *w_down, *b_down, *final_g;
    float* out;
    unsigned char* ws;
};
struct Args { P p; int ph_lo, ph_hi; };

#define GAS __attribute__((address_space(1)))
#define LAS __attribute__((address_space(3)))
typedef unsigned short bf16_t;
typedef short bf16x8 __attribute__((ext_vector_type(8)));
typedef float f32x4 __attribute__((ext_vector_type(4)));
typedef float f32x2 __attribute__((ext_vector_type(2)));
typedef unsigned u32x4 __attribute__((ext_vector_type(4)));
typedef unsigned u32x2 __attribute__((ext_vector_type(2)));

__device__ __forceinline__ float wave_sum(float v) {
#pragma unroll
    for (int o = 1; o < 64; o <<= 1) v += __shfl_xor(v, o);
    return v;
}
__device__ __forceinline__ float block_sum256(float v, float* red) {
    v = wave_sum(v);
    __syncthreads();
    if ((threadIdx.x & 63) == 0) red[threadIdx.x >> 6] = v;
    __syncthreads();
    return red[0] + red[1] + red[2] + red[3];
}
__device__ __forceinline__ float sigmoidf_(float x) { return 1.0f / (1.0f + expf(-x)); }
__device__ __forceinline__ unsigned cvt_pk_bf16(float lo, float hi) { unsigned r; asm volatile("v_cvt_pk_bf16_f32 %0, %1, %2" : "=v"(r) : "v"(lo), "v"(hi)); return r; }
__device__ __forceinline__ float bf2f(bf16_t b) { return __uint_as_float(((unsigned)b) << 16); }
__device__ __forceinline__ bf16_t f2bf(float f) { return (bf16_t)(cvt_pk_bf16(f, 0.f) & 0xffffu); }

namespace pg8 {
constexpr int BM = 256, BK = 64, HALF = 128, HTB = HALF * BK * 2  , STAGE_BYTES = 8 * HTB, NXCD = 8, WGM = 8;
__host__ __device__ __forceinline__ int lds_byte(int r, int c) { const int st = (r >> 4) * 2 + (c >> 5), rr = r & 15, cc = c & 31, ob = rr * 64 + cc * 2; return st * 1024 + (ob ^ (((ob >> 9) & 1) << 5)); }
__host__ __device__ __forceinline__ void stage_rc(int b, int& R, int& C) { const int st = b / 1024, sb = b % 1024, swz = sb ^ (((sb >> 9) & 1) << 5); R = (st >> 1) * 16 + swz / 64; C = (st & 1) * 32 + (swz % 64) / 2; }
__host__ __device__ __forceinline__ int perm32(int rho) { const int n = rho >> 4, i = rho & 15; return 8 * (i >> 2) + 4 * n + (i & 3); }

struct Unit { int pm, pn, e, prow0, mt; };

__device__ __forceinline__ bool flat_to_tile(long L, int nM, int nN, int& pm, int& pn) {
    const int nwg = nM * nN; if (L >= nwg) return false;
    int wgid = (int)L; { const int q = nwg / NXCD, r = nwg % NXCD, xcd = wgid % NXCD, off = wgid / NXCD; wgid = (xcd < r ? xcd * (q + 1) : r * (q + 1) + (xcd - r) * q) + off; }
    const int nig = WGM * nN, gid = wgid / nig, fm = gid * WGM, gsz = (nM - fm) < WGM ? (nM - fm) : WGM;
    pm = fm + ((wgid % nig) % gsz); pn = (wgid % nig) / gsz; return true;
}

struct DenseSched {
    static constexpr bool GATHER = false;
    const bf16_t* A; const bf16_t* Bt; int K, nM, nN, Gn, c;
    __device__ void init(const bf16_t* A_, const bf16_t* Bt_, int M, int N, int K_, int G_, int c_) { A = A_; Bt = Bt_; K = K_; nM = M / BM; nN = N / BM; Gn = G_; c = c_; }
    __device__ __forceinline__ bool next(int i, Unit& u) const { u.e = 0; u.prow0 = 0; u.mt = 0; return flat_to_tile((long)i * Gn + c, nM, nN, u.pm, u.pn); }
    __device__ __forceinline__ const char* a_ptr(const Unit& u) const { return (const char*)A + (size_t)u.pm * BM * K * 2; }
    __device__ __forceinline__ const char* b_ptr(const Unit& u) const { return (const char*)Bt + (size_t)u.pn * BM * K * 2; }
    __device__ __forceinline__ void a_off(const Unit&, const int (&R)[2], const int (&C)[2], unsigned (&off)[2][2]) const {
#pragma unroll
        for (int h = 0; h < 2; ++h)
#pragma unroll
            for (int i = 0; i < 2; ++i) off[h][i] = (unsigned)((h * HALF + R[i]) * K + C[i]) * 2u;
    }
};

template <int STAGE>
struct MoeSched {
    static constexpr bool GATHER = (STAGE == 1);
    const bf16_t* A; const bf16_t* Bt; const int* cnt; const int* list; int K, N, nM, nN, Gn, c;
    __device__ void init(const bf16_t* A_, const bf16_t* Bt_, const int* cnt_, const int* list_, int N_, int K_, int G_, int c_) {
        A = A_; Bt = Bt_; cnt = cnt_; list = list_; K = K_; N = N_; nN = N_ / BM; Gn = G_; c = c_;
        int t = 0; for (int j = 0; j < NE; ++j) t += (cnt[j] + 255) >> 8; nM = t;
    }
    __device__ __forceinline__ bool next(int i, Unit& u) const {
        if (!flat_to_tile((long)i * Gn + c, nM, nN, u.pm, u.pn)) return false;
        int acc = 0, e = 0, mt = 0;
        for (int j = 0; j < NE; ++j) { const int nt = (cnt[j] + 255) >> 8; if (u.pm >= acc && u.pm < acc + nt) { e = j; mt = u.pm - acc; } acc += nt; }
        u.e = e; u.mt = mt; u.prow0 = u.pm * BM; return true;
    }
    __device__ __forceinline__ const char* a_ptr(const Unit& u) const { return (STAGE == 1) ? (const char*)A : (const char*)A + (size_t)u.prow0 * K * 2; }
    __device__ __forceinline__ const char* b_ptr(const Unit& u) const { return (const char*)Bt + ((size_t)u.e * N + (size_t)u.pn * BM) * K * 2; }
    __device__ __forceinline__ void a_off(const Unit& u, const int (&R)[2], const int (&C)[2], unsigned (&off)[2][2]) const {
        if (STAGE == 1) {
            const int ce = cnt[u.e];
#pragma unroll
            for (int h = 0; h < 2; ++h)
#pragma unroll
                for (int i = 0; i < 2; ++i) { int lr = u.mt * BM + h * HALF + R[i]; lr = lr < ce ? lr : ce - 1; const int tok = list[(size_t)u.e * S + lr] >> 2; off[h][i] = (unsigned)(tok * K + C[i]) * 2u; }
        } else {
#pragma unroll
            for (int h = 0; h < 2; ++h)
#pragma unroll
                for (int i = 0; i < 2; ++i) off[h][i] = (unsigned)((h * HALF + R[i]) * K + C[i]) * 2u;
        }
    }
};

template <class Epi, class Sched>
__device__ __forceinline__ void gemm_phase(LAS unsigned char* lds, const Sched& S, const Epi& E) {
    const int tid = threadIdx.x, wid = __builtin_amdgcn_readfirstlane(tid >> 6), lane = tid & 63, wr = wid >> 2, wc = wid & 3, fr = lane & 15, fq = lane >> 4;
    const int K = S.K, nt = K / BK;
    int sR[2], sC[2]; unsigned voffB[2];
#pragma unroll
    for (int i = 0; i < 2; ++i) { stage_rc(tid * 16 + i * 8192, sR[i], sC[i]); const int Rb = Epi::PERM ? ((sR[i] & ~31) + perm32(sR[i] & 31)) : sR[i]; voffB[i] = (unsigned)(Rb * K + sC[i]) * 2u; }
    const size_t kstep = (size_t)(BK * 2);
    const size_t hstep = (size_t)HALF * K * 2;
    const unsigned ldsw = (unsigned)wid * 1024u;
    const int aoff = lds_byte(wr * 64 + fr, fq * 8), boff = lds_byte(wc * 32 + fr, fq * 8);
#define PG8_SA(b, h) (((b) * 2 + (h)) * HTB)
#define PG8_SB(b, h) ((4 + (b) * 2 + (h)) * HTB)
#define PG8_STAGE(bufoff, gbase, voff) do { _Pragma("unroll") for (int _i = 0; _i < 2; ++_i) \
        __builtin_amdgcn_global_load_lds((const unsigned*)((const char*)(gbase) + (voff)[_i]), (LAS unsigned*)(lds + (bufoff) + ldsw + _i * 8192), 16, 0, 0); } while (0)
#define PG8_LDA(dst, b, h) do { _Pragma("unroll") for (int m = 0; m < 4; ++m) _Pragma("unroll") for (int k = 0; k < 2; ++k) dst[m][k] = *(const LAS bf16x8*)(lds + PG8_SA(b, h) + aoff + m * 2048 + k * 1024); } while (0)
#define PG8_LDB(dst, b, h) do { _Pragma("unroll") for (int n = 0; n < 2; ++n) _Pragma("unroll") for (int k = 0; k < 2; ++k) dst[n][k] = *(const LAS bf16x8*)(lds + PG8_SB(b, h) + boff + n * 2048 + k * 1024); } while (0)
#define PG8_MMA(ai, bj, At, Bt) do { __builtin_amdgcn_s_setprio(1); _Pragma("unroll") for (int m = 0; m < 4; ++m) _Pragma("unroll") for (int n = 0; n < 2; ++n) _Pragma("unroll") for (int k = 0; k < 2; ++k) \
        acc[ai][bj][m][n] = __builtin_amdgcn_mfma_f32_16x16x32_bf16(Bt[n][k], At[m][k], acc[ai][bj][m][n], 0, 0, 0); __builtin_amdgcn_s_setprio(0); } while (0)
#define PG8_WAIT_V(n) asm volatile("s_waitcnt vmcnt(" #n ")" ::: "memory")
#define PG8_WAIT_L(n) asm volatile("s_waitcnt lgkmcnt(" #n ")" ::: "memory")
#define PG8_BAR __builtin_amdgcn_s_barrier()
#define PG8_SCHED __builtin_amdgcn_sched_barrier(0)
    Unit cur, nxt; int ui = 0;
    if (!S.next(0, cur)) return;
    f32x4 acc[2][2][4][2];
#pragma unroll
    for (int a = 0; a < 2; ++a)
#pragma unroll
        for (int b = 0; b < 2; ++b)
#pragma unroll
            for (int m = 0; m < 4; ++m)
#pragma unroll
                for (int n = 0; n < 2; ++n) acc[a][b][m][n] = (f32x4){0.f, 0.f, 0.f, 0.f};
    bf16x8 At[4][2], B0[2][2], B1[2][2];
    const char* cA = S.a_ptr(cur); const char* cB = S.b_ptr(cur);
    unsigned ao[2][2]; S.a_off(cur, sR, sC, ao);
    PG8_STAGE(PG8_SB(0, 0), cB, voffB); PG8_STAGE(PG8_SB(0, 1), cB + hstep, voffB); PG8_STAGE(PG8_SA(0, 0), cA, ao[0]); PG8_STAGE(PG8_SA(0, 1), cA, ao[1]);
    if (wr == 1) PG8_BAR;
    PG8_WAIT_V(2); PG8_BAR;
    PG8_STAGE(PG8_SB(1, 0), cB + kstep, voffB); PG8_STAGE(PG8_SA(1, 0), cA + kstep, ao[0]); PG8_STAGE(PG8_SB(1, 1), cB + hstep + kstep, voffB);
    PG8_WAIT_V(6); PG8_BAR;
    for (;;) {
        const bool has_next = S.next(ui + 1, nxt);
        const char* nA = has_next ? S.a_ptr(nxt) : cA; const char* nB = has_next ? S.b_ptr(nxt) : cB;
        unsigned no[2][2];
        if (Sched::GATHER) { if (has_next) S.a_off(nxt, sR, sC, no); else {
#pragma unroll
            for (int h = 0; h < 2; ++h)
#pragma unroll
                for (int i = 0; i < 2; ++i) no[h][i] = ao[h][i]; } }
        for (int t = 0; t < nt; t += 2) {
            const bool last = (t == nt - 2);
            const char* a1 = cA + (size_t)(t + 1) * kstep;
            const char* a2 = last ? nA : cA + (size_t)(t + 2) * kstep; const char* b2 = last ? nB : cB + (size_t)(t + 2) * kstep;
            const char* a3 = a2 + kstep; const char* b3 = b2 + kstep;
            unsigned o2[2][2];
#pragma unroll
            for (int h = 0; h < 2; ++h)
#pragma unroll
                for (int i = 0; i < 2; ++i) o2[h][i] = (Sched::GATHER && last) ? no[h][i] : ao[h][i];
            PG8_LDB(B0, 0, 0); PG8_LDB(B1, 0, 1); PG8_SCHED; PG8_LDA(At, 0, 0); PG8_STAGE(PG8_SA(1, 1), a1, ao[1]);
            PG8_WAIT_V(8); PG8_WAIT_L(0); PG8_BAR; PG8_MMA(0, 0, At, B0); PG8_MMA(0, 1, At, B1); PG8_BAR; PG8_SCHED;
            PG8_LDA(At, 0, 1); PG8_STAGE(PG8_SB(0, 0), b2, voffB); PG8_STAGE(PG8_SB(0, 1), b2 + hstep, voffB); PG8_STAGE(PG8_SA(0, 0), a2, o2[0]);
            PG8_WAIT_V(8); PG8_WAIT_L(0); PG8_BAR; PG8_MMA(1, 0, At, B0); PG8_MMA(1, 1, At, B1); PG8_BAR; PG8_SCHED;
            PG8_LDB(B0, 1, 0); PG8_LDB(B1, 1, 1); PG8_SCHED; PG8_LDA(At, 1, 0); PG8_STAGE(PG8_SA(0, 1), a2, o2[1]);
            PG8_WAIT_V(8); PG8_WAIT_L(0); PG8_BAR; PG8_MMA(0, 0, At, B0); PG8_MMA(0, 1, At, B1); PG8_BAR; PG8_SCHED;
            PG8_LDA(At, 1, 1); PG8_STAGE(PG8_SB(1, 0), b3, voffB); PG8_STAGE(PG8_SB(1, 1), b3 + hstep, voffB); PG8_STAGE(PG8_SA(1, 0), a3, o2[0]);
            PG8_WAIT_V(8); PG8_WAIT_L(0); PG8_BAR; PG8_MMA(1, 0, At, B0); PG8_MMA(1, 1, At, B1); PG8_BAR; PG8_SCHED;
        }
        if (wr == 0) PG8_BAR;
        E(acc, cur, wr, wc, fr, fq);
        if (!has_next) break;
#pragma unroll
        for (int a = 0; a < 2; ++a)
#pragma unroll
            for (int b = 0; b < 2; ++b)
#pragma unroll
                for (int m = 0; m < 4; ++m)
#pragma unroll
                    for (int n = 0; n < 2; ++n) acc[a][b][m][n] = (f32x4){0.f, 0.f, 0.f, 0.f};
        cur = nxt; cA = nA; cB = nB; ++ui;
        if (Sched::GATHER) {
#pragma unroll
            for (int h = 0; h < 2; ++h)
#pragma unroll
                for (int i = 0; i < 2; ++i) ao[h][i] = no[h][i]; }
        if (wr == 1) PG8_BAR;
    }
    PG8_WAIT_V(0);
    PG8_BAR;
#undef PG8_SA
#undef PG8_SB
#undef PG8_STAGE
#undef PG8_LDA
#undef PG8_LDB
#undef PG8_MMA
#undef PG8_WAIT_V
#undef PG8_WAIT_L
#undef PG8_BAR
#undef PG8_SCHED
}

struct EpiF32 {
    static constexpr bool PERM = false;
    float* C; int ldc;
    __device__ __forceinline__ void operator()(const f32x4 (&acc)[2][2][4][2], const Unit& u, int wr, int wc, int fr, int fq) const {
        const int row0 = u.pm * BM + wr * 64 + fr, col0 = u.pn * BM + wc * 32 + 4 * fq;
#pragma unroll
        for (int ai = 0; ai < 2; ++ai)
#pragma unroll
            for (int m = 0; m < 4; ++m) { float* rowp = C + (size_t)(row0 + ai * HALF + m * 16) * ldc + col0;
#pragma unroll
                for (int bj = 0; bj < 2; ++bj)
#pragma unroll
                    for (int n = 0; n < 2; ++n) *(f32x4*)(rowp + bj * HALF + n * 16) = acc[ai][bj][m][n]; }
    }
};
struct EpiGlu {
    static constexpr bool PERM = false;
    const float* yg; const float* bias; float* Z;
    __device__ __forceinline__ void operator()(const f32x4 (&acc)[2][2][4][2], const Unit& u, int wr, int wc, int fr, int fq) const {
        const int row0 = u.pm * BM + wr * 64 + fr, col0 = u.pn * BM + wc * 32 + 4 * fq;
#pragma unroll
        for (int ai = 0; ai < 2; ++ai)
#pragma unroll
            for (int m = 0; m < 4; ++m) { const size_t ro = (size_t)(row0 + ai * HALF + m * 16) * SW + col0;
#pragma unroll
                for (int bj = 0; bj < 2; ++bj)
#pragma unroll
                    for (int n = 0; n < 2; ++n) { const int co = bj * HALF + n * 16; const f32x4 y = *(const f32x4*)(yg + ro + co); const f32x4 b = *(const f32x4*)(bias + col0 + co); f32x4 o;
#pragma unroll
                        for (int j = 0; j < 4; ++j) o[j] = y[j] * sigmoidf_(acc[ai][bj][m][n][j] + b[j]);
                        *(f32x4*)(Z + ro + co) = o; } }
    }
};
struct EpiResid {
    static constexpr bool PERM = false;
    const float* x; const float* gate; float* X1;
    __device__ __forceinline__ void operator()(const f32x4 (&acc)[2][2][4][2], const Unit& u, int wr, int wc, int fr, int fq) const {
        const int row0 = u.pm * BM + wr * 64 + fr, col0 = u.pn * BM + wc * 32 + 4 * fq;
#pragma unroll
        for (int ai = 0; ai < 2; ++ai)
#pragma unroll
            for (int m = 0; m < 4; ++m) { const size_t ro = (size_t)(row0 + ai * HALF + m * 16) * D + col0;
#pragma unroll
                for (int bj = 0; bj < 2; ++bj)
#pragma unroll
                    for (int n = 0; n < 2; ++n) { const int co = bj * HALF + n * 16; const f32x4 xv = *(const f32x4*)(x + ro + co); const f32x4 g = *(const f32x4*)(gate + col0 + co);
                        *(f32x4*)(X1 + ro + co) = xv + g * acc[ai][bj][m][n]; } }
    }
};
struct EpiMoe1 {
    static constexpr bool PERM = true;
    const float* b_gu; bf16_t* ACT;
    __device__ __forceinline__ void operator()(const f32x4 (&acc)[2][2][4][2], const Unit& u, int wr, int wc, int fr, int fq) const {
        const int row0 = u.prow0 + wr * 64 + fr, j0 = u.pn * HALF + wc * 32 + 8 * fq;
        const float* bias = b_gu + (size_t)u.e * 2 * FF + 2 * j0;
        float bg[8], bl[8];
#pragma unroll
        for (int j = 0; j < 8; ++j) { bg[j] = bias[2 * j]; bl[j] = bias[2 * j + 1]; }
#pragma unroll
        for (int ai = 0; ai < 2; ++ai)
#pragma unroll
            for (int m = 0; m < 4; ++m) { bf16_t* rowp = ACT + (size_t)(row0 + ai * HALF + m * 16) * FF + j0; float o[8];
#pragma unroll
                for (int n = 0; n < 2; ++n)
#pragma unroll
                    for (int j = 0; j < 4; ++j) { const float gl = fminf(acc[ai][0][m][n][j] + bg[4 * n + j], 7.0f); const float ln = fminf(fmaxf(acc[ai][1][m][n][j] + bl[4 * n + j], -7.0f), 7.0f);
                        o[4 * n + j] = gl * sigmoidf_(1.702f * gl) * (ln + 1.0f); }
                u32x4 w; w.x = cvt_pk_bf16(o[0], o[1]); w.y = cvt_pk_bf16(o[2], o[3]); w.z = cvt_pk_bf16(o[4], o[5]); w.w = cvt_pk_bf16(o[6], o[7]);
                *(u32x4*)rowp = w; }
    }
};
struct EpiMoe2 {
    static constexpr bool PERM = true;
    const float* b_down; const int* cnt; const int* list; const float* gate; bf16_t* YA;
    __device__ __forceinline__ void operator()(const f32x4 (&acc)[2][2][4][2], const Unit& u, int wr, int wc, int fr, int fq) const {
        const int lr0 = u.mt * BM + wr * 64 + fr, row0 = u.prow0 + wr * 64 + fr, col0 = u.pn * BM + wc * 32 + 8 * fq;
        const int ce = cnt[u.e];
        f32x4 bv[2][2];
#pragma unroll
        for (int bj = 0; bj < 2; ++bj)
#pragma unroll
            for (int n = 0; n < 2; ++n) bv[bj][n] = *(const f32x4*)(b_down + (size_t)u.e * D + col0 + bj * HALF + 4 * n);
#pragma unroll
        for (int ai = 0; ai < 2; ++ai)
#pragma unroll
            for (int m = 0; m < 4; ++m) { const int lr = lr0 + ai * HALF + m * 16; float g = 0.f; if (lr < ce) g = gate[list[(size_t)u.e * S + lr]];
                bf16_t* rowp = YA + (size_t)(row0 + ai * HALF + m * 16) * D + col0;
#pragma unroll
                for (int bj = 0; bj < 2; ++bj) { const f32x4 v0 = (acc[ai][bj][m][0] + bv[bj][0]) * g, v1 = (acc[ai][bj][m][1] + bv[bj][1]) * g;
                    u32x4 w; w.x = cvt_pk_bf16(v0[0], v0[1]); w.y = cvt_pk_bf16(v0[2], v0[3]); w.z = cvt_pk_bf16(v1[0], v1[1]); w.w = cvt_pk_bf16(v1[2], v1[3]);
                    *(u32x4*)(rowp + bj * HALF) = w; } }
    }
};
}

__global__ void k_mod(P p) {
    const int j = blockIdx.x * blockDim.x + threadIdx.x;
    if (j >= 6 * D) return;
    float acc = p.b_ada[j];
    for (int i = 0; i < D; ++i) { const float cv = p.c[i]; const float s = cv / (1.0f + expf(-cv)); acc += s * p.w_ada[(size_t)i * 6 * D + j]; }
    ((float*)(p.ws + WS_MOD))[j] = acc;
}
__global__ void k_s5params(P p) {
    const int i = blockIdx.x * blockDim.x + threadIdx.x;
    if (i >= G * NS) return;
    const int g = i / NS;
    float* sp = (float*)(p.ws + WS_S5P);
    float *abr = sp, *abi = sp + 4096, *bbr = sp + 8192, *bbi = sp + 8192 + 65536;
    const float dt = expf(p.log_dt[g]), lr = p.lam_re[i], li = p.lam_im[i];
    const float mag = expf(lr * dt), ar = mag * cosf(li * dt), ai = mag * sinf(li * dt);
    const float den = lr * lr + li * li, nr = ar - 1.0f, ni = ai;
    const float fr = (nr * lr + ni * li) / den, fi = (ni * lr - nr * li) / den;
    abr[i] = ar; abi[i] = ai;
    for (int q = 0; q < PC; ++q) { const float br = p.b_re[(size_t)i * PC + q], bi = p.b_im[(size_t)i * PC + q];
        bbr[(size_t)i * PC + q] = fr * br - fi * bi; bbi[(size_t)i * PC + q] = fr * bi + fi * br; }
}
template <int WHICH>
__global__ __launch_bounds__(256) void k_norm_mod(P p) {
    __shared__ float red[4];
    const float* mod = (const float*)(p.ws + WS_MOD);
    const float* xin = (WHICH == 1) ? p.x : (const float*)(p.ws + WS_X1);
    const float* gain = (WHICH == 1) ? p.norm1_g : p.norm2_g;
    const float* mod_sc = (WHICH == 1) ? mod + 1 * D : mod + 4 * D;
    const float* mod_sh = (WHICH == 1) ? mod + 0 * D : mod + 3 * D;
    bf16_t* hb = (bf16_t*)(p.ws + WS_HB);
    float* h2 = (float*)(p.ws + WS_H2);
    const int t = blockIdx.x;
    const float* xr = xin + (size_t)t * D;
    float v[8]; float ss = 0.f;
#pragma unroll
    for (int j = 0; j < 8; ++j) { v[j] = xr[threadIdx.x + 256 * j]; ss += v[j] * v[j]; }
    const float tot = block_sum256(ss, red);
    const float rs = 1.0f / sqrtf(tot * (1.0f / D) + EPS);
#pragma unroll
    for (int j = 0; j < 8; ++j) { const int cidx = threadIdx.x + 256 * j; const float o = v[j] * rs * gain[cidx] * (1.0f + mod_sc[cidx]) + mod_sh[cidx];
        hb[(size_t)t * D + cidx] = f2bf(o); if (WHICH == 2) h2[(size_t)t * D + cidx] = o; }
}
__global__ __launch_bounds__(256) void k_attn_naive(P p) {
    const float* proj = (const float*)(p.ws + WS_PROJ); float* yatt = (float*)(p.ws + WS_YATT);
    const int w = (blockIdx.x * 256 + threadIdx.x) >> 6, lane = threadIdx.x & 63;
    if (w >= S * NH) return;
    const int t = w / NH, h = w % NH;
    const float q = proj[(size_t)t * INW + h * HD + lane] * 0.125f;
    float m = -INFINITY, l = 0.f, o = 0.f;
    for (int br = 0; br < 3; ++br) {
        const int d = (br == 0) ? 1 : (br == 1 ? 4 : 16);
        for (int j = 0; j <= 128; ++j) {
            const int pos = t - j * d;
            if (pos < 0) break;
            const float kv = proj[(size_t)pos * INW + AW + h * HD + lane];
            const float vv = proj[(size_t)pos * INW + 2 * AW + h * HD + lane];
            const float s = wave_sum(q * kv);
            const float mn = fmaxf(m, s), corr = expf(m - mn), pe = expf(s - mn);
            l = l * corr + pe; o = o * corr + pe * vv; m = mn;
        }
    }
    yatt[(size_t)t * AW + h * HD + lane] = o / l;
}
__global__ __launch_bounds__(256) void k_s5_passA(P p) {
    const int w = (blockIdx.x * 256 + threadIdx.x) >> 6, n = threadIdx.x & 63;
    if (w >= NCH * G) return;
    const int c = w / G, g = w % G;
    const float* sp = (const float*)(p.ws + WS_S5P);
    const float ar = sp[g * NS + n], ai = sp[4096 + g * NS + n];
    float br[PC], bi[PC];
#pragma unroll
    for (int q = 0; q < PC; ++q) { br[q] = sp[8192 + (size_t)(g * NS + n) * PC + q]; bi[q] = sp[8192 + 65536 + (size_t)(g * NS + n) * PC + q]; }
    const float* proj = (const float*)(p.ws + WS_PROJ);
    float xr = 0.f, xi = 0.f;
    for (int t = c * LCH; t < (c + 1) * LCH; ++t) {
        const float* u = proj + (size_t)t * INW + 3 * AW + g * PC;
        float bur = 0.f, bui = 0.f;
#pragma unroll
        for (int q = 0; q < PC; ++q) { const float uv = u[q]; bur += br[q] * uv; bui += bi[q] * uv; }
        const float nr = ar * xr - ai * xi + bur, ni = ar * xi + ai * xr + bui;
        xr = nr; xi = ni;
    }
    float* E = (float*)(p.ws + WS_ECH);
    E[((size_t)(c * G + g) * NS + n) * 2 + 0] = xr; E[((size_t)(c * G + g) * NS + n) * 2 + 1] = xi;
}
__global__ void k_s5_carry(P p) {
    const int i = blockIdx.x * blockDim.x + threadIdx.x;
    if (i >= G * NS) return;
    const float* sp = (const float*)(p.ws + WS_S5P);
    float pr = sp[i], pi = sp[4096 + i];
    for (int s = 0; s < 7; ++s) { const float nr = pr * pr - pi * pi, ni = 2.f * pr * pi; pr = nr; pi = ni; }
    const float* E = (const float*)(p.ws + WS_ECH);
    float* X0 = (float*)(p.ws + WS_X0);
    float xr = 0.f, xi = 0.f;
    for (int c = 0; c < NCH; ++c) {
        X0[((size_t)c * G * NS + i) * 2 + 0] = xr; X0[((size_t)c * G * NS + i) * 2 + 1] = xi;
        const float er = E[((size_t)c * G * NS + i) * 2 + 0], ei = E[((size_t)c * G * NS + i) * 2 + 1];
        const float nr = pr * xr - pi * xi + er, ni = pr * xi + pi * xr + ei;
        xr = nr; xi = ni;
    }
}
__device__ __forceinline__ float gelu_tanh(float y) { const float u = 0.7978845608028654f * (y + 0.044715f * y * y * y); return 0.5f * y * (1.0f + tanhf(u)); }
__global__ __launch_bounds__(256) void k_s5_passB(P p) {
    const int w = (blockIdx.x * 256 + threadIdx.x) >> 6, n = threadIdx.x & 63;
    if (w >= NCH * G) return;
    const int c = w / G, g = w % G;
    const float* sp = (const float*)(p.ws + WS_S5P);
    const float ar = sp[g * NS + n], ai = sp[4096 + g * NS + n];
    float br[PC], bi[PC], cr[PC], ci[PC];
#pragma unroll
    for (int q = 0; q < PC; ++q) { br[q] = sp[8192 + (size_t)(g * NS + n) * PC + q]; bi[q] = sp[8192 + 65536 + (size_t)(g * NS + n) * PC + q];
        cr[q] = p.c_re[((size_t)g * PC + q) * NS + n]; ci[q] = p.c_im[((size_t)g * PC + q) * NS + n]; }
    const float dsk = (n < PC) ? p.d_skip[g * PC + n] : 0.f;
    const float* proj = (const float*)(p.ws + WS_PROJ);
    const float* X0 = (const float*)(p.ws + WS_X0);
    float* YG = (float*)(p.ws + WS_YG);
    bf16_t* YGB = (bf16_t*)(p.ws + WS_YGB);
    float xr = X0[((size_t)(c * G + g) * NS + n) * 2 + 0], xi = X0[((size_t)(c * G + g) * NS + n) * 2 + 1];
    for (int t = c * LCH; t < (c + 1) * LCH; ++t) {
        const float* u = proj + (size_t)t * INW + 3 * AW + g * PC;
        float bur = 0.f, bui = 0.f;
#pragma unroll
        for (int q = 0; q < PC; ++q) { const float uv = u[q]; bur += br[q] * uv; bui += bi[q] * uv; }
        const float nr = ar * xr - ai * xi + bur, ni = ar * xi + ai * xr + bui;
        xr = nr; xi = ni;
        float mine = 0.f;
#pragma unroll
        for (int q = 0; q < PC; ++q) { const float s = wave_sum(cr[q] * xr - ci[q] * xi); mine = (n == q) ? s : mine; }
        if (n < PC) { const float y = gelu_tanh(mine + dsk * u[n]); YG[(size_t)t * SW + g * PC + n] = y; YGB[(size_t)t * SW + g * PC + n] = f2bf(y); }
    }
}
__global__ __launch_bounds__(256) void k_mix(P p) {
    __shared__ float red[4];
    const int t = blockIdx.x;
    const float* ya = (const float*)(p.ws + WS_YATT) + (size_t)t * AW;
    const float* z = (const float*)(p.ws + WS_Z) + (size_t)t * SW;
    bf16_t* ym = (bf16_t*)(p.ws + WS_YMIXB) + (size_t)t * D;
    float a[4], b[4]; float sa = 0.f, sb = 0.f;
#pragma unroll
    for (int j = 0; j < 4; ++j) { a[j] = ya[threadIdx.x + 256 * j]; b[j] = z[threadIdx.x + 256 * j]; sa += a[j] * a[j]; sb += b[j] * b[j]; }
    const float ta = block_sum256(sa, red);
    const float tb = block_sum256(sb, red);
    const float ra = 1.0f / sqrtf(ta * (1.0f / AW) + EPS), rb = 1.0f / sqrtf(tb * (1.0f / SW) + EPS);
#pragma unroll
    for (int j = 0; j < 4; ++j) { const int cidx = threadIdx.x + 256 * j; ym[cidx] = f2bf(a[j] * ra * p.attn_g[cidx]); ym[AW + cidx] = f2bf(b[j] * rb * p.ssm_g[cidx]); }
}
__global__ __launch_bounds__(256) void k_router(P p) {
    __shared__ float hrow[D];
    __shared__ float part[8][NE];
    __shared__ float logit[NE];
    const int t = blockIdx.x;
    const float* h2 = (const float*)(p.ws + WS_H2) + (size_t)t * D;
    for (int j = threadIdx.x; j < D; j += 256) hrow[j] = h2[j];
    __syncthreads();
    const int e = threadIdx.x & 31, part_id = threadIdx.x >> 5;
    float acc = 0.f;
    for (int k = part_id * 256; k < (part_id + 1) * 256; ++k) acc += hrow[k] * p.w_router[(size_t)k * NE + e];
    part[part_id][e] = acc;
    __syncthreads();
    if (threadIdx.x < NE) { float s = p.b_router[threadIdx.x];
#pragma unroll
        for (int q = 0; q < 8; ++q) s += part[q][threadIdx.x];
        logit[threadIdx.x] = s; }
    __syncthreads();
    if (threadIdx.x == 0) {
        unsigned used = 0u; float tv[TOPK]; int ti[TOPK];
#pragma unroll
        for (int k = 0; k < TOPK; ++k) { float best = -INFINITY; int bi = 0;
            for (int j = 0; j < NE; ++j) { const float v = logit[j]; if (!((used >> j) & 1u) && v > best) { best = v; bi = j; } }
            used |= 1u << bi; tv[k] = best; ti[k] = bi; }
        const float mx = tv[0]; float ex[TOPK], sum = 0.f;
#pragma unroll
        for (int k = 0; k < TOPK; ++k) { ex[k] = expf(tv[k] - mx); sum += ex[k]; }
        int* idx = (int*)(p.ws + WS_IDX); float* gate = (float*)(p.ws + WS_GATE); int* slot = (int*)(p.ws + WS_SLOT);
        int* cnt = (int*)(p.ws + WS_CTL); int* list = (int*)(p.ws + WS_LIST);
#pragma unroll
        for (int k = 0; k < TOPK; ++k) { const int sl = atomicAdd(&cnt[ti[k]], 1);
            idx[t * TOPK + k] = ti[k]; gate[t * TOPK + k] = ex[k] / sum; slot[t * TOPK + k] = sl; list[ti[k] * S + sl] = t * TOPK + k; }
    }
}
__global__ __launch_bounds__(256) void k_final(P p) {
    __shared__ float red[4];
    __shared__ int poff[NE];
    const int t = blockIdx.x;
    const int* cnt = (const int*)(p.ws + WS_CTL);
    if (threadIdx.x == 0) { int acc = 0; for (int j = 0; j < NE; ++j) { poff[j] = acc; acc += (cnt[j] + 255) & ~255; } }
    __syncthreads();
    const int* idx = (const int*)(p.ws + WS_IDX); const int* slot = (const int*)(p.ws + WS_SLOT);
    const float* mod = (const float*)(p.ws + WS_MOD);
    const float* x1 = (const float*)(p.ws + WS_X1) + (size_t)t * D;
    const bf16_t* YA = (const bf16_t*)(p.ws + WS_YA);
    int prow[TOPK];
#pragma unroll
    for (int k = 0; k < TOPK; ++k) prow[k] = poff[idx[t * TOPK + k]] + slot[t * TOPK + k];
    float v[8]; float ss = 0.f;
#pragma unroll
    for (int j = 0; j < 8; ++j) { const int cidx = threadIdx.x + 256 * j; float m = 0.f;
#pragma unroll
        for (int k = 0; k < TOPK; ++k) m += bf2f(YA[(size_t)prow[k] * D + cidx]);
        v[j] = x1[cidx] + mod[5 * D + cidx] * m; ss += v[j] * v[j]; }
    const float tot = block_sum256(ss, red);
    const float rs = 1.0f / sqrtf(tot * (1.0f / D) + EPS);
#pragma unroll
    for (int j = 0; j < 8; ++j) { const int cidx = threadIdx.x + 256 * j; p.out[(size_t)t * D + cidx] = v[j] * rs * p.final_g[cidx]; }
}

constexpr int NWAVES = 8;
constexpr int LDS_BYTES = 147456;
constexpr int RING_OFF = 0;

template <bool DEINT>
__device__ __forceinline__ void convert_tile(const float* W, int K, int N, bf16_t* WT, int tk, int tn, LAS float* scr) {
    const int tid = threadIdx.x, k0 = tk * 64, n0 = tn * 256;
    __syncthreads();
#pragma unroll
    for (int j = 0; j < 8; ++j) { const int k = j * 8 + (tid >> 6), g = tid & 63;
        const f32x4 v = *(const f32x4*)(W + (size_t)(k0 + k) * N + n0 + 4 * g);
        *(LAS f32x4*)(scr + k * 256 + ((g ^ j) << 2)) = v; }
    __syncthreads();
#pragma unroll
    for (int jj = 0; jj < 4; ++jj) { const int n = jj * 64 + (tid >> 3), c = tid & 7; float v[8];
#pragma unroll
        for (int q = 0; q < 8; ++q) v[q] = scr[(8 * c + q) * 256 + ((((n >> 2) ^ c)) << 2) + (n & 3)];
        u32x4 o; o.x = cvt_pk_bf16(v[0], v[1]); o.y = cvt_pk_bf16(v[2], v[3]); o.z = cvt_pk_bf16(v[4], v[5]); o.w = cvt_pk_bf16(v[6], v[7]);
        int row = n0 + n;
        if (DEINT) { const int s = n & 1, jl = n >> 1; row = n0 + s * 128 + jl; }
        *(u32x4*)(WT + (size_t)row * K + k0 + 8 * c) = o; }
}

__global__ void __launch_bounds__(NWAVES * 64, 2) mk_fwd(Args args) {
    extern __shared__ __attribute__((aligned(16))) unsigned char lds_raw[];
    LAS unsigned char* lds = (LAS unsigned char*)lds_raw;
    const P& p = args.p;
    unsigned char* ws = p.ws;
    const int lo = args.ph_lo, hi = args.ph_hi;
    const int Gn = gridDim.x, bid = blockIdx.x;
#define IN(k) (lo <= (k) && (k) < hi)
    if (IN(0)) {
        LAS float* scr = (LAS float*)(lds + RING_OFF);
        constexpr int T_IN = 32 * 16, T_GLU = 16 * 4, T_OUT = 32 * 8, T_GU = 32 * 16, T_DN = 32 * 8;
        constexpr int NT = T_IN + T_GLU + T_OUT + NE * (T_GU + T_DN);
        for (int it = bid; it < NT; it += Gn) {
            int r = it;
            if (r < T_IN) { convert_tile<false>(p.w_in, D, INW, (bf16_t*)(ws + WS_WIN), r / 16, r % 16, scr); continue; } r -= T_IN;
            if (r < T_GLU) { convert_tile<false>(p.w_glu, SW, SW, (bf16_t*)(ws + WS_WGLU), r / 4, r % 4, scr); continue; } r -= T_GLU;
            if (r < T_OUT) { convert_tile<false>(p.w_out, D, D, (bf16_t*)(ws + WS_WOUT), r / 8, r % 8, scr); continue; } r -= T_OUT;
            if (r < NE * T_GU) { const int e = r / T_GU, q = r % T_GU; convert_tile<true>(p.w_gu + (size_t)e * D * 2 * FF, D, 2 * FF, (bf16_t*)(ws + WS_WGU) + (size_t)e * 2 * FF * D, q / 16, q % 16, scr); continue; } r -= NE * T_GU;
            { const int e = r / T_DN, q = r % T_DN; convert_tile<false>(p.w_down + (size_t)e * FF * D, FF, D, (bf16_t*)(ws + WS_WDN) + (size_t)e * D * FF, q / 8, q % 8, scr); }
        }
        __syncthreads();
    }
    if (IN(2)) {
        pg8::DenseSched Sd; Sd.init((const bf16_t*)(ws + WS_HB), (const bf16_t*)(ws + WS_WIN), S, INW, D, Gn, bid);
        pg8::EpiF32 E{(float*)(ws + WS_PROJ), INW};
        pg8::gemm_phase<pg8::EpiF32, pg8::DenseSched>(lds + RING_OFF, Sd, E);
    }
    if (IN(5)) {
        pg8::DenseSched Sd; Sd.init((const bf16_t*)(ws + WS_YGB), (const bf16_t*)(ws + WS_WGLU), S, SW, SW, Gn, bid);
        pg8::EpiGlu E{(const float*)(ws + WS_YG), p.b_glu, (float*)(ws + WS_Z)};
        pg8::gemm_phase<pg8::EpiGlu, pg8::DenseSched>(lds + RING_OFF, Sd, E);
    }
    if (IN(7)) {
        pg8::DenseSched Sd; Sd.init((const bf16_t*)(ws + WS_YMIXB), (const bf16_t*)(ws + WS_WOUT), S, D, D, Gn, bid);
        pg8::EpiResid E{p.x, (const float*)(ws + WS_MOD) + 2 * D, (float*)(ws + WS_X1)};
        pg8::gemm_phase<pg8::EpiResid, pg8::DenseSched>(lds + RING_OFF, Sd, E);
    }
    if (IN(9)) {
        pg8::MoeSched<1> Sm; Sm.init((const bf16_t*)(ws + WS_HB), (const bf16_t*)(ws + WS_WGU), (const int*)(ws + WS_CTL), (const int*)(ws + WS_LIST), 2 * FF, D, Gn, bid);
        pg8::EpiMoe1 E{p.b_gu, (bf16_t*)(ws + WS_ACT)};
        pg8::gemm_phase<pg8::EpiMoe1, pg8::MoeSched<1>>(lds + RING_OFF, Sm, E);
    }
    if (IN(10)) {
        pg8::MoeSched<2> Sm; Sm.init((const bf16_t*)(ws + WS_ACT), (const bf16_t*)(ws + WS_WDN), (const int*)(ws + WS_CTL), (const int*)(ws + WS_LIST), D, FF, Gn, bid);
        pg8::EpiMoe2 E{p.b_down, (const int*)(ws + WS_CTL), (const int*)(ws + WS_LIST), (const float*)(ws + WS_GATE), (bf16_t*)(ws + WS_YA)};
        pg8::gemm_phase<pg8::EpiMoe2, pg8::MoeSched<2>>(lds + RING_OFF, Sm, E);
    }
#undef IN
}

extern "C" void kernel_launch(void* const* d_in, const int* in_sizes, int n_in, void* d_out, int out_size, void* d_ws, size_t ws_size, hipStream_t stream) {
    static int grid = 0;
    if (grid == 0) {
        if (n_in != 27 || ws_size < WS_END) { fprintf(stderr, "kernel_launch: unexpected n_in %d or ws_size %zu (< %zu)\n", n_in, ws_size, (size_t)WS_END); grid = -1; return; }
        int dev = 0, cus = 0;
        if (hipGetDevice(&dev) != hipSuccess || hipDeviceGetAttribute(&cus, hipDeviceAttributeMultiprocessorCount, dev) != hipSuccess) { grid = -1; return; }
        if (hipFuncSetAttribute((const void*)mk_fwd, hipFuncAttributeMaxDynamicSharedMemorySize, LDS_BYTES) != hipSuccess) { fprintf(stderr, "hipFuncSetAttribute failed\n"); grid = -1; return; }
        grid = cus;
    }
    if (grid < 0) return;
    Args a{};
    const float** f = (const float**)&a.p;
    for (int i = 0; i < 27; ++i) f[i] = (const float*)d_in[i];
    a.p.out = (float*)d_out; a.p.ws = (unsigned char*)d_ws;
    const P p = a.p;
    unsigned char* ws = p.ws;
    (void)hipMemsetAsync(ws + WS_CTL, 0, 1 * MiB, stream);
#define MK(lo_, hi_) do { a.ph_lo = (lo_); a.ph_hi = (hi_); hipLaunchKernelGGL(mk_fwd, dim3(grid), dim3(NWAVES * 64), LDS_BYTES, stream, a); } while (0)
    k_mod<<<(6 * D + 255) / 256, 256, 0, stream>>>(p);
    k_s5params<<<(G * NS + 255) / 256, 256, 0, stream>>>(p);
    MK(0, 1);
    k_norm_mod<1><<<S, 256, 0, stream>>>(p);
    MK(2, 3);
    k_attn_naive<<<(S * NH * 64) / 256, 256, 0, stream>>>(p);
    k_s5_passA<<<(NCH * G * 64) / 256, 256, 0, stream>>>(p);
    k_s5_carry<<<(G * NS + 255) / 256, 256, 0, stream>>>(p);
    k_s5_passB<<<(NCH * G * 64) / 256, 256, 0, stream>>>(p);
    MK(5, 6);
    k_mix<<<S, 256, 0, stream>>>(p);
    MK(7, 8);
    k_norm_mod<2><<<S, 256, 0, stream>>>(p);
    k_router<<<S, 256, 0, stream>>>(p);
    MK(9, 10);
    MK(10, 11);
    k_final<<<S, 256, 0, stream>>>(p);
#undef MK
}
```

```cpp
#include <hip/hip_runtime.h>
#include <cstdio>
#include <cstdint>

constexpr int S = 16384, D = 2048, AW = 1024, SW = 1024, INW = 4096, NH = 16, HD = 64;
constexpr int G = 64, NS = 64, PC = 16;
constexpr int NE = 32, TOPK = 4, FF = 2048;
constexpr int LCH = 128, NCH = S / LCH;
constexpr int NASSIGN = S * TOPK;
constexpr int PADROWS = NASSIGN + NE * 256;
constexpr float EPS = 1e-6f;

constexpr size_t MiB = 1ull << 20;
constexpr size_t WS_CTL = 0;
constexpr size_t WS_MOD = 1 * MiB;
constexpr size_t WS_S5P = 2 * MiB;
constexpr size_t WS_IDX = 4 * MiB;
constexpr size_t WS_GATE = 5 * MiB;
constexpr size_t WS_SLOT = 6 * MiB;
constexpr size_t WS_LIST = 8 * MiB;
constexpr size_t WS_ECH = 12 * MiB;
constexpr size_t WS_X0 = 16 * MiB;
constexpr size_t WS_WIN = 32 * MiB;
constexpr size_t WS_WGLU = 48 * MiB;
constexpr size_t WS_WOUT = 50 * MiB;
constexpr size_t WS_HB = 64 * MiB;
constexpr size_t WS_PROJ = 128 * MiB;
constexpr size_t WS_QKV = WS_PROJ;
constexpr size_t WS_U = WS_PROJ + 96 * MiB;
constexpr size_t WS_OB = WS_PROJ + 160 * MiB;
constexpr size_t WS_LSE = 20 * MiB;
constexpr size_t WS_YATT = WS_PROJ + 256 * MiB;
constexpr size_t WS_YG = WS_YATT + 64 * MiB;
constexpr size_t WS_YGB = WS_YG + 64 * MiB;
constexpr size_t WS_Z = WS_YGB + 32 * MiB;
constexpr size_t WS_YMIXB = WS_Z + 64 * MiB;
constexpr size_t WS_X1 = WS_YMIXB + 64 * MiB;
constexpr size_t WS_H2 = WS_X1 + 128 * MiB;
constexpr size_t WS_ACT = WS_H2 + 128 * MiB;
constexpr size_t WS_YA = WS_ACT + 288 * MiB;
constexpr size_t WS_WGU = WS_YA + 288 * MiB;
constexpr size_t WS_WDN = WS_WGU + 512 * MiB;
constexpr size_t WS_END = WS_WDN + 256 * MiB;

struct P {
    const float *x, *c, *w_ada, *b_ada, *norm1_g, *w_in, *lam_re, *lam_im, *b_re, *b_im, *c_re, *c_im, *d_skip, *log_dt,
        *w_glu, *b_glu, *attn_g, *ssm_g, *w_out, *norm2_g, *w_router, *b_router, *w_gu, *b_gu, *w_down, *b_down, *final_g;
    float* out;
    unsigned char* ws;
};
struct Args { P p; int ph_lo, ph_hi; };

#define GAS __attribute__((address_space(1)))
#define LAS __attribute__((address_space(3)))
typedef unsigned short bf16_t;
typedef short bf16x8 __attribute__((ext_vector_type(8)));
typedef float f32x4 __attribute__((ext_vector_type(4)));
typedef float f32x2 __attribute__((ext_vector_type(2)));
typedef unsigned u32x4 __attribute__((ext_vector_type(4)));
typedef unsigned u32x2 __attribute__((ext_vector_type(2)));

__device__ __forceinline__ float wave_sum(float v) {
#pragma unroll
    for (int o = 1; o < 64; o <<= 1) v += __shfl_xor(v, o);
    return v;
}
__device__ __forceinline__ float block_sum256(float v, float* red) {
    v = wave_sum(v);
    __syncthreads();
    if ((threadIdx.x & 63) == 0) red[threadIdx.x >> 6] = v;
    __syncthreads();
    return red[0] + red[1] + red[2] + red[3];
}
__device__ __forceinline__ float sigmoidf_(float x) { return __builtin_amdgcn_rcpf(1.0f + __builtin_amdgcn_exp2f(-1.4426950408889634f * x)); }
__device__ __forceinline__ unsigned cvt_pk_bf16(float lo, float hi) { unsigned r; asm volatile("v_cvt_pk_bf16_f32 %0, %1, %2" : "=v"(r) : "v"(lo), "v"(hi)); return r; }
__device__ __forceinline__ float bf2f(bf16_t b) { return __uint_as_float(((unsigned)b) << 16); }
__device__ __forceinline__ bf16_t f2bf(float f) { return (bf16_t)(cvt_pk_bf16(f, 0.f) & 0xffffu); }
__device__ __forceinline__ int otid() { int t = threadIdx.x; asm volatile("" : "+v"(t)); return t; }

namespace pg8 {
constexpr int BM = 256, BK = 64, HALF = 128, HTB = HALF * BK * 2  , STAGE_BYTES = 8 * HTB, NXCD = 8, WGM = 8;
__host__ __device__ __forceinline__ int lds_byte(int r, int c) { const int st = (r >> 4) * 2 + (c >> 5), rr = r & 15, cc = c & 31, ob = rr * 64 + cc * 2; return st * 1024 + (ob ^ (((ob >> 9) & 1) << 5)); }
__host__ __device__ __forceinline__ void stage_rc(int b, int& R, int& C) { const int st = b / 1024, sb = b % 1024, swz = sb ^ (((sb >> 9) & 1) << 5); R = (st >> 1) * 16 + swz / 64; C = (st & 1) * 32 + (swz % 64) / 2; }
__host__ __device__ __forceinline__ int perm32(int rho) { const int n = rho >> 4, i = rho & 15; return 8 * (i >> 2) + 4 * n + (i & 3); }

struct Unit { int pm, pn, e, mt; };

__device__ __forceinline__ bool flat_to_tile(long L, int nM, int nN, int& pm, int& pn) {
    const int nwg = nM * nN; if (L >= nwg) return false;
    int wgid = (int)L; { const int q = nwg / NXCD, r = nwg % NXCD, xcd = wgid % NXCD, off = wgid / NXCD; wgid = (xcd < r ? xcd * (q + 1) : r * (q + 1) + (xcd - r) * q) + off; }
    const int nig = WGM * nN, gid = wgid / nig, fm = gid * WGM, gsz = (nM - fm) < WGM ? (nM - fm) : WGM;
    pm = fm + ((wgid % nig) % gsz); pn = (wgid % nig) / gsz; return true;
}

template <size_t AOFF, size_t BOFF, int M_, int N_, int K_>
struct DenseSched {
    static constexpr bool GATHER = false;
    static constexpr int K = K_, nM = M_ / BM, nN = N_ / BM;
    const unsigned char* ws; int Gn, c;
    __device__ void init(const unsigned char* ws_, int G_, int c_) { ws = ws_; Gn = G_; c = c_; }
    __device__ __forceinline__ bool next(int i, Unit& u) const { u.e = 0; u.mt = 0; return flat_to_tile((long)i * Gn + c, nM, nN, u.pm, u.pn); }
    __device__ __forceinline__ const char* a_ptr(const Unit& u) const { return (const char*)ws + AOFF + (size_t)u.pm * BM * K * 2; }
    __device__ __forceinline__ const char* b_ptr(const Unit& u) const { return (const char*)ws + BOFF + (size_t)u.pn * BM * K * 2; }
    __device__ __forceinline__ void a_off(const Unit&, unsigned (&off)[2][2]) const {
        const int tid = otid();
#pragma unroll
        for (int i = 0; i < 2; ++i) { int R, C; stage_rc(tid * 16 + i * 8192, R, C);
#pragma unroll
            for (int h = 0; h < 2; ++h) off[h][i] = (unsigned)((h * HALF + R) * K + C) * 2u; }
    }
};

template <int STAGE>
struct MoeSched {
    static constexpr bool GATHER = (STAGE == 1);
    static constexpr int K = (STAGE == 1) ? D : FF, N = (STAGE == 1) ? 2 * FF : D, nN = N / BM;
    static constexpr size_t AOFF = (STAGE == 1) ? WS_HB : WS_ACT, BOFF = (STAGE == 1) ? WS_WGU : WS_WDN;
    const unsigned char* ws; int nM, Gn, c;
    __device__ void init(const unsigned char* ws_, int G_, int c_) {
        ws = ws_; Gn = G_; c = c_;
        const int* cnt = (const int*)(ws + WS_CTL);
        int t = 0; for (int j = 0; j < NE; ++j) t += (cnt[j] + 255) >> 8; nM = __builtin_amdgcn_readfirstlane(t);
    }
    __device__ __forceinline__ bool next(int i, Unit& u) const {
        if (!flat_to_tile((long)i * Gn + c, nM, nN, u.pm, u.pn)) return false;
        const int* cnt = (const int*)(ws + WS_CTL);
        int acc = 0, e = 0, mt = 0;
        for (int j = 0; j < NE; ++j) { const int nt = (cnt[j] + 255) >> 8; if (u.pm >= acc && u.pm < acc + nt) { e = j; mt = u.pm - acc; } acc += nt; }
        u.e = __builtin_amdgcn_readfirstlane(e); u.mt = __builtin_amdgcn_readfirstlane(mt); return true;
    }
    __device__ __forceinline__ const char* a_ptr(const Unit& u) const { return (STAGE == 1) ? (const char*)ws + AOFF : (const char*)ws + AOFF + (size_t)u.pm * BM * K * 2; }
    __device__ __forceinline__ const char* b_ptr(const Unit& u) const { return (const char*)ws + BOFF + ((size_t)u.e * N + (size_t)u.pn * BM) * K * 2; }
    __device__ __forceinline__ void a_off(const Unit& u, unsigned (&off)[2][2]) const {
        const int tid = otid();
        if (STAGE == 1) {
            const int* cnt = (const int*)(ws + WS_CTL); const int* list = (const int*)(ws + WS_LIST);
            const int ce = __builtin_amdgcn_readfirstlane(cnt[u.e]);
#pragma unroll
            for (int i = 0; i < 2; ++i) { int R, C; stage_rc(tid * 16 + i * 8192, R, C);
#pragma unroll
                for (int h = 0; h < 2; ++h) { int lr = u.mt * BM + h * HALF + R; lr = lr < ce ? lr : ce - 1; const int tok = list[(size_t)u.e * S + lr] >> 2; off[h][i] = (unsigned)(tok * K + C) * 2u; } }
        } else {
#pragma unroll
            for (int i = 0; i < 2; ++i) { int R, C; stage_rc(tid * 16 + i * 8192, R, C);
#pragma unroll
                for (int h = 0; h < 2; ++h) off[h][i] = (unsigned)((h * HALF + R) * K + C) * 2u; }
        }
    }
};

template <class Epi, class Sched>
__device__ __forceinline__ void gemm_phase(LAS unsigned char* lds, const Sched& S, const Epi& E) {
    const int tid = otid(), wid = __builtin_amdgcn_readfirstlane(tid >> 6), lane = tid & 63, wr = wid >> 2, wc = wid & 3, fr = lane & 15, fq = lane >> 4;
    constexpr int K = Sched::K, nt = K / BK;
    unsigned voffB[2];
#pragma unroll
    for (int i = 0; i < 2; ++i) { int sR, sC; stage_rc(tid * 16 + i * 8192, sR, sC); const int Rb = Epi::PERM ? ((sR & ~31) + perm32(sR & 31)) : sR; voffB[i] = (unsigned)(Rb * K + sC) * 2u; }
    const size_t kstep = (size_t)(BK * 2);
    const size_t hstep = (size_t)HALF * K * 2;
    const unsigned ldsw = (unsigned)wid * 1024u;
    const int aoff = lds_byte(wr * 64 + fr, fq * 8), boff = lds_byte(wc * 32 + fr, fq * 8);
#define PG8_SA(b, h) (((b) * 2 + (h)) * HTB)
#define PG8_SB(b, h) ((4 + (b) * 2 + (h)) * HTB)
#define PG8_STAGE(bufoff, gbase, voff) do { _Pragma("unroll") for (int _i = 0; _i < 2; ++_i) \
        __builtin_amdgcn_global_load_lds((const unsigned*)((const char*)(gbase) + (voff)[_i]), (LAS unsigned*)(lds + (bufoff) + ldsw + _i * 8192), 16, 0, 0); } while (0)
#define PG8_LDA(dst, b, h) do { _Pragma("unroll") for (int m = 0; m < 4; ++m) _Pragma("unroll") for (int k = 0; k < 2; ++k) dst[m][k] = *(const LAS bf16x8*)(lds + PG8_SA(b, h) + aoff + m * 2048 + k * 1024); } while (0)
#define PG8_LDB(dst, b, h) do { _Pragma("unroll") for (int n = 0; n < 2; ++n) _Pragma("unroll") for (int k = 0; k < 2; ++k) dst[n][k] = *(const LAS bf16x8*)(lds + PG8_SB(b, h) + boff + n * 2048 + k * 1024); } while (0)
#define PG8_MMA(ai, bj, At, Bt) do { __builtin_amdgcn_s_setprio(1); _Pragma("unroll") for (int m = 0; m < 4; ++m) _Pragma("unroll") for (int n = 0; n < 2; ++n) _Pragma("unroll") for (int k = 0; k < 2; ++k) \
        acc[ai][bj][m][n] = __builtin_amdgcn_mfma_f32_16x16x32_bf16(Bt[n][k], At[m][k], acc[ai][bj][m][n], 0, 0, 0); __builtin_amdgcn_s_setprio(0); } while (0)
#define PG8_WAIT_V(n) asm volatile("s_waitcnt vmcnt(" #n ")" ::: "memory")
#define PG8_WAIT_L(n) asm volatile("s_waitcnt lgkmcnt(" #n ")" ::: "memory")
#define PG8_BAR __builtin_amdgcn_s_barrier()
#define PG8_SCHED __builtin_amdgcn_sched_barrier(0)
    Unit cur, nxt; int ui = 0;
    if (!S.next(0, cur)) return;
    f32x4 acc[2][2][4][2];
#pragma unroll
    for (int a = 0; a < 2; ++a)
#pragma unroll
        for (int b = 0; b < 2; ++b)
#pragma unroll
            for (int m = 0; m < 4; ++m)
#pragma unroll
                for (int n = 0; n < 2; ++n) acc[a][b][m][n] = (f32x4){0.f, 0.f, 0.f, 0.f};
    bf16x8 At[4][2], B0[2][2], B1[2][2];
    const char* cA = S.a_ptr(cur); const char* cB = S.b_ptr(cur);
    unsigned ao[2][2]; S.a_off(cur, ao);
    PG8_STAGE(PG8_SB(0, 0), cB, voffB); PG8_STAGE(PG8_SB(0, 1), cB + hstep, voffB); PG8_STAGE(PG8_SA(0, 0), cA, ao[0]); PG8_STAGE(PG8_SA(0, 1), cA, ao[1]);
    if (wr == 1) PG8_BAR;
    PG8_WAIT_V(2); PG8_BAR;
    PG8_STAGE(PG8_SB(1, 0), cB + kstep, voffB); PG8_STAGE(PG8_SA(1, 0), cA + kstep, ao[0]); PG8_STAGE(PG8_SB(1, 1), cB + hstep + kstep, voffB);
    PG8_WAIT_V(6); PG8_BAR;
    for (;;) {
        const bool has_next = S.next(ui + 1, nxt);
        const char* nA = has_next ? S.a_ptr(nxt) : cA; const char* nB = has_next ? S.b_ptr(nxt) : cB;
        for (int t = 0; t < nt; t += 2) {
            const bool last = (t == nt - 2);
            const char* a1 = cA + (size_t)(t + 1) * kstep;
            const char* a2 = last ? nA : cA + (size_t)(t + 2) * kstep; const char* b2 = last ? nB : cB + (size_t)(t + 2) * kstep;
            const char* a3 = a2 + kstep; const char* b3 = b2 + kstep;

            PG8_LDB(B0, 0, 0); PG8_LDB(B1, 0, 1); PG8_SCHED; PG8_LDA(At, 0, 0); PG8_STAGE(PG8_SA(1, 1), a1, ao[1]);
            PG8_WAIT_V(8); PG8_WAIT_L(0); PG8_BAR; PG8_MMA(0, 0, At, B0); PG8_MMA(0, 1, At, B1); PG8_BAR; PG8_SCHED;
            if (Sched::GATHER) { if (last && has_next) S.a_off(nxt, ao); }
            PG8_LDA(At, 0, 1); PG8_STAGE(PG8_SB(0, 0), b2, voffB); PG8_STAGE(PG8_SB(0, 1), b2 + hstep, voffB); PG8_STAGE(PG8_SA(0, 0), a2, ao[0]);
            PG8_WAIT_V(8); PG8_WAIT_L(0); PG8_BAR; PG8_MMA(1, 0, At, B0); PG8_MMA(1, 1, At, B1); PG8_BAR; PG8_SCHED;
            PG8_LDB(B0, 1, 0); PG8_LDB(B1, 1, 1); PG8_SCHED; PG8_LDA(At, 1, 0); PG8_STAGE(PG8_SA(0, 1), a2, ao[1]);
            PG8_WAIT_V(8); PG8_WAIT_L(0); PG8_BAR; PG8_MMA(0, 0, At, B0); PG8_MMA(0, 1, At, B1); PG8_BAR; PG8_SCHED;
            PG8_LDA(At, 1, 1); PG8_STAGE(PG8_SB(1, 0), b3, voffB); PG8_STAGE(PG8_SB(1, 1), b3 + hstep, voffB); PG8_STAGE(PG8_SA(1, 0), a3, ao[0]);
            PG8_WAIT_V(8); PG8_WAIT_L(0); PG8_BAR; PG8_MMA(1, 0, At, B0); PG8_MMA(1, 1, At, B1); PG8_BAR; PG8_SCHED;
        }
        if (wr == 0) PG8_BAR;
        E(acc, cur, wr, wc, fr, fq);
        if (!has_next) break;
#pragma unroll
        for (int a = 0; a < 2; ++a)
#pragma unroll
            for (int b = 0; b < 2; ++b)
#pragma unroll
                for (int m = 0; m < 4; ++m)
#pragma unroll
                    for (int n = 0; n < 2; ++n) acc[a][b][m][n] = (f32x4){0.f, 0.f, 0.f, 0.f};
        cur = nxt; cA = nA; cB = nB; ++ui;
        if (wr == 1) PG8_BAR;
    }
    PG8_WAIT_V(0);
    PG8_BAR;
#undef PG8_SA
#undef PG8_SB
#undef PG8_STAGE
#undef PG8_LDA
#undef PG8_LDB
#undef PG8_MMA
#undef PG8_WAIT_V
#undef PG8_WAIT_L
#undef PG8_BAR
#undef PG8_SCHED
}

struct EpiF32 {
    static constexpr bool PERM = false;
    float* C; int ldc;
    __device__ __forceinline__ void operator()(const f32x4 (&acc)[2][2][4][2], const Unit& u, int wr, int wc, int fr, int fq) const {
        const int row0 = u.pm * BM + wr * 64 + fr, col0 = u.pn * BM + wc * 32 + 4 * fq;
#pragma unroll
        for (int ai = 0; ai < 2; ++ai)
#pragma unroll
            for (int m = 0; m < 4; ++m) { float* rowp = C + (size_t)(row0 + ai * HALF + m * 16) * ldc + col0;
#pragma unroll
                for (int bj = 0; bj < 2; ++bj)
#pragma unroll
                    for (int n = 0; n < 2; ++n) *(f32x4*)(rowp + bj * HALF + n * 16) = acc[ai][bj][m][n]; }
    }
};
struct EpiGlu {
    static constexpr bool PERM = false;
    const float* yg; const float* bias; float* Z;
    __device__ __forceinline__ void operator()(const f32x4 (&acc)[2][2][4][2], const Unit& u, int wr, int wc, int fr, int fq) const {
        const int row0 = u.pm * BM + wr * 64 + fr, col0 = u.pn * BM + wc * 32 + 4 * fq;
#pragma unroll
        for (int ai = 0; ai < 2; ++ai)
#pragma unroll
            for (int m = 0; m < 4; ++m) { const size_t ro = (size_t)(row0 + ai * HALF + m * 16) * SW + col0;
#pragma unroll
                for (int bj = 0; bj < 2; ++bj)
#pragma unroll
                    for (int n = 0; n < 2; ++n) { const int co = bj * HALF + n * 16; const f32x4 y = *(const f32x4*)(yg + ro + co); const f32x4 b = *(const f32x4*)(bias + col0 + co); f32x4 o;
#pragma unroll
                        for (int j = 0; j < 4; ++j) o[j] = y[j] * sigmoidf_(acc[ai][bj][m][n][j] + b[j]);
                        *(f32x4*)(Z + ro + co) = o; } }
    }
};
struct EpiResid {
    static constexpr bool PERM = false;
    const float* x; const float* gate; float* X1;
    __device__ __forceinline__ void operator()(const f32x4 (&acc)[2][2][4][2], const Unit& u, int wr, int wc, int fr, int fq) const {
        const int row0 = u.pm * BM + wr * 64 + fr, col0 = u.pn * BM + wc * 32 + 4 * fq;
#pragma unroll
        for (int ai = 0; ai < 2; ++ai)
#pragma unroll
            for (int m = 0; m < 4; ++m) { const size_t ro = (size_t)(row0 + ai * HALF + m * 16) * D + col0;
#pragma unroll
                for (int bj = 0; bj < 2; ++bj)
#pragma unroll
                    for (int n = 0; n < 2; ++n) { const int co = bj * HALF + n * 16; const f32x4 xv = *(const f32x4*)(x + ro + co); const f32x4 g = *(const f32x4*)(gate + col0 + co);
                        *(f32x4*)(X1 + ro + co) = xv + g * acc[ai][bj][m][n]; } }
    }
};
struct EpiMoe1 {
    static constexpr bool PERM = true;
    const float* b_gu; bf16_t* ACT;
    __device__ __forceinline__ void operator()(const f32x4 (&acc)[2][2][4][2], const Unit& u, int wr, int wc, int fr, int fq) const {
        const int row0 = u.pm * BM + wr * 64 + fr, j0 = u.pn * HALF + wc * 32 + 8 * fq;
        const float* bias = b_gu + (size_t)u.e * 2 * FF + 2 * j0;
        float bg[8], bl[8];
#pragma unroll
        for (int j = 0; j < 8; ++j) { bg[j] = bias[2 * j]; bl[j] = bias[2 * j + 1]; }
#pragma unroll
        for (int ai = 0; ai < 2; ++ai)
#pragma unroll
            for (int m = 0; m < 4; ++m) { bf16_t* rowp = ACT + (size_t)(row0 + ai * HALF + m * 16) * FF + j0; float o[8];
#pragma unroll
                for (int n = 0; n < 2; ++n)
#pragma unroll
                    for (int j = 0; j < 4; ++j) { const float gl = fminf(acc[ai][0][m][n][j] + bg[4 * n + j], 7.0f); const float ln = fminf(fmaxf(acc[ai][1][m][n][j] + bl[4 * n + j], -7.0f), 7.0f);
                        o[4 * n + j] = gl * sigmoidf_(1.702f * gl) * (ln + 1.0f); }
                u32x4 w; w.x = cvt_pk_bf16(o[0], o[1]); w.y = cvt_pk_bf16(o[2], o[3]); w.z = cvt_pk_bf16(o[4], o[5]); w.w = cvt_pk_bf16(o[6], o[7]);
                *(u32x4*)rowp = w; }
    }
};
struct EpiMoe2 {
    static constexpr bool PERM = true;
    const float* b_down; const unsigned char* ws;
    __device__ __forceinline__ void operator()(const f32x4 (&acc)[2][2][4][2], const Unit& u, int wr, int wc, int fr, int fq) const {
        const int lr0 = u.mt * BM + wr * 64 + fr, row0 = u.pm * BM + wr * 64 + fr, col0 = u.pn * BM + wc * 32 + 8 * fq;
        const int* cnt = (const int*)(ws + WS_CTL); const int* list = (const int*)(ws + WS_LIST); const float* gate = (const float*)(ws + WS_GATE); bf16_t* YA = (bf16_t*)(ws + WS_YA);
        const int ce = __builtin_amdgcn_readfirstlane(cnt[u.e]);
        f32x4 bv[2][2];
#pragma unroll
        for (int bj = 0; bj < 2; ++bj)
#pragma unroll
            for (int n = 0; n < 2; ++n) bv[bj][n] = *(const f32x4*)(b_down + (size_t)u.e * D + col0 + bj * HALF + 4 * n);
#pragma unroll
        for (int ai = 0; ai < 2; ++ai)
#pragma unroll
            for (int m = 0; m < 4; ++m) { const int lr = lr0 + ai * HALF + m * 16; float g = 0.f; if (lr < ce) g = gate[list[(size_t)u.e * S + lr]];
                bf16_t* rowp = YA + (size_t)(row0 + ai * HALF + m * 16) * D + col0;
#pragma unroll
                for (int bj = 0; bj < 2; ++bj) { const f32x4 v0 = (acc[ai][bj][m][0] + bv[bj][0]) * g, v1 = (acc[ai][bj][m][1] + bv[bj][1]) * g;
                    u32x4 w; w.x = cvt_pk_bf16(v0[0], v0[1]); w.y = cvt_pk_bf16(v0[2], v0[3]); w.z = cvt_pk_bf16(v1[0], v1[1]); w.w = cvt_pk_bf16(v1[2], v1[3]);
                    *(u32x4*)(rowp + bj * HALF) = w; } }
    }
};
struct EpiProj {
    static constexpr bool PERM = false;
    bf16_t* QKV; float* U;
    __device__ __forceinline__ void operator()(const f32x4 (&acc)[2][2][4][2], const Unit& u, int wr, int wc, int fr, int fq) const {
        const int row0 = u.pm * BM + wr * 64 + fr, col0 = u.pn * BM + wc * 32 + 4 * fq;
        if (u.pn < 12) {
            const float sc = (u.pn < 4) ? 0.125f : 1.0f;
#pragma unroll
            for (int ai = 0; ai < 2; ++ai)
#pragma unroll
                for (int m = 0; m < 4; ++m) { bf16_t* rowp = QKV + (size_t)(row0 + ai * HALF + m * 16) * (3 * AW) + col0;
#pragma unroll
                    for (int bj = 0; bj < 2; ++bj)
#pragma unroll
                        for (int n = 0; n < 2; ++n) { const f32x4 v = acc[ai][bj][m][n] * sc; u32x2 w; w.x = cvt_pk_bf16(v[0], v[1]); w.y = cvt_pk_bf16(v[2], v[3]); *(u32x2*)(rowp + bj * HALF + n * 16) = w; } }
        } else {
#pragma unroll
            for (int ai = 0; ai < 2; ++ai)
#pragma unroll
                for (int m = 0; m < 4; ++m) { float* rowp = U + (size_t)(row0 + ai * HALF + m * 16) * SW + (col0 - 3 * AW);
#pragma unroll
                    for (int bj = 0; bj < 2; ++bj)
#pragma unroll
                        for (int n = 0; n < 2; ++n) *(f32x4*)(rowp + bj * HALF + n * 16) = acc[ai][bj][m][n]; }
        }
    }
};
}

constexpr int NWAVES = 8;
constexpr int LDS_BYTES = 147456;
constexpr int RING_OFF = 0;
typedef short s16x4 __attribute__((ext_vector_type(4)));
typedef float f32x16 __attribute__((ext_vector_type(16)));

template <bool DEINT>
__device__ __forceinline__ void convert_tile(const float* W, int K, int N, bf16_t* WT, int tk, int tn, LAS float* scr) {
    const int tid = otid(), k0 = tk * 64, n0 = tn * 256;
    __syncthreads();
#pragma unroll
    for (int j = 0; j < 8; ++j) { const int k = j * 8 + (tid >> 6), g = tid & 63;
        const f32x4 v = *(const f32x4*)(W + (size_t)(k0 + k) * N + n0 + 4 * g);
        *(LAS f32x4*)(scr + k * 256 + ((g ^ j) << 2)) = v; }
    __syncthreads();
#pragma unroll
    for (int jj = 0; jj < 4; ++jj) { const int n = jj * 64 + (tid >> 3), c = tid & 7; float v[8];
#pragma unroll
        for (int q = 0; q < 8; ++q) v[q] = scr[(8 * c + q) * 256 + ((((n >> 2) ^ c)) << 2) + (n & 3)];
        u32x4 o; o.x = cvt_pk_bf16(v[0], v[1]); o.y = cvt_pk_bf16(v[2], v[3]); o.z = cvt_pk_bf16(v[4], v[5]); o.w = cvt_pk_bf16(v[6], v[7]);
        int row = n0 + n;
        if (DEINT) { const int s = n & 1, jl = n >> 1; row = n0 + s * 128 + jl; }
        *(u32x4*)(WT + (size_t)row * K + k0 + 8 * c) = o; }
}

__device__ __forceinline__ void phase_prologue(const P& p, LAS unsigned char* lds, int bid, int Gn) {
    unsigned char* ws = p.ws;
    const int tid = otid();
    if (bid < 192) {
        LAS f32x4* red = (LAS f32x4*)lds;
        const int cq = tid & 15, rg = tid >> 4;
        f32x4 acc = (f32x4){0.f, 0.f, 0.f, 0.f};
        for (int it = 0; it < 64; ++it) { const int i = rg + 32 * it; const float cv = p.c[i]; const float sv = cv / (1.0f + expf(-cv));
            const f32x4 w = *(const f32x4*)(p.w_ada + (size_t)i * 6 * D + 64 * bid + 4 * cq); acc += w * sv; }
        red[rg * 16 + cq] = acc;
        __syncthreads();
        if (tid < 64) { const LAS float* rf = (const LAS float*)lds; float s = p.b_ada[64 * bid + tid];
            for (int r = 0; r < 32; ++r) s += rf[r * 64 + tid];
            ((float*)(ws + WS_MOD))[64 * bid + tid] = s; }
    } else if (tid < 64) {
        const int i = (bid - 192) * 64 + tid;
        if (i < G * NS) {
            const int g = i / NS;
            float* sp = (float*)(ws + WS_S5P);
            float *abr = sp, *abi = sp + 4096, *bbr = sp + 8192, *bbi = sp + 8192 + 65536;
            const float dt = expf(p.log_dt[g]), lr = p.lam_re[i], li = p.lam_im[i];
            const float mag = expf(lr * dt), ar = mag * cosf(li * dt), ai = mag * sinf(li * dt);
            const float den = lr * lr + li * li, nr = ar - 1.0f, ni = ai;
            const float fr = (nr * lr + ni * li) / den, fi = (ni * lr - nr * li) / den;
            abr[i] = ar; abi[i] = ai;
            for (int q = 0; q < PC; ++q) { const float br = p.b_re[(size_t)i * PC + q], bi = p.b_im[(size_t)i * PC + q];
                bbr[(size_t)i * PC + q] = fr * br - fi * bi; bbi[(size_t)i * PC + q] = fr * bi + fi * br; }
        }
    }
    LAS float* scr = (LAS float*)(lds + RING_OFF);
    constexpr int T_IN = 32 * 16, T_GLU = 16 * 4, T_OUT = 32 * 8, T_GU = 32 * 16, T_DN = 32 * 8;
    constexpr int NT = T_IN + T_GLU + T_OUT + NE * (T_GU + T_DN);
    for (int it = bid; it < NT; it += Gn) {
        int r = it;
        if (r < T_IN) { convert_tile<false>(p.w_in, D, INW, (bf16_t*)(ws + WS_WIN), r / 16, r % 16, scr); continue; } r -= T_IN;
        if (r < T_GLU) { convert_tile<false>(p.w_glu, SW, SW, (bf16_t*)(ws + WS_WGLU), r / 4, r % 4, scr); continue; } r -= T_GLU;
        if (r < T_OUT) { convert_tile<false>(p.w_out, D, D, (bf16_t*)(ws + WS_WOUT), r / 8, r % 8, scr); continue; } r -= T_OUT;
        if (r < NE * T_GU) { const int e = r / T_GU, q = r % T_GU; convert_tile<true>(p.w_gu + (size_t)e * D * 2 * FF, D, 2 * FF, (bf16_t*)(ws + WS_WGU) + (size_t)e * 2 * FF * D, q / 16, q % 16, scr); continue; } r -= NE * T_GU;
        { const int e = r / T_DN, q = r % T_DN; convert_tile<false>(p.w_down + (size_t)e * FF * D, FF, D, (bf16_t*)(ws + WS_WDN) + (size_t)e * D * FF, q / 8, q % 8, scr); }
    }
    __syncthreads();
}

__device__ __forceinline__ void phase_norm1(const P& p, int bid, int Gn) {
    const int tid_ = otid(); const int lane = tid_ & 63, gw = bid * NWAVES + (tid_ >> 6), NGW = Gn * NWAVES;
    const float* mod = (const float*)(p.ws + WS_MOD);
    bf16_t* hb = (bf16_t*)(p.ws + WS_HB);
    for (int row = gw; row < S; row += NGW) {
        const f32x4* xr = (const f32x4*)(p.x + (size_t)row * D) + lane;
        f32x4 v[8]; float ss = 0.f;
#pragma unroll
        for (int j = 0; j < 8; ++j) { v[j] = xr[64 * j]; ss += (v[j].x * v[j].x + v[j].y * v[j].y) + (v[j].z * v[j].z + v[j].w * v[j].w); }
        const float rs = 1.0f / sqrtf(wave_sum(ss) * (1.0f / D) + EPS);
#pragma unroll
        for (int j = 0; j < 8; ++j) { const int c0 = 4 * lane + 256 * j;
            const f32x4 g = *(const f32x4*)(p.norm1_g + c0), sc = *(const f32x4*)(mod + D + c0), sh = *(const f32x4*)(mod + c0);
            const f32x4 o = v[j] * rs * g * (sc + 1.0f) + sh;
            u32x2 w; w.x = cvt_pk_bf16(o.x, o.y); w.y = cvt_pk_bf16(o.z, o.w);
            *(u32x2*)(hb + (size_t)row * D + c0) = w; }
    }
}

__device__ __forceinline__ s16x4 tr_read(unsigned lds_addr) { s16x4 r; asm volatile("ds_read_b64_tr_b16 %0, %1\n\ts_waitcnt lgkmcnt(0)" : "=&v"(r) : "v"(lds_addr) : "memory"); return r; }
__device__ __forceinline__ void phase_attn(const P& p, LAS unsigned char* lds, int bid, int Gn) {
    const bf16_t* QKV = (const bf16_t*)(p.ws + WS_QKV);
    bf16_t* OB = (bf16_t*)(p.ws + WS_OB);
    float* LSE = (float*)(p.ws + WS_LSE);
    const int tid = otid(), w = __builtin_amdgcn_readfirstlane(tid >> 6), lane = tid & 63, us = w >> 2, wq = w & 3;
    const int l31 = lane & 31, hh = lane >> 5, i0 = 32 * wq;
    constexpr int RS = 3 * AW;
    LAS unsigned char* vl = lds + us * 32768;
    for (int pr = bid; pr < 3072; pr += Gn) {
        const int u = pr * 2 + us;
        const int b = u >> 11, rem = u & 2047, blk = rem >> 4, h = rem & 15;
        const int dsh = 2 * b, d = 1 << dsh;
        const int n = blk >> dsh, r = blk & (d - 1);
        const int qbase = n * 128 * d + r, kbase = qbase - 128 * d;
#pragma unroll
        for (int it = 0; it < 8; ++it) { const int id = it * 64 + lane, row = 64 * wq + (id >> 3), ch = id & 7; const int kp = kbase + row * d;
            u32x4 v = (u32x4){0u, 0u, 0u, 0u};
            if (kp >= 0) v = *(const u32x4*)(QKV + (size_t)kp * RS + 2 * AW + h * HD + ch * 8);
            *(LAS u32x4*)(vl + row * 128 + ch * 16) = v; }
        const int qp = qbase + (i0 + l31) * d;
        bf16x8 qf[4];
#pragma unroll
        for (int s = 0; s < 4; ++s) qf[s] = *(const bf16x8*)(QKV + (size_t)qp * RS + h * HD + 16 * s + 8 * hh);
        f32x16 sc[5];
#pragma unroll
        for (int kb = 0; kb < 5; ++kb) {
            const int j = i0 + 32 * kb + l31; int kp = kbase + j * d; kp = kp < 0 ? 0 : kp;
            bf16x8 kf[4];
#pragma unroll
            for (int s = 0; s < 4; ++s) kf[s] = *(const bf16x8*)(QKV + (size_t)kp * RS + AW + h * HD + 16 * s + 8 * hh);
            f32x16 a;
#pragma unroll
            for (int e = 0; e < 16; ++e) a[e] = 0.f;
#pragma unroll
            for (int s = 0; s < 4; ++s) a = __builtin_amdgcn_mfma_f32_32x32x16_bf16(kf[s], qf[s], a, 0, 0, 0);
            sc[kb] = a;
        }
        float m = -INFINITY;
#pragma unroll
        for (int kb = 0; kb < 5; ++kb)
#pragma unroll
            for (int e = 0; e < 16; ++e) { const int jrel = 32 * kb + (e & 3) + 8 * (e >> 2) + 4 * hh;
                const bool valid = (jrel >= l31) && (jrel <= l31 + 128) && (n > 0 || (i0 + jrel) >= 128);
                const float sv = valid ? sc[kb][e] : -INFINITY; sc[kb][e] = sv; m = fmaxf(m, sv); }
        m = fmaxf(m, __shfl_xor(m, 32));
        float l = 0.f;
#pragma unroll
        for (int kb = 0; kb < 5; ++kb)
#pragma unroll
            for (int e = 0; e < 16; ++e) { const float pe = __expf(sc[kb][e] - m); sc[kb][e] = pe; l += pe; }
        l += __shfl_xor(l, 32);
        __syncthreads();
        f32x16 o[2];
#pragma unroll
        for (int c = 0; c < 2; ++c)
#pragma unroll
            for (int e = 0; e < 16; ++e) o[c][e] = 0.f;
        const unsigned vbase = (unsigned)(size_t)vl;
        const int q4 = (lane & 15) >> 2, pp = lane & 3, bk = (lane >> 4) & 1;
#pragma unroll
        for (int kb = 0; kb < 5; ++kb)
#pragma unroll
            for (int s2 = 0; s2 < 2; ++s2) {
                u32x4 pw; pw.x = cvt_pk_bf16(sc[kb][8 * s2 + 0], sc[kb][8 * s2 + 1]); pw.y = cvt_pk_bf16(sc[kb][8 * s2 + 2], sc[kb][8 * s2 + 3]);
                pw.z = cvt_pk_bf16(sc[kb][8 * s2 + 4], sc[kb][8 * s2 + 5]); pw.w = cvt_pk_bf16(sc[kb][8 * s2 + 6], sc[kb][8 * s2 + 7]);
                const bf16x8 pf = __builtin_bit_cast(bf16x8, pw);
                const int rowb = i0 + 32 * kb + 16 * s2 + 4 * hh + q4;
#pragma unroll
                for (int c = 0; c < 2; ++c) {
                    const unsigned a0 = vbase + (unsigned)(rowb * 128 + 64 * c + 32 * bk + 8 * pp);
                    const s16x4 v0 = tr_read(a0), v1 = tr_read(a0 + 8 * 128);
                    bf16x8 vf; vf[0] = v0[0]; vf[1] = v0[1]; vf[2] = v0[2]; vf[3] = v0[3]; vf[4] = v1[0]; vf[5] = v1[1]; vf[6] = v1[2]; vf[7] = v1[3];
                    o[c] = __builtin_amdgcn_mfma_f32_32x32x16_bf16(vf, pf, o[c], 0, 0, 0);
                }
            }
        const float inv = 1.0f / l;
        bf16_t* orow = OB + ((size_t)b * S + qp) * AW + h * HD;
#pragma unroll
        for (int c = 0; c < 2; ++c)
#pragma unroll
            for (int rg = 0; rg < 4; ++rg) { u32x2 wv; wv.x = cvt_pk_bf16(o[c][4 * rg] * inv, o[c][4 * rg + 1] * inv); wv.y = cvt_pk_bf16(o[c][4 * rg + 2] * inv, o[c][4 * rg + 3] * inv);
                *(u32x2*)(orow + 32 * c + 8 * rg + 4 * hh) = wv; }
        if (hh == 0) LSE[((size_t)b * S + qp) * NH + h] = m + __logf(l);
        __syncthreads();
    }
}

__device__ __forceinline__ float gelu_tanh(float y) { const float u = 0.7978845608028654f * (y + 0.044715f * y * y * y); return 0.5f * y * (1.0f + tanhf(u)); }
__device__ __forceinline__ void phase_s5_passA(const P& p, int bid, int Gn) {
    const int tid_ = otid(); const int n = tid_ & 63, gw = bid * NWAVES + (tid_ >> 6), NGW = Gn * NWAVES;
    const float* sp = (const float*)(p.ws + WS_S5P);
    const float* U = (const float*)(p.ws + WS_U);
    float* E = (float*)(p.ws + WS_ECH);
    for (int task = gw; task < NCH * G; task += NGW) {
        const int c = task / G, g = task % G;
        const float ar = sp[g * NS + n], ai = sp[4096 + g * NS + n];
        float br[PC], bi[PC];
#pragma unroll
        for (int q = 0; q < PC; ++q) { br[q] = sp[8192 + (size_t)(g * NS + n) * PC + q]; bi[q] = sp[8192 + 65536 + (size_t)(g * NS + n) * PC + q]; }
        float xr = 0.f, xi = 0.f;
        for (int t = c * LCH; t < (c + 1) * LCH; ++t) {
            const float* u = U + (size_t)t * SW + g * PC;
            float bur = 0.f, bui = 0.f;
#pragma unroll
            for (int q = 0; q < PC; ++q) { const float uv = u[q]; bur += br[q] * uv; bui += bi[q] * uv; }
            const float nr = ar * xr - ai * xi + bur, ni = ar * xi + ai * xr + bui;
            xr = nr; xi = ni;
        }
        E[((size_t)(c * G + g) * NS + n) * 2 + 0] = xr; E[((size_t)(c * G + g) * NS + n) * 2 + 1] = xi;
    }
}
__device__ __forceinline__ void phase_s5_passB(const P& p, int bid, int Gn) {
    const int tid_ = otid(); const int n = tid_ & 63, gw = bid * NWAVES + (tid_ >> 6), NGW = Gn * NWAVES;
    const float* sp = (const float*)(p.ws + WS_S5P);
    const float* U = (const float*)(p.ws + WS_U);
    const float* E = (const float*)(p.ws + WS_ECH);
    float* YG = (float*)(p.ws + WS_YG);
    bf16_t* YGB = (bf16_t*)(p.ws + WS_YGB);
    for (int task = gw; task < NCH * G; task += NGW) {
        const int c = task / G, g = task % G;
        const float ar = sp[g * NS + n], ai = sp[4096 + g * NS + n];
        float br[PC], bi[PC], cr[PC], ci[PC];
#pragma unroll
        for (int q = 0; q < PC; ++q) { br[q] = sp[8192 + (size_t)(g * NS + n) * PC + q]; bi[q] = sp[8192 + 65536 + (size_t)(g * NS + n) * PC + q];
            cr[q] = p.c_re[((size_t)g * PC + q) * NS + n]; ci[q] = p.c_im[((size_t)g * PC + q) * NS + n]; }
        const float dsk = (n < PC) ? p.d_skip[g * PC + n] : 0.f;
        float pr = ar, pi = ai;
#pragma unroll
        for (int s = 0; s < 7; ++s) { const float nr = pr * pr - pi * pi, ni = 2.f * pr * pi; pr = nr; pi = ni; }
        float xr = 0.f, xi = 0.f;
        for (int j = 0; j < c; ++j) { const float er = E[((size_t)(j * G + g) * NS + n) * 2 + 0], ei = E[((size_t)(j * G + g) * NS + n) * 2 + 1];
            const float nr = pr * xr - pi * xi + er, ni = pr * xi + pi * xr + ei; xr = nr; xi = ni; }
        for (int t = c * LCH; t < (c + 1) * LCH; ++t) {
            const float* u = U + (size_t)t * SW + g * PC;
            float bur = 0.f, bui = 0.f;
#pragma unroll
            for (int q = 0; q < PC; ++q) { const float uv = u[q]; bur += br[q] * uv; bui += bi[q] * uv; }
            const float nr = ar * xr - ai * xi + bur, ni = ar * xi + ai * xr + bui;
            xr = nr; xi = ni;
            float mine = 0.f;
#pragma unroll
            for (int q = 0; q < PC; ++q) { const float s = wave_sum(cr[q] * xr - ci[q] * xi); mine = (n == q) ? s : mine; }
            if (n < PC) { const float y = gelu_tanh(mine + dsk * u[n]); YG[(size_t)t * SW + g * PC + n] = y; YGB[(size_t)t * SW + g * PC + n] = f2bf(y); }
        }
    }
}

__device__ __forceinline__ void phase_mix(const P& p, int bid, int Gn) {
    const int tid_ = otid(); const int lane = tid_ & 63, gw = bid * NWAVES + (tid_ >> 6), NGW = Gn * NWAVES;
    const bf16_t* OB = (const bf16_t*)(p.ws + WS_OB);
    const float* LSE = (const float*)(p.ws + WS_LSE);
    const float* Z = (const float*)(p.ws + WS_Z);
    bf16_t* YM = (bf16_t*)(p.ws + WS_YMIXB);
    for (int row = gw; row < S; row += NGW) {
        f32x4 a[4], z[4]; float sa = 0.f, sz = 0.f;
#pragma unroll
        for (int j = 0; j < 4; ++j) { const int c0 = 4 * lane + 256 * j, hd = c0 >> 6;
            float ls[3], mx = -INFINITY;
#pragma unroll
            for (int b = 0; b < 3; ++b) { ls[b] = LSE[((size_t)b * S + row) * NH + hd]; mx = fmaxf(mx, ls[b]); }
            float wsum = 0.f; f32x4 acc = (f32x4){0.f, 0.f, 0.f, 0.f};
#pragma unroll
            for (int b = 0; b < 3; ++b) { const float wb = __expf(ls[b] - mx); wsum += wb; const u32x2 ov = *(const u32x2*)(OB + ((size_t)b * S + row) * AW + c0);
                acc.x += wb * __uint_as_float(ov.x << 16); acc.y += wb * __uint_as_float(ov.x & 0xffff0000u); acc.z += wb * __uint_as_float(ov.y << 16); acc.w += wb * __uint_as_float(ov.y & 0xffff0000u); }
            a[j] = acc * (1.0f / wsum); sa += (a[j].x * a[j].x + a[j].y * a[j].y) + (a[j].z * a[j].z + a[j].w * a[j].w);
            z[j] = *(const f32x4*)(Z + (size_t)row * SW + c0); sz += (z[j].x * z[j].x + z[j].y * z[j].y) + (z[j].z * z[j].z + z[j].w * z[j].w); }
        const float ra = 1.0f / sqrtf(wave_sum(sa) * (1.0f / AW) + EPS), rz = 1.0f / sqrtf(wave_sum(sz) * (1.0f / SW) + EPS);
#pragma unroll
        for (int j = 0; j < 4; ++j) { const int c0 = 4 * lane + 256 * j;
            const f32x4 ga = *(const f32x4*)(p.attn_g + c0), gs = *(const f32x4*)(p.ssm_g + c0);
            const f32x4 oa = a[j] * ra * ga, oz = z[j] * rz * gs;
            u32x2 wa, wz; wa.x = cvt_pk_bf16(oa.x, oa.y); wa.y = cvt_pk_bf16(oa.z, oa.w); wz.x = cvt_pk_bf16(oz.x, oz.y); wz.y = cvt_pk_bf16(oz.z, oz.w);
            *(u32x2*)(YM + (size_t)row * D + c0) = wa; *(u32x2*)(YM + (size_t)row * D + AW + c0) = wz; }
    }
}

__device__ __forceinline__ void phase_norm2_router(const P& p, LAS unsigned char* lds, int bid, int Gn) {
    const int tid = otid(), lane = tid & 63, w = tid >> 6;
    const float* mod = (const float*)(p.ws + WS_MOD);
    const float* X1 = (const float*)(p.ws + WS_X1);
    bf16_t* hb = (bf16_t*)(p.ws + WS_HB);
    LAS float* hrow = (LAS float*)lds;
    LAS float* part = (LAS float*)(lds + 65536);
    LAS float* logit = (LAS float*)(lds + 65536 + 16384);
    int* idx = (int*)(p.ws + WS_IDX); float* gate = (float*)(p.ws + WS_GATE); int* slot = (int*)(p.ws + WS_SLOT);
    int* cnt = (int*)(p.ws + WS_CTL); int* list = (int*)(p.ws + WS_LIST);
    for (int base = bid * 8; base < S; base += Gn * 8) {
        {   const int row = base + w;
            const f32x4* xr = (const f32x4*)(X1 + (size_t)row * D) + lane;
            f32x4 v[8]; float ss = 0.f;
#pragma unroll
            for (int j = 0; j < 8; ++j) { v[j] = xr[64 * j]; ss += (v[j].x * v[j].x + v[j].y * v[j].y) + (v[j].z * v[j].z + v[j].w * v[j].w); }
            const float rs = 1.0f / sqrtf(wave_sum(ss) * (1.0f / D) + EPS);
#pragma unroll
            for (int j = 0; j < 8; ++j) { const int c0 = 4 * lane + 256 * j;
                const f32x4 g = *(const f32x4*)(p.norm2_g + c0), sc = *(const f32x4*)(mod + 4 * D + c0), sh = *(const f32x4*)(mod + 3 * D + c0);
                const f32x4 o = v[j] * rs * g * (sc + 1.0f) + sh;
                u32x2 wv; wv.x = cvt_pk_bf16(o.x, o.y); wv.y = cvt_pk_bf16(o.z, o.w);
                *(u32x2*)(hb + (size_t)row * D + c0) = wv;
                *(LAS f32x4*)(hrow + w * D + c0) = o; }
        }
        __syncthreads();
        {   const int e = tid & 31, pt = tid >> 5;
            float acc[8];
#pragma unroll
            for (int r = 0; r < 8; ++r) acc[r] = 0.f;
            for (int k = pt * 128; k < (pt + 1) * 128; ++k) { const float wv = p.w_router[(size_t)k * NE + e];
#pragma unroll
                for (int r = 0; r < 8; ++r) acc[r] += hrow[r * D + k] * wv; }
#pragma unroll
            for (int r = 0; r < 8; ++r) part[(pt * 8 + r) * 32 + e] = acc[r];
        }
        __syncthreads();
        if (tid < 256) { const int r = tid >> 5, e = tid & 31; float s = p.b_router[e];
#pragma unroll
            for (int q = 0; q < 16; ++q) s += part[(q * 8 + r) * 32 + e];
            logit[r * 32 + e] = s; }
        __syncthreads();
        if (tid < 8) {
            const int t = base + tid;
            unsigned used = 0u; float tv[TOPK]; int ti[TOPK];
#pragma unroll
            for (int k = 0; k < TOPK; ++k) { float best = -INFINITY; int bi = 0;
                for (int j = 0; j < NE; ++j) { const float v = logit[tid * 32 + j]; if (!((used >> j) & 1u) && v > best) { best = v; bi = j; } }
                used |= 1u << bi; tv[k] = best; ti[k] = bi; }
            const float mx = tv[0]; float ex[TOPK], sum = 0.f;
#pragma unroll
            for (int k = 0; k < TOPK; ++k) { ex[k] = expf(tv[k] - mx); sum += ex[k]; }
#pragma unroll
            for (int k = 0; k < TOPK; ++k) { const int sl = atomicAdd(&cnt[ti[k]], 1);
                idx[t * TOPK + k] = ti[k]; gate[t * TOPK + k] = ex[k] / sum; slot[t * TOPK + k] = sl; list[ti[k] * S + sl] = t * TOPK + k; }
        }
        __syncthreads();
    }
}

__device__ __forceinline__ void phase_final(const P& p, int bid, int Gn) {
    const int tid_ = otid(); const int lane = tid_ & 63, gw = bid * NWAVES + (tid_ >> 6), NGW = Gn * NWAVES;
    const int* cnt = (const int*)(p.ws + WS_CTL);
    const int* idx = (const int*)(p.ws + WS_IDX); const int* slot = (const int*)(p.ws + WS_SLOT);
    const float* mod = (const float*)(p.ws + WS_MOD);
    const float* X1 = (const float*)(p.ws + WS_X1);
    const bf16_t* YA = (const bf16_t*)(p.ws + WS_YA);
    for (int row = gw; row < S; row += NGW) {
        int prow[TOPK];
#pragma unroll
        for (int k = 0; k < TOPK; ++k) { const int e = idx[row * TOPK + k]; int off = 0;
            for (int j = 0; j < NE; ++j) off += (j < e) ? ((cnt[j] + 255) & ~255) : 0;
            prow[k] = off + slot[row * TOPK + k]; }
        f32x4 v[8]; float ss = 0.f;
#pragma unroll
        for (int j = 0; j < 8; ++j) { const int c0 = 4 * lane + 256 * j; f32x4 m = (f32x4){0.f, 0.f, 0.f, 0.f};
#pragma unroll
            for (int k = 0; k < TOPK; ++k) { const u32x2 yv = *(const u32x2*)(YA + (size_t)prow[k] * D + c0);
                m.x += __uint_as_float(yv.x << 16); m.y += __uint_as_float(yv.x & 0xffff0000u); m.z += __uint_as_float(yv.y << 16); m.w += __uint_as_float(yv.y & 0xffff0000u); }
            const f32x4 g2 = *(const f32x4*)(mod + 5 * D + c0);
            v[j] = *(const f32x4*)(X1 + (size_t)row * D + c0) + g2 * m;
            ss += (v[j].x * v[j].x + v[j].y * v[j].y) + (v[j].z * v[j].z + v[j].w * v[j].w); }
        const float rs = 1.0f / sqrtf(wave_sum(ss) * (1.0f / D) + EPS);
#pragma unroll
        for (int j = 0; j < 8; ++j) { const int c0 = 4 * lane + 256 * j; const f32x4 fg = *(const f32x4*)(p.final_g + c0);
            *(f32x4*)(p.out + (size_t)row * D + c0) = v[j] * rs * fg; }
    }
}


#define XB_TMO      128
#define XB_XCNT(j)  (256  + 64 * (j))
#define XB_XSUB(j)  (1280 + 64 * (j))
#define XB_XGEN(j)  (2304 + 64 * (j))
#define XB_TOP      3328
#define XB_TOPGEN   3392
#define XCD_BAR_WORDS 3456
#define XB_SPIN_CAP (1u << 18)

__device__ __forceinline__ unsigned xb_ld(unsigned* p)              { return __hip_atomic_load(p, __ATOMIC_RELAXED, __HIP_MEMORY_SCOPE_AGENT); }
__device__ __forceinline__ unsigned xb_add(unsigned* p, unsigned v) { return __hip_atomic_fetch_add(p, v, __ATOMIC_RELAXED, __HIP_MEMORY_SCOPE_AGENT); }
__device__ __forceinline__ unsigned xb_xcc_id() { return (unsigned)__builtin_amdgcn_s_getreg((3 << 11) | 20) & 0xFu; }
#define XB_SPIN(cond, bar) do { unsigned _sp = 0; while (cond) { __builtin_amdgcn_s_sleep(1); \
    if ((++_sp & 255u) == 0u) { if (xb_ld(&(bar)[XB_TMO])) break; if (_sp > XB_SPIN_CAP) { atomicAdd(&(bar)[XB_TMO], 1u); break; } } } } while (0)

struct XcdBarrier {
    unsigned* bar; unsigned x;
    volatile LAS unsigned* st;
};

__device__ __forceinline__ XcdBarrier xcd_barrier_post(unsigned* bar, volatile LAS unsigned* st) {
    XcdBarrier b; b.bar = bar; b.x = xb_xcc_id(); b.st = st;
    if (threadIdx.x == 0) (void)xb_add(&bar[XB_XCNT(b.x)], 1u);
    return b;
}
__device__ __forceinline__ void xcd_barrier_complete(unsigned* bar, unsigned x, unsigned& nloc, unsigned& nx) {
    const unsigned G = gridDim.x * gridDim.y * gridDim.z;
    unsigned sum, cnt, mine, sp = 0u;
    for (;;) {
        sum = 0u; cnt = 0u; mine = 0u;
#pragma unroll
        for (unsigned j = 0; j < 16; ++j) { const unsigned c = xb_ld(&bar[XB_XCNT(j)]); sum += c; cnt += (c > 0u) ? 1u : 0u; mine = (j == x) ? c : mine; }
        if (sum == G) break;
        __builtin_amdgcn_s_sleep(1);
        if ((++sp & 255u) == 0u) { if (xb_ld(&bar[XB_TMO])) break; if (sp > XB_SPIN_CAP) { atomicAdd(&bar[XB_TMO], 1u); break; } }
    }
    nloc = mine > 0u ? mine : 1u; nx = cnt > 0u ? cnt : 1u;
}

__device__ __forceinline__ void xcd_barrier(const XcdBarrier& b) {
    asm volatile("s_waitcnt vmcnt(0)" ::: "memory");
    __syncthreads();
    if (threadIdx.x == 0) {
        unsigned* bar = b.bar;
        __builtin_amdgcn_s_waitcnt(0);
        unsigned nloc = b.st[0], nx = b.st[1];
        if (nloc == 0u) { xcd_barrier_complete(bar, b.x, nloc, nx); b.st[0] = nloc; b.st[1] = nx; }
        const unsigned old = xb_add(&bar[XB_XSUB(b.x)], 1u);
        const unsigned gen = old / nloc;
        if (old + 1u == (gen + 1u) * nloc) {
            __builtin_amdgcn_fence(__ATOMIC_RELEASE, "agent");
            asm volatile("s_waitcnt vmcnt(0)" ::: "memory");
            const unsigned og = xb_add(&bar[XB_TOP], 1u);
            const unsigned tg = og / nx;
            if (og + 1u == (tg + 1u) * nx) xb_add(&bar[XB_TOPGEN], 1u);
            else XB_SPIN(xb_ld(&bar[XB_TOPGEN]) == tg, bar);
            __builtin_amdgcn_fence(__ATOMIC_ACQUIRE, "agent");
            xb_add(&bar[XB_XGEN(b.x)], 1u);
            asm volatile("s_waitcnt vmcnt(0)" ::: "memory");
        } else {
            XB_SPIN(xb_ld(&bar[XB_XGEN(b.x)]) == gen, bar);
            __builtin_amdgcn_fence(__ATOMIC_ACQUIRE, "agent");
            asm volatile("s_waitcnt vmcnt(0)" ::: "memory");
        }
    }
    __syncthreads();
}
constexpr int CW_BAR = 4096;
constexpr int MISC_OFF = 131072;

typedef __attribute__((address_space(4))) const Args CArgs;
__device__ __forceinline__ const Args* kargs() { CArgs* k = (CArgs*)__builtin_amdgcn_kernarg_segment_ptr(); asm volatile("" : "+s"(k)); return (const Args*)k; }
__device__ __forceinline__ const float* asg(const float* q) { return (const float*)(GAS const float*)q; }
__device__ __forceinline__ P globalize(const P& q) {
    P r;
#define GZ(m) r.m = asg(q.m)
    GZ(x); GZ(c); GZ(w_ada); GZ(b_ada); GZ(norm1_g); GZ(w_in); GZ(lam_re); GZ(lam_im); GZ(b_re); GZ(b_im); GZ(c_re); GZ(c_im); GZ(d_skip); GZ(log_dt);
    GZ(w_glu); GZ(b_glu); GZ(attn_g); GZ(ssm_g); GZ(w_out); GZ(norm2_g); GZ(w_router); GZ(b_router); GZ(w_gu); GZ(b_gu); GZ(w_down); GZ(b_down); GZ(final_g);
#undef GZ
    r.out = (float*)(GAS float*)q.out; r.ws = (unsigned char*)(GAS unsigned char*)q.ws;
    return r;
}
__global__ void __launch_bounds__(NWAVES * 64, 2) mk_fwd(Args args_unused) {
    extern __shared__ __attribute__((aligned(16))) unsigned char lds_raw[];
    LAS unsigned char* lds = (LAS unsigned char*)lds_raw;
    const int lo = kargs()->ph_lo, hi = kargs()->ph_hi;
    const int Gn = gridDim.x, bid = blockIdx.x;
    if (threadIdx.x == 0) *(LAS u32x4*)(lds + MISC_OFF) = (u32x4){0u, 0u, 0u, 0u};
    __syncthreads();
    XcdBarrier bar; bar.bar = nullptr; bar.x = 0; bar.st = nullptr;
    if (hi - lo > 1) { unsigned* bw = (unsigned*)((unsigned char*)(GAS unsigned char*)kargs()->p.ws + WS_CTL) + CW_BAR; bar = xcd_barrier_post(bw, (volatile LAS unsigned*)(lds + MISC_OFF)); }
#define SEAM(k) do { if (lo <= (k) && (k) + 1 < hi) xcd_barrier(bar); } while (0)
#ifndef PHMASK
#define PHMASK 0xfff
#endif
#define IN(k) (((PHMASK >> (k)) & 1) && lo <= (k) && (k) < hi)
#define PHASE_P const P p = globalize(kargs()->p); unsigned char* ws = p.ws; (void)ws
    if (IN(0)) { PHASE_P; phase_prologue(p, lds, bid, Gn); }
    SEAM(0);
    if (IN(1)) { PHASE_P; phase_norm1(p, bid, Gn); }
    SEAM(1);
    if (IN(2)) {
        PHASE_P;
        typedef pg8::DenseSched<WS_HB, WS_WIN, S, INW, D> Sch; Sch Sd; Sd.init(ws, Gn, bid);
        pg8::EpiProj E{(bf16_t*)(ws + WS_QKV), (float*)(ws + WS_U)};
        pg8::gemm_phase<pg8::EpiProj, Sch>(lds + RING_OFF, Sd, E);
    }
    SEAM(2);
    if (IN(3)) { PHASE_P; phase_attn(p, lds, bid, Gn); phase_s5_passA(p, bid, Gn); }
    SEAM(3);
    if (IN(4)) { PHASE_P; phase_s5_passB(p, bid, Gn); }
    SEAM(4);
    if (IN(5)) {
        PHASE_P;
        typedef pg8::DenseSched<WS_YGB, WS_WGLU, S, SW, SW> Sch; Sch Sd; Sd.init(ws, Gn, bid);
        pg8::EpiGlu E{(const float*)(ws + WS_YG), p.b_glu, (float*)(ws + WS_Z)};
        pg8::gemm_phase<pg8::EpiGlu, Sch>(lds + RING_OFF, Sd, E);
    }
    SEAM(5);
    if (IN(6)) { PHASE_P; phase_mix(p, bid, Gn); }
    SEAM(6);
    if (IN(7)) {
        PHASE_P;
        typedef pg8::DenseSched<WS_YMIXB, WS_WOUT, S, D, D> Sch; Sch Sd; Sd.init(ws, Gn, bid);
        pg8::EpiResid E{p.x, (const float*)(ws + WS_MOD) + 2 * D, (float*)(ws + WS_X1)};
        pg8::gemm_phase<pg8::EpiResid, Sch>(lds + RING_OFF, Sd, E);
    }
    SEAM(7);
    if (IN(8)) { PHASE_P; phase_norm2_router(p, lds, bid, Gn); }
    SEAM(8);
    if (IN(9)) {
        PHASE_P;
        pg8::MoeSched<1> Sm; Sm.init(ws, Gn, bid);
        pg8::EpiMoe1 E{p.b_gu, (bf16_t*)(ws + WS_ACT)};
        pg8::gemm_phase<pg8::EpiMoe1, pg8::MoeSched<1>>(lds + RING_OFF, Sm, E);
    }
    SEAM(9);
    if (IN(10)) {
        PHASE_P;
        pg8::MoeSched<2> Sm; Sm.init(ws, Gn, bid);
        pg8::EpiMoe2 E{p.b_down, ws};
        pg8::gemm_phase<pg8::EpiMoe2, pg8::MoeSched<2>>(lds + RING_OFF, Sm, E);
    }
    SEAM(10);
    if (IN(11)) { PHASE_P; phase_final(p, bid, Gn); }
#undef IN
#undef PHASE_P
#undef SEAM
}

extern "C" void kernel_launch(void* const* d_in, const int* in_sizes, int n_in, void* d_out, int out_size, void* d_ws, size_t ws_size, hipStream_t stream) {
    static int grid = 0;
    if (grid == 0) {
        if (n_in != 27 || ws_size < WS_END) { fprintf(stderr, "kernel_launch: unexpected n_in %d or ws_size %zu (< %zu)\n", n_in, ws_size, (size_t)WS_END); grid = -1; return; }
        int dev = 0, cus = 0;
        if (hipGetDevice(&dev) != hipSuccess || hipDeviceGetAttribute(&cus, hipDeviceAttributeMultiprocessorCount, dev) != hipSuccess) { grid = -1; return; }
        if (hipFuncSetAttribute((const void*)mk_fwd, hipFuncAttributeMaxDynamicSharedMemorySize, LDS_BYTES) != hipSuccess) { fprintf(stderr, "hipFuncSetAttribute failed\n"); grid = -1; return; }
        grid = cus;
    }
    if (grid < 0) return;
    Args a{};
    const float** f = (const float**)&a.p;
    for (int i = 0; i < 27; ++i) f[i] = (const float*)d_in[i];
    a.p.out = (float*)d_out; a.p.ws = (unsigned char*)d_ws;
    (void)hipMemsetAsync(a.p.ws + WS_CTL, 0, 1 * MiB, stream);
#ifndef MK_PER_PHASE
    a.ph_lo = 0; a.ph_hi = 12; hipLaunchKernelGGL(mk_fwd, dim3(grid), dim3(NWAVES * 64), LDS_BYTES, stream, a);
#else
    for (int ph = 0; ph < 12; ++ph) { a.ph_lo = ph; a.ph_hi = ph + 1; hipLaunchKernelGGL(mk_fwd, dim3(grid), dim3(NWAVES * 64), LDS_BYTES, stream, a); }
#endif
}
```

```cpp
#include <hip/hip_runtime.h>
#include <cstdio>
#include <cstdint>

constexpr int S = 16384, D = 2048, AW = 1024, SW = 1024, INW = 4096, NH = 16, HD = 64;
constexpr int G = 64, NS = 64, PC = 16;
constexpr int NE = 32, TOPK = 4, FF = 2048;
constexpr int LCH = 32, NCH = S / LCH;
constexpr int CROWS = 40;
constexpr int KS5 = 640, KS5E = 512;
constexpr int NASSIGN = S * TOPK;
constexpr int PADROWS = NASSIGN + NE * 256;
constexpr float EPS = 1e-6f;

constexpr size_t MiB = 1ull << 20;
constexpr size_t WS_CTL = 0;
constexpr size_t WS_MOD = 1 * MiB;
constexpr size_t WS_S5P = 2 * MiB;
constexpr size_t WS_IDX = 4 * MiB;
constexpr size_t WS_GATE = 5 * MiB;
constexpr size_t WS_SLOT = 6 * MiB;
constexpr size_t WS_LIST = 8 * MiB;
constexpr size_t WS_ECH = 12 * MiB;
constexpr size_t WS_X0 = 16 * MiB;
constexpr size_t WS_WIN = 32 * MiB;
constexpr size_t WS_WGLU = 48 * MiB;
constexpr size_t WS_WOUT = 50 * MiB;
constexpr size_t WS_HB = 64 * MiB;
constexpr size_t WS_PROJ = 128 * MiB;
constexpr size_t WS_QKV = WS_PROJ;
constexpr size_t WS_UB2 = WS_PROJ + 96 * MiB;
constexpr size_t WS_OB = WS_PROJ + 160 * MiB;
constexpr size_t WS_LSE = 20 * MiB;
constexpr size_t WS_YATT = WS_PROJ + 256 * MiB;
constexpr size_t WS_S5E = WS_YATT;
constexpr size_t WS_EF = WS_YATT + 16 * MiB;
constexpr size_t WS_YG = WS_YATT + 64 * MiB;
constexpr size_t WS_S5T = WS_YG;
constexpr size_t WS_YGB = WS_YG + 64 * MiB;
constexpr size_t WS_Z = WS_YGB + 32 * MiB;
constexpr size_t WS_YMIXB = WS_Z + 64 * MiB;
constexpr size_t WS_X1 = WS_YMIXB + 64 * MiB;
constexpr size_t WS_H2 = WS_X1 + 128 * MiB;
constexpr size_t WS_ACT = WS_H2 + 128 * MiB;
constexpr size_t WS_YA = WS_ACT + 288 * MiB;
constexpr size_t WS_WGU = WS_YA + 288 * MiB;
constexpr size_t WS_WDN = WS_WGU + 512 * MiB;
constexpr size_t WS_END = WS_WDN + 256 * MiB;

struct P {
    const float *x, *c, *w_ada, *b_ada, *norm1_g, *w_in, *lam_re, *lam_im, *b_re, *b_im, *c_re, *c_im, *d_skip, *log_dt,
        *w_glu, *b_glu, *attn_g, *ssm_g, *w_out, *norm2_g, *w_router, *b_router, *w_gu, *b_gu, *w_down, *b_down, *final_g;
    float* out;
    unsigned char* ws;
};
struct Args { P p; int ph_lo, ph_hi; };

#define GAS __attribute__((address_space(1)))
#define LAS __attribute__((address_space(3)))
typedef unsigned short bf16_t;
typedef short bf16x8 __attribute__((ext_vector_type(8)));
typedef float f32x4 __attribute__((ext_vector_type(4)));
typedef float f32x2 __attribute__((ext_vector_type(2)));
typedef unsigned u32x4 __attribute__((ext_vector_type(4)));
typedef unsigned u32x2 __attribute__((ext_vector_type(2)));

__device__ __forceinline__ float wave_sum(float v) {
#pragma unroll
    for (int o = 1; o < 64; o <<= 1) v += __shfl_xor(v, o);
    return v;
}
__device__ __forceinline__ float block_sum256(float v, float* red) {
    v = wave_sum(v);
    __syncthreads();
    if ((threadIdx.x & 63) == 0) red[threadIdx.x >> 6] = v;
    __syncthreads();
    return red[0] + red[1] + red[2] + red[3];
}
__device__ __forceinline__ float sigmoidf_(float x) { return __builtin_amdgcn_rcpf(1.0f + __builtin_amdgcn_exp2f(-1.4426950408889634f * x)); }
__device__ __forceinline__ unsigned cvt_pk_bf16(float lo, float hi) { unsigned r; asm volatile("v_cvt_pk_bf16_f32 %0, %1, %2" : "=v"(r) : "v"(lo), "v"(hi)); return r; }
__device__ __forceinline__ float bf2f(bf16_t b) { return __uint_as_float(((unsigned)b) << 16); }
__device__ __forceinline__ bf16_t f2bf(float f) { return (bf16_t)(cvt_pk_bf16(f, 0.f) & 0xffffu); }
__device__ __forceinline__ int otid() { int t = threadIdx.x; asm volatile("" : "+v"(t)); return t; }

namespace pg8 {
constexpr int BM = 256, BK = 64, HALF = 128, HTB = HALF * BK * 2  , STAGE_BYTES = 8 * HTB, NXCD = 8, WGM = 8;
__host__ __device__ __forceinline__ int lds_byte(int r, int c) { const int st = (r >> 4) * 2 + (c >> 5), rr = r & 15, cc = c & 31, ob = rr * 64 + cc * 2; return st * 1024 + (ob ^ (((ob >> 9) & 1) << 5)); }
__host__ __device__ __forceinline__ void stage_rc(int b, int& R, int& C) { const int st = b / 1024, sb = b % 1024, swz = sb ^ (((sb >> 9) & 1) << 5); R = (st >> 1) * 16 + swz / 64; C = (st & 1) * 32 + (swz % 64) / 2; }
__host__ __device__ __forceinline__ int perm32(int rho) { const int n = rho >> 4, i = rho & 15; return 8 * (i >> 2) + 4 * n + (i & 3); }

struct Unit { int pm, pn, e, mt; };

__device__ __forceinline__ bool flat_to_tile(long L, int nM, int nN, int& pm, int& pn) {
    const int nwg = nM * nN; if (L >= nwg) return false;
    int wgid = (int)L; { const int q = nwg / NXCD, r = nwg % NXCD, xcd = wgid % NXCD, off = wgid / NXCD; wgid = (xcd < r ? xcd * (q + 1) : r * (q + 1) + (xcd - r) * q) + off; }
    const int nig = WGM * nN, gid = wgid / nig, fm = gid * WGM, gsz = (nM - fm) < WGM ? (nM - fm) : WGM;
    pm = fm + ((wgid % nig) % gsz); pn = (wgid % nig) / gsz; return true;
}

template <size_t AOFF, size_t BOFF, int M_, int N_, int K_>
struct DenseSched {
    static constexpr bool GATHER = false;
    static constexpr int K = K_, nM = M_ / BM, nN = N_ / BM, KSTEP_A = 128;
    const unsigned char* ws; int Gn, c;
    __device__ void init(const unsigned char* ws_, int G_, int c_) { ws = ws_; Gn = G_; c = c_; }
    __device__ __forceinline__ bool next(int i, Unit& u) const { u.e = 0; u.mt = 0; return flat_to_tile((long)i * Gn + c, nM, nN, u.pm, u.pn); }
    __device__ __forceinline__ const char* a_ptr(const Unit& u) const { return (const char*)ws + AOFF + (size_t)u.pm * BM * K * 2; }
    __device__ __forceinline__ const char* b_ptr(const Unit& u) const { return (const char*)ws + BOFF + (size_t)u.pn * BM * K * 2; }
    __device__ __forceinline__ void a_off(const Unit&, unsigned (&off)[2][2]) const {
        const int tid = otid();
#pragma unroll
        for (int i = 0; i < 2; ++i) { int R, C; stage_rc(tid * 16 + i * 8192, R, C);
#pragma unroll
            for (int h = 0; h < 2; ++h) off[h][i] = (unsigned)((h * HALF + R) * K + C) * 2u; }
    }
};

template <int STAGE>
struct MoeSched {
    static constexpr bool GATHER = (STAGE == 1);
    static constexpr int K = (STAGE == 1) ? D : FF, N = (STAGE == 1) ? 2 * FF : D, nN = N / BM, KSTEP_A = 128;
    static constexpr size_t AOFF = (STAGE == 1) ? WS_HB : WS_ACT, BOFF = (STAGE == 1) ? WS_WGU : WS_WDN;
    const unsigned char* ws; int nM, Gn, c;
    __device__ void init(const unsigned char* ws_, int G_, int c_) {
        ws = ws_; Gn = G_; c = c_;
        const int* cnt = (const int*)(ws + WS_CTL);
        int t = 0; for (int j = 0; j < NE; ++j) t += (cnt[j] + 255) >> 8; nM = __builtin_amdgcn_readfirstlane(t);
    }
    __device__ __forceinline__ bool next(int i, Unit& u) const {
        if (!flat_to_tile((long)i * Gn + c, nM, nN, u.pm, u.pn)) return false;
        const int* cnt = (const int*)(ws + WS_CTL);
        int acc = 0, e = 0, mt = 0;
        for (int j = 0; j < NE; ++j) { const int nt = (cnt[j] + 255) >> 8; if (u.pm >= acc && u.pm < acc + nt) { e = j; mt = u.pm - acc; } acc += nt; }
        u.e = __builtin_amdgcn_readfirstlane(e); u.mt = __builtin_amdgcn_readfirstlane(mt); return true;
    }
    __device__ __forceinline__ const char* a_ptr(const Unit& u) const { return (STAGE == 1) ? (const char*)ws + AOFF : (const char*)ws + AOFF + (size_t)u.pm * BM * K * 2; }
    __device__ __forceinline__ const char* b_ptr(const Unit& u) const { return (const char*)ws + BOFF + ((size_t)u.e * N + (size_t)u.pn * BM) * K * 2; }
    __device__ __forceinline__ void a_off(const Unit& u, unsigned (&off)[2][2]) const {
        const int tid = otid();
        if (STAGE == 1) {
            const int* cnt = (const int*)(ws + WS_CTL); const int* list = (const int*)(ws + WS_LIST);
            const int ce = __builtin_amdgcn_readfirstlane(cnt[u.e]);
#pragma unroll
            for (int i = 0; i < 2; ++i) { int R, C; stage_rc(tid * 16 + i * 8192, R, C);
#pragma unroll
                for (int h = 0; h < 2; ++h) { int lr = u.mt * BM + h * HALF + R; lr = lr < ce ? lr : ce - 1; const int tok = list[(size_t)u.e * S + lr] >> 2; off[h][i] = (unsigned)(tok * K + C) * 2u; } }
        } else {
#pragma unroll
            for (int i = 0; i < 2; ++i) { int R, C; stage_rc(tid * 16 + i * 8192, R, C);
#pragma unroll
                for (int h = 0; h < 2; ++h) off[h][i] = (unsigned)((h * HALF + R) * K + C) * 2u; }
        }
    }
};

template <int MODE>
struct S5Sched {
    static constexpr bool GATHER = true;
    static constexpr int K = MODE ? KS5 : KS5E, KSTEP_A = 4 * 1024 * 2, NCT = MODE ? 2 : 1, NUNITS = G * 2 * NCT;
    const unsigned char* ws; int Gn, c;
    __device__ void init(const unsigned char* ws_, int G_, int c_) { ws = ws_; Gn = G_; c = c_; }
    __device__ __forceinline__ bool next(int i, Unit& u) const {
        const int L = i * Gn + c; if (L >= NUNITS) return false;
        u.e = L / (2 * NCT); const int rem = L % (2 * NCT); u.pm = rem / NCT; u.pn = rem % NCT; u.mt = 0; return true;
    }
    __device__ __forceinline__ const char* a_ptr(const Unit& u) const { return (const char*)ws + WS_UB2 + (size_t)u.e * (PC * 2); }
    __device__ __forceinline__ const char* b_ptr(const Unit& u) const { return (const char*)ws + (MODE ? WS_S5T : WS_S5E) + ((size_t)u.e * (MODE ? 512 : 256) + (size_t)u.pn * BM) * K * 2; }
    __device__ __forceinline__ void a_off(const Unit& u, unsigned (&off)[2][2]) const {
        const int tid = otid();
#pragma unroll
        for (int i = 0; i < 2; ++i) { int R, C; stage_rc(tid * 16 + i * 8192, R, C);
#pragma unroll
            for (int h = 0; h < 2; ++h) off[h][i] = (unsigned)(((u.pm * BM + h * HALF + R) * CROWS + (C >> 4)) * 2048 + (C & 15) * 2); }
    }
};

template <class Epi, class Sched>
__device__ __forceinline__ void gemm_phase(LAS unsigned char* lds, const Sched& S, const Epi& E) {
    const int tid = otid(), wid = __builtin_amdgcn_readfirstlane(tid >> 6), lane = tid & 63, wr = wid >> 2, wc = wid & 3, fr = lane & 15, fq = lane >> 4;
    constexpr int K = Sched::K, nt = K / BK;
    unsigned voffB[2];
#pragma unroll
    for (int i = 0; i < 2; ++i) { int sR, sC; stage_rc(tid * 16 + i * 8192, sR, sC); const int Rb = Epi::PERM ? ((sR & ~31) + perm32(sR & 31)) : sR; voffB[i] = (unsigned)(Rb * K + sC) * 2u; }
    const size_t kstep = (size_t)(BK * 2);
    constexpr size_t kstepA = (size_t)Sched::KSTEP_A;
    const size_t hstep = (size_t)HALF * K * 2;
    const unsigned ldsw = (unsigned)wid * 1024u;
    const int aoff = lds_byte(wr * 64 + fr, fq * 8), boff = lds_byte(wc * 32 + fr, fq * 8);
#define PG8_SA(b, h) (((b) * 2 + (h)) * HTB)
#define PG8_SB(b, h) ((4 + (b) * 2 + (h)) * HTB)
#define PG8_STAGE(bufoff, gbase, voff) do { _Pragma("unroll") for (int _i = 0; _i < 2; ++_i) \
        __builtin_amdgcn_global_load_lds((const unsigned*)((const char*)(gbase) + (voff)[_i]), (LAS unsigned*)(lds + (bufoff) + ldsw + _i * 8192), 16, 0, 0); } while (0)
#define PG8_LDA(dst, b, h) do { _Pragma("unroll") for (int m = 0; m < 4; ++m) _Pragma("unroll") for (int k = 0; k < 2; ++k) dst[m][k] = *(const LAS bf16x8*)(lds + PG8_SA(b, h) + aoff + m * 2048 + k * 1024); } while (0)
#define PG8_LDB(dst, b, h) do { _Pragma("unroll") for (int n = 0; n < 2; ++n) _Pragma("unroll") for (int k = 0; k < 2; ++k) dst[n][k] = *(const LAS bf16x8*)(lds + PG8_SB(b, h) + boff + n * 2048 + k * 1024); } while (0)
#define PG8_MMA(ai, bj, At, Bt) do { __builtin_amdgcn_s_setprio(1); _Pragma("unroll") for (int m = 0; m < 4; ++m) _Pragma("unroll") for (int n = 0; n < 2; ++n) _Pragma("unroll") for (int k = 0; k < 2; ++k) \
        acc[ai][bj][m][n] = __builtin_amdgcn_mfma_f32_16x16x32_bf16(Bt[n][k], At[m][k], acc[ai][bj][m][n], 0, 0, 0); __builtin_amdgcn_s_setprio(0); } while (0)
#define PG8_WAIT_V(n) asm volatile("s_waitcnt vmcnt(" #n ")" ::: "memory")
#define PG8_WAIT_L(n) asm volatile("s_waitcnt lgkmcnt(" #n ")" ::: "memory")
#define PG8_BAR __builtin_amdgcn_s_barrier()
#define PG8_SCHED __builtin_amdgcn_sched_barrier(0)
    Unit cur, nxt; int ui = 0;
    if (!S.next(0, cur)) return;
    f32x4 acc[2][2][4][2];
#pragma unroll
    for (int a = 0; a < 2; ++a)
#pragma unroll
        for (int b = 0; b < 2; ++b)
#pragma unroll
            for (int m = 0; m < 4; ++m)
#pragma unroll
                for (int n = 0; n < 2; ++n) acc[a][b][m][n] = (f32x4){0.f, 0.f, 0.f, 0.f};
    bf16x8 At[4][2], B0[2][2], B1[2][2];
    const char* cA = S.a_ptr(cur); const char* cB = S.b_ptr(cur);
    unsigned ao[2][2]; S.a_off(cur, ao);
    PG8_STAGE(PG8_SB(0, 0), cB, voffB); PG8_STAGE(PG8_SB(0, 1), cB + hstep, voffB); PG8_STAGE(PG8_SA(0, 0), cA, ao[0]); PG8_STAGE(PG8_SA(0, 1), cA, ao[1]);
    if (wr == 1) PG8_BAR;
    PG8_WAIT_V(2); PG8_BAR;
    PG8_STAGE(PG8_SB(1, 0), cB + kstep, voffB); PG8_STAGE(PG8_SA(1, 0), cA + kstepA, ao[0]); PG8_STAGE(PG8_SB(1, 1), cB + hstep + kstep, voffB);
    PG8_WAIT_V(6); PG8_BAR;
    for (;;) {
        const bool has_next = S.next(ui + 1, nxt);
        const char* nA = has_next ? S.a_ptr(nxt) : cA; const char* nB = has_next ? S.b_ptr(nxt) : cB;
        for (int t = 0; t < nt; t += 2) {
            const bool last = (t == nt - 2);
            const char* a1 = cA + (size_t)(t + 1) * kstepA;
            const char* a2 = last ? nA : cA + (size_t)(t + 2) * kstepA; const char* b2 = last ? nB : cB + (size_t)(t + 2) * kstep;
            const char* a3 = a2 + kstepA; const char* b3 = b2 + kstep;

            PG8_LDB(B0, 0, 0); PG8_LDB(B1, 0, 1); PG8_SCHED; PG8_LDA(At, 0, 0); PG8_STAGE(PG8_SA(1, 1), a1, ao[1]);
            PG8_WAIT_V(8); PG8_WAIT_L(0); PG8_BAR; PG8_MMA(0, 0, At, B0); PG8_MMA(0, 1, At, B1); PG8_BAR; PG8_SCHED;
            if (Sched::GATHER) { if (last && has_next) S.a_off(nxt, ao); }
            PG8_LDA(At, 0, 1); PG8_STAGE(PG8_SB(0, 0), b2, voffB); PG8_STAGE(PG8_SB(0, 1), b2 + hstep, voffB); PG8_STAGE(PG8_SA(0, 0), a2, ao[0]);
            PG8_WAIT_V(8); PG8_WAIT_L(0); PG8_BAR; PG8_MMA(1, 0, At, B0); PG8_MMA(1, 1, At, B1); PG8_BAR; PG8_SCHED;
            PG8_LDB(B0, 1, 0); PG8_LDB(B1, 1, 1); PG8_SCHED; PG8_LDA(At, 1, 0); PG8_STAGE(PG8_SA(0, 1), a2, ao[1]);
            PG8_WAIT_V(8); PG8_WAIT_L(0); PG8_BAR; PG8_MMA(0, 0, At, B0); PG8_MMA(0, 1, At, B1); PG8_BAR; PG8_SCHED;
            PG8_LDA(At, 1, 1); PG8_STAGE(PG8_SB(1, 0), b3, voffB); PG8_STAGE(PG8_SB(1, 1), b3 + hstep, voffB); PG8_STAGE(PG8_SA(1, 0), a3, ao[0]);
            PG8_WAIT_V(8); PG8_WAIT_L(0); PG8_BAR; PG8_MMA(1, 0, At, B0); PG8_MMA(1, 1, At, B1); PG8_BAR; PG8_SCHED;
        }
        if (wr == 0) PG8_BAR;
        E(acc, cur, wr, wc, fr, fq);
        if (!has_next) break;
#pragma unroll
        for (int a = 0; a < 2; ++a)
#pragma unroll
            for (int b = 0; b < 2; ++b)
#pragma unroll
                for (int m = 0; m < 4; ++m)
#pragma unroll
                    for (int n = 0; n < 2; ++n) acc[a][b][m][n] = (f32x4){0.f, 0.f, 0.f, 0.f};
        cur = nxt; cA = nA; cB = nB; ++ui;
        if (wr == 1) PG8_BAR;
    }
    PG8_WAIT_V(0);
    PG8_BAR;
#undef PG8_SA
#undef PG8_SB
#undef PG8_STAGE
#undef PG8_LDA
#undef PG8_LDB
#undef PG8_MMA
#undef PG8_WAIT_V
#undef PG8_WAIT_L
#undef PG8_BAR
#undef PG8_SCHED
}

struct EpiF32 {
    static constexpr bool PERM = false;
    float* C; int ldc;
    __device__ __forceinline__ void operator()(const f32x4 (&acc)[2][2][4][2], const Unit& u, int wr, int wc, int fr, int fq) const {
        const int row0 = u.pm * BM + wr * 64 + fr, col0 = u.pn * BM + wc * 32 + 4 * fq;
#pragma unroll
        for (int ai = 0; ai < 2; ++ai)
#pragma unroll
            for (int m = 0; m < 4; ++m) { float* rowp = C + (size_t)(row0 + ai * HALF + m * 16) * ldc + col0;
#pragma unroll
                for (int bj = 0; bj < 2; ++bj)
#pragma unroll
                    for (int n = 0; n < 2; ++n) *(f32x4*)(rowp + bj * HALF + n * 16) = acc[ai][bj][m][n]; }
    }
};
struct EpiGlu {
    static constexpr bool PERM = false;
    const bf16_t* yg; const float* bias; float* Z;
    __device__ __forceinline__ void operator()(const f32x4 (&acc)[2][2][4][2], const Unit& u, int wr, int wc, int fr, int fq) const {
        const int row0 = u.pm * BM + wr * 64 + fr, col0 = u.pn * BM + wc * 32 + 4 * fq;
#pragma unroll
        for (int ai = 0; ai < 2; ++ai)
#pragma unroll
            for (int m = 0; m < 4; ++m) { const size_t ro = (size_t)(row0 + ai * HALF + m * 16) * SW + col0;
#pragma unroll
                for (int bj = 0; bj < 2; ++bj)
#pragma unroll
                    for (int n = 0; n < 2; ++n) { const int co = bj * HALF + n * 16; const u32x2 yb = *(const u32x2*)(yg + ro + co); const f32x4 y = (f32x4){__uint_as_float(yb.x << 16), __uint_as_float(yb.x & 0xffff0000u), __uint_as_float(yb.y << 16), __uint_as_float(yb.y & 0xffff0000u)};
                        const f32x4 b = *(const f32x4*)(bias + col0 + co); f32x4 o;
#pragma unroll
                        for (int j = 0; j < 4; ++j) o[j] = y[j] * sigmoidf_(acc[ai][bj][m][n][j] + b[j]);
                        *(f32x4*)(Z + ro + co) = o; } }
    }
};
struct EpiResid {
    static constexpr bool PERM = false;
    const float* x; const float* gate; float* X1;
    __device__ __forceinline__ void operator()(const f32x4 (&acc)[2][2][4][2], const Unit& u, int wr, int wc, int fr, int fq) const {
        const int row0 = u.pm * BM + wr * 64 + fr, col0 = u.pn * BM + wc * 32 + 4 * fq;
#pragma unroll
        for (int ai = 0; ai < 2; ++ai)
#pragma unroll
            for (int m = 0; m < 4; ++m) { const size_t ro = (size_t)(row0 + ai * HALF + m * 16) * D + col0;
#pragma unroll
                for (int bj = 0; bj < 2; ++bj)
#pragma unroll
                    for (int n = 0; n < 2; ++n) { const int co = bj * HALF + n * 16; const f32x4 xv = *(const f32x4*)(x + ro + co); const f32x4 g = *(const f32x4*)(gate + col0 + co);
                        *(f32x4*)(X1 + ro + co) = xv + g * acc[ai][bj][m][n]; } }
    }
};
struct EpiMoe1 {
    static constexpr bool PERM = true;
    const float* b_gu; bf16_t* ACT;
    __device__ __forceinline__ void operator()(const f32x4 (&acc)[2][2][4][2], const Unit& u, int wr, int wc, int fr, int fq) const {
        const int row0 = u.pm * BM + wr * 64 + fr, j0 = u.pn * HALF + wc * 32 + 8 * fq;
        const float* bias = b_gu + (size_t)u.e * 2 * FF + 2 * j0;
        float bg[8], bl[8];
#pragma unroll
        for (int j = 0; j < 8; ++j) { bg[j] = bias[2 * j]; bl[j] = bias[2 * j + 1]; }
#pragma unroll
        for (int ai = 0; ai < 2; ++ai)
#pragma unroll
            for (int m = 0; m < 4; ++m) { bf16_t* rowp = ACT + (size_t)(row0 + ai * HALF + m * 16) * FF + j0; float o[8];
#pragma unroll
                for (int n = 0; n < 2; ++n)
#pragma unroll
                    for (int j = 0; j < 4; ++j) { const float gl = fminf(acc[ai][0][m][n][j] + bg[4 * n + j], 7.0f); const float ln = fminf(fmaxf(acc[ai][1][m][n][j] + bl[4 * n + j], -7.0f), 7.0f);
                        o[4 * n + j] = gl * sigmoidf_(1.702f * gl) * (ln + 1.0f); }
                u32x4 w; w.x = cvt_pk_bf16(o[0], o[1]); w.y = cvt_pk_bf16(o[2], o[3]); w.z = cvt_pk_bf16(o[4], o[5]); w.w = cvt_pk_bf16(o[6], o[7]);
                *(u32x4*)rowp = w; }
    }
};
struct EpiMoe2 {
    static constexpr bool PERM = true;
    const float* b_down; const unsigned char* ws;
    __device__ __forceinline__ void operator()(const f32x4 (&acc)[2][2][4][2], const Unit& u, int wr, int wc, int fr, int fq) const {
        const int lr0 = u.mt * BM + wr * 64 + fr, row0 = u.pm * BM + wr * 64 + fr, col0 = u.pn * BM + wc * 32 + 8 * fq;
        const int* cnt = (const int*)(ws + WS_CTL); const int* list = (const int*)(ws + WS_LIST); const float* gate = (const float*)(ws + WS_GATE); bf16_t* YA = (bf16_t*)(ws + WS_YA);
        const int ce = __builtin_amdgcn_readfirstlane(cnt[u.e]);
        f32x4 bv[2][2];
#pragma unroll
        for (int bj = 0; bj < 2; ++bj)
#pragma unroll
            for (int n = 0; n < 2; ++n) bv[bj][n] = *(const f32x4*)(b_down + (size_t)u.e * D + col0 + bj * HALF + 4 * n);
#pragma unroll
        for (int ai = 0; ai < 2; ++ai)
#pragma unroll
            for (int m = 0; m < 4; ++m) { const int lr = lr0 + ai * HALF + m * 16; float g = 0.f; if (lr < ce) g = gate[list[(size_t)u.e * S + lr]];
                bf16_t* rowp = YA + (size_t)(row0 + ai * HALF + m * 16) * D + col0;
#pragma unroll
                for (int bj = 0; bj < 2; ++bj) { const f32x4 v0 = (acc[ai][bj][m][0] + bv[bj][0]) * g, v1 = (acc[ai][bj][m][1] + bv[bj][1]) * g;
                    u32x4 w; w.x = cvt_pk_bf16(v0[0], v0[1]); w.y = cvt_pk_bf16(v0[2], v0[3]); w.z = cvt_pk_bf16(v1[0], v1[1]); w.w = cvt_pk_bf16(v1[2], v1[3]);
                    *(u32x4*)(rowp + bj * HALF) = w; } }
    }
};
struct EpiS5E {
    static constexpr bool PERM = false;
    float* EF;
    __device__ __forceinline__ void operator()(const f32x4 (&acc)[2][2][4][2], const Unit& u, int wr, int wc, int fr, int fq) const {
        const int row0 = u.pm * BM + wr * 64 + fr, col0 = wc * 32 + 4 * fq;
#pragma unroll
        for (int ai = 0; ai < 2; ++ai)
#pragma unroll
            for (int m = 0; m < 4; ++m) { float* rowp = EF + ((size_t)u.e * NCH + row0 + ai * HALF + m * 16) * 128 + col0;
#pragma unroll
                for (int n = 0; n < 2; ++n) *(f32x4*)(rowp + n * 16) = acc[ai][0][m][n]; }
    }
};
struct EpiS5Y {
    static constexpr bool PERM = true;
    bf16_t* YGB;
    __device__ __forceinline__ void operator()(const f32x4 (&acc)[2][2][4][2], const Unit& u, int wr, int wc, int fr, int fq) const {
        const int c0 = u.pm * BM + wr * 64 + fr;
#pragma unroll
        for (int ai = 0; ai < 2; ++ai)
#pragma unroll
            for (int m = 0; m < 4; ++m) { const int c = c0 + ai * HALF + m * 16;
#pragma unroll
                for (int bj = 0; bj < 2; ++bj) { const int np = u.pn * BM + bj * HALF + wc * 32 + 8 * fq, i = np >> 4, p0 = np & 15; float o[8];
#pragma unroll
                    for (int n = 0; n < 2; ++n)
#pragma unroll
                        for (int j = 0; j < 4; ++j) { const float y = acc[ai][bj][m][n][j]; const float uu = 0.7978845608028654f * (y + 0.044715f * y * y * y);
                            o[4 * n + j] = y * __builtin_amdgcn_rcpf(1.0f + __builtin_amdgcn_exp2f(-2.885390081777927f * uu)); }
                    u32x4 w; w.x = cvt_pk_bf16(o[0], o[1]); w.y = cvt_pk_bf16(o[2], o[3]); w.z = cvt_pk_bf16(o[4], o[5]); w.w = cvt_pk_bf16(o[6], o[7]);
                    *(u32x4*)(YGB + (size_t)(c * LCH + i) * SW + u.e * PC + p0) = w; } }
    }
};
struct EpiProj {
    static constexpr bool PERM = false;
    bf16_t* QKV; bf16_t* UB2;
    __device__ __forceinline__ void operator()(const f32x4 (&acc)[2][2][4][2], const Unit& u, int wr, int wc, int fr, int fq) const {
        const int row0 = u.pm * BM + wr * 64 + fr, col0 = u.pn * BM + wc * 32 + 4 * fq;
        if (u.pn < 12) {
            const float sc = (u.pn < 4) ? 0.125f : 1.0f;
#pragma unroll
            for (int ai = 0; ai < 2; ++ai)
#pragma unroll
                for (int m = 0; m < 4; ++m) { bf16_t* rowp = QKV + (size_t)(row0 + ai * HALF + m * 16) * (3 * AW) + col0;
#pragma unroll
                    for (int bj = 0; bj < 2; ++bj)
#pragma unroll
                        for (int n = 0; n < 2; ++n) { const f32x4 v = acc[ai][bj][m][n] * sc; u32x2 w; w.x = cvt_pk_bf16(v[0], v[1]); w.y = cvt_pk_bf16(v[2], v[3]); *(u32x2*)(rowp + bj * HALF + n * 16) = w; } }
        } else {
#pragma unroll
            for (int ai = 0; ai < 2; ++ai)
#pragma unroll
                for (int m = 0; m < 4; ++m) { const int t = row0 + ai * HALF + m * 16; bf16_t* rowp = UB2 + (size_t)((t >> 5) * CROWS + (t & 31)) * SW + (col0 - 3 * AW);
#pragma unroll
                    for (int bj = 0; bj < 2; ++bj)
#pragma unroll
                        for (int n = 0; n < 2; ++n) { const f32x4 v = acc[ai][bj][m][n]; u32x2 w; w.x = cvt_pk_bf16(v[0], v[1]); w.y = cvt_pk_bf16(v[2], v[3]); *(u32x2*)(rowp + bj * HALF + n * 16) = w; } }
        }
    }
};
}

constexpr int NWAVES = 8;
constexpr int LDS_BYTES = 147456;
constexpr int RING_OFF = 0;
typedef short s16x4 __attribute__((ext_vector_type(4)));
typedef float f32x16 __attribute__((ext_vector_type(16)));

template <bool DEINT>
__device__ __forceinline__ void convert_tile(const float* W, int K, int N, bf16_t* WT, int tk, int tn, LAS float* scr) {
    const int tid = otid(), k0 = tk * 64, n0 = tn * 256;
    __syncthreads();
#pragma unroll
    for (int j = 0; j < 8; ++j) { const int k = j * 8 + (tid >> 6), g = tid & 63;
        const f32x4 v = *(const f32x4*)(W + (size_t)(k0 + k) * N + n0 + 4 * g);
        *(LAS f32x4*)(scr + k * 256 + ((g ^ j) << 2)) = v; }
    __syncthreads();
#pragma unroll
    for (int jj = 0; jj < 4; ++jj) { const int n = jj * 64 + (tid >> 3), c = tid & 7; float v[8];
#pragma unroll
        for (int q = 0; q < 8; ++q) v[q] = scr[(8 * c + q) * 256 + ((((n >> 2) ^ c)) << 2) + (n & 3)];
        u32x4 o; o.x = cvt_pk_bf16(v[0], v[1]); o.y = cvt_pk_bf16(v[2], v[3]); o.z = cvt_pk_bf16(v[4], v[5]); o.w = cvt_pk_bf16(v[6], v[7]);
        int row = n0 + n;
        if (DEINT) { const int s = n & 1, jl = n >> 1; row = n0 + s * 128 + jl; }
        *(u32x4*)(WT + (size_t)row * K + k0 + 8 * c) = o; }
}

__device__ __forceinline__ void phase_s5_tables(const P& p, LAS unsigned char* lds, int g);
__device__ __forceinline__ void phase_prologue(const P& p, LAS unsigned char* lds, int bid, int Gn) {
    unsigned char* ws = p.ws;
    const int tid = otid();
    if (bid < 192) {
        LAS f32x4* red = (LAS f32x4*)lds;
        const int cq = tid & 15, rg = tid >> 4;
        f32x4 acc = (f32x4){0.f, 0.f, 0.f, 0.f};
        for (int it = 0; it < 64; ++it) { const int i = rg + 32 * it; const float cv = p.c[i]; const float sv = cv / (1.0f + expf(-cv));
            const f32x4 w = *(const f32x4*)(p.w_ada + (size_t)i * 6 * D + 64 * bid + 4 * cq); acc += w * sv; }
        red[rg * 16 + cq] = acc;
        __syncthreads();
        if (tid < 64) { const LAS float* rf = (const LAS float*)lds; float s = p.b_ada[64 * bid + tid];
            for (int r = 0; r < 32; ++r) s += rf[r * 64 + tid];
            ((float*)(ws + WS_MOD))[64 * bid + tid] = s; }
    } else phase_s5_tables(p, lds, bid - 192);
    LAS float* scr = (LAS float*)(lds + RING_OFF);
    constexpr int T_IN = 32 * 16, T_GLU = 16 * 4, T_OUT = 32 * 8, T_GU = 32 * 16, T_DN = 32 * 8;
    constexpr int NT = T_IN + T_GLU + T_OUT + NE * (T_GU + T_DN);
    for (int it = bid; it < NT; it += Gn) {
        int r = it;
        if (r < T_IN) { convert_tile<false>(p.w_in, D, INW, (bf16_t*)(ws + WS_WIN), r / 16, r % 16, scr); continue; } r -= T_IN;
        if (r < T_GLU) { convert_tile<false>(p.w_glu, SW, SW, (bf16_t*)(ws + WS_WGLU), r / 4, r % 4, scr); continue; } r -= T_GLU;
        if (r < T_OUT) { convert_tile<false>(p.w_out, D, D, (bf16_t*)(ws + WS_WOUT), r / 8, r % 8, scr); continue; } r -= T_OUT;
        if (r < NE * T_GU) { const int e = r / T_GU, q = r % T_GU; convert_tile<true>(p.w_gu + (size_t)e * D * 2 * FF, D, 2 * FF, (bf16_t*)(ws + WS_WGU) + (size_t)e * 2 * FF * D, q / 16, q % 16, scr); continue; } r -= NE * T_GU;
        { const int e = r / T_DN, q = r % T_DN; convert_tile<false>(p.w_down + (size_t)e * FF * D, FF, D, (bf16_t*)(ws + WS_WDN) + (size_t)e * D * FF, q / 8, q % 8, scr); }
    }
    __syncthreads();
}

__device__ __forceinline__ void phase_norm1(const P& p, int bid, int Gn) {
    const int tid_ = otid(); const int lane = tid_ & 63, gw = bid * NWAVES + (tid_ >> 6), NGW = Gn * NWAVES;
    const float* mod = (const float*)(p.ws + WS_MOD);
    bf16_t* hb = (bf16_t*)(p.ws + WS_HB);
    for (int row = gw; row < S; row += NGW) {
        const f32x4* xr = (const f32x4*)(p.x + (size_t)row * D) + lane;
        f32x4 v[8]; float ss = 0.f;
#pragma unroll
        for (int j = 0; j < 8; ++j) { v[j] = xr[64 * j]; ss += (v[j].x * v[j].x + v[j].y * v[j].y) + (v[j].z * v[j].z + v[j].w * v[j].w); }
        const float rs = 1.0f / sqrtf(wave_sum(ss) * (1.0f / D) + EPS);
#pragma unroll
        for (int j = 0; j < 8; ++j) { const int c0 = 4 * lane + 256 * j;
            const f32x4 g = *(const f32x4*)(p.norm1_g + c0), sc = *(const f32x4*)(mod + D + c0), sh = *(const f32x4*)(mod + c0);
            const f32x4 o = v[j] * rs * g * (sc + 1.0f) + sh;
            u32x2 w; w.x = cvt_pk_bf16(o.x, o.y); w.y = cvt_pk_bf16(o.z, o.w);
            *(u32x2*)(hb + (size_t)row * D + c0) = w; }
    }
}

__device__ __forceinline__ s16x4 tr_read(unsigned lds_addr) { s16x4 r; asm volatile("ds_read_b64_tr_b16 %0, %1\n\ts_waitcnt lgkmcnt(0)" : "=&v"(r) : "v"(lds_addr) : "memory"); return r; }
__device__ __forceinline__ void phase_attn(const P& p, LAS unsigned char* lds, int bid, int Gn) {
    const bf16_t* QKV = (const bf16_t*)(p.ws + WS_QKV);
    bf16_t* OB = (bf16_t*)(p.ws + WS_OB);
    float* LSE = (float*)(p.ws + WS_LSE);
    const int tid = otid(), w = __builtin_amdgcn_readfirstlane(tid >> 6), lane = tid & 63, us = w >> 2, wq = w & 3;
    const int l31 = lane & 31, hh = lane >> 5, i0 = 32 * wq;
    constexpr int RS = 3 * AW;
    LAS unsigned char* vl = lds + us * 32768;
    for (int pr = bid; pr < 3072; pr += Gn) {
        const int u = pr * 2 + us;
        const int b = u >> 11, rem = u & 2047, blk = rem >> 4, h = rem & 15;
        const int dsh = 2 * b, d = 1 << dsh;
        const int n = blk >> dsh, r = blk & (d - 1);
        const int qbase = n * 128 * d + r, kbase = qbase - 128 * d;
#pragma unroll
        for (int it = 0; it < 8; ++it) { const int id = it * 64 + lane, row = 64 * wq + (id >> 3), ch = id & 7; const int kp = kbase + row * d;
            u32x4 v = (u32x4){0u, 0u, 0u, 0u};
            if (kp >= 0) v = *(const u32x4*)(QKV + (size_t)kp * RS + 2 * AW + h * HD + ch * 8);
            *(LAS u32x4*)(vl + row * 128 + ch * 16) = v; }
        const int qp = qbase + (i0 + l31) * d;
        bf16x8 qf[4];
#pragma unroll
        for (int s = 0; s < 4; ++s) qf[s] = *(const bf16x8*)(QKV + (size_t)qp * RS + h * HD + 16 * s + 8 * hh);
        f32x16 sc[5];
#pragma unroll
        for (int kb = 0; kb < 5; ++kb) {
            const int j = i0 + 32 * kb + l31; int kp = kbase + j * d; kp = kp < 0 ? 0 : kp;
            bf16x8 kf[4];
#pragma unroll
            for (int s = 0; s < 4; ++s) kf[s] = *(const bf16x8*)(QKV + (size_t)kp * RS + AW + h * HD + 16 * s + 8 * hh);
            f32x16 a;
#pragma unroll
            for (int e = 0; e < 16; ++e) a[e] = 0.f;
#pragma unroll
            for (int s = 0; s < 4; ++s) a = __builtin_amdgcn_mfma_f32_32x32x16_bf16(kf[s], qf[s], a, 0, 0, 0);
            sc[kb] = a;
        }
        float m = -INFINITY;
#pragma unroll
        for (int kb = 0; kb < 5; ++kb)
#pragma unroll
            for (int e = 0; e < 16; ++e) { const int jrel = 32 * kb + (e & 3) + 8 * (e >> 2) + 4 * hh;
                const bool valid = (jrel >= l31) && (jrel <= l31 + 128) && (n > 0 || (i0 + jrel) >= 128);
                const float sv = valid ? sc[kb][e] : -INFINITY; sc[kb][e] = sv; m = fmaxf(m, sv); }
        m = fmaxf(m, __shfl_xor(m, 32));
        float l = 0.f;
#pragma unroll
        for (int kb = 0; kb < 5; ++kb)
#pragma unroll
            for (int e = 0; e < 16; ++e) { const float pe = __expf(sc[kb][e] - m); sc[kb][e] = pe; l += pe; }
        l += __shfl_xor(l, 32);
        __syncthreads();
        f32x16 o[2];
#pragma unroll
        for (int c = 0; c < 2; ++c)
#pragma unroll
            for (int e = 0; e < 16; ++e) o[c][e] = 0.f;
        const unsigned vbase = (unsigned)(size_t)vl;
        const int q4 = (lane & 15) >> 2, pp = lane & 3, bk = (lane >> 4) & 1;
#pragma unroll
        for (int kb = 0; kb < 5; ++kb)
#pragma unroll
            for (int s2 = 0; s2 < 2; ++s2) {
                u32x4 pw; pw.x = cvt_pk_bf16(sc[kb][8 * s2 + 0], sc[kb][8 * s2 + 1]); pw.y = cvt_pk_bf16(sc[kb][8 * s2 + 2], sc[kb][8 * s2 + 3]);
                pw.z = cvt_pk_bf16(sc[kb][8 * s2 + 4], sc[kb][8 * s2 + 5]); pw.w = cvt_pk_bf16(sc[kb][8 * s2 + 6], sc[kb][8 * s2 + 7]);
                const bf16x8 pf = __builtin_bit_cast(bf16x8, pw);
                const int rowb = i0 + 32 * kb + 16 * s2 + 4 * hh + q4;
#pragma unroll
                for (int c = 0; c < 2; ++c) {
                    const unsigned a0 = vbase + (unsigned)(rowb * 128 + 64 * c + 32 * bk + 8 * pp);
                    const s16x4 v0 = tr_read(a0), v1 = tr_read(a0 + 8 * 128);
                    bf16x8 vf; vf[0] = v0[0]; vf[1] = v0[1]; vf[2] = v0[2]; vf[3] = v0[3]; vf[4] = v1[0]; vf[5] = v1[1]; vf[6] = v1[2]; vf[7] = v1[3];
                    o[c] = __builtin_amdgcn_mfma_f32_32x32x16_bf16(vf, pf, o[c], 0, 0, 0);
                }
            }
        const float inv = 1.0f / l;
        bf16_t* orow = OB + ((size_t)b * S + qp) * AW + h * HD;
#pragma unroll
        for (int c = 0; c < 2; ++c)
#pragma unroll
            for (int rg = 0; rg < 4; ++rg) { u32x2 wv; wv.x = cvt_pk_bf16(o[c][4 * rg] * inv, o[c][4 * rg + 1] * inv); wv.y = cvt_pk_bf16(o[c][4 * rg + 2] * inv, o[c][4 * rg + 3] * inv);
                *(u32x2*)(orow + 32 * c + 8 * rg + 4 * hh) = wv; }
        if (hh == 0) LSE[((size_t)b * S + qp) * NH + h] = m + __logf(l);
        __syncthreads();
    }
}

__device__ __forceinline__ void phase_s5_tables(const P& p, LAS unsigned char* lds, int g) {
    const int tid = otid();
    LAS float* pwr = (LAS float*)lds;
    LAS float* pwi = pwr + 33 * 64;
    LAS float* cre = pwi + 33 * 64;
    LAS float* cim = cre + 1024;
    LAS float* bbr = cim + 1024;
    LAS float* bbi = bbr + 1024;
    LAS float* Mt = bbi + 1024;
    __syncthreads();
    if (tid < NS) {
        const int n = tid, i = g * NS + n;
        const float dt = expf(p.log_dt[g]), lr = p.lam_re[i], li = p.lam_im[i];
        const float mag = expf(lr * dt), ar = mag * cosf(li * dt), ai = mag * sinf(li * dt);
        const float den = lr * lr + li * li, nr = ar - 1.0f, ni = ai;
        const float fr = (nr * lr + ni * li) / den, fi = (ni * lr - nr * li) / den;
        for (int q = 0; q < PC; ++q) { const float br = p.b_re[(size_t)i * PC + q], bi = p.b_im[(size_t)i * PC + q];
            bbr[n * PC + q] = fr * br - fi * bi; bbi[n * PC + q] = fr * bi + fi * br; }
        float xr = 1.0f, xi = 0.0f;
        for (int t = 0; t <= LCH; ++t) { pwr[t * NS + n] = xr; pwi[t * NS + n] = xi; const float yr = xr * ar - xi * ai, yi = xr * ai + xi * ar; xr = yr; xi = yi; }
        float* lamL = (float*)(p.ws + WS_S5P);
        lamL[(g * NS + n) * 2 + 0] = pwr[LCH * NS + n]; lamL[(g * NS + n) * 2 + 1] = pwi[LCH * NS + n];
    }
    for (int k = tid; k < PC * NS; k += NWAVES * 64) { cre[k] = p.c_re[(size_t)g * PC * NS + k]; cim[k] = p.c_im[(size_t)g * PC * NS + k]; }
    __syncthreads();
    for (int k = 0; k < 16; ++k) { const int idx = tid + 512 * k, tau = idx >> 8, pp = (idx >> 4) & 15, q = idx & 15;
        float acc = 0.f;
        for (int n = 0; n < NS; ++n) { const float cr = cre[pp * NS + n], ci = cim[pp * NS + n], pr = pwr[tau * NS + n], pi = pwi[tau * NS + n];
            const float xr = cr * pr - ci * pi, xi = cr * pi + ci * pr; acc += xr * bbr[n * PC + q] - xi * bbi[n * PC + q]; }
        if (tau == 0 && pp == q) acc += p.d_skip[g * PC + pp];
        Mt[idx] = acc; }
    __syncthreads();
    bf16_t* T = (bf16_t*)(p.ws + WS_S5T) + (size_t)g * 512 * KS5;
    for (int k = 0; k < 80; ++k) { const int ch = tid + 512 * k, row = ch / 80, cc = ch % 80, i = row >> 4, pp = row & 15; float v[8];
        if (cc < 64) { const int j = cc >> 1, q0 = (cc & 1) * 8;
#pragma unroll
            for (int e = 0; e < 8; ++e) v[e] = (j <= i) ? Mt[((i - j) * 16 + pp) * 16 + q0 + e] : 0.f;
        } else { const int m0 = (cc - 64) * 8;
#pragma unroll
            for (int e = 0; e < 8; ++e) { const int m = m0 + e, n = m & 63; const float cr = cre[pp * NS + n], ci = cim[pp * NS + n], pr = pwr[(i + 1) * NS + n], pi = pwi[(i + 1) * NS + n];
                v[e] = (m < 64) ? (cr * pr - ci * pi) : -(cr * pi + ci * pr); } }
        u32x4 o; o.x = cvt_pk_bf16(v[0], v[1]); o.y = cvt_pk_bf16(v[2], v[3]); o.z = cvt_pk_bf16(v[4], v[5]); o.w = cvt_pk_bf16(v[6], v[7]);
        *(u32x4*)(T + (size_t)row * KS5 + cc * 8) = o; }
    bf16_t* Eb = (bf16_t*)(p.ws + WS_S5E) + (size_t)g * 256 * KS5E;
    for (int k = 0; k < 32; ++k) { const int ch = tid + 512 * k, row = ch >> 6, cc = ch & 63, j = cc >> 1, q0 = (cc & 1) * 8, n = row & 63; float v[8];
#pragma unroll
        for (int e = 0; e < 8; ++e) { const float pr = pwr[(LCH - 1 - j) * NS + n], pi = pwi[(LCH - 1 - j) * NS + n], br = bbr[n * PC + q0 + e], bi = bbi[n * PC + q0 + e];
            v[e] = (row < 64) ? (pr * br - pi * bi) : ((row < 128) ? (pr * bi + pi * br) : 0.f); }
        u32x4 o; o.x = cvt_pk_bf16(v[0], v[1]); o.y = cvt_pk_bf16(v[2], v[3]); o.z = cvt_pk_bf16(v[4], v[5]); o.w = cvt_pk_bf16(v[6], v[7]);
        *(u32x4*)(Eb + (size_t)row * KS5E + cc * 8) = o; }
    __syncthreads();
}
__device__ __forceinline__ void phase_s5_carry(const P& p, int bid) {
    const int gt = bid * (NWAVES * 64) + otid();
    if (gt >= G * NS) return;
    const int g = gt >> 6, n = gt & 63;
    const float* lamL = (const float*)(p.ws + WS_S5P);
    const float* EF = (const float*)(p.ws + WS_EF) + (size_t)g * NCH * 128;
    bf16_t* UB2 = (bf16_t*)(p.ws + WS_UB2);
    const float lr = lamL[gt * 2], li = lamL[gt * 2 + 1];
    float xr = 0.f, xi = 0.f;
    for (int c0 = 0; c0 < NCH; c0 += 8) {
        float er[8], ei[8];
#pragma unroll
        for (int k = 0; k < 8; ++k) { er[k] = EF[(size_t)(c0 + k) * 128 + n]; ei[k] = EF[(size_t)(c0 + k) * 128 + 64 + n]; }
#pragma unroll
        for (int k = 0; k < 8; ++k) { const int c = c0 + k;
            bf16_t* xrow = UB2 + (size_t)(c * CROWS + LCH + (n >> 4)) * SW + g * PC + (n & 15);
            xrow[0] = f2bf(xr); xrow[4 * SW] = f2bf(xi);
            const float yr = lr * xr - li * xi + er[k], yi = lr * xi + li * xr + ei[k]; xr = yr; xi = yi; }
    }
}

__device__ __forceinline__ void phase_mix(const P& p, int bid, int Gn) {
    const int tid_ = otid(); const int lane = tid_ & 63, gw = bid * NWAVES + (tid_ >> 6), NGW = Gn * NWAVES;
    const bf16_t* OB = (const bf16_t*)(p.ws + WS_OB);
    const float* LSE = (const float*)(p.ws + WS_LSE);
    const float* Z = (const float*)(p.ws + WS_Z);
    bf16_t* YM = (bf16_t*)(p.ws + WS_YMIXB);
    for (int row = gw; row < S; row += NGW) {
        f32x4 a[4], z[4]; float sa = 0.f, sz = 0.f;
#pragma unroll
        for (int j = 0; j < 4; ++j) { const int c0 = 4 * lane + 256 * j, hd = c0 >> 6;
            float ls[3], mx = -INFINITY;
#pragma unroll
            for (int b = 0; b < 3; ++b) { ls[b] = LSE[((size_t)b * S + row) * NH + hd]; mx = fmaxf(mx, ls[b]); }
            float wsum = 0.f; f32x4 acc = (f32x4){0.f, 0.f, 0.f, 0.f};
#pragma unroll
            for (int b = 0; b < 3; ++b) { const float wb = __expf(ls[b] - mx); wsum += wb; const u32x2 ov = *(const u32x2*)(OB + ((size_t)b * S + row) * AW + c0);
                acc.x += wb * __uint_as_float(ov.x << 16); acc.y += wb * __uint_as_float(ov.x & 0xffff0000u); acc.z += wb * __uint_as_float(ov.y << 16); acc.w += wb * __uint_as_float(ov.y & 0xffff0000u); }
            a[j] = acc * (1.0f / wsum); sa += (a[j].x * a[j].x + a[j].y * a[j].y) + (a[j].z * a[j].z + a[j].w * a[j].w);
            z[j] = *(const f32x4*)(Z + (size_t)row * SW + c0); sz += (z[j].x * z[j].x + z[j].y * z[j].y) + (z[j].z * z[j].z + z[j].w * z[j].w); }
        const float ra = 1.0f / sqrtf(wave_sum(sa) * (1.0f / AW) + EPS), rz = 1.0f / sqrtf(wave_sum(sz) * (1.0f / SW) + EPS);
#pragma unroll
        for (int j = 0; j < 4; ++j) { const int c0 = 4 * lane + 256 * j;
            const f32x4 ga = *(const f32x4*)(p.attn_g + c0), gs = *(const f32x4*)(p.ssm_g + c0);
            const f32x4 oa = a[j] * ra * ga, oz = z[j] * rz * gs;
            u32x2 wa, wz; wa.x = cvt_pk_bf16(oa.x, oa.y); wa.y = cvt_pk_bf16(oa.z, oa.w); wz.x = cvt_pk_bf16(oz.x, oz.y); wz.y = cvt_pk_bf16(oz.z, oz.w);
            *(u32x2*)(YM + (size_t)row * D + c0) = wa; *(u32x2*)(YM + (size_t)row * D + AW + c0) = wz; }
    }
}

__device__ __forceinline__ void phase_norm2_router(const P& p, LAS unsigned char* lds, int bid, int Gn) {
    const int tid = otid(), lane = tid & 63, w = tid >> 6;
    const float* mod = (const float*)(p.ws + WS_MOD);
    const float* X1 = (const float*)(p.ws + WS_X1);
    bf16_t* hb = (bf16_t*)(p.ws + WS_HB);
    LAS float* hrow = (LAS float*)lds;
    LAS float* part = (LAS float*)(lds + 65536);
    LAS float* logit = (LAS float*)(lds + 65536 + 16384);
    int* idx = (int*)(p.ws + WS_IDX); float* gate = (float*)(p.ws + WS_GATE); int* slot = (int*)(p.ws + WS_SLOT);
    int* cnt = (int*)(p.ws + WS_CTL); int* list = (int*)(p.ws + WS_LIST);
    for (int base = bid * 8; base < S; base += Gn * 8) {
        {   const int row = base + w;
            const f32x4* xr = (const f32x4*)(X1 + (size_t)row * D) + lane;
            f32x4 v[8]; float ss = 0.f;
#pragma unroll
            for (int j = 0; j < 8; ++j) { v[j] = xr[64 * j]; ss += (v[j].x * v[j].x + v[j].y * v[j].y) + (v[j].z * v[j].z + v[j].w * v[j].w); }
            const float rs = 1.0f / sqrtf(wave_sum(ss) * (1.0f / D) + EPS);
#pragma unroll
            for (int j = 0; j < 8; ++j) { const int c0 = 4 * lane + 256 * j;
                const f32x4 g = *(const f32x4*)(p.norm2_g + c0), sc = *(const f32x4*)(mod + 4 * D + c0), sh = *(const f32x4*)(mod + 3 * D + c0);
                const f32x4 o = v[j] * rs * g * (sc + 1.0f) + sh;
                u32x2 wv; wv.x = cvt_pk_bf16(o.x, o.y); wv.y = cvt_pk_bf16(o.z, o.w);
                *(u32x2*)(hb + (size_t)row * D + c0) = wv;
                *(LAS f32x4*)(hrow + w * D + c0) = o; }
        }
        __syncthreads();
        {   const int e = tid & 31, pt = tid >> 5;
            float acc[8];
#pragma unroll
            for (int r = 0; r < 8; ++r) acc[r] = 0.f;
            for (int k = pt * 128; k < (pt + 1) * 128; ++k) { const float wv = p.w_router[(size_t)k * NE + e];
#pragma unroll
                for (int r = 0; r < 8; ++r) acc[r] += hrow[r * D + k] * wv; }
#pragma unroll
            for (int r = 0; r < 8; ++r) part[(pt * 8 + r) * 32 + e] = acc[r];
        }
        __syncthreads();
        if (tid < 256) { const int r = tid >> 5, e = tid & 31; float s = p.b_router[e];
#pragma unroll
            for (int q = 0; q < 16; ++q) s += part[(q * 8 + r) * 32 + e];
            logit[r * 32 + e] = s; }
        __syncthreads();
        if (tid < 8) {
            const int t = base + tid;
            unsigned used = 0u; float tv[TOPK]; int ti[TOPK];
#pragma unroll
            for (int k = 0; k < TOPK; ++k) { float best = -INFINITY; int bi = 0;
                for (int j = 0; j < NE; ++j) { const float v = logit[tid * 32 + j]; if (!((used >> j) & 1u) && v > best) { best = v; bi = j; } }
                used |= 1u << bi; tv[k] = best; ti[k] = bi; }
            const float mx = tv[0]; float ex[TOPK], sum = 0.f;
#pragma unroll
            for (int k = 0; k < TOPK; ++k) { ex[k] = expf(tv[k] - mx); sum += ex[k]; }
#pragma unroll
            for (int k = 0; k < TOPK; ++k) { const int sl = atomicAdd(&cnt[ti[k]], 1);
                idx[t * TOPK + k] = ti[k]; gate[t * TOPK + k] = ex[k] / sum; slot[t * TOPK + k] = sl; list[ti[k] * S + sl] = t * TOPK + k; }
        }
        __syncthreads();
    }
}

__device__ __forceinline__ void phase_final(const P& p, int bid, int Gn) {
    const int tid_ = otid(); const int lane = tid_ & 63, gw = bid * NWAVES + (tid_ >> 6), NGW = Gn * NWAVES;
    const int* cnt = (const int*)(p.ws + WS_CTL);
    const int* idx = (const int*)(p.ws + WS_IDX); const int* slot = (const int*)(p.ws + WS_SLOT);
    const float* mod = (const float*)(p.ws + WS_MOD);
    const float* X1 = (const float*)(p.ws + WS_X1);
    const bf16_t* YA = (const bf16_t*)(p.ws + WS_YA);
    for (int row = gw; row < S; row += NGW) {
        int prow[TOPK];
#pragma unroll
        for (int k = 0; k < TOPK; ++k) { const int e = idx[row * TOPK + k]; int off = 0;
            for (int j = 0; j < NE; ++j) off += (j < e) ? ((cnt[j] + 255) & ~255) : 0;
            prow[k] = off + slot[row * TOPK + k]; }
        f32x4 v[8]; float ss = 0.f;
#pragma unroll
        for (int j = 0; j < 8; ++j) { const int c0 = 4 * lane + 256 * j; f32x4 m = (f32x4){0.f, 0.f, 0.f, 0.f};
#pragma unroll
            for (int k = 0; k < TOPK; ++k) { const u32x2 yv = *(const u32x2*)(YA + (size_t)prow[k] * D + c0);
                m.x += __uint_as_float(yv.x << 16); m.y += __uint_as_float(yv.x & 0xffff0000u); m.z += __uint_as_float(yv.y << 16); m.w += __uint_as_float(yv.y & 0xffff0000u); }
            const f32x4 g2 = *(const f32x4*)(mod + 5 * D + c0);
            v[j] = *(const f32x4*)(X1 + (size_t)row * D + c0) + g2 * m;
            ss += (v[j].x * v[j].x + v[j].y * v[j].y) + (v[j].z * v[j].z + v[j].w * v[j].w); }
        const float rs = 1.0f / sqrtf(wave_sum(ss) * (1.0f / D) + EPS);
#pragma unroll
        for (int j = 0; j < 8; ++j) { const int c0 = 4 * lane + 256 * j; const f32x4 fg = *(const f32x4*)(p.final_g + c0);
            *(f32x4*)(p.out + (size_t)row * D + c0) = v[j] * rs * fg; }
    }
}


#define XB_TMO      128
#define XB_XCNT(j)  (256  + 64 * (j))
#define XB_XSUB(j)  (1280 + 64 * (j))
#define XB_XGEN(j)  (2304 + 64 * (j))
#define XB_TOP      3328
#define XB_TOPGEN   3392
#define XCD_BAR_WORDS 3456
#define XB_SPIN_CAP (1u << 18)

__device__ __forceinline__ unsigned xb_ld(unsigned* p)              { return __hip_atomic_load(p, __ATOMIC_RELAXED, __HIP_MEMORY_SCOPE_AGENT); }
__device__ __forceinline__ unsigned xb_add(unsigned* p, unsigned v) { return __hip_atomic_fetch_add(p, v, __ATOMIC_RELAXED, __HIP_MEMORY_SCOPE_AGENT); }
__device__ __forceinline__ unsigned xb_xcc_id() { return (unsigned)__builtin_amdgcn_s_getreg((3 << 11) | 20) & 0xFu; }
#define XB_SPIN(cond, bar) do { unsigned _sp = 0; while (cond) { __builtin_amdgcn_s_sleep(1); \
    if ((++_sp & 255u) == 0u) { if (xb_ld(&(bar)[XB_TMO])) break; if (_sp > XB_SPIN_CAP) { atomicAdd(&(bar)[XB_TMO], 1u); break; } } } } while (0)

struct XcdBarrier {
    unsigned* bar; unsigned x;
    volatile LAS unsigned* st;
};

__device__ __forceinline__ XcdBarrier xcd_barrier_post(unsigned* bar, volatile LAS unsigned* st) {
    XcdBarrier b; b.bar = bar; b.x = xb_xcc_id(); b.st = st;
    if (threadIdx.x == 0) (void)xb_add(&bar[XB_XCNT(b.x)], 1u);
    return b;
}
__device__ __forceinline__ void xcd_barrier_complete(unsigned* bar, unsigned x, unsigned& nloc, unsigned& nx) {
    const unsigned G = gridDim.x * gridDim.y * gridDim.z;
    unsigned sum, cnt, mine, sp = 0u;
    for (;;) {
        sum = 0u; cnt = 0u; mine = 0u;
#pragma unroll
        for (unsigned j = 0; j < 16; ++j) { const unsigned c = xb_ld(&bar[XB_XCNT(j)]); sum += c; cnt += (c > 0u) ? 1u : 0u; mine = (j == x) ? c : mine; }
        if (sum == G) break;
        __builtin_amdgcn_s_sleep(1);
        if ((++sp & 255u) == 0u) { if (xb_ld(&bar[XB_TMO])) break; if (sp > XB_SPIN_CAP) { atomicAdd(&bar[XB_TMO], 1u); break; } }
    }
    nloc = mine > 0u ? mine : 1u; nx = cnt > 0u ? cnt : 1u;
}

__device__ __forceinline__ void xcd_barrier(const XcdBarrier& b) {
    asm volatile("s_waitcnt vmcnt(0)" ::: "memory");
    __syncthreads();
    if (threadIdx.x == 0) {
        unsigned* bar = b.bar;
        __builtin_amdgcn_s_waitcnt(0);
        unsigned nloc = b.st[0], nx = b.st[1];
        if (nloc == 0u) { xcd_barrier_complete(bar, b.x, nloc, nx); b.st[0] = nloc; b.st[1] = nx; }
        const unsigned old = xb_add(&bar[XB_XSUB(b.x)], 1u);
        const unsigned gen = old / nloc;
        if (old + 1u == (gen + 1u) * nloc) {
            __builtin_amdgcn_fence(__ATOMIC_RELEASE, "agent");
            asm volatile("s_waitcnt vmcnt(0)" ::: "memory");
            const unsigned og = xb_add(&bar[XB_TOP], 1u);
            const unsigned tg = og / nx;
            if (og + 1u == (tg + 1u) * nx) xb_add(&bar[XB_TOPGEN], 1u);
            else XB_SPIN(xb_ld(&bar[XB_TOPGEN]) == tg, bar);
            __builtin_amdgcn_fence(__ATOMIC_ACQUIRE, "agent");
            xb_add(&bar[XB_XGEN(b.x)], 1u);
            asm volatile("s_waitcnt vmcnt(0)" ::: "memory");
        } else {
            XB_SPIN(xb_ld(&bar[XB_XGEN(b.x)]) == gen, bar);
            __builtin_amdgcn_fence(__ATOMIC_ACQUIRE, "agent");
            asm volatile("s_waitcnt vmcnt(0)" ::: "memory");
        }
    }
    __syncthreads();
}
constexpr int CW_BAR = 4096;
constexpr int MISC_OFF = 131072;

typedef __attribute__((address_space(4))) const Args CArgs;
__device__ __forceinline__ const Args* kargs() { CArgs* k = (CArgs*)__builtin_amdgcn_kernarg_segment_ptr(); asm volatile("" : "+s"(k)); return (const Args*)k; }
__device__ __forceinline__ const float* asg(const float* q) { return (const float*)(GAS const float*)q; }
__device__ __forceinline__ P globalize(const P& q) {
    P r;
#define GZ(m) r.m = asg(q.m)
    GZ(x); GZ(c); GZ(w_ada); GZ(b_ada); GZ(norm1_g); GZ(w_in); GZ(lam_re); GZ(lam_im); GZ(b_re); GZ(b_im); GZ(c_re); GZ(c_im); GZ(d_skip); GZ(log_dt);
    GZ(w_glu); GZ(b_glu); GZ(attn_g); GZ(ssm_g); GZ(w_out); GZ(norm2_g); GZ(w_router); GZ(b_router); GZ(w_gu); GZ(b_gu); GZ(w_down); GZ(b_down); GZ(final_g);
#undef GZ
    r.out = (float*)(GAS float*)q.out; r.ws = (unsigned char*)(GAS unsigned char*)q.ws;
    return r;
}
__global__ void __launch_bounds__(NWAVES * 64, 2) mk_fwd(Args args_unused) {
    extern __shared__ __attribute__((aligned(16))) unsigned char lds_raw[];
    LAS unsigned char* lds = (LAS unsigned char*)lds_raw;
    const int lo = kargs()->ph_lo, hi = kargs()->ph_hi;
    const int Gn = gridDim.x, bid = blockIdx.x;
    if (threadIdx.x == 0) *(LAS u32x4*)(lds + MISC_OFF) = (u32x4){0u, 0u, 0u, 0u};
    __syncthreads();
    XcdBarrier bar; bar.bar = nullptr; bar.x = 0; bar.st = nullptr;
    if (hi - lo > 1) { unsigned* bw = (unsigned*)((unsigned char*)(GAS unsigned char*)kargs()->p.ws + WS_CTL) + CW_BAR; bar = xcd_barrier_post(bw, (volatile LAS unsigned*)(lds + MISC_OFF)); }
#define SEAM(k) do { if (lo <= (k) && (k) + 1 < hi) xcd_barrier(bar); } while (0)
#ifndef PHMASK
#define PHMASK 0x1fff
#endif
#define IN(k) (((PHMASK >> (k)) & 1) && lo <= (k) && (k) < hi)
#ifndef REPMASK
#define REPMASK 0
#endif
#define REPS(k) for (int rep_ = 0; rep_ < ((((REPMASK) >> (k)) & 1) ? 2 : 1); ++rep_)
#define PHASE_P const P p = globalize(kargs()->p); unsigned char* ws = p.ws; (void)ws
    if (IN(0)) REPS(0) { __syncthreads(); PHASE_P; phase_prologue(p, lds, bid, Gn); }
    SEAM(0);
    if (IN(1)) REPS(1) { __syncthreads(); PHASE_P; phase_norm1(p, bid, Gn); }
    SEAM(1);
    if (IN(2)) REPS(2) { __syncthreads();
        PHASE_P;
        typedef pg8::DenseSched<WS_HB, WS_WIN, S, INW, D> Sch; Sch Sd; Sd.init(ws, Gn, bid);
        pg8::EpiProj E{(bf16_t*)(ws + WS_QKV), (bf16_t*)(ws + WS_UB2)};
        pg8::gemm_phase<pg8::EpiProj, Sch>(lds + RING_OFF, Sd, E);
    }
    SEAM(2);
    if (IN(3)) REPS(3) { __syncthreads();
        PHASE_P;
        {   typedef pg8::S5Sched<0> Sch; Sch Ss; Ss.init(ws, Gn, bid);
            pg8::EpiS5E E{(float*)(ws + WS_EF)};
            pg8::gemm_phase<pg8::EpiS5E, Sch>(lds + RING_OFF, Ss, E); }
        __syncthreads();
        phase_attn(p, lds, bid, Gn);
    }
    SEAM(3);
    if (IN(4)) REPS(4) { __syncthreads(); PHASE_P; phase_s5_carry(p, bid); }
    SEAM(4);
    if (IN(5)) REPS(5) { __syncthreads();
        PHASE_P;
        typedef pg8::S5Sched<1> Sch; Sch Ss; Ss.init(ws, Gn, bid);
        pg8::EpiS5Y E{(bf16_t*)(ws + WS_YGB)};
        pg8::gemm_phase<pg8::EpiS5Y, Sch>(lds + RING_OFF, Ss, E);
    }
    SEAM(5);
    if (IN(6)) REPS(6) { __syncthreads();
        PHASE_P;
        typedef pg8::DenseSched<WS_YGB, WS_WGLU, S, SW, SW> Sch; Sch Sd; Sd.init(ws, Gn, bid);
        pg8::EpiGlu E{(const bf16_t*)(ws + WS_YGB), p.b_glu, (float*)(ws + WS_Z)};
        pg8::gemm_phase<pg8::EpiGlu, Sch>(lds + RING_OFF, Sd, E);
    }
    SEAM(6);
    if (IN(7)) REPS(7) { __syncthreads(); PHASE_P; phase_mix(p, bid, Gn); }
    SEAM(7);
    if (IN(8)) REPS(8) { __syncthreads();
        PHASE_P;
        typedef pg8::DenseSched<WS_YMIXB, WS_WOUT, S, D, D> Sch; Sch Sd; Sd.init(ws, Gn, bid);
        pg8::EpiResid E{p.x, (const float*)(ws + WS_MOD) + 2 * D, (float*)(ws + WS_X1)};
        pg8::gemm_phase<pg8::EpiResid, Sch>(lds + RING_OFF, Sd, E);
    }
    SEAM(8);
    if (IN(9)) REPS(9) { __syncthreads(); PHASE_P; phase_norm2_router(p, lds, bid, Gn); }
    SEAM(9);
    if (IN(10)) REPS(10) { __syncthreads();
        PHASE_P;
        pg8::MoeSched<1> Sm; Sm.init(ws, Gn, bid);
        pg8::EpiMoe1 E{p.b_gu, (bf16_t*)(ws + WS_ACT)};
        pg8::gemm_phase<pg8::EpiMoe1, pg8::MoeSched<1>>(lds + RING_OFF, Sm, E);
    }
    SEAM(10);
    if (IN(11)) REPS(11) { __syncthreads();
        PHASE_P;
        pg8::MoeSched<2> Sm; Sm.init(ws, Gn, bid);
        pg8::EpiMoe2 E{p.b_down, ws};
        pg8::gemm_phase<pg8::EpiMoe2, pg8::MoeSched<2>>(lds + RING_OFF, Sm, E);
    }
    SEAM(11);
    if (IN(12)) REPS(12) { __syncthreads(); PHASE_P; phase_final(p, bid, Gn); }
#undef IN
#undef PHASE_P
#undef SEAM
}

extern "C" void kernel_launch(void* const* d_in, const int* in_sizes, int n_in, void* d_out, int out_size, void* d_ws, size_t ws_size, hipStream_t stream) {
    static int grid = 0;
    if (grid == 0) {
        if (n_in != 27 || ws_size < WS_END) { fprintf(stderr, "kernel_launch: unexpected n_in %d or ws_size %zu (< %zu)\n", n_in, ws_size, (size_t)WS_END); grid = -1; return; }
        int dev = 0, cus = 0;
        if (hipGetDevice(&dev) != hipSuccess || hipDeviceGetAttribute(&cus, hipDeviceAttributeMultiprocessorCount, dev) != hipSuccess) { grid = -1; return; }
        if (hipFuncSetAttribute((const void*)mk_fwd, hipFuncAttributeMaxDynamicSharedMemorySize, LDS_BYTES) != hipSuccess) { fprintf(stderr, "hipFuncSetAttribute failed\n"); grid = -1; return; }
        grid = cus;
    }
    if (grid < 0) return;
    Args a{};
    const float** f = (const float**)&a.p;
    for (int i = 0; i < 27; ++i) f[i] = (const float*)d_in[i];
    a.p.out = (float*)d_out; a.p.ws = (unsigned char*)d_ws;
    (void)hipMemsetAsync(a.p.ws + WS_CTL, 0, 1 * MiB, stream);
#ifndef MK_PER_PHASE
    a.ph_lo = 0; a.ph_hi = 13; hipLaunchKernelGGL(mk_fwd, dim3(grid), dim3(NWAVES * 64), LDS_BYTES, stream, a);
#else
    for (int ph = 0; ph < 13; ++ph) { a.ph_lo = ph; a.ph_hi = ph + 1; hipLaunchKernelGGL(mk_fwd, dim3(grid), dim3(NWAVES * 64), LDS_BYTES, stream, a); }
#endif
}
```

```cpp
#include <hip/hip_runtime.h>
#include <cstdio>
#include <cstdint>

constexpr int S = 16384, D = 2048, AW = 1024, SW = 1024, INW = 4096, NH = 16, HD = 64;
constexpr int G = 64, NS = 64, PC = 16;
constexpr int NE = 32, TOPK = 4, FF = 2048;
constexpr int LCH = 32, NCH = S / LCH;
constexpr int CROWS = 40;
constexpr int KS5 = 640, KS5E = 512;
constexpr int NASSIGN = S * TOPK;
constexpr int PADROWS = NASSIGN + NE * 256;
constexpr float EPS = 1e-6f;

constexpr size_t MiB = 1ull << 20;
constexpr size_t WS_CTL = 0;
constexpr size_t WS_MOD = 1 * MiB;
constexpr size_t WS_S5P = 2 * MiB;
constexpr size_t WS_IDX = 4 * MiB;
constexpr size_t WS_GATE = 5 * MiB;
constexpr size_t WS_SLOT = 6 * MiB;
constexpr size_t WS_LIST = 8 * MiB;
constexpr size_t WS_ECH = 12 * MiB;
constexpr size_t WS_X0 = 16 * MiB;
constexpr size_t WS_WIN = 32 * MiB;
constexpr size_t WS_WGLU = 48 * MiB;
constexpr size_t WS_WOUT = 50 * MiB;
constexpr size_t WS_HB = 64 * MiB;
constexpr size_t WS_PROJ = 128 * MiB;
constexpr size_t WS_QKV = WS_PROJ;
constexpr size_t WS_UB2 = WS_PROJ + 96 * MiB;
constexpr size_t WS_OB = WS_PROJ + 160 * MiB;
constexpr size_t WS_LSE = 20 * MiB;
constexpr size_t WS_YATT = WS_PROJ + 256 * MiB;
constexpr size_t WS_S5E = WS_YATT;
constexpr size_t WS_EF = WS_YATT + 16 * MiB;
constexpr size_t WS_YG = WS_YATT + 64 * MiB;
constexpr size_t WS_S5T = WS_YG;
constexpr size_t WS_YGB = WS_YG + 64 * MiB;
constexpr size_t WS_Z = WS_YGB + 32 * MiB;
constexpr size_t WS_YMIXB = WS_Z + 64 * MiB;
constexpr size_t WS_X1 = WS_YMIXB + 64 * MiB;
constexpr size_t WS_H2 = WS_X1 + 128 * MiB;
constexpr size_t WS_ACT = WS_H2 + 128 * MiB;
constexpr size_t WS_YA = WS_ACT + 288 * MiB;
constexpr size_t WS_WGU = WS_YA + 288 * MiB;
constexpr size_t WS_WDN = WS_WGU + 512 * MiB;
constexpr size_t WS_END = WS_WDN + 256 * MiB;

struct P {
    const float *x, *c, *w_ada, *b_ada, *norm1_g, *w_in, *lam_re, *lam_im, *b_re, *b_im, *c_re, *c_im, *d_skip, *log_dt,
        *w_glu, *b_glu, *attn_g, *ssm_g, *w_out, *norm2_g, *w_router, *b_router, *w_gu, *b_gu, *w_down, *b_down, *final_g;
    float* out;
    unsigned char* ws;
};
struct Args { P p; int ph_lo, ph_hi; };

#define GAS __attribute__((address_space(1)))
#define LAS __attribute__((address_space(3)))
typedef unsigned short bf16_t;
typedef short bf16x8 __attribute__((ext_vector_type(8)));
typedef float f32x4 __attribute__((ext_vector_type(4)));
typedef float f32x2 __attribute__((ext_vector_type(2)));
typedef unsigned u32x4 __attribute__((ext_vector_type(4)));
typedef unsigned u32x2 __attribute__((ext_vector_type(2)));

__device__ __forceinline__ float wave_sum(float v) {
#pragma unroll
    for (int o = 1; o < 64; o <<= 1) v += __shfl_xor(v, o);
    return v;
}
__device__ __forceinline__ float block_sum256(float v, float* red) {
    v = wave_sum(v);
    __syncthreads();
    if ((threadIdx.x & 63) == 0) red[threadIdx.x >> 6] = v;
    __syncthreads();
    return red[0] + red[1] + red[2] + red[3];
}
__device__ __forceinline__ float sigmoidf_(float x) { return __builtin_amdgcn_rcpf(1.0f + __builtin_amdgcn_exp2f(-1.4426950408889634f * x)); }
__device__ __forceinline__ unsigned cvt_pk_bf16(float lo, float hi) { unsigned r; asm volatile("v_cvt_pk_bf16_f32 %0, %1, %2" : "=v"(r) : "v"(lo), "v"(hi)); return r; }
__device__ __forceinline__ float bf2f(bf16_t b) { return __uint_as_float(((unsigned)b) << 16); }
__device__ __forceinline__ bf16_t f2bf(float f) { return (bf16_t)(cvt_pk_bf16(f, 0.f) & 0xffffu); }
__device__ __forceinline__ int otid() { int t = threadIdx.x; asm volatile("" : "+v"(t)); return t; }

namespace pg8 {
constexpr int BM = 256, BK = 64, HALF = 128, HTB = HALF * BK * 2  , STAGE_BYTES = 8 * HTB, NXCD = 8, WGM = 8;
__host__ __device__ __forceinline__ int lds_byte(int r, int c) { const int st = (r >> 4) * 2 + (c >> 5), rr = r & 15, cc = c & 31, ob = rr * 64 + cc * 2; return st * 1024 + (ob ^ (((ob >> 9) & 1) << 5)); }
__host__ __device__ __forceinline__ void stage_rc(int b, int& R, int& C) { const int st = b / 1024, sb = b % 1024, swz = sb ^ (((sb >> 9) & 1) << 5); R = (st >> 1) * 16 + swz / 64; C = (st & 1) * 32 + (swz % 64) / 2; }
__host__ __device__ __forceinline__ int perm32(int rho) { const int n = rho >> 4, i = rho & 15; return 8 * (i >> 2) + 4 * n + (i & 3); }

struct Unit { int pm, pn, e, mt; };

__device__ __forceinline__ bool flat_to_tile(long L, int nM, int nN, int& pm, int& pn) {
    const int nwg = nM * nN; if (L >= nwg) return false;
    int wgid = (int)L; { const int q = nwg / NXCD, r = nwg % NXCD, xcd = wgid % NXCD, off = wgid / NXCD; wgid = (xcd < r ? xcd * (q + 1) : r * (q + 1) + (xcd - r) * q) + off; }
    const int nig = WGM * nN, gid = wgid / nig, fm = gid * WGM, gsz = (nM - fm) < WGM ? (nM - fm) : WGM;
    pm = fm + ((wgid % nig) % gsz); pn = (wgid % nig) / gsz; return true;
}

template <size_t AOFF, size_t BOFF, int M_, int N_, int K_>
struct DenseSched {
    static constexpr bool GATHER = false;
    static constexpr int K = K_, nM = M_ / BM, nN = N_ / BM, KSTEP_A = 128;
    const unsigned char* ws; int Gn, c;
    __device__ void init(const unsigned char* ws_, int G_, int c_) { ws = ws_; Gn = G_; c = c_; }
    __device__ __forceinline__ bool next(int i, Unit& u) const { u.e = 0; u.mt = 0; return flat_to_tile((long)i * Gn + c, nM, nN, u.pm, u.pn); }
    __device__ __forceinline__ const char* a_ptr(const Unit& u) const { return (const char*)ws + AOFF + (size_t)u.pm * BM * K * 2; }
    __device__ __forceinline__ const char* b_ptr(const Unit& u) const { return (const char*)ws + BOFF + (size_t)u.pn * BM * K * 2; }
    __device__ __forceinline__ void a_off(const Unit&, unsigned (&off)[2][2]) const {
        const int tid = otid();
#pragma unroll
        for (int i = 0; i < 2; ++i) { int R, C; stage_rc(tid * 16 + i * 8192, R, C);
#pragma unroll
            for (int h = 0; h < 2; ++h) off[h][i] = (unsigned)((h * HALF + R) * K + C) * 2u; }
    }
};

template <int STAGE>
struct MoeSched {
    static constexpr bool GATHER = (STAGE == 1);
    static constexpr int K = (STAGE == 1) ? D : FF, N = (STAGE == 1) ? 2 * FF : D, nN = N / BM, KSTEP_A = 128;
    static constexpr size_t AOFF = (STAGE == 1) ? WS_HB : WS_ACT, BOFF = (STAGE == 1) ? WS_WGU : WS_WDN;
    const unsigned char* ws; int nM, Gn, c;
    __device__ void init(const unsigned char* ws_, int G_, int c_) {
        ws = ws_; Gn = G_; c = c_;
        const int* cnt = (const int*)(ws + WS_CTL);
        int t = 0; for (int j = 0; j < NE; ++j) t += (cnt[j] + 255) >> 8; nM = __builtin_amdgcn_readfirstlane(t);
    }
    __device__ __forceinline__ bool next(int i, Unit& u) const {
        if (!flat_to_tile((long)i * Gn + c, nM, nN, u.pm, u.pn)) return false;
        const int* cnt = (const int*)(ws + WS_CTL);
        int acc = 0, e = 0, mt = 0;
        for (int j = 0; j < NE; ++j) { const int nt = (cnt[j] + 255) >> 8; if (u.pm >= acc && u.pm < acc + nt) { e = j; mt = u.pm - acc; } acc += nt; }
        u.e = __builtin_amdgcn_readfirstlane(e); u.mt = __builtin_amdgcn_readfirstlane(mt); return true;
    }
    __device__ __forceinline__ const char* a_ptr(const Unit& u) const { return (STAGE == 1) ? (const char*)ws + AOFF : (const char*)ws + AOFF + (size_t)u.pm * BM * K * 2; }
    __device__ __forceinline__ const char* b_ptr(const Unit& u) const { return (const char*)ws + BOFF + ((size_t)u.e * N + (size_t)u.pn * BM) * K * 2; }
    __device__ __forceinline__ void a_off(const Unit& u, unsigned (&off)[2][2]) const {
        const int tid = otid();
        if (STAGE == 1) {
            const int* cnt = (const int*)(ws + WS_CTL); const int* list = (const int*)(ws + WS_LIST);
            const int ce = __builtin_amdgcn_readfirstlane(cnt[u.e]);
#pragma unroll
            for (int i = 0; i < 2; ++i) { int R, C; stage_rc(tid * 16 + i * 8192, R, C);
#pragma unroll
                for (int h = 0; h < 2; ++h) { int lr = u.mt * BM + h * HALF + R; lr = lr < ce ? lr : ce - 1; const int tok = list[(size_t)u.e * S + lr] >> 2; off[h][i] = (unsigned)(tok * K + C) * 2u; } }
        } else {
#pragma unroll
            for (int i = 0; i < 2; ++i) { int R, C; stage_rc(tid * 16 + i * 8192, R, C);
#pragma unroll
                for (int h = 0; h < 2; ++h) off[h][i] = (unsigned)((h * HALF + R) * K + C) * 2u; }
        }
    }
};

template <int MODE>
struct S5Sched {
    static constexpr bool GATHER = true;
    static constexpr int K = MODE ? KS5 : KS5E, KSTEP_A = 4 * 1024 * 2, NCT = MODE ? 2 : 1, NUNITS = G * 2 * NCT;
    const unsigned char* ws; int Gn, c;
    __device__ void init(const unsigned char* ws_, int G_, int c_) { ws = ws_; Gn = G_; c = c_; }
    __device__ __forceinline__ bool next(int i, Unit& u) const {
        const int L = i * Gn + c; if (L >= NUNITS) return false;
        u.e = L / (2 * NCT); const int rem = L % (2 * NCT); u.pm = rem / NCT; u.pn = rem % NCT; u.mt = 0; return true;
    }
    __device__ __forceinline__ const char* a_ptr(const Unit& u) const { return (const char*)ws + WS_UB2 + (size_t)u.e * (PC * 2); }
    __device__ __forceinline__ const char* b_ptr(const Unit& u) const { return (const char*)ws + (MODE ? WS_S5T : WS_S5E) + ((size_t)u.e * (MODE ? 512 : 256) + (size_t)u.pn * BM) * K * 2; }
    __device__ __forceinline__ void a_off(const Unit& u, unsigned (&off)[2][2]) const {
        const int tid = otid();
#pragma unroll
        for (int i = 0; i < 2; ++i) { int R, C; stage_rc(tid * 16 + i * 8192, R, C);
#pragma unroll
            for (int h = 0; h < 2; ++h) off[h][i] = (unsigned)(((u.pm * BM + h * HALF + R) * CROWS + (C >> 4)) * 2048 + (C & 15) * 2); }
    }
};

template <class Epi, class Sched>
__device__ __forceinline__ void gemm_phase(LAS unsigned char* lds, const Sched& S, const Epi& E) {
    const int tid = otid(), wid = __builtin_amdgcn_readfirstlane(tid >> 6), lane = tid & 63, wr = wid >> 2, wc = wid & 3, fr = lane & 15, fq = lane >> 4;
    constexpr int K = Sched::K, nt = K / BK;
    unsigned voffB[2];
#pragma unroll
    for (int i = 0; i < 2; ++i) { int sR, sC; stage_rc(tid * 16 + i * 8192, sR, sC); const int Rb = Epi::PERM ? ((sR & ~31) + perm32(sR & 31)) : sR; voffB[i] = (unsigned)(Rb * K + sC) * 2u; }
    const size_t kstep = (size_t)(BK * 2);
    constexpr size_t kstepA = (size_t)Sched::KSTEP_A;
    const size_t hstep = (size_t)HALF * K * 2;
    const unsigned ldsw = (unsigned)wid * 1024u;
    const int aoff = lds_byte(wr * 64 + fr, fq * 8), boff = lds_byte(wc * 32 + fr, fq * 8);
#define PG8_SA(b, h) (((b) * 2 + (h)) * HTB)
#define PG8_SB(b, h) ((4 + (b) * 2 + (h)) * HTB)
#define PG8_STAGE(bufoff, gbase, voff) do { _Pragma("unroll") for (int _i = 0; _i < 2; ++_i) \
        __builtin_amdgcn_global_load_lds((const unsigned*)((const char*)(gbase) + (voff)[_i]), (LAS unsigned*)(lds + (bufoff) + ldsw + _i * 8192), 16, 0, 0); } while (0)
#define PG8_LDA(dst, b, h) do { _Pragma("unroll") for (int m = 0; m < 4; ++m) _Pragma("unroll") for (int k = 0; k < 2; ++k) dst[m][k] = *(const LAS bf16x8*)(lds + PG8_SA(b, h) + aoff + m * 2048 + k * 1024); } while (0)
#define PG8_LDB(dst, b, h) do { _Pragma("unroll") for (int n = 0; n < 2; ++n) _Pragma("unroll") for (int k = 0; k < 2; ++k) dst[n][k] = *(const LAS bf16x8*)(lds + PG8_SB(b, h) + boff + n * 2048 + k * 1024); } while (0)
#define PG8_MMA(ai, bj, At, Bt) do { __builtin_amdgcn_s_setprio(1); _Pragma("unroll") for (int m = 0; m < 4; ++m) _Pragma("unroll") for (int n = 0; n < 2; ++n) _Pragma("unroll") for (int k = 0; k < 2; ++k) \
        acc[ai][bj][m][n] = __builtin_amdgcn_mfma_f32_16x16x32_bf16(Bt[n][k], At[m][k], acc[ai][bj][m][n], 0, 0, 0); __builtin_amdgcn_s_setprio(0); } while (0)
#define PG8_WAIT_V(n) asm volatile("s_waitcnt vmcnt(" #n ")" ::: "memory")
#define PG8_WAIT_L(n) asm volatile("s_waitcnt lgkmcnt(" #n ")" ::: "memory")
#define PG8_BAR __builtin_amdgcn_s_barrier()
#define PG8_SCHED __builtin_amdgcn_sched_barrier(0)
    Unit cur, nxt; int ui = 0;
    if (!S.next(0, cur)) return;
    f32x4 acc[2][2][4][2];
#pragma unroll
    for (int a = 0; a < 2; ++a)
#pragma unroll
        for (int b = 0; b < 2; ++b)
#pragma unroll
            for (int m = 0; m < 4; ++m)
#pragma unroll
                for (int n = 0; n < 2; ++n) acc[a][b][m][n] = (f32x4){0.f, 0.f, 0.f, 0.f};
    bf16x8 At[4][2], B0[2][2], B1[2][2];
    const char* cA = S.a_ptr(cur); const char* cB = S.b_ptr(cur);
    unsigned ao[2][2]; S.a_off(cur, ao);
    PG8_STAGE(PG8_SB(0, 0), cB, voffB); PG8_STAGE(PG8_SB(0, 1), cB + hstep, voffB); PG8_STAGE(PG8_SA(0, 0), cA, ao[0]); PG8_STAGE(PG8_SA(0, 1), cA, ao[1]);
    if (wr == 1) PG8_BAR;
    PG8_WAIT_V(2); PG8_BAR;
    PG8_STAGE(PG8_SB(1, 0), cB + kstep, voffB); PG8_STAGE(PG8_SA(1, 0), cA + kstepA, ao[0]); PG8_STAGE(PG8_SB(1, 1), cB + hstep + kstep, voffB);
    PG8_WAIT_V(6); PG8_BAR;
    for (;;) {
        const bool has_next = S.next(ui + 1, nxt);
        const char* nA = has_next ? S.a_ptr(nxt) : cA; const char* nB = has_next ? S.b_ptr(nxt) : cB;
        for (int t = 0; t < nt; t += 2) {
            const bool last = (t == nt - 2);
            const char* a1 = cA + (size_t)(t + 1) * kstepA;
            const char* a2 = last ? nA : cA + (size_t)(t + 2) * kstepA; const char* b2 = last ? nB : cB + (size_t)(t + 2) * kstep;
            const char* a3 = a2 + kstepA; const char* b3 = b2 + kstep;

            PG8_LDB(B0, 0, 0); PG8_LDB(B1, 0, 1); PG8_SCHED; PG8_LDA(At, 0, 0); PG8_STAGE(PG8_SA(1, 1), a1, ao[1]);
            PG8_WAIT_V(8); PG8_WAIT_L(0); PG8_BAR; PG8_MMA(0, 0, At, B0); PG8_MMA(0, 1, At, B1); PG8_BAR; PG8_SCHED;
            if (Sched::GATHER) { if (last && has_next) S.a_off(nxt, ao); }
            PG8_LDA(At, 0, 1); PG8_STAGE(PG8_SB(0, 0), b2, voffB); PG8_STAGE(PG8_SB(0, 1), b2 + hstep, voffB); PG8_STAGE(PG8_SA(0, 0), a2, ao[0]);
            PG8_WAIT_V(8); PG8_WAIT_L(0); PG8_BAR; PG8_MMA(1, 0, At, B0); PG8_MMA(1, 1, At, B1); PG8_BAR; PG8_SCHED;
            PG8_LDB(B0, 1, 0); PG8_LDB(B1, 1, 1); PG8_SCHED; PG8_LDA(At, 1, 0); PG8_STAGE(PG8_SA(0, 1), a2, ao[1]);
            PG8_WAIT_V(8); PG8_WAIT_L(0); PG8_BAR; PG8_MMA(0, 0, At, B0); PG8_MMA(0, 1, At, B1); PG8_BAR; PG8_SCHED;
            PG8_LDA(At, 1, 1); PG8_STAGE(PG8_SB(1, 0), b3, voffB); PG8_STAGE(PG8_SB(1, 1), b3 + hstep, voffB); PG8_STAGE(PG8_SA(1, 0), a3, ao[0]);
            PG8_WAIT_V(8); PG8_WAIT_L(0); PG8_BAR; PG8_MMA(1, 0, At, B0); PG8_MMA(1, 1, At, B1); PG8_BAR; PG8_SCHED;
        }
        if (wr == 0) PG8_BAR;
        E(acc, cur, wr, wc, fr, fq);
        if (!has_next) break;
#pragma unroll
        for (int a = 0; a < 2; ++a)
#pragma unroll
            for (int b = 0; b < 2; ++b)
#pragma unroll
                for (int m = 0; m < 4; ++m)
#pragma unroll
                    for (int n = 0; n < 2; ++n) acc[a][b][m][n] = (f32x4){0.f, 0.f, 0.f, 0.f};
        cur = nxt; cA = nA; cB = nB; ++ui;
        if (wr == 1) PG8_BAR;
    }
    PG8_WAIT_V(0);
    PG8_BAR;
#undef PG8_SA
#undef PG8_SB
#undef PG8_STAGE
#undef PG8_LDA
#undef PG8_LDB
#undef PG8_MMA
#undef PG8_WAIT_V
#undef PG8_WAIT_L
#undef PG8_BAR
#undef PG8_SCHED
}

struct EpiF32 {
    static constexpr bool PERM = false;
    float* C; int ldc;
    __device__ __forceinline__ void operator()(const f32x4 (&acc)[2][2][4][2], const Unit& u, int wr, int wc, int fr, int fq) const {
        const int row0 = u.pm * BM + wr * 64 + fr, col0 = u.pn * BM + wc * 32 + 4 * fq;
#pragma unroll
        for (int ai = 0; ai < 2; ++ai)
#pragma unroll
            for (int m = 0; m < 4; ++m) { float* rowp = C + (size_t)(row0 + ai * HALF + m * 16) * ldc + col0;
#pragma unroll
                for (int bj = 0; bj < 2; ++bj)
#pragma unroll
                    for (int n = 0; n < 2; ++n) *(f32x4*)(rowp + bj * HALF + n * 16) = acc[ai][bj][m][n]; }
    }
};
struct EpiGlu {
    static constexpr bool PERM = false;
    const bf16_t* yg; const float* bias; float* Z;
    __device__ __forceinline__ void operator()(const f32x4 (&acc)[2][2][4][2], const Unit& u, int wr, int wc, int fr, int fq) const {
        const int row0 = u.pm * BM + wr * 64 + fr, col0 = u.pn * BM + wc * 32 + 4 * fq;
#pragma unroll
        for (int ai = 0; ai < 2; ++ai)
#pragma unroll
            for (int m = 0; m < 4; ++m) { const size_t ro = (size_t)(row0 + ai * HALF + m * 16) * SW + col0;
#pragma unroll
                for (int bj = 0; bj < 2; ++bj)
#pragma unroll
                    for (int n = 0; n < 2; ++n) { const int co = bj * HALF + n * 16; const u32x2 yb = *(const u32x2*)(yg + ro + co); const f32x4 y = (f32x4){__uint_as_float(yb.x << 16), __uint_as_float(yb.x & 0xffff0000u), __uint_as_float(yb.y << 16), __uint_as_float(yb.y & 0xffff0000u)};
                        const f32x4 b = *(const f32x4*)(bias + col0 + co); f32x4 o;
#pragma unroll
                        for (int j = 0; j < 4; ++j) o[j] = y[j] * sigmoidf_(acc[ai][bj][m][n][j] + b[j]);
                        *(f32x4*)(Z + ro + co) = o; } }
    }
};
struct EpiResid {
    static constexpr bool PERM = false;
    const float* x; const float* gate; float* X1;
    __device__ __forceinline__ void operator()(const f32x4 (&acc)[2][2][4][2], const Unit& u, int wr, int wc, int fr, int fq) const {
        const int row0 = u.pm * BM + wr * 64 + fr, col0 = u.pn * BM + wc * 32 + 4 * fq;
#pragma unroll
        for (int ai = 0; ai < 2; ++ai)
#pragma unroll
            for (int m = 0; m < 4; ++m) { const size_t ro = (size_t)(row0 + ai * HALF + m * 16) * D + col0;
#pragma unroll
                for (int bj = 0; bj < 2; ++bj)
#pragma unroll
                    for (int n = 0; n < 2; ++n) { const int co = bj * HALF + n * 16; const f32x4 xv = *(const f32x4*)(x + ro + co); const f32x4 g = *(const f32x4*)(gate + col0 + co);
                        *(f32x4*)(X1 + ro + co) = xv + g * acc[ai][bj][m][n]; } }
    }
};
struct EpiMoe1 {
    static constexpr bool PERM = true;
    const float* b_gu; bf16_t* ACT;
    __device__ __forceinline__ void operator()(const f32x4 (&acc)[2][2][4][2], const Unit& u, int wr, int wc, int fr, int fq) const {
        const int row0 = u.pm * BM + wr * 64 + fr, j0 = u.pn * HALF + wc * 32 + 8 * fq;
        const float* bias = b_gu + (size_t)u.e * 2 * FF + 2 * j0;
        float bg[8], bl[8];
#pragma unroll
        for (int j = 0; j < 8; ++j) { bg[j] = bias[2 * j]; bl[j] = bias[2 * j + 1]; }
#pragma unroll
        for (int ai = 0; ai < 2; ++ai)
#pragma unroll
            for (int m = 0; m < 4; ++m) { bf16_t* rowp = ACT + (size_t)(row0 + ai * HALF + m * 16) * FF + j0; float o[8];
#pragma unroll
                for (int n = 0; n < 2; ++n)
#pragma unroll
                    for (int j = 0; j < 4; ++j) { const float gl = fminf(acc[ai][0][m][n][j] + bg[4 * n + j], 7.0f); const float ln = fminf(fmaxf(acc[ai][1][m][n][j] + bl[4 * n + j], -7.0f), 7.0f);
                        o[4 * n + j] = gl * sigmoidf_(1.702f * gl) * (ln + 1.0f); }
                u32x4 w; w.x = cvt_pk_bf16(o[0], o[1]); w.y = cvt_pk_bf16(o[2], o[3]); w.z = cvt_pk_bf16(o[4], o[5]); w.w = cvt_pk_bf16(o[6], o[7]);
                *(u32x4*)rowp = w; }
    }
};
struct EpiMoe2 {
    static constexpr bool PERM = true;
    const float* b_down; const unsigned char* ws;
    __device__ __forceinline__ void operator()(const f32x4 (&acc)[2][2][4][2], const Unit& u, int wr, int wc, int fr, int fq) const {
        const int lr0 = u.mt * BM + wr * 64 + fr, row0 = u.pm * BM + wr * 64 + fr, col0 = u.pn * BM + wc * 32 + 8 * fq;
        const int* cnt = (const int*)(ws + WS_CTL); const int* list = (const int*)(ws + WS_LIST); const float* gate = (const float*)(ws + WS_GATE); bf16_t* YA = (bf16_t*)(ws + WS_YA);
        const int ce = __builtin_amdgcn_readfirstlane(cnt[u.e]);
        f32x4 bv[2][2];
#pragma unroll
        for (int bj = 0; bj < 2; ++bj)
#pragma unroll
            for (int n = 0; n < 2; ++n) bv[bj][n] = *(const f32x4*)(b_down + (size_t)u.e * D + col0 + bj * HALF + 4 * n);
#pragma unroll
        for (int ai = 0; ai < 2; ++ai)
#pragma unroll
            for (int m = 0; m < 4; ++m) { const int lr = lr0 + ai * HALF + m * 16; float g = 0.f; if (lr < ce) g = gate[list[(size_t)u.e * S + lr]];
                bf16_t* rowp = YA + (size_t)(row0 + ai * HALF + m * 16) * D + col0;
#pragma unroll
                for (int bj = 0; bj < 2; ++bj) { const f32x4 v0 = (acc[ai][bj][m][0] + bv[bj][0]) * g, v1 = (acc[ai][bj][m][1] + bv[bj][1]) * g;
                    u32x4 w; w.x = cvt_pk_bf16(v0[0], v0[1]); w.y = cvt_pk_bf16(v0[2], v0[3]); w.z = cvt_pk_bf16(v1[0], v1[1]); w.w = cvt_pk_bf16(v1[2], v1[3]);
                    *(u32x4*)(rowp + bj * HALF) = w; } }
    }
};
struct EpiS5E {
    static constexpr bool PERM = false;
    float* EF;
    __device__ __forceinline__ void operator()(const f32x4 (&acc)[2][2][4][2], const Unit& u, int wr, int wc, int fr, int fq) const {
        const int row0 = u.pm * BM + wr * 64 + fr, col0 = wc * 32 + 4 * fq;
#pragma unroll
        for (int ai = 0; ai < 2; ++ai)
#pragma unroll
            for (int m = 0; m < 4; ++m) { float* rowp = EF + ((size_t)u.e * NCH + row0 + ai * HALF + m * 16) * 128 + col0;
#pragma unroll
                for (int n = 0; n < 2; ++n) *(f32x4*)(rowp + n * 16) = acc[ai][0][m][n]; }
    }
};
struct EpiS5Y {
    static constexpr bool PERM = true;
    bf16_t* YGB;
    __device__ __forceinline__ void operator()(const f32x4 (&acc)[2][2][4][2], const Unit& u, int wr, int wc, int fr, int fq) const {
        const int c0 = u.pm * BM + wr * 64 + fr;
#pragma unroll
        for (int ai = 0; ai < 2; ++ai)
#pragma unroll
            for (int m = 0; m < 4; ++m) { const int c = c0 + ai * HALF + m * 16;
#pragma unroll
                for (int bj = 0; bj < 2; ++bj) { const int np = u.pn * BM + bj * HALF + wc * 32 + 8 * fq, i = np >> 4, p0 = np & 15; float o[8];
#pragma unroll
                    for (int n = 0; n < 2; ++n)
#pragma unroll
                        for (int j = 0; j < 4; ++j) { const float y = acc[ai][bj][m][n][j]; const float uu = 0.7978845608028654f * (y + 0.044715f * y * y * y);
                            o[4 * n + j] = y * __builtin_amdgcn_rcpf(1.0f + __builtin_amdgcn_exp2f(-2.885390081777927f * uu)); }
                    u32x4 w; w.x = cvt_pk_bf16(o[0], o[1]); w.y = cvt_pk_bf16(o[2], o[3]); w.z = cvt_pk_bf16(o[4], o[5]); w.w = cvt_pk_bf16(o[6], o[7]);
                    *(u32x4*)(YGB + (size_t)(c * LCH + i) * SW + u.e * PC + p0) = w; } }
    }
};
struct EpiProj {
    static constexpr bool PERM = false;
    bf16_t* QKV; bf16_t* UB2;
    __device__ __forceinline__ void operator()(const f32x4 (&acc)[2][2][4][2], const Unit& u, int wr, int wc, int fr, int fq) const {
        const int row0 = u.pm * BM + wr * 64 + fr, col0 = u.pn * BM + wc * 32 + 4 * fq;
        if (u.pn < 12) {
            const float sc = (u.pn < 4) ? 0.125f : 1.0f;
#pragma unroll
            for (int ai = 0; ai < 2; ++ai)
#pragma unroll
                for (int m = 0; m < 4; ++m) { bf16_t* rowp = QKV + (size_t)(row0 + ai * HALF + m * 16) * (3 * AW) + col0;
#pragma unroll
                    for (int bj = 0; bj < 2; ++bj)
#pragma unroll
                        for (int n = 0; n < 2; ++n) { const f32x4 v = acc[ai][bj][m][n] * sc; u32x2 w; w.x = cvt_pk_bf16(v[0], v[1]); w.y = cvt_pk_bf16(v[2], v[3]); *(u32x2*)(rowp + bj * HALF + n * 16) = w; } }
        } else {
#pragma unroll
            for (int ai = 0; ai < 2; ++ai)
#pragma unroll
                for (int m = 0; m < 4; ++m) { const int t = row0 + ai * HALF + m * 16; bf16_t* rowp = UB2 + (size_t)((t >> 5) * CROWS + (t & 31)) * SW + (col0 - 3 * AW);
#pragma unroll
                    for (int bj = 0; bj < 2; ++bj)
#pragma unroll
                        for (int n = 0; n < 2; ++n) { const f32x4 v = acc[ai][bj][m][n]; u32x2 w; w.x = cvt_pk_bf16(v[0], v[1]); w.y = cvt_pk_bf16(v[2], v[3]); *(u32x2*)(rowp + bj * HALF + n * 16) = w; } }
        }
    }
};
}

constexpr int NWAVES = 8;
constexpr int LDS_BYTES = 147456;
constexpr int RING_OFF = 0;
typedef short s16x4 __attribute__((ext_vector_type(4)));
typedef float f32x16 __attribute__((ext_vector_type(16)));

template <bool DEINT>
__device__ __forceinline__ void convert_tile(const float* W, int K, int N, bf16_t* WT, int tk, int tn, LAS float* scr) {
    const int tid = otid(), k0 = tk * 64, n0 = tn * 256;
    __syncthreads();
#pragma unroll
    for (int j = 0; j < 8; ++j) { const int k = j * 8 + (tid >> 6), g = tid & 63;
        const f32x4 v = *(const f32x4*)(W + (size_t)(k0 + k) * N + n0 + 4 * g);
        *(LAS f32x4*)(scr + k * 256 + ((g ^ j) << 2)) = v; }
    __syncthreads();
#pragma unroll
    for (int jj = 0; jj < 4; ++jj) { const int n = jj * 64 + (tid >> 3), c = tid & 7; float v[8];
#pragma unroll
        for (int q = 0; q < 8; ++q) v[q] = scr[(8 * c + q) * 256 + ((((n >> 2) ^ c)) << 2) + (n & 3)];
        u32x4 o; o.x = cvt_pk_bf16(v[0], v[1]); o.y = cvt_pk_bf16(v[2], v[3]); o.z = cvt_pk_bf16(v[4], v[5]); o.w = cvt_pk_bf16(v[6], v[7]);
        int row = n0 + n;
        if (DEINT) { const int s = n & 1, jl = n >> 1; row = n0 + s * 128 + jl; }
        *(u32x4*)(WT + (size_t)row * K + k0 + 8 * c) = o; }
}

__device__ __forceinline__ void phase_s5_tables(const P& p, LAS unsigned char* lds, int g);
__device__ __forceinline__ void phase_prologue(const P& p, LAS unsigned char* lds, int bid, int Gn) {
    unsigned char* ws = p.ws;
    const int tid = otid();
    if (bid < 192) {
        LAS f32x4* red = (LAS f32x4*)lds;
        const int cq = tid & 15, rg = tid >> 4;
        f32x4 acc = (f32x4){0.f, 0.f, 0.f, 0.f};
        for (int it = 0; it < 64; ++it) { const int i = rg + 32 * it; const float cv = p.c[i]; const float sv = cv / (1.0f + expf(-cv));
            const f32x4 w = *(const f32x4*)(p.w_ada + (size_t)i * 6 * D + 64 * bid + 4 * cq); acc += w * sv; }
        red[rg * 16 + cq] = acc;
        __syncthreads();
        if (tid < 64) { const LAS float* rf = (const LAS float*)lds; float s = p.b_ada[64 * bid + tid];
            for (int r = 0; r < 32; ++r) s += rf[r * 64 + tid];
            ((float*)(ws + WS_MOD))[64 * bid + tid] = s; }
    } else phase_s5_tables(p, lds, bid - 192);
    LAS float* scr = (LAS float*)(lds + RING_OFF);
    constexpr int T_IN = 32 * 16, T_GLU = 16 * 4, T_OUT = 32 * 8, T_GU = 32 * 16, T_DN = 32 * 8;
    constexpr int NT = T_IN + T_GLU + T_OUT + NE * (T_GU + T_DN);
    for (int it = bid; it < NT; it += Gn) {
        int r = it;
        if (r < T_IN) { convert_tile<false>(p.w_in, D, INW, (bf16_t*)(ws + WS_WIN), r / 16, r % 16, scr); continue; } r -= T_IN;
        if (r < T_GLU) { convert_tile<false>(p.w_glu, SW, SW, (bf16_t*)(ws + WS_WGLU), r / 4, r % 4, scr); continue; } r -= T_GLU;
        if (r < T_OUT) { convert_tile<false>(p.w_out, D, D, (bf16_t*)(ws + WS_WOUT), r / 8, r % 8, scr); continue; } r -= T_OUT;
        if (r < NE * T_GU) { const int e = r / T_GU, q = r % T_GU; convert_tile<true>(p.w_gu + (size_t)e * D * 2 * FF, D, 2 * FF, (bf16_t*)(ws + WS_WGU) + (size_t)e * 2 * FF * D, q / 16, q % 16, scr); continue; } r -= NE * T_GU;
        { const int e = r / T_DN, q = r % T_DN; convert_tile<false>(p.w_down + (size_t)e * FF * D, FF, D, (bf16_t*)(ws + WS_WDN) + (size_t)e * D * FF, q / 8, q % 8, scr); }
    }
    __syncthreads();
}

__device__ __forceinline__ void phase_norm1(const P& p, int bid, int Gn) {
    const int tid_ = otid(); const int lane = tid_ & 63, gw = bid * NWAVES + (tid_ >> 6), NGW = Gn * NWAVES;
    const float* mod = (const float*)(p.ws + WS_MOD);
    bf16_t* hb = (bf16_t*)(p.ws + WS_HB);
    for (int row = gw; row < S; row += NGW) {
        const f32x4* xr = (const f32x4*)(p.x + (size_t)row * D) + lane;
        f32x4 v[8]; float ss = 0.f;
#pragma unroll
        for (int j = 0; j < 8; ++j) { v[j] = xr[64 * j]; ss += (v[j].x * v[j].x + v[j].y * v[j].y) + (v[j].z * v[j].z + v[j].w * v[j].w); }
        const float rs = 1.0f / sqrtf(wave_sum(ss) * (1.0f / D) + EPS);
#pragma unroll
        for (int j = 0; j < 8; ++j) { const int c0 = 4 * lane + 256 * j;
            const f32x4 g = *(const f32x4*)(p.norm1_g + c0), sc = *(const f32x4*)(mod + D + c0), sh = *(const f32x4*)(mod + c0);
            const f32x4 o = v[j] * rs * g * (sc + 1.0f) + sh;
            u32x2 w; w.x = cvt_pk_bf16(o.x, o.y); w.y = cvt_pk_bf16(o.z, o.w);
            *(u32x2*)(hb + (size_t)row * D + c0) = w; }
    }
}

__device__ __forceinline__ s16x4 tr_read(unsigned lds_addr) { s16x4 r; asm volatile("ds_read_b64_tr_b16 %0, %1\n\ts_waitcnt lgkmcnt(0)" : "=&v"(r) : "v"(lds_addr) : "memory"); return r; }
__device__ __forceinline__ void phase_attn(const P& p, LAS unsigned char* lds, int bid, int Gn) {
    const bf16_t* QKV = (const bf16_t*)(p.ws + WS_QKV);
    bf16_t* OB = (bf16_t*)(p.ws + WS_OB);
    float* LSE = (float*)(p.ws + WS_LSE);
    const int tid = otid(), w = __builtin_amdgcn_readfirstlane(tid >> 6), lane = tid & 63, us = w >> 2, wq = w & 3;
    const int l31 = lane & 31, hh = lane >> 5, i0 = 32 * wq;
    constexpr int RS = 3 * AW;
    LAS unsigned char* vl = lds + us * 32768;
    for (int pr = bid; pr < 3072; pr += Gn) {
        const int u = pr * 2 + us;
        const int b = u >> 11, rem = u & 2047, blk = rem >> 4, h = rem & 15;
        const int dsh = 2 * b, d = 1 << dsh;
        const int n = blk >> dsh, r = blk & (d - 1);
        const int qbase = n * 128 * d + r, kbase = qbase - 128 * d;
#pragma unroll
        for (int it = 0; it < 8; ++it) { const int id = it * 64 + lane, row = 64 * wq + (id >> 3), ch = id & 7; const int kp = kbase + row * d;
            u32x4 v = (u32x4){0u, 0u, 0u, 0u};
            if (kp >= 0) v = *(const u32x4*)(QKV + (size_t)kp * RS + 2 * AW + h * HD + ch * 8);
            *(LAS u32x4*)(vl + row * 128 + ch * 16) = v; }
        const int qp = qbase + (i0 + l31) * d;
        bf16x8 qf[4];
#pragma unroll
        for (int s = 0; s < 4; ++s) qf[s] = *(const bf16x8*)(QKV + (size_t)qp * RS + h * HD + 16 * s + 8 * hh);
        f32x16 sc[5];
#pragma unroll
        for (int kb = 0; kb < 5; ++kb) {
            const int j = i0 + 32 * kb + l31; int kp = kbase + j * d; kp = kp < 0 ? 0 : kp;
            bf16x8 kf[4];
#pragma unroll
            for (int s = 0; s < 4; ++s) kf[s] = *(const bf16x8*)(QKV + (size_t)kp * RS + AW + h * HD + 16 * s + 8 * hh);
            f32x16 a;
#pragma unroll
            for (int e = 0; e < 16; ++e) a[e] = 0.f;
#pragma unroll
            for (int s = 0; s < 4; ++s) a = __builtin_amdgcn_mfma_f32_32x32x16_bf16(kf[s], qf[s], a, 0, 0, 0);
            sc[kb] = a;
        }
        float m = -INFINITY;
#pragma unroll
        for (int kb = 0; kb < 5; ++kb)
#pragma unroll
            for (int e = 0; e < 16; ++e) { const int jrel = 32 * kb + (e & 3) + 8 * (e >> 2) + 4 * hh;
                const bool valid = (jrel >= l31) && (jrel <= l31 + 128) && (n > 0 || (i0 + jrel) >= 128);
                const float sv = valid ? sc[kb][e] : -INFINITY; sc[kb][e] = sv; m = fmaxf(m, sv); }
        m = fmaxf(m, __shfl_xor(m, 32));
        float l = 0.f;
#pragma unroll
        for (int kb = 0; kb < 5; ++kb)
#pragma unroll
            for (int e = 0; e < 16; ++e) { const float pe = __expf(sc[kb][e] - m); sc[kb][e] = pe; l += pe; }
        l += __shfl_xor(l, 32);
        __syncthreads();
        f32x16 o[2];
#pragma unroll
        for (int c = 0; c < 2; ++c)
#pragma unroll
            for (int e = 0; e < 16; ++e) o[c][e] = 0.f;
        const unsigned vbase = (unsigned)(size_t)vl;
        const int q4 = (lane & 15) >> 2, pp = lane & 3, bk = (lane >> 4) & 1;
#pragma unroll
        for (int kb = 0; kb < 5; ++kb)
#pragma unroll
            for (int s2 = 0; s2 < 2; ++s2) {
                u32x4 pw; pw.x = cvt_pk_bf16(sc[kb][8 * s2 + 0], sc[kb][8 * s2 + 1]); pw.y = cvt_pk_bf16(sc[kb][8 * s2 + 2], sc[kb][8 * s2 + 3]);
                pw.z = cvt_pk_bf16(sc[kb][8 * s2 + 4], sc[kb][8 * s2 + 5]); pw.w = cvt_pk_bf16(sc[kb][8 * s2 + 6], sc[kb][8 * s2 + 7]);
                const bf16x8 pf = __builtin_bit_cast(bf16x8, pw);
                const int rowb = i0 + 32 * kb + 16 * s2 + 4 * hh + q4;
#pragma unroll
                for (int c = 0; c < 2; ++c) {
                    const unsigned a0 = vbase + (unsigned)(rowb * 128 + 64 * c + 32 * bk + 8 * pp);
                    const s16x4 v0 = tr_read(a0), v1 = tr_read(a0 + 8 * 128);
                    bf16x8 vf; vf[0] = v0[0]; vf[1] = v0[1]; vf[2] = v0[2]; vf[3] = v0[3]; vf[4] = v1[0]; vf[5] = v1[1]; vf[6] = v1[2]; vf[7] = v1[3];
                    o[c] = __builtin_amdgcn_mfma_f32_32x32x16_bf16(vf, pf, o[c], 0, 0, 0);
                }
            }
        const float inv = 1.0f / l;
        bf16_t* orow = OB + ((size_t)b * S + qp) * AW + h * HD;
#pragma unroll
        for (int c = 0; c < 2; ++c)
#pragma unroll
            for (int rg = 0; rg < 4; ++rg) { u32x2 wv; wv.x = cvt_pk_bf16(o[c][4 * rg] * inv, o[c][4 * rg + 1] * inv); wv.y = cvt_pk_bf16(o[c][4 * rg + 2] * inv, o[c][4 * rg + 3] * inv);
                *(u32x2*)(orow + 32 * c + 8 * rg + 4 * hh) = wv; }
        if (hh == 0) LSE[((size_t)b * S + qp) * NH + h] = m + __logf(l);
        __syncthreads();
    }
}

__device__ __forceinline__ void phase_s5_tables(const P& p, LAS unsigned char* lds, int g) {
    const int tid = otid();
    LAS float* pwr = (LAS float*)lds;
    LAS float* pwi = pwr + 33 * 64;
    LAS float* cre = pwi + 33 * 64;
    LAS float* cim = cre + 1024;
    LAS float* bbr = cim + 1024;
    LAS float* bbi = bbr + 1024;
    LAS float* Mt = bbi + 1024;
    __syncthreads();
    if (tid < NS) {
        const int n = tid, i = g * NS + n;
        const float dt = expf(p.log_dt[g]), lr = p.lam_re[i], li = p.lam_im[i];
        const float mag = expf(lr * dt), ar = mag * cosf(li * dt), ai = mag * sinf(li * dt);
        const float den = lr * lr + li * li, nr = ar - 1.0f, ni = ai;
        const float fr = (nr * lr + ni * li) / den, fi = (ni * lr - nr * li) / den;
        for (int q = 0; q < PC; ++q) { const float br = p.b_re[(size_t)i * PC + q], bi = p.b_im[(size_t)i * PC + q];
            bbr[n * PC + q] = fr * br - fi * bi; bbi[n * PC + q] = fr * bi + fi * br; }
        float xr = 1.0f, xi = 0.0f;
        for (int t = 0; t <= LCH; ++t) { pwr[t * NS + n] = xr; pwi[t * NS + n] = xi; const float yr = xr * ar - xi * ai, yi = xr * ai + xi * ar; xr = yr; xi = yi; }
        float* lamL = (float*)(p.ws + WS_S5P);
        lamL[(g * NS + n) * 2 + 0] = pwr[LCH * NS + n]; lamL[(g * NS + n) * 2 + 1] = pwi[LCH * NS + n];
    }
    for (int k = tid; k < PC * NS; k += NWAVES * 64) { cre[k] = p.c_re[(size_t)g * PC * NS + k]; cim[k] = p.c_im[(size_t)g * PC * NS + k]; }
    __syncthreads();
    for (int k = 0; k < 16; ++k) { const int idx = tid + 512 * k, tau = idx >> 8, pp = (idx >> 4) & 15, q = idx & 15;
        float acc = 0.f;
        for (int n = 0; n < NS; ++n) { const float cr = cre[pp * NS + n], ci = cim[pp * NS + n], pr = pwr[tau * NS + n], pi = pwi[tau * NS + n];
            const float xr = cr * pr - ci * pi, xi = cr * pi + ci * pr; acc += xr * bbr[n * PC + q] - xi * bbi[n * PC + q]; }
        if (tau == 0 && pp == q) acc += p.d_skip[g * PC + pp];
        Mt[idx] = acc; }
    __syncthreads();
    bf16_t* T = (bf16_t*)(p.ws + WS_S5T) + (size_t)g * 512 * KS5;
    for (int k = 0; k < 80; ++k) { const int ch = tid + 512 * k, row = ch / 80, cc = ch % 80, i = row >> 4, pp = row & 15; float v[8];
        if (cc < 64) { const int j = cc >> 1, q0 = (cc & 1) * 8;
#pragma unroll
            for (int e = 0; e < 8; ++e) v[e] = (j <= i) ? Mt[((i - j) * 16 + pp) * 16 + q0 + e] : 0.f;
        } else { const int m0 = (cc - 64) * 8;
#pragma unroll
            for (int e = 0; e < 8; ++e) { const int m = m0 + e, n = m & 63; const float cr = cre[pp * NS + n], ci = cim[pp * NS + n], pr = pwr[(i + 1) * NS + n], pi = pwi[(i + 1) * NS + n];
                v[e] = (m < 64) ? (cr * pr - ci * pi) : -(cr * pi + ci * pr); } }
        u32x4 o; o.x = cvt_pk_bf16(v[0], v[1]); o.y = cvt_pk_bf16(v[2], v[3]); o.z = cvt_pk_bf16(v[4], v[5]); o.w = cvt_pk_bf16(v[6], v[7]);
        *(u32x4*)(T + (size_t)row * KS5 + cc * 8) = o; }
    bf16_t* Eb = (bf16_t*)(p.ws + WS_S5E) + (size_t)g * 256 * KS5E;
    for (int k = 0; k < 32; ++k) { const int ch = tid + 512 * k, row = ch >> 6, cc = ch & 63, j = cc >> 1, q0 = (cc & 1) * 8, n = row & 63; float v[8];
#pragma unroll
        for (int e = 0; e < 8; ++e) { const float pr = pwr[(LCH - 1 - j) * NS + n], pi = pwi[(LCH - 1 - j) * NS + n], br = bbr[n * PC + q0 + e], bi = bbi[n * PC + q0 + e];
            v[e] = (row < 64) ? (pr * br - pi * bi) : ((row < 128) ? (pr * bi + pi * br) : 0.f); }
        u32x4 o; o.x = cvt_pk_bf16(v[0], v[1]); o.y = cvt_pk_bf16(v[2], v[3]); o.z = cvt_pk_bf16(v[4], v[5]); o.w = cvt_pk_bf16(v[6], v[7]);
        *(u32x4*)(Eb + (size_t)row * KS5E + cc * 8) = o; }
    __syncthreads();
}
__device__ __forceinline__ void phase_s5_carry(const P& p, int bid) {
    const int gt = bid * (NWAVES * 64) + otid();
    if (gt >= G * NS) return;
    const int g = gt >> 6, n = gt & 63;
    const float* lamL = (const float*)(p.ws + WS_S5P);
    const float* EF = (const float*)(p.ws + WS_EF) + (size_t)g * NCH * 128;
    bf16_t* UB2 = (bf16_t*)(p.ws + WS_UB2);
    const float lr = lamL[gt * 2], li = lamL[gt * 2 + 1];
    float xr = 0.f, xi = 0.f;
    for (int c0 = 0; c0 < NCH; c0 += 8) {
        float er[8], ei[8];
#pragma unroll
        for (int k = 0; k < 8; ++k) { er[k] = EF[(size_t)(c0 + k) * 128 + n]; ei[k] = EF[(size_t)(c0 + k) * 128 + 64 + n]; }
#pragma unroll
        for (int k = 0; k < 8; ++k) { const int c = c0 + k;
            bf16_t* xrow = UB2 + (size_t)(c * CROWS + LCH + (n >> 4)) * SW + g * PC + (n & 15);
            xrow[0] = f2bf(xr); xrow[4 * SW] = f2bf(xi);
            const float yr = lr * xr - li * xi + er[k], yi = lr * xi + li * xr + ei[k]; xr = yr; xi = yi; }
    }
}

__device__ __forceinline__ void phase_mix(const P& p, int bid, int Gn) {
    const int tid_ = otid(); const int lane = tid_ & 63, gw = bid * NWAVES + (tid_ >> 6), NGW = Gn * NWAVES;
    const bf16_t* OB = (const bf16_t*)(p.ws + WS_OB);
    const float* LSE = (const float*)(p.ws + WS_LSE);
    const float* Z = (const float*)(p.ws + WS_Z);
    bf16_t* YM = (bf16_t*)(p.ws + WS_YMIXB);
    for (int row = gw; row < S; row += NGW) {
        f32x4 a[4], z[4]; float sa = 0.f, sz = 0.f;
#pragma unroll
        for (int j = 0; j < 4; ++j) { const int c0 = 4 * lane + 256 * j, hd = c0 >> 6;
            float ls[3], mx = -INFINITY;
#pragma unroll
            for (int b = 0; b < 3; ++b) { ls[b] = LSE[((size_t)b * S + row) * NH + hd]; mx = fmaxf(mx, ls[b]); }
            float wsum = 0.f; f32x4 acc = (f32x4){0.f, 0.f, 0.f, 0.f};
#pragma unroll
            for (int b = 0; b < 3; ++b) { const float wb = __expf(ls[b] - mx); wsum += wb; const u32x2 ov = *(const u32x2*)(OB + ((size_t)b * S + row) * AW + c0);
                acc.x += wb * __uint_as_float(ov.x << 16); acc.y += wb * __uint_as_float(ov.x & 0xffff0000u); acc.z += wb * __uint_as_float(ov.y << 16); acc.w += wb * __uint_as_float(ov.y & 0xffff0000u); }
            a[j] = acc * (1.0f / wsum); sa += (a[j].x * a[j].x + a[j].y * a[j].y) + (a[j].z * a[j].z + a[j].w * a[j].w);
            z[j] = *(const f32x4*)(Z + (size_t)row * SW + c0); sz += (z[j].x * z[j].x + z[j].y * z[j].y) + (z[j].z * z[j].z + z[j].w * z[j].w); }
        const float ra = 1.0f / sqrtf(wave_sum(sa) * (1.0f / AW) + EPS), rz = 1.0f / sqrtf(wave_sum(sz) * (1.0f / SW) + EPS);
#pragma unroll
        for (int j = 0; j < 4; ++j) { const int c0 = 4 * lane + 256 * j;
            const f32x4 ga = *(const f32x4*)(p.attn_g + c0), gs = *(const f32x4*)(p.ssm_g + c0);
            const f32x4 oa = a[j] * ra * ga, oz = z[j] * rz * gs;
            u32x2 wa, wz; wa.x = cvt_pk_bf16(oa.x, oa.y); wa.y = cvt_pk_bf16(oa.z, oa.w); wz.x = cvt_pk_bf16(oz.x, oz.y); wz.y = cvt_pk_bf16(oz.z, oz.w);
            *(u32x2*)(YM + (size_t)row * D + c0) = wa; *(u32x2*)(YM + (size_t)row * D + AW + c0) = wz; }
    }
}

__device__ __forceinline__ void phase_norm2_router(const P& p, LAS unsigned char* lds, int bid, int Gn) {
    const int tid = otid(), lane = tid & 63, w = tid >> 6;
    const float* mod = (const float*)(p.ws + WS_MOD);
    const float* X1 = (const float*)(p.ws + WS_X1);
    bf16_t* hb = (bf16_t*)(p.ws + WS_HB);
    LAS float* hrow = (LAS float*)lds;
    LAS float* part = (LAS float*)(lds + 65536);
    LAS float* logit = (LAS float*)(lds + 81920);
    LAS int* sel_e = (LAS int*)(lds + 83968);
    LAS float* sel_g = (LAS float*)(lds + 84992);
    LAS int* sel_t = (LAS int*)(lds + 86016);
    LAS int* rank = (LAS int*)(lds + 86272);
    LAS int* hist = (LAS int*)(lds + 87296);
    LAS int* gbase = (LAS int*)(lds + 87424);
    int* idx = (int*)(p.ws + WS_IDX); float* gate = (float*)(p.ws + WS_GATE); int* slot = (int*)(p.ws + WS_SLOT);
    int* cnt = (int*)(p.ws + WS_CTL); int* list = (int*)(p.ws + WS_LIST);
    const int nit = (S / 8 + Gn - 1) / Gn;
    for (int it = 0; it < nit; ++it) {
        const int base = (it * Gn + bid) * 8, buf = it & 7;
        const bool live = base < S;
        if (live) {
            const int row = base + w;
            const f32x4* xr = (const f32x4*)(X1 + (size_t)row * D) + lane;
            f32x4 v[8]; float ss = 0.f;
#pragma unroll
            for (int j = 0; j < 8; ++j) { v[j] = xr[64 * j]; ss += (v[j].x * v[j].x + v[j].y * v[j].y) + (v[j].z * v[j].z + v[j].w * v[j].w); }
            const float rs = 1.0f / sqrtf(wave_sum(ss) * (1.0f / D) + EPS);
#pragma unroll
            for (int j = 0; j < 8; ++j) { const int c0 = 4 * lane + 256 * j;
                const f32x4 g = *(const f32x4*)(p.norm2_g + c0), sc = *(const f32x4*)(mod + 4 * D + c0), sh = *(const f32x4*)(mod + 3 * D + c0);
                const f32x4 o = v[j] * rs * g * (sc + 1.0f) + sh;
                u32x2 wv; wv.x = cvt_pk_bf16(o.x, o.y); wv.y = cvt_pk_bf16(o.z, o.w);
                *(u32x2*)(hb + (size_t)row * D + c0) = wv;
                *(LAS f32x4*)(hrow + w * D + c0) = o; }
        }
        __syncthreads();
        if (live) {
            const int e = tid & 31, pt = tid >> 5;
            float acc[8];
#pragma unroll
            for (int r = 0; r < 8; ++r) acc[r] = 0.f;
            for (int k4 = 0; k4 < 32; ++k4) { const int kk = pt * 128 + 4 * k4;
                const float w0 = p.w_router[(size_t)(kk + 0) * NE + e], w1 = p.w_router[(size_t)(kk + 1) * NE + e], w2 = p.w_router[(size_t)(kk + 2) * NE + e], w3 = p.w_router[(size_t)(kk + 3) * NE + e];
#pragma unroll
                for (int r = 0; r < 8; ++r) { const f32x4 h4 = *(const LAS f32x4*)(hrow + r * D + kk); acc[r] += (h4.x * w0 + h4.y * w1) + (h4.z * w2 + h4.w * w3); } }
#pragma unroll
            for (int r = 0; r < 8; ++r) part[(pt * 8 + r) * 32 + e] = acc[r];
        }
        __syncthreads();
        if (live && tid < 256) { const int r = tid >> 5, e = tid & 31; float sacc = p.b_router[e];
#pragma unroll
            for (int q = 0; q < 16; ++q) sacc += part[(q * 8 + r) * 32 + e];
            logit[r * 32 + e] = sacc; }
        __syncthreads();
        if (live && tid < 8) {
            unsigned used = 0u; float tv[TOPK]; int ti[TOPK];
#pragma unroll
            for (int k = 0; k < TOPK; ++k) { float best = -INFINITY; int bi = 0;
                for (int j = 0; j < NE; ++j) { const float v = logit[tid * 32 + j]; if (!((used >> j) & 1u) && v > best) { best = v; bi = j; } }
                used |= 1u << bi; tv[k] = best; ti[k] = bi; }
            const float mx = tv[0]; float ex[TOPK], sum = 0.f;
#pragma unroll
            for (int k = 0; k < TOPK; ++k) { ex[k] = __expf(tv[k] - mx); sum += ex[k]; }
            const float inv = 1.0f / sum; const int br = buf * 8 + tid;
            sel_t[br] = base + tid;
#pragma unroll
            for (int k = 0; k < TOPK; ++k) { sel_e[br * 4 + k] = ti[k]; sel_g[br * 4 + k] = ex[k] * inv; }
        }
        if (!live && tid < 8) sel_t[buf * 8 + tid] = -1;
        if (buf == 7 || it == nit - 1) {
            const int nrow = (buf + 1) * 8;
            if (tid < NE) hist[tid] = 0;
            __syncthreads();
            int my_e = 0, my_t = -1;
            if (tid < nrow * 4) { my_t = sel_t[tid >> 2]; if (my_t >= 0) { my_e = sel_e[tid]; rank[tid] = __hip_atomic_fetch_add((int*)(hist + my_e), 1, __ATOMIC_RELAXED, __HIP_MEMORY_SCOPE_WORKGROUP); } }
            __syncthreads();
            if (tid < NE) gbase[tid] = atomicAdd(&cnt[tid], hist[tid]);
            __syncthreads();
            if (tid < nrow * 4 && my_t >= 0) { const int a = my_t * TOPK + (tid & 3), sl = gbase[my_e] + rank[tid];
                idx[a] = my_e; gate[a] = sel_g[tid]; slot[a] = sl; list[(size_t)my_e * S + sl] = a; }
        }
        __syncthreads();
    }
}

__device__ __forceinline__ void phase_final(const P& p, int bid, int Gn) {
    const int tid_ = otid(); const int lane = tid_ & 63, gw = bid * NWAVES + (tid_ >> 6), NGW = Gn * NWAVES;
    const int* cnt = (const int*)(p.ws + WS_CTL);
    const int* idx = (const int*)(p.ws + WS_IDX); const int* slot = (const int*)(p.ws + WS_SLOT);
    const float* mod = (const float*)(p.ws + WS_MOD);
    const float* X1 = (const float*)(p.ws + WS_X1);
    const bf16_t* YA = (const bf16_t*)(p.ws + WS_YA);
    for (int row = gw; row < S; row += NGW) {
        int prow[TOPK];
#pragma unroll
        for (int k = 0; k < TOPK; ++k) { const int e = idx[row * TOPK + k]; int off = 0;
            for (int j = 0; j < NE; ++j) off += (j < e) ? ((cnt[j] + 255) & ~255) : 0;
            prow[k] = off + slot[row * TOPK + k]; }
        f32x4 v[8]; float ss = 0.f;
#pragma unroll
        for (int j = 0; j < 8; ++j) { const int c0 = 4 * lane + 256 * j; f32x4 m = (f32x4){0.f, 0.f, 0.f, 0.f};
#pragma unroll
            for (int k = 0; k < TOPK; ++k) { const u32x2 yv = *(const u32x2*)(YA + (size_t)prow[k] * D + c0);
                m.x += __uint_as_float(yv.x << 16); m.y += __uint_as_float(yv.x & 0xffff0000u); m.z += __uint_as_float(yv.y << 16); m.w += __uint_as_float(yv.y & 0xffff0000u); }
            const f32x4 g2 = *(const f32x4*)(mod + 5 * D + c0);
            v[j] = *(const f32x4*)(X1 + (size_t)row * D + c0) + g2 * m;
            ss += (v[j].x * v[j].x + v[j].y * v[j].y) + (v[j].z * v[j].z + v[j].w * v[j].w); }
        const float rs = 1.0f / sqrtf(wave_sum(ss) * (1.0f / D) + EPS);
#pragma unroll
        for (int j = 0; j < 8; ++j) { const int c0 = 4 * lane + 256 * j; const f32x4 fg = *(const f32x4*)(p.final_g + c0);
            *(f32x4*)(p.out + (size_t)row * D + c0) = v[j] * rs * fg; }
    }
}


#define XB_TMO      128
#define XB_XCNT(j)  (256  + 64 * (j))
#define XB_XSUB(j)  (1280 + 64 * (j))
#define XB_XGEN(j)  (2304 + 64 * (j))
#define XB_TOP      3328
#define XB_TOPGEN   3392
#define XCD_BAR_WORDS 3456
#define XB_SPIN_CAP (1u << 18)

__device__ __forceinline__ unsigned xb_ld(unsigned* p)              { return __hip_atomic_load(p, __ATOMIC_RELAXED, __HIP_MEMORY_SCOPE_AGENT); }
__device__ __forceinline__ unsigned xb_add(unsigned* p, unsigned v) { return __hip_atomic_fetch_add(p, v, __ATOMIC_RELAXED, __HIP_MEMORY_SCOPE_AGENT); }
__device__ __forceinline__ unsigned xb_xcc_id() { return (unsigned)__builtin_amdgcn_s_getreg((3 << 11) | 20) & 0xFu; }
#define XB_SPIN(cond, bar) do { unsigned _sp = 0; while (cond) { __builtin_amdgcn_s_sleep(1); \
    if ((++_sp & 255u) == 0u) { if (xb_ld(&(bar)[XB_TMO])) break; if (_sp > XB_SPIN_CAP) { atomicAdd(&(bar)[XB_TMO], 1u); break; } } } } while (0)

struct XcdBarrier {
    unsigned* bar; unsigned x;
    volatile LAS unsigned* st;
};

__device__ __forceinline__ XcdBarrier xcd_barrier_post(unsigned* bar, volatile LAS unsigned* st) {
    XcdBarrier b; b.bar = bar; b.x = xb_xcc_id(); b.st = st;
    if (threadIdx.x == 0) (void)xb_add(&bar[XB_XCNT(b.x)], 1u);
    return b;
}
__device__ __forceinline__ void xcd_barrier_complete(unsigned* bar, unsigned x, unsigned& nloc, unsigned& nx) {
    const unsigned G = gridDim.x * gridDim.y * gridDim.z;
    unsigned sum, cnt, mine, sp = 0u;
    for (;;) {
        sum = 0u; cnt = 0u; mine = 0u;
#pragma unroll
        for (unsigned j = 0; j < 16; ++j) { const unsigned c = xb_ld(&bar[XB_XCNT(j)]); sum += c; cnt += (c > 0u) ? 1u : 0u; mine = (j == x) ? c : mine; }
        if (sum == G) break;
        __builtin_amdgcn_s_sleep(1);
        if ((++sp & 255u) == 0u) { if (xb_ld(&bar[XB_TMO])) break; if (sp > XB_SPIN_CAP) { atomicAdd(&bar[XB_TMO], 1u); break; } }
    }
    nloc = mine > 0u ? mine : 1u; nx = cnt > 0u ? cnt : 1u;
}

__device__ __forceinline__ void xcd_barrier(const XcdBarrier& b) {
    asm volatile("s_waitcnt vmcnt(0)" ::: "memory");
    __syncthreads();
    if (threadIdx.x == 0) {
        unsigned* bar = b.bar;
        __builtin_amdgcn_s_waitcnt(0);
        unsigned nloc = b.st[0], nx = b.st[1];
        if (nloc == 0u) { xcd_barrier_complete(bar, b.x, nloc, nx); b.st[0] = nloc; b.st[1] = nx; }
        const unsigned old = xb_add(&bar[XB_XSUB(b.x)], 1u);
        const unsigned gen = old / nloc;
        if (old + 1u == (gen + 1u) * nloc) {
            __builtin_amdgcn_fence(__ATOMIC_RELEASE, "agent");
            asm volatile("s_waitcnt vmcnt(0)" ::: "memory");
            const unsigned og = xb_add(&bar[XB_TOP], 1u);
            const unsigned tg = og / nx;
            if (og + 1u == (tg + 1u) * nx) xb_add(&bar[XB_TOPGEN], 1u);
            else XB_SPIN(xb_ld(&bar[XB_TOPGEN]) == tg, bar);
            __builtin_amdgcn_fence(__ATOMIC_ACQUIRE, "agent");
            xb_add(&bar[XB_XGEN(b.x)], 1u);
            asm volatile("s_waitcnt vmcnt(0)" ::: "memory");
        } else {
            XB_SPIN(xb_ld(&bar[XB_XGEN(b.x)]) == gen, bar);
            __builtin_amdgcn_fence(__ATOMIC_ACQUIRE, "agent");
            asm volatile("s_waitcnt vmcnt(0)" ::: "memory");
        }
    }
    __syncthreads();
}
constexpr int CW_BAR = 4096;
constexpr int MISC_OFF = 131072;

typedef __attribute__((address_space(4))) const Args CArgs;
__device__ __forceinline__ const Args* kargs() { CArgs* k = (CArgs*)__builtin_amdgcn_kernarg_segment_ptr(); asm volatile("" : "+s"(k)); return (const Args*)k; }
__device__ __forceinline__ const float* asg(const float* q) { return (const float*)(GAS const float*)q; }
__device__ __forceinline__ P globalize(const P& q) {
    P r;
#define GZ(m) r.m = asg(q.m)
    GZ(x); GZ(c); GZ(w_ada); GZ(b_ada); GZ(norm1_g); GZ(w_in); GZ(lam_re); GZ(lam_im); GZ(b_re); GZ(b_im); GZ(c_re); GZ(c_im); GZ(d_skip); GZ(log_dt);
    GZ(w_glu); GZ(b_glu); GZ(attn_g); GZ(ssm_g); GZ(w_out); GZ(norm2_g); GZ(w_router); GZ(b_router); GZ(w_gu); GZ(b_gu); GZ(w_down); GZ(b_down); GZ(final_g);
#undef GZ
    r.out = (float*)(GAS float*)q.out; r.ws = (unsigned char*)(GAS unsigned char*)q.ws;
    return r;
}
__global__ void __launch_bounds__(NWAVES * 64, 2) mk_fwd(Args args_unused) {
    extern __shared__ __attribute__((aligned(16))) unsigned char lds_raw[];
    LAS unsigned char* lds = (LAS unsigned char*)lds_raw;
    const int lo = kargs()->ph_lo, hi = kargs()->ph_hi;
    const int Gn = gridDim.x, bid = blockIdx.x;
    if (threadIdx.x == 0) *(LAS u32x4*)(lds + MISC_OFF) = (u32x4){0u, 0u, 0u, 0u};
    __syncthreads();
    XcdBarrier bar; bar.bar = nullptr; bar.x = 0; bar.st = nullptr;
    if (hi - lo > 1) { unsigned* bw = (unsigned*)((unsigned char*)(GAS unsigned char*)kargs()->p.ws + WS_CTL) + CW_BAR; bar = xcd_barrier_post(bw, (volatile LAS unsigned*)(lds + MISC_OFF)); }
#define SEAM(k) do { if (lo <= (k) && (k) + 1 < hi) xcd_barrier(bar); } while (0)
#ifndef PHMASK
#define PHMASK 0x1fff
#endif
#define IN(k) (((PHMASK >> (k)) & 1) && lo <= (k) && (k) < hi)
#ifndef REPMASK
#define REPMASK 0
#endif
#define REPS(k) for (int rep_ = 0; rep_ < ((((REPMASK) >> (k)) & 1) ? 2 : 1); ++rep_)
#define PHASE_P const P p = globalize(kargs()->p); unsigned char* ws = p.ws; (void)ws
    if (IN(0)) REPS(0) { __syncthreads(); PHASE_P; phase_prologue(p, lds, bid, Gn); }
    SEAM(0);
    if (IN(1)) REPS(1) { __syncthreads(); PHASE_P; phase_norm1(p, bid, Gn); }
    SEAM(1);
    if (IN(2)) REPS(2) { __syncthreads();
        PHASE_P;
        typedef pg8::DenseSched<WS_HB, WS_WIN, S, INW, D> Sch; Sch Sd; Sd.init(ws, Gn, bid);
        pg8::EpiProj E{(bf16_t*)(ws + WS_QKV), (bf16_t*)(ws + WS_UB2)};
        pg8::gemm_phase<pg8::EpiProj, Sch>(lds + RING_OFF, Sd, E);
    }
    SEAM(2);
    if (IN(3)) REPS(3) { __syncthreads();
        PHASE_P;
        {   typedef pg8::S5Sched<0> Sch; Sch Ss; Ss.init(ws, Gn, bid);
            pg8::EpiS5E E{(float*)(ws + WS_EF)};
            pg8::gemm_phase<pg8::EpiS5E, Sch>(lds + RING_OFF, Ss, E); }
        __syncthreads();
        phase_attn(p, lds, bid, Gn);
    }
    SEAM(3);
    if (IN(4)) REPS(4) { __syncthreads(); PHASE_P; phase_s5_carry(p, bid); }
    SEAM(4);
    if (IN(5)) REPS(5) { __syncthreads();
        PHASE_P;
        typedef pg8::S5Sched<1> Sch; Sch Ss; Ss.init(ws, Gn, bid);
        pg8::EpiS5Y E{(bf16_t*)(ws + WS_YGB)};
        pg8::gemm_phase<pg8::EpiS5Y, Sch>(lds + RING_OFF, Ss, E);
    }
    SEAM(5);
    if (IN(6)) REPS(6) { __syncthreads();
        PHASE_P;
        typedef pg8::DenseSched<WS_YGB, WS_WGLU, S, SW, SW> Sch; Sch Sd; Sd.init(ws, Gn, bid);
        pg8::EpiGlu E{(const bf16_t*)(ws + WS_YGB), p.b_glu, (float*)(ws + WS_Z)};
        pg8::gemm_phase<pg8::EpiGlu, Sch>(lds + RING_OFF, Sd, E);
    }
    SEAM(6);
    if (IN(7)) REPS(7) { __syncthreads(); PHASE_P; phase_mix(p, bid, Gn); }
    SEAM(7);
    if (IN(8)) REPS(8) { __syncthreads();
        PHASE_P;
        typedef pg8::DenseSched<WS_YMIXB, WS_WOUT, S, D, D> Sch; Sch Sd; Sd.init(ws, Gn, bid);
        pg8::EpiResid E{p.x, (const float*)(ws + WS_MOD) + 2 * D, (float*)(ws + WS_X1)};
        pg8::gemm_phase<pg8::EpiResid, Sch>(lds + RING_OFF, Sd, E);
    }
    SEAM(8);
    if (IN(9)) REPS(9) { __syncthreads(); PHASE_P; phase_norm2_router(p, lds, bid, Gn); }
    SEAM(9);
    if (IN(10)) REPS(10) { __syncthreads();
        PHASE_P;
        pg8::MoeSched<1> Sm; Sm.init(ws, Gn, bid);
        pg8::EpiMoe1 E{p.b_gu, (bf16_t*)(ws + WS_ACT)};
        pg8::gemm_phase<pg8::EpiMoe1, pg8::MoeSched<1>>(lds + RING_OFF, Sm, E);
    }
    SEAM(10);
    if (IN(11)) REPS(11) { __syncthreads();
        PHASE_P;
        pg8::MoeSched<2> Sm; Sm.init(ws, Gn, bid);
        pg8::EpiMoe2 E{p.b_down, ws};
        pg8::gemm_phase<pg8::EpiMoe2, pg8::MoeSched<2>>(lds + RING_OFF, Sm, E);
    }
    SEAM(11);
    if (IN(12)) REPS(12) { __syncthreads(); PHASE_P; phase_final(p, bid, Gn); }
#undef IN
#undef PHASE_P
#undef SEAM
}

extern "C" void kernel_launch(void* const* d_in, const int* in_sizes, int n_in, void* d_out, int out_size, void* d_ws, size_t ws_size, hipStream_t stream) {
    static int grid = 0;
    if (grid == 0) {
        if (n_in != 27 || ws_size < WS_END) { fprintf(stderr, "kernel_launch: unexpected n_in %d or ws_size %zu (< %zu)\n", n_in, ws_size, (size_t)WS_END); grid = -1; return; }
        int dev = 0, cus = 0;
        if (hipGetDevice(&dev) != hipSuccess || hipDeviceGetAttribute(&cus, hipDeviceAttributeMultiprocessorCount, dev) != hipSuccess) { grid = -1; return; }
        if (hipFuncSetAttribute((const void*)mk_fwd, hipFuncAttributeMaxDynamicSharedMemorySize, LDS_BYTES) != hipSuccess) { fprintf(stderr, "hipFuncSetAttribute failed\n"); grid = -1; return; }
        grid = cus;
    }
    if (grid < 0) return;
    Args a{};
    const float** f = (const float**)&a.p;
    for (int i = 0; i < 27; ++i) f[i] = (const float*)d_in[i];
    a.p.out = (float*)d_out; a.p.ws = (unsigned char*)d_ws;
    (void)hipMemsetAsync(a.p.ws + WS_CTL, 0, 1 * MiB, stream);
#ifndef MK_PER_PHASE
    a.ph_lo = 0; a.ph_hi = 13; hipLaunchKernelGGL(mk_fwd, dim3(grid), dim3(NWAVES * 64), LDS_BYTES, stream, a);
#else
    for (int ph = 0; ph < 13; ++ph) { a.ph_lo = ph; a.ph_hi = ph + 1; hipLaunchKernelGGL(mk_fwd, dim3(grid), dim3(NWAVES * 64), LDS_BYTES, stream, a); }
#endif
}
```

```cpp
#include <hip/hip_runtime.h>
#include <cstdio>
#include <cstdint>

#ifndef MOE_FP8
#define MOE_FP8 1
#endif
constexpr int S = 16384, D = 2048, AW = 1024, SW = 1024, INW = 4096, NH = 16, HD = 64;
constexpr int G = 64, NS = 64, PC = 16;
constexpr int NE = 32, TOPK = 4, FF = 2048;
constexpr int LCH = 32, NCH = S / LCH;
constexpr int CROWS = 40;
constexpr int KS5 = 640, KS5E = 512;
constexpr int NASSIGN = S * TOPK;
constexpr int PADROWS = NASSIGN + NE * 256;
constexpr float EPS = 1e-6f;

constexpr size_t MiB = 1ull << 20;
constexpr size_t WS_CTL = 0;
constexpr size_t WS_MOD = 1 * MiB;
constexpr size_t WS_S5P = 2 * MiB;
constexpr size_t WS_IDX = 4 * MiB;
constexpr size_t WS_GATE = 5 * MiB;
constexpr size_t WS_SLOT = 6 * MiB;
constexpr size_t WS_LIST = 8 * MiB;
constexpr size_t WS_ECH = 12 * MiB;
constexpr size_t WS_X0 = 16 * MiB;
constexpr size_t WS_WIN = 32 * MiB;
constexpr size_t WS_WGLU = 48 * MiB;
constexpr size_t WS_WOUT = 50 * MiB;
constexpr size_t WS_HB = 64 * MiB;
constexpr size_t WS_PROJ = 128 * MiB;
constexpr size_t WS_QKV = WS_PROJ;
constexpr size_t WS_UB2 = WS_PROJ + 96 * MiB;
constexpr size_t WS_OB = WS_PROJ + 160 * MiB;
constexpr size_t WS_LSE = 20 * MiB;
constexpr size_t WS_YATT = WS_PROJ + 256 * MiB;
constexpr size_t WS_S5E = WS_YATT;
constexpr size_t WS_EF = WS_YATT + 16 * MiB;
constexpr size_t WS_YG = WS_YATT + 64 * MiB;
constexpr size_t WS_S5T = WS_YG;
constexpr size_t WS_YGB = WS_YG + 64 * MiB;
constexpr size_t WS_Z = WS_YGB + 32 * MiB;
constexpr size_t WS_YMIXB = WS_Z + 64 * MiB;
constexpr size_t WS_X1 = WS_YMIXB + 64 * MiB;
constexpr size_t WS_H2 = WS_X1 + 128 * MiB;
constexpr size_t WS_ACT = WS_H2 + 128 * MiB;
constexpr size_t WS_YA = WS_ACT + 288 * MiB;
constexpr size_t WS_WGU = WS_YA + 288 * MiB;
constexpr size_t WS_WDN = WS_WGU + 512 * MiB;
constexpr size_t WS_END = WS_WDN + 256 * MiB;

struct P {
    const float *x, *c, *w_ada, *b_ada, *norm1_g, *w_in, *lam_re, *lam_im, *b_re, *b_im, *c_re, *c_im, *d_skip, *log_dt,
        *w_glu, *b_glu, *attn_g, *ssm_g, *w_out, *norm2_g, *w_router, *b_router, *w_gu, *b_gu, *w_down, *b_down, *final_g;
    float* out;
    unsigned char* ws;
};
struct Args { P p; int ph_lo, ph_hi; };

#define GAS __attribute__((address_space(1)))
#define LAS __attribute__((address_space(3)))
typedef unsigned short bf16_t;
typedef short bf16x8 __attribute__((ext_vector_type(8)));
typedef float f32x4 __attribute__((ext_vector_type(4)));
typedef float f32x2 __attribute__((ext_vector_type(2)));
typedef unsigned u32x4 __attribute__((ext_vector_type(4)));
typedef unsigned u32x2 __attribute__((ext_vector_type(2)));
typedef int v4i32 __attribute__((ext_vector_type(4)));
typedef int v8i32 __attribute__((ext_vector_type(8)));

__device__ __forceinline__ float wave_sum(float v) {
#pragma unroll
    for (int o = 1; o < 64; o <<= 1) v += __shfl_xor(v, o);
    return v;
}
__device__ __forceinline__ float block_sum256(float v, float* red) {
    v = wave_sum(v);
    __syncthreads();
    if ((threadIdx.x & 63) == 0) red[threadIdx.x >> 6] = v;
    __syncthreads();
    return red[0] + red[1] + red[2] + red[3];
}
__device__ __forceinline__ float sigmoidf_(float x) { return __builtin_amdgcn_rcpf(1.0f + __builtin_amdgcn_exp2f(-1.4426950408889634f * x)); }
__device__ __forceinline__ unsigned cvt_pk_bf16(float lo, float hi) { unsigned r; asm volatile("v_cvt_pk_bf16_f32 %0, %1, %2" : "=v"(r) : "v"(lo), "v"(hi)); return r; }
__device__ __forceinline__ unsigned pk4_fp8(float a, float b, float c, float d) { int w = 0; w = __builtin_amdgcn_cvt_pk_fp8_f32(a, b, w, false); w = __builtin_amdgcn_cvt_pk_fp8_f32(c, d, w, true); return (unsigned)w; }
__device__ __forceinline__ float bf2f(bf16_t b) { return __uint_as_float(((unsigned)b) << 16); }
__device__ __forceinline__ bf16_t f2bf(float f) { return (bf16_t)(cvt_pk_bf16(f, 0.f) & 0xffffu); }
__device__ __forceinline__ int otid() { int t = threadIdx.x; asm volatile("" : "+v"(t)); return t; }

namespace pg8 {
constexpr int BM = 256, BK = 64, HALF = 128, HTB = HALF * BK * 2  , STAGE_BYTES = 8 * HTB, NXCD = 8, WGM = 8;
__host__ __device__ __forceinline__ int lds_byte(int r, int c) { const int st = (r >> 4) * 2 + (c >> 5), rr = r & 15, cc = c & 31, ob = rr * 64 + cc * 2; return st * 1024 + (ob ^ (((ob >> 9) & 1) << 5)); }
__host__ __device__ __forceinline__ void stage_rc(int b, int& R, int& C) { const int st = b / 1024, sb = b % 1024, swz = sb ^ (((sb >> 9) & 1) << 5); R = (st >> 1) * 16 + swz / 64; C = (st & 1) * 32 + (swz % 64) / 2; }
__host__ __device__ __forceinline__ int perm32(int rho) { const int n = rho >> 4, i = rho & 15; return 8 * (i >> 2) + 4 * n + (i & 3); }

struct Unit { int pm, pn, e, mt; };

__device__ __forceinline__ bool flat_to_tile(long L, int nM, int nN, int& pm, int& pn) {
    const int nwg = nM * nN; if (L >= nwg) return false;
    int wgid = (int)L; { const int q = nwg / NXCD, r = nwg % NXCD, xcd = wgid % NXCD, off = wgid / NXCD; wgid = (xcd < r ? xcd * (q + 1) : r * (q + 1) + (xcd - r) * q) + off; }
    const int nig = WGM * nN, gid = wgid / nig, fm = gid * WGM, gsz = (nM - fm) < WGM ? (nM - fm) : WGM;
    pm = fm + ((wgid % nig) % gsz); pn = (wgid % nig) / gsz; return true;
}

template <size_t AOFF, size_t BOFF, int M_, int N_, int K_>
struct DenseSched {
    static constexpr bool GATHER = false, FP8 = false;
    static constexpr int K = K_, nM = M_ / BM, nN = N_ / BM, KSTEP_A = 128;
    const unsigned char* ws; int Gn, c;
    __device__ void init(const unsigned char* ws_, int G_, int c_) { ws = ws_; Gn = G_; c = c_; }
    __device__ __forceinline__ bool next(int i, Unit& u) const { u.e = 0; u.mt = 0; return flat_to_tile((long)i * Gn + c, nM, nN, u.pm, u.pn); }
    __device__ __forceinline__ const char* a_ptr(const Unit& u) const { return (const char*)ws + AOFF + (size_t)u.pm * BM * K * 2; }
    __device__ __forceinline__ const char* b_ptr(const Unit& u) const { return (const char*)ws + BOFF + (size_t)u.pn * BM * K * 2; }
    __device__ __forceinline__ void a_off(const Unit&, unsigned (&off)[2][2]) const {
        const int tid = otid();
#pragma unroll
        for (int i = 0; i < 2; ++i) { int R, C; stage_rc(tid * 16 + i * 8192, R, C);
#pragma unroll
            for (int h = 0; h < 2; ++h) off[h][i] = (unsigned)((h * HALF + R) * K + C) * 2u; }
    }
};

template <int STAGE>
struct MoeSched {
    static constexpr bool GATHER = true, FP8 = (MOE_FP8 != 0);
    static constexpr int K = (STAGE == 1) ? D : FF, N = (STAGE == 1) ? 2 * FF : D, nN = N / BM, KSTEP_A = 128, KB = FP8 ? K : 2 * K;
    static constexpr size_t AOFF = (STAGE == 1) ? WS_HB : WS_ACT, BOFF = (STAGE == 1) ? WS_WGU : WS_WDN;
    const unsigned char* ws; int nM, Gn, c;
    __device__ void init(const unsigned char* ws_, int G_, int c_) {
        ws = ws_; Gn = G_; c = c_;
        const int* cnt = (const int*)(ws + WS_CTL);
        int t = 0; for (int j = 0; j < NE; ++j) t += (cnt[j] + 255) >> 8; nM = __builtin_amdgcn_readfirstlane(t);
    }
    __device__ __forceinline__ bool next(int i, Unit& u) const {
        if (!flat_to_tile((long)i * Gn + c, nM, nN, u.pm, u.pn)) return false;
        const int* cnt = (const int*)(ws + WS_CTL);
        int acc = 0, e = 0, mt = 0;
        for (int j = 0; j < NE; ++j) { const int nt = (cnt[j] + 255) >> 8; if (u.pm >= acc && u.pm < acc + nt) { e = j; mt = u.pm - acc; } acc += nt; }
        u.e = __builtin_amdgcn_readfirstlane(e); u.mt = __builtin_amdgcn_readfirstlane(mt); return true;
    }
    __device__ __forceinline__ const char* a_ptr(const Unit& u) const { return (STAGE == 1) ? (const char*)ws + AOFF : (const char*)ws + AOFF + (size_t)u.pm * BM * KB; }
    __device__ __forceinline__ const char* b_ptr(const Unit& u) const { return (const char*)ws + BOFF + ((size_t)u.e * N + (size_t)u.pn * BM) * KB; }
    __device__ __forceinline__ void a_off(const Unit& u, unsigned (&off)[2][2]) const {
        const int tid = otid();
        if (STAGE == 1) {
            const int* cnt = (const int*)(ws + WS_CTL); const int* list = (const int*)(ws + WS_LIST);
            const int ce = __builtin_amdgcn_readfirstlane(cnt[u.e]);
#pragma unroll
            for (int i = 0; i < 2; ++i) { int R, C; stage_rc(tid * 16 + i * 8192, R, C);
#pragma unroll
                for (int h = 0; h < 2; ++h) { int lr = u.mt * BM + h * HALF + R; lr = lr < ce ? lr : ce - 1; const int tok = list[(size_t)u.e * S + lr] >> 2; off[h][i] = (unsigned)(tok * KB + C * 2); } }
        } else {
#pragma unroll
            for (int i = 0; i < 2; ++i) { int R, C; stage_rc(tid * 16 + i * 8192, R, C);
#pragma unroll
                for (int h = 0; h < 2; ++h) off[h][i] = (unsigned)((h * HALF + R) * KB + C * 2); }
        }
    }
};

template <int MODE>
struct S5Sched {
    static constexpr bool GATHER = true, FP8 = false;
    static constexpr int K = MODE ? KS5 : KS5E, KSTEP_A = 4 * 1024 * 2, NCT = MODE ? 2 : 1, NUNITS = G * 2 * NCT;
    const unsigned char* ws; int Gn, c;
    __device__ void init(const unsigned char* ws_, int G_, int c_) { ws = ws_; Gn = G_; c = c_; }
    __device__ __forceinline__ bool next(int i, Unit& u) const {
        const int L = i * Gn + c; if (L >= NUNITS) return false;
        u.e = L / (2 * NCT); const int rem = L % (2 * NCT); u.pm = rem / NCT; u.pn = rem % NCT; u.mt = 0; return true;
    }
    __device__ __forceinline__ const char* a_ptr(const Unit& u) const { return (const char*)ws + WS_UB2 + (size_t)u.e * (PC * 2); }
    __device__ __forceinline__ const char* b_ptr(const Unit& u) const { return (const char*)ws + (MODE ? WS_S5T : WS_S5E) + ((size_t)u.e * (MODE ? 512 : 256) + (size_t)u.pn * BM) * K * 2; }
    __device__ __forceinline__ void a_off(const Unit& u, unsigned (&off)[2][2]) const {
        const int tid = otid();
#pragma unroll
        for (int i = 0; i < 2; ++i) { int R, C; stage_rc(tid * 16 + i * 8192, R, C);
#pragma unroll
            for (int h = 0; h < 2; ++h) off[h][i] = (unsigned)(((u.pm * BM + h * HALF + R) * CROWS + (C >> 4)) * 2048 + (C & 15) * 2); }
    }
};

template <class Epi, class Sched>
__device__ __forceinline__ void gemm_phase(LAS unsigned char* lds, const Sched& S, const Epi& E) {
    const int tid = otid(), wid = __builtin_amdgcn_readfirstlane(tid >> 6), lane = tid & 63, wr = wid >> 2, wc = wid & 3, fr = lane & 15, fq = lane >> 4;
    constexpr int K = Sched::K, KB = Sched::FP8 ? K : 2 * K, nt = KB / (BK * 2);
    unsigned voffB[2];
#pragma unroll
    for (int i = 0; i < 2; ++i) { int sR, sC; stage_rc(tid * 16 + i * 8192, sR, sC); const int Rb = Epi::PERM ? ((sR & ~31) + perm32(sR & 31)) : sR; voffB[i] = (unsigned)(Rb * KB + sC * 2); }
    const size_t kstep = (size_t)(BK * 2);
    constexpr size_t kstepA = (size_t)Sched::KSTEP_A;
    const size_t hstep = (size_t)HALF * KB;
    const unsigned ldsw = (unsigned)wid * 1024u;
    const int aoff = lds_byte(wr * 64 + fr, fq * 8), boff = lds_byte(wc * 32 + fr, fq * 8);
#define PG8_SA(b, h) (((b) * 2 + (h)) * HTB)
#define PG8_SB(b, h) ((4 + (b) * 2 + (h)) * HTB)
#define PG8_STAGE(bufoff, gbase, voff) do { _Pragma("unroll") for (int _i = 0; _i < 2; ++_i) \
        __builtin_amdgcn_global_load_lds((const unsigned*)((const char*)(gbase) + (voff)[_i]), (LAS unsigned*)(lds + (bufoff) + ldsw + _i * 8192), 16, 0, 0); } while (0)
#define PG8_LDA(dst, b, h) do { _Pragma("unroll") for (int m = 0; m < 4; ++m) _Pragma("unroll") for (int k = 0; k < 2; ++k) dst[m][k] = *(const LAS bf16x8*)(lds + PG8_SA(b, h) + aoff + m * 2048 + k * 1024); } while (0)
#define PG8_LDB(dst, b, h) do { _Pragma("unroll") for (int n = 0; n < 2; ++n) _Pragma("unroll") for (int k = 0; k < 2; ++k) dst[n][k] = *(const LAS bf16x8*)(lds + PG8_SB(b, h) + boff + n * 2048 + k * 1024); } while (0)
#define PG8_MMA(ai, bj, At, Bt) do { __builtin_amdgcn_s_setprio(1); _Pragma("unroll") for (int m = 0; m < 4; ++m) _Pragma("unroll") for (int n = 0; n < 2; ++n) { \
        if constexpr (Sched::FP8) {   \
            const v8i32 a8_ = __builtin_shufflevector(__builtin_bit_cast(v4i32, At[m][0]), __builtin_bit_cast(v4i32, At[m][1]), 0, 1, 2, 3, 4, 5, 6, 7); \
            const v8i32 b8_ = __builtin_shufflevector(__builtin_bit_cast(v4i32, Bt[n][0]), __builtin_bit_cast(v4i32, Bt[n][1]), 0, 1, 2, 3, 4, 5, 6, 7); \
            acc[ai][bj][m][n] = __builtin_amdgcn_mfma_scale_f32_16x16x128_f8f6f4(b8_, a8_, acc[ai][bj][m][n], 0, 0, 0, 0x79797979  , 0, 0x7f7f7f7f); \
        } else { _Pragma("unroll") for (int k = 0; k < 2; ++k) acc[ai][bj][m][n] = __builtin_amdgcn_mfma_f32_16x16x32_bf16(Bt[n][k], At[m][k], acc[ai][bj][m][n], 0, 0, 0); } } \
        __builtin_amdgcn_s_setprio(0); } while (0)
#define PG8_WAIT_V(n) asm volatile("s_waitcnt vmcnt(" #n ")" ::: "memory")
#define PG8_WAIT_L(n) asm volatile("s_waitcnt lgkmcnt(" #n ")" ::: "memory")
#define PG8_BAR __builtin_amdgcn_s_barrier()
#define PG8_SCHED __builtin_amdgcn_sched_barrier(0)
    Unit cur, nxt; int ui = 0;
    if (!S.next(0, cur)) return;
    f32x4 acc[2][2][4][2];
#pragma unroll
    for (int a = 0; a < 2; ++a)
#pragma unroll
        for (int b = 0; b < 2; ++b)
#pragma unroll
            for (int m = 0; m < 4; ++m)
#pragma unroll
                for (int n = 0; n < 2; ++n) acc[a][b][m][n] = (f32x4){0.f, 0.f, 0.f, 0.f};
    bf16x8 At[4][2], B0[2][2], B1[2][2];
    const char* cA = S.a_ptr(cur); const char* cB = S.b_ptr(cur);
    unsigned ao[2][2]; S.a_off(cur, ao);
    PG8_STAGE(PG8_SB(0, 0), cB, voffB); PG8_STAGE(PG8_SB(0, 1), cB + hstep, voffB); PG8_STAGE(PG8_SA(0, 0), cA, ao[0]); PG8_STAGE(PG8_SA(0, 1), cA, ao[1]);
    if (wr == 1) PG8_BAR;
    PG8_WAIT_V(2); PG8_BAR;
    PG8_STAGE(PG8_SB(1, 0), cB + kstep, voffB); PG8_STAGE(PG8_SA(1, 0), cA + kstepA, ao[0]); PG8_STAGE(PG8_SB(1, 1), cB + hstep + kstep, voffB);
    PG8_WAIT_V(6); PG8_BAR;
    for (;;) {
        const bool has_next = S.next(ui + 1, nxt);
        const char* nA = has_next ? S.a_ptr(nxt) : cA; const char* nB = has_next ? S.b_ptr(nxt) : cB;
        for (int t = 0; t < nt; t += 2) {
            const bool last = (t == nt - 2);
            const char* a1 = cA + (size_t)(t + 1) * kstepA;
            const char* a2 = last ? nA : cA + (size_t)(t + 2) * kstepA; const char* b2 = last ? nB : cB + (size_t)(t + 2) * kstep;
            const char* a3 = a2 + kstepA; const char* b3 = b2 + kstep;
            asm volatile("" : "+v"(voffB[0]), "+v"(voffB[1]), "+v"(ao[0][0]), "+v"(ao[0][1]), "+v"(ao[1][0]), "+v"(ao[1][1]));

            PG8_LDB(B0, 0, 0); PG8_LDB(B1, 0, 1); PG8_SCHED; PG8_LDA(At, 0, 0); PG8_STAGE(PG8_SA(1, 1), a1, ao[1]);
            PG8_WAIT_V(8); PG8_WAIT_L(0); PG8_BAR; PG8_MMA(0, 0, At, B0); PG8_MMA(0, 1, At, B1); PG8_BAR; PG8_SCHED;
            if (Sched::GATHER) { if (last && has_next) S.a_off(nxt, ao); }
            PG8_LDA(At, 0, 1); PG8_STAGE(PG8_SB(0, 0), b2, voffB); PG8_STAGE(PG8_SB(0, 1), b2 + hstep, voffB); PG8_STAGE(PG8_SA(0, 0), a2, ao[0]);
            PG8_WAIT_V(8); PG8_WAIT_L(0); PG8_BAR; PG8_MMA(1, 0, At, B0); PG8_MMA(1, 1, At, B1); PG8_BAR; PG8_SCHED;
            PG8_LDB(B0, 1, 0); PG8_LDB(B1, 1, 1); PG8_SCHED; PG8_LDA(At, 1, 0); PG8_STAGE(PG8_SA(0, 1), a2, ao[1]);
            PG8_WAIT_V(8); PG8_WAIT_L(0); PG8_BAR; PG8_MMA(0, 0, At, B0); PG8_MMA(0, 1, At, B1); PG8_BAR; PG8_SCHED;
            PG8_LDA(At, 1, 1); PG8_STAGE(PG8_SB(1, 0), b3, voffB); PG8_STAGE(PG8_SB(1, 1), b3 + hstep, voffB); PG8_STAGE(PG8_SA(1, 0), a3, ao[0]);
            PG8_WAIT_V(8); PG8_WAIT_L(0); PG8_BAR; PG8_MMA(1, 0, At, B0); PG8_MMA(1, 1, At, B1); PG8_BAR; PG8_SCHED;
        }
        if (wr == 0) PG8_BAR;
        {
            const int t2 = otid(), wid2 = __builtin_amdgcn_readfirstlane(t2 >> 6), lane2 = t2 & 63;
            E(acc, cur, wid2 >> 2, wid2 & 3, lane2 & 15, lane2 >> 4); }
        if (!has_next) break;
#pragma unroll
        for (int a = 0; a < 2; ++a)
#pragma unroll
            for (int b = 0; b < 2; ++b)
#pragma unroll
                for (int m = 0; m < 4; ++m)
#pragma unroll
                    for (int n = 0; n < 2; ++n) acc[a][b][m][n] = (f32x4){0.f, 0.f, 0.f, 0.f};
        cur = nxt; cA = nA; cB = nB; ++ui;
        if (wr == 1) PG8_BAR;
    }
    PG8_WAIT_V(0);
    PG8_BAR;
#undef PG8_SA
#undef PG8_SB
#undef PG8_STAGE
#undef PG8_LDA
#undef PG8_LDB
#undef PG8_MMA
#undef PG8_WAIT_V
#undef PG8_WAIT_L
#undef PG8_BAR
#undef PG8_SCHED
}

struct EpiF32 {
    static constexpr bool PERM = false;
    float* C; int ldc;
    __device__ __forceinline__ void operator()(const f32x4 (&acc)[2][2][4][2], const Unit& u, int wr, int wc, int fr, int fq) const {
        const int row0 = u.pm * BM + wr * 64 + fr, col0 = u.pn * BM + wc * 32 + 4 * fq;
#pragma unroll
        for (int ai = 0; ai < 2; ++ai)
#pragma unroll
            for (int m = 0; m < 4; ++m) { float* rowp = C + (size_t)(row0 + ai * HALF + m * 16) * ldc + col0;
#pragma unroll
                for (int bj = 0; bj < 2; ++bj)
#pragma unroll
                    for (int n = 0; n < 2; ++n) *(f32x4*)(rowp + bj * HALF + n * 16) = acc[ai][bj][m][n]; }
    }
};
struct EpiGlu {
    static constexpr bool PERM = false;
    const bf16_t* yg; const float* bias; float* Z;
    __device__ __forceinline__ void operator()(const f32x4 (&acc)[2][2][4][2], const Unit& u, int wr, int wc, int fr, int fq) const {
        const int row0 = u.pm * BM + wr * 64 + fr, col0 = u.pn * BM + wc * 32 + 4 * fq;
#pragma unroll
        for (int ai = 0; ai < 2; ++ai)
#pragma unroll
            for (int m = 0; m < 4; ++m) { const size_t ro = (size_t)(row0 + ai * HALF + m * 16) * SW + col0;
#pragma unroll
                for (int bj = 0; bj < 2; ++bj)
#pragma unroll
                    for (int n = 0; n < 2; ++n) { const int co = bj * HALF + n * 16; const u32x2 yb = *(const u32x2*)(yg + ro + co); const f32x4 y = (f32x4){__uint_as_float(yb.x << 16), __uint_as_float(yb.x & 0xffff0000u), __uint_as_float(yb.y << 16), __uint_as_float(yb.y & 0xffff0000u)};
                        const f32x4 b = *(const f32x4*)(bias + col0 + co); f32x4 o;
#pragma unroll
                        for (int j = 0; j < 4; ++j) o[j] = y[j] * sigmoidf_(acc[ai][bj][m][n][j] + b[j]);
                        *(f32x4*)(Z + ro + co) = o; } }
    }
};
struct EpiResid {
    static constexpr bool PERM = false;
    const float* x; const float* gate; float* X1;
    __device__ __forceinline__ void operator()(const f32x4 (&acc)[2][2][4][2], const Unit& u, int wr, int wc, int fr, int fq) const {
        const int row0 = u.pm * BM + wr * 64 + fr, col0 = u.pn * BM + wc * 32 + 4 * fq;
#pragma unroll
        for (int ai = 0; ai < 2; ++ai)
#pragma unroll
            for (int m = 0; m < 4; ++m) { const size_t ro = (size_t)(row0 + ai * HALF + m * 16) * D + col0;
#pragma unroll
                for (int bj = 0; bj < 2; ++bj)
#pragma unroll
                    for (int n = 0; n < 2; ++n) { const int co = bj * HALF + n * 16; const f32x4 xv = *(const f32x4*)(x + ro + co); const f32x4 g = *(const f32x4*)(gate + col0 + co);
                        *(f32x4*)(X1 + ro + co) = xv + g * acc[ai][bj][m][n]; } }
    }
};
struct EpiMoe1 {
    static constexpr bool PERM = true;
    const float* b_gu; unsigned char* ACT;
    __device__ __forceinline__ void operator()(const f32x4 (&acc)[2][2][4][2], const Unit& u, int wr, int wc, int fr, int fq) const {
        const int row0 = u.pm * BM + wr * 64 + fr, j0 = u.pn * HALF + wc * 32 + 8 * fq;
        const float* bias = b_gu + (size_t)u.e * 2 * FF + 2 * j0;
        float bg[8], bl[8];
#pragma unroll
        for (int j = 0; j < 8; ++j) { bg[j] = bias[2 * j]; bl[j] = bias[2 * j + 1]; }
#pragma unroll
        for (int ai = 0; ai < 2; ++ai)
#pragma unroll
            for (int m = 0; m < 4; ++m) { const size_t eo = (size_t)(row0 + ai * HALF + m * 16) * FF + j0; float o[8];
#pragma unroll
                for (int n = 0; n < 2; ++n)
#pragma unroll
                    for (int j = 0; j < 4; ++j) { const float gl = fminf(acc[ai][0][m][n][j] + bg[4 * n + j], 7.0f); const float ln = fminf(fmaxf(acc[ai][1][m][n][j] + bl[4 * n + j], -7.0f), 7.0f);
                        o[4 * n + j] = gl * sigmoidf_(1.702f * gl) * (ln + 1.0f); }
#if MOE_FP8
                u32x2 w; w.x = pk4_fp8(o[0], o[1], o[2], o[3]); w.y = pk4_fp8(o[4], o[5], o[6], o[7]);
                *(u32x2*)(ACT + eo) = w; }
#else
                u32x4 w; w.x = cvt_pk_bf16(o[0], o[1]); w.y = cvt_pk_bf16(o[2], o[3]); w.z = cvt_pk_bf16(o[4], o[5]); w.w = cvt_pk_bf16(o[6], o[7]);
                *(u32x4*)(ACT + eo * 2) = w; }
#endif
    }
};
struct EpiMoe2 {
    static constexpr bool PERM = true;
    const float* b_down; const unsigned char* ws;
    __device__ __forceinline__ void operator()(const f32x4 (&acc)[2][2][4][2], const Unit& u, int wr, int wc, int fr, int fq) const {
        const int lr0 = u.mt * BM + wr * 64 + fr, row0 = u.pm * BM + wr * 64 + fr, col0 = u.pn * BM + wc * 32 + 8 * fq;
        const int* cnt = (const int*)(ws + WS_CTL); const int* list = (const int*)(ws + WS_LIST); const float* gate = (const float*)(ws + WS_GATE); bf16_t* YA = (bf16_t*)(ws + WS_YA);
        const int ce = __builtin_amdgcn_readfirstlane(cnt[u.e]);
        f32x4 bv[2][2];
#pragma unroll
        for (int bj = 0; bj < 2; ++bj)
#pragma unroll
            for (int n = 0; n < 2; ++n) bv[bj][n] = *(const f32x4*)(b_down + (size_t)u.e * D + col0 + bj * HALF + 4 * n);
#pragma unroll
        for (int ai = 0; ai < 2; ++ai)
#pragma unroll
            for (int m = 0; m < 4; ++m) { const int lr = lr0 + ai * HALF + m * 16; float g = 0.f; if (lr < ce) g = gate[list[(size_t)u.e * S + lr]];
                bf16_t* rowp = YA + (size_t)(row0 + ai * HALF + m * 16) * D + col0;
#pragma unroll
                for (int bj = 0; bj < 2; ++bj) { const f32x4 v0 = (acc[ai][bj][m][0] + bv[bj][0]) * g, v1 = (acc[ai][bj][m][1] + bv[bj][1]) * g;
                    u32x4 w; w.x = cvt_pk_bf16(v0[0], v0[1]); w.y = cvt_pk_bf16(v0[2], v0[3]); w.z = cvt_pk_bf16(v1[0], v1[1]); w.w = cvt_pk_bf16(v1[2], v1[3]);
                    *(u32x4*)(rowp + bj * HALF) = w; } }
    }
};
struct EpiS5E {
    static constexpr bool PERM = false;
    float* EF;
    __device__ __forceinline__ void operator()(const f32x4 (&acc)[2][2][4][2], const Unit& u, int wr, int wc, int fr, int fq) const {
        const int row0 = u.pm * BM + wr * 64 + fr, col0 = wc * 32 + 4 * fq;
#pragma unroll
        for (int ai = 0; ai < 2; ++ai)
#pragma unroll
            for (int m = 0; m < 4; ++m) { float* rowp = EF + ((size_t)u.e * NCH + row0 + ai * HALF + m * 16) * 128 + col0;
#pragma unroll
                for (int n = 0; n < 2; ++n) *(f32x4*)(rowp + n * 16) = acc[ai][0][m][n]; }
    }
};
struct EpiS5Y {
    static constexpr bool PERM = true;
    bf16_t* YGB;
    __device__ __forceinline__ void operator()(const f32x4 (&acc)[2][2][4][2], const Unit& u, int wr, int wc, int fr, int fq) const {
        const int c0 = u.pm * BM + wr * 64 + fr;
#pragma unroll
        for (int ai = 0; ai < 2; ++ai)
#pragma unroll
            for (int m = 0; m < 4; ++m) { const int c = c0 + ai * HALF + m * 16;
#pragma unroll
                for (int bj = 0; bj < 2; ++bj) { const int np = u.pn * BM + bj * HALF + wc * 32 + 8 * fq, i = np >> 4, p0 = np & 15; float o[8];
#pragma unroll
                    for (int n = 0; n < 2; ++n)
#pragma unroll
                        for (int j = 0; j < 4; ++j) { const float y = acc[ai][bj][m][n][j]; const float uu = 0.7978845608028654f * (y + 0.044715f * y * y * y);
                            o[4 * n + j] = y * __builtin_amdgcn_rcpf(1.0f + __builtin_amdgcn_exp2f(-2.885390081777927f * uu)); }
                    u32x4 w; w.x = cvt_pk_bf16(o[0], o[1]); w.y = cvt_pk_bf16(o[2], o[3]); w.z = cvt_pk_bf16(o[4], o[5]); w.w = cvt_pk_bf16(o[6], o[7]);
                    *(u32x4*)(YGB + (size_t)(c * LCH + i) * SW + u.e * PC + p0) = w; } }
    }
};
struct EpiProj {
    static constexpr bool PERM = false;
    bf16_t* QKV; bf16_t* UB2;
    __device__ __forceinline__ void operator()(const f32x4 (&acc)[2][2][4][2], const Unit& u, int wr, int wc, int fr, int fq) const {
        const int row0 = u.pm * BM + wr * 64 + fr, col0 = u.pn * BM + wc * 32 + 4 * fq;
        if (u.pn < 12) {
            const float sc = (u.pn < 4) ? 0.125f : 1.0f;
#pragma unroll
            for (int ai = 0; ai < 2; ++ai)
#pragma unroll
                for (int m = 0; m < 4; ++m) { bf16_t* rowp = QKV + (size_t)(row0 + ai * HALF + m * 16) * (3 * AW) + col0;
#pragma unroll
                    for (int bj = 0; bj < 2; ++bj)
#pragma unroll
                        for (int n = 0; n < 2; ++n) { const f32x4 v = acc[ai][bj][m][n] * sc; u32x2 w; w.x = cvt_pk_bf16(v[0], v[1]); w.y = cvt_pk_bf16(v[2], v[3]); *(u32x2*)(rowp + bj * HALF + n * 16) = w; } }
        } else {
#pragma unroll
            for (int ai = 0; ai < 2; ++ai)
#pragma unroll
                for (int m = 0; m < 4; ++m) { const int t = row0 + ai * HALF + m * 16; bf16_t* rowp = UB2 + (size_t)((t >> 5) * CROWS + (t & 31)) * SW + (col0 - 3 * AW);
#pragma unroll
                    for (int bj = 0; bj < 2; ++bj)
#pragma unroll
                        for (int n = 0; n < 2; ++n) { const f32x4 v = acc[ai][bj][m][n]; u32x2 w; w.x = cvt_pk_bf16(v[0], v[1]); w.y = cvt_pk_bf16(v[2], v[3]); *(u32x2*)(rowp + bj * HALF + n * 16) = w; } }
        }
    }
};
}

constexpr int NWAVES = 8;
constexpr int LDS_BYTES = 147456;
constexpr int RING_OFF = 0;
typedef short s16x4 __attribute__((ext_vector_type(4)));
typedef float f32x16 __attribute__((ext_vector_type(16)));

template <bool DEINT, bool OUT8 = false>
__device__ __forceinline__ void convert_tile(const float* W, int K, int N, bf16_t* WT, int tk, int tn, LAS float* scr) {
    const int tid = otid(), k0 = tk * 64, n0 = tn * 256;
    __syncthreads();
#pragma unroll
    for (int j = 0; j < 8; ++j) { const int k = j * 8 + (tid >> 6), g = tid & 63;
        const f32x4 v = *(const f32x4*)(W + (size_t)(k0 + k) * N + n0 + 4 * g);
        *(LAS f32x4*)(scr + k * 256 + ((g ^ j) << 2)) = v; }
    __syncthreads();
#pragma unroll
    for (int jj = 0; jj < 4; ++jj) { const int n = jj * 64 + (tid >> 3), c = tid & 7; float v[8];
#pragma unroll
        for (int q = 0; q < 8; ++q) v[q] = scr[(8 * c + q) * 256 + ((((n >> 2) ^ c)) << 2) + (n & 3)];
        u32x4 o; o.x = cvt_pk_bf16(v[0], v[1]); o.y = cvt_pk_bf16(v[2], v[3]); o.z = cvt_pk_bf16(v[4], v[5]); o.w = cvt_pk_bf16(v[6], v[7]);
        int row = n0 + n;
        if (DEINT) { const int s = n & 1, jl = n >> 1; row = n0 + s * 128 + jl; }
        if (OUT8) { u32x2 o8; o8.x = pk4_fp8(v[0] * 64.f, v[1] * 64.f, v[2] * 64.f, v[3] * 64.f); o8.y = pk4_fp8(v[4] * 64.f, v[5] * 64.f, v[6] * 64.f, v[7] * 64.f);
            *(u32x2*)((unsigned char*)WT + (size_t)row * K + k0 + 8 * c) = o8; }
        else *(u32x4*)(WT + (size_t)row * K + k0 + 8 * c) = o; }
}

__device__ __forceinline__ void phase_s5_tables(const P& p, LAS unsigned char* lds, int g);
__device__ __forceinline__ void phase_prologue(const P& p, LAS unsigned char* lds, int bid, int Gn) {
    unsigned char* ws = p.ws;
    const int tid = otid();
    if (bid < 192) {
        LAS f32x4* red = (LAS f32x4*)lds;
        const int cq = tid & 15, rg = tid >> 4;
        f32x4 acc = (f32x4){0.f, 0.f, 0.f, 0.f};
        for (int it = 0; it < 64; ++it) { const int i = rg + 32 * it; const float cv = p.c[i]; const float sv = cv / (1.0f + expf(-cv));
            const f32x4 w = *(const f32x4*)(p.w_ada + (size_t)i * 6 * D + 64 * bid + 4 * cq); acc += w * sv; }
        red[rg * 16 + cq] = acc;
        __syncthreads();
        if (tid < 64) { const LAS float* rf = (const LAS float*)lds; float s = p.b_ada[64 * bid + tid];
            for (int r = 0; r < 32; ++r) s += rf[r * 64 + tid];
            ((float*)(ws + WS_MOD))[64 * bid + tid] = s; }
    } else phase_s5_tables(p, lds, bid - 192);
    LAS float* scr = (LAS float*)(lds + RING_OFF);
    constexpr int T_IN = 32 * 16, T_GLU = 16 * 4, T_OUT = 32 * 8, T_GU = 32 * 16, T_DN = 32 * 8;
    constexpr int NT = T_IN + T_GLU + T_OUT + NE * (T_GU + T_DN);
    for (int it = bid; it < NT; it += Gn) {
        int r = it;
        if (r < T_IN) { convert_tile<false>(p.w_in, D, INW, (bf16_t*)(ws + WS_WIN), r / 16, r % 16, scr); continue; } r -= T_IN;
        if (r < T_GLU) { convert_tile<false>(p.w_glu, SW, SW, (bf16_t*)(ws + WS_WGLU), r / 4, r % 4, scr); continue; } r -= T_GLU;
        if (r < T_OUT) { convert_tile<false>(p.w_out, D, D, (bf16_t*)(ws + WS_WOUT), r / 8, r % 8, scr); continue; } r -= T_OUT;
        if (r < NE * T_GU) { const int e = r / T_GU, q = r % T_GU; convert_tile<true, MOE_FP8 != 0>(p.w_gu + (size_t)e * D * 2 * FF, D, 2 * FF, (bf16_t*)(ws + WS_WGU + (size_t)e * 2 * FF * D * (MOE_FP8 ? 1 : 2)), q / 16, q % 16, scr); continue; } r -= NE * T_GU;
        { const int e = r / T_DN, q = r % T_DN; convert_tile<false, MOE_FP8 != 0>(p.w_down + (size_t)e * FF * D, FF, D, (bf16_t*)(ws + WS_WDN + (size_t)e * D * FF * (MOE_FP8 ? 1 : 2)), q / 8, q % 8, scr); }
    }
    __syncthreads();
}

__device__ __forceinline__ void phase_norm1(const P& p, int bid, int Gn) {
    const int tid_ = otid(); const int lane = tid_ & 63, gw = bid * NWAVES + (tid_ >> 6), NGW = Gn * NWAVES;
    const float* mod = (const float*)(p.ws + WS_MOD);
    bf16_t* hb = (bf16_t*)(p.ws + WS_HB);
    for (int row = gw; row < S; row += NGW) {
        const f32x4* xr = (const f32x4*)(p.x + (size_t)row * D) + lane;
        f32x4 v[8]; float ss = 0.f;
#pragma unroll
        for (int j = 0; j < 8; ++j) { v[j] = xr[64 * j]; ss += (v[j].x * v[j].x + v[j].y * v[j].y) + (v[j].z * v[j].z + v[j].w * v[j].w); }
        const float rs = 1.0f / sqrtf(wave_sum(ss) * (1.0f / D) + EPS);
#pragma unroll
        for (int j = 0; j < 8; ++j) { const int c0 = 4 * lane + 256 * j;
            const f32x4 g = *(const f32x4*)(p.norm1_g + c0), sc = *(const f32x4*)(mod + D + c0), sh = *(const f32x4*)(mod + c0);
            const f32x4 o = v[j] * rs * g * (sc + 1.0f) + sh;
            u32x2 w; w.x = cvt_pk_bf16(o.x, o.y); w.y = cvt_pk_bf16(o.z, o.w);
            *(u32x2*)(hb + (size_t)row * D + c0) = w; }
    }
}

__device__ __forceinline__ s16x4 tr_read(unsigned lds_addr) { s16x4 r; asm volatile("ds_read_b64_tr_b16 %0, %1\n\ts_waitcnt lgkmcnt(0)" : "=&v"(r) : "v"(lds_addr) : "memory"); return r; }
__device__ __forceinline__ void phase_attn(const P& p, LAS unsigned char* lds, int bid, int Gn) {
    const bf16_t* QKV = (const bf16_t*)(p.ws + WS_QKV);
    bf16_t* OB = (bf16_t*)(p.ws + WS_OB);
    float* LSE = (float*)(p.ws + WS_LSE);
    const int tid = otid(), w = __builtin_amdgcn_readfirstlane(tid >> 6), lane = tid & 63, us = w >> 2, wq = w & 3;
    const int l31 = lane & 31, hh = lane >> 5, i0 = 32 * wq;
    constexpr int RS = 3 * AW;
    LAS unsigned char* vl = lds + us * 32768;
    for (int pr = bid; pr < 3072; pr += Gn) {
        const int u = pr * 2 + us;
        const int b = u >> 11, rem = u & 2047, blk = rem >> 4, h = rem & 15;
        const int dsh = 2 * b, d = 1 << dsh;
        const int n = blk >> dsh, r = blk & (d - 1);
        const int qbase = n * 128 * d + r, kbase = qbase - 128 * d;
#pragma unroll
        for (int it = 0; it < 8; ++it) { const int id = it * 64 + lane, row = 64 * wq + (id >> 3), ch = id & 7; const int kp = kbase + row * d;
            u32x4 v = (u32x4){0u, 0u, 0u, 0u};
            if (kp >= 0) v = *(const u32x4*)(QKV + (size_t)kp * RS + 2 * AW + h * HD + ch * 8);
            *(LAS u32x4*)(vl + row * 128 + ch * 16) = v; }
        const int qp = qbase + (i0 + l31) * d;
        bf16x8 qf[4];
#pragma unroll
        for (int s = 0; s < 4; ++s) qf[s] = *(const bf16x8*)(QKV + (size_t)qp * RS + h * HD + 16 * s + 8 * hh);
        f32x16 sc[5];
#pragma unroll
        for (int kb = 0; kb < 5; ++kb) {
            const int j = i0 + 32 * kb + l31; int kp = kbase + j * d; kp = kp < 0 ? 0 : kp;
            bf16x8 kf[4];
#pragma unroll
            for (int s = 0; s < 4; ++s) kf[s] = *(const bf16x8*)(QKV + (size_t)kp * RS + AW + h * HD + 16 * s + 8 * hh);
            f32x16 a;
#pragma unroll
            for (int e = 0; e < 16; ++e) a[e] = 0.f;
#pragma unroll
            for (int s = 0; s < 4; ++s) a = __builtin_amdgcn_mfma_f32_32x32x16_bf16(kf[s], qf[s], a, 0, 0, 0);
            sc[kb] = a;
        }
        float m = -INFINITY;
#pragma unroll
        for (int kb = 0; kb < 5; ++kb)
#pragma unroll
            for (int e = 0; e < 16; ++e) { const int jrel = 32 * kb + (e & 3) + 8 * (e >> 2) + 4 * hh;
                const bool valid = (jrel >= l31) && (jrel <= l31 + 128) && (n > 0 || (i0 + jrel) >= 128);
                const float sv = valid ? sc[kb][e] : -INFINITY; sc[kb][e] = sv; m = fmaxf(m, sv); }
        m = fmaxf(m, __shfl_xor(m, 32));
        float l = 0.f;
#pragma unroll
        for (int kb = 0; kb < 5; ++kb)
#pragma unroll
            for (int e = 0; e < 16; ++e) { const float pe = __expf(sc[kb][e] - m); sc[kb][e] = pe; l += pe; }
        l += __shfl_xor(l, 32);
        __syncthreads();
        f32x16 o[2];
#pragma unroll
        for (int c = 0; c < 2; ++c)
#pragma unroll
            for (int e = 0; e < 16; ++e) o[c][e] = 0.f;
        const unsigned vbase = (unsigned)(size_t)vl;
        const int q4 = (lane & 15) >> 2, pp = lane & 3, bk = (lane >> 4) & 1;
#pragma unroll
        for (int kb = 0; kb < 5; ++kb)
#pragma unroll
            for (int s2 = 0; s2 < 2; ++s2) {
                u32x4 pw; pw.x = cvt_pk_bf16(sc[kb][8 * s2 + 0], sc[kb][8 * s2 + 1]); pw.y = cvt_pk_bf16(sc[kb][8 * s2 + 2], sc[kb][8 * s2 + 3]);
                pw.z = cvt_pk_bf16(sc[kb][8 * s2 + 4], sc[kb][8 * s2 + 5]); pw.w = cvt_pk_bf16(sc[kb][8 * s2 + 6], sc[kb][8 * s2 + 7]);
                const bf16x8 pf = __builtin_bit_cast(bf16x8, pw);
                const int rowb = i0 + 32 * kb + 16 * s2 + 4 * hh + q4;
#pragma unroll
                for (int c = 0; c < 2; ++c) {
                    const unsigned a0 = vbase + (unsigned)(rowb * 128 + 64 * c + 32 * bk + 8 * pp);
                    const s16x4 v0 = tr_read(a0), v1 = tr_read(a0 + 8 * 128);
                    bf16x8 vf; vf[0] = v0[0]; vf[1] = v0[1]; vf[2] = v0[2]; vf[3] = v0[3]; vf[4] = v1[0]; vf[5] = v1[1]; vf[6] = v1[2]; vf[7] = v1[3];
                    o[c] = __builtin_amdgcn_mfma_f32_32x32x16_bf16(vf, pf, o[c], 0, 0, 0);
                }
            }
        const float inv = 1.0f / l;
        bf16_t* orow = OB + ((size_t)b * S + qp) * AW + h * HD;
#pragma unroll
        for (int c = 0; c < 2; ++c)
#pragma unroll
            for (int rg = 0; rg < 4; ++rg) { u32x2 wv; wv.x = cvt_pk_bf16(o[c][4 * rg] * inv, o[c][4 * rg + 1] * inv); wv.y = cvt_pk_bf16(o[c][4 * rg + 2] * inv, o[c][4 * rg + 3] * inv);
                *(u32x2*)(orow + 32 * c + 8 * rg + 4 * hh) = wv; }
        if (hh == 0) LSE[((size_t)b * S + qp) * NH + h] = m + __logf(l);
        __syncthreads();
    }
}

__device__ __forceinline__ void phase_s5_tables(const P& p, LAS unsigned char* lds, int g) {
    const int tid = otid();
    LAS float* pwr = (LAS float*)lds;
    LAS float* pwi = pwr + 33 * 64;
    LAS float* cre = pwi + 33 * 64;
    LAS float* cim = cre + 1024;
    LAS float* bbr = cim + 1024;
    LAS float* bbi = bbr + 1024;
    LAS float* Mt = bbi + 1024;
    __syncthreads();
    if (tid < NS) {
        const int n = tid, i = g * NS + n;
        const float dt = expf(p.log_dt[g]), lr = p.lam_re[i], li = p.lam_im[i];
        const float mag = expf(lr * dt), ar = mag * cosf(li * dt), ai = mag * sinf(li * dt);
        const float den = lr * lr + li * li, nr = ar - 1.0f, ni = ai;
        const float fr = (nr * lr + ni * li) / den, fi = (ni * lr - nr * li) / den;
        for (int q = 0; q < PC; ++q) { const float br = p.b_re[(size_t)i * PC + q], bi = p.b_im[(size_t)i * PC + q];
            bbr[n * PC + q] = fr * br - fi * bi; bbi[n * PC + q] = fr * bi + fi * br; }
        float xr = 1.0f, xi = 0.0f;
        for (int t = 0; t <= LCH; ++t) { pwr[t * NS + n] = xr; pwi[t * NS + n] = xi; const float yr = xr * ar - xi * ai, yi = xr * ai + xi * ar; xr = yr; xi = yi; }
        float* lamL = (float*)(p.ws + WS_S5P);
        lamL[(g * NS + n) * 2 + 0] = pwr[LCH * NS + n]; lamL[(g * NS + n) * 2 + 1] = pwi[LCH * NS + n];
    }
    for (int k = tid; k < PC * NS; k += NWAVES * 64) { cre[k] = p.c_re[(size_t)g * PC * NS + k]; cim[k] = p.c_im[(size_t)g * PC * NS + k]; }
    __syncthreads();
    for (int k = 0; k < 16; ++k) { const int idx = tid + 512 * k, tau = idx >> 8, pp = (idx >> 4) & 15, q = idx & 15;
        float acc = 0.f;
        for (int n = 0; n < NS; ++n) { const float cr = cre[pp * NS + n], ci = cim[pp * NS + n], pr = pwr[tau * NS + n], pi = pwi[tau * NS + n];
            const float xr = cr * pr - ci * pi, xi = cr * pi + ci * pr; acc += xr * bbr[n * PC + q] - xi * bbi[n * PC + q]; }
        if (tau == 0 && pp == q) acc += p.d_skip[g * PC + pp];
        Mt[idx] = acc; }
    __syncthreads();
    bf16_t* T = (bf16_t*)(p.ws + WS_S5T) + (size_t)g * 512 * KS5;
    for (int k = 0; k < 80; ++k) { const int ch = tid + 512 * k, row = ch / 80, cc = ch % 80, i = row >> 4, pp = row & 15; float v[8];
        if (cc < 64) { const int j = cc >> 1, q0 = (cc & 1) * 8;
#pragma unroll
            for (int e = 0; e < 8; ++e) v[e] = (j <= i) ? Mt[((i - j) * 16 + pp) * 16 + q0 + e] : 0.f;
        } else { const int m0 = (cc - 64) * 8;
#pragma unroll
            for (int e = 0; e < 8; ++e) { const int m = m0 + e, n = m & 63; const float cr = cre[pp * NS + n], ci = cim[pp * NS + n], pr = pwr[(i + 1) * NS + n], pi = pwi[(i + 1) * NS + n];
                v[e] = (m < 64) ? (cr * pr - ci * pi) : -(cr * pi + ci * pr); } }
        u32x4 o; o.x = cvt_pk_bf16(v[0], v[1]); o.y = cvt_pk_bf16(v[2], v[3]); o.z = cvt_pk_bf16(v[4], v[5]); o.w = cvt_pk_bf16(v[6], v[7]);
        *(u32x4*)(T + (size_t)row * KS5 + cc * 8) = o; }
    bf16_t* Eb = (bf16_t*)(p.ws + WS_S5E) + (size_t)g * 256 * KS5E;
    for (int k = 0; k < 32; ++k) { const int ch = tid + 512 * k, row = ch >> 6, cc = ch & 63, j = cc >> 1, q0 = (cc & 1) * 8, n = row & 63; float v[8];
#pragma unroll
        for (int e = 0; e < 8; ++e) { const float pr = pwr[(LCH - 1 - j) * NS + n], pi = pwi[(LCH - 1 - j) * NS + n], br = bbr[n * PC + q0 + e], bi = bbi[n * PC + q0 + e];
            v[e] = (row < 64) ? (pr * br - pi * bi) : ((row < 128) ? (pr * bi + pi * br) : 0.f); }
        u32x4 o; o.x = cvt_pk_bf16(v[0], v[1]); o.y = cvt_pk_bf16(v[2], v[3]); o.z = cvt_pk_bf16(v[4], v[5]); o.w = cvt_pk_bf16(v[6], v[7]);
        *(u32x4*)(Eb + (size_t)row * KS5E + cc * 8) = o; }
    __syncthreads();
}
__device__ __forceinline__ void phase_s5_carry(const P& p, int bid) {
    const int gt = bid * (NWAVES * 64) + otid();
    if (gt >= G * NS) return;
    const int g = gt >> 6, n = gt & 63;
    const float* lamL = (const float*)(p.ws + WS_S5P);
    const float* EF = (const float*)(p.ws + WS_EF) + (size_t)g * NCH * 128;
    bf16_t* UB2 = (bf16_t*)(p.ws + WS_UB2);
    const float lr = lamL[gt * 2], li = lamL[gt * 2 + 1];
    float xr = 0.f, xi = 0.f;
    for (int c0 = 0; c0 < NCH; c0 += 8) {
        float er[8], ei[8];
#pragma unroll
        for (int k = 0; k < 8; ++k) { er[k] = EF[(size_t)(c0 + k) * 128 + n]; ei[k] = EF[(size_t)(c0 + k) * 128 + 64 + n]; }
#pragma unroll
        for (int k = 0; k < 8; ++k) { const int c = c0 + k;
            bf16_t* xrow = UB2 + (size_t)(c * CROWS + LCH + (n >> 4)) * SW + g * PC + (n & 15);
            xrow[0] = f2bf(xr); xrow[4 * SW] = f2bf(xi);
            const float yr = lr * xr - li * xi + er[k], yi = lr * xi + li * xr + ei[k]; xr = yr; xi = yi; }
    }
}

__device__ __forceinline__ void phase_mix(const P& p, int bid, int Gn) {
    const int tid_ = otid(); const int lane = tid_ & 63, gw = bid * NWAVES + (tid_ >> 6), NGW = Gn * NWAVES;
    const bf16_t* OB = (const bf16_t*)(p.ws + WS_OB);
    const float* LSE = (const float*)(p.ws + WS_LSE);
    const float* Z = (const float*)(p.ws + WS_Z);
    bf16_t* YM = (bf16_t*)(p.ws + WS_YMIXB);
    for (int row = gw; row < S; row += NGW) {
        f32x4 a[4], z[4]; float sa = 0.f, sz = 0.f;
#pragma unroll
        for (int j = 0; j < 4; ++j) { const int c0 = 4 * lane + 256 * j, hd = c0 >> 6;
            float ls[3], mx = -INFINITY;
#pragma unroll
            for (int b = 0; b < 3; ++b) { ls[b] = LSE[((size_t)b * S + row) * NH + hd]; mx = fmaxf(mx, ls[b]); }
            float wsum = 0.f; f32x4 acc = (f32x4){0.f, 0.f, 0.f, 0.f};
#pragma unroll
            for (int b = 0; b < 3; ++b) { const float wb = __expf(ls[b] - mx); wsum += wb; const u32x2 ov = *(const u32x2*)(OB + ((size_t)b * S + row) * AW + c0);
                acc.x += wb * __uint_as_float(ov.x << 16); acc.y += wb * __uint_as_float(ov.x & 0xffff0000u); acc.z += wb * __uint_as_float(ov.y << 16); acc.w += wb * __uint_as_float(ov.y & 0xffff0000u); }
            a[j] = acc * (1.0f / wsum); sa += (a[j].x * a[j].x + a[j].y * a[j].y) + (a[j].z * a[j].z + a[j].w * a[j].w);
            z[j] = *(const f32x4*)(Z + (size_t)row * SW + c0); sz += (z[j].x * z[j].x + z[j].y * z[j].y) + (z[j].z * z[j].z + z[j].w * z[j].w); }
        const float ra = 1.0f / sqrtf(wave_sum(sa) * (1.0f / AW) + EPS), rz = 1.0f / sqrtf(wave_sum(sz) * (1.0f / SW) + EPS);
#pragma unroll
        for (int j = 0; j < 4; ++j) { const int c0 = 4 * lane + 256 * j;
            const f32x4 ga = *(const f32x4*)(p.attn_g + c0), gs = *(const f32x4*)(p.ssm_g + c0);
            const f32x4 oa = a[j] * ra * ga, oz = z[j] * rz * gs;
            u32x2 wa, wz; wa.x = cvt_pk_bf16(oa.x, oa.y); wa.y = cvt_pk_bf16(oa.z, oa.w); wz.x = cvt_pk_bf16(oz.x, oz.y); wz.y = cvt_pk_bf16(oz.z, oz.w);
            *(u32x2*)(YM + (size_t)row * D + c0) = wa; *(u32x2*)(YM + (size_t)row * D + AW + c0) = wz; }
    }
}

__device__ __forceinline__ void phase_norm2_router(const P& p, LAS unsigned char* lds, int bid, int Gn) {
    const int tid = otid(), lane = tid & 63, w = tid >> 6;
    const float* mod = (const float*)(p.ws + WS_MOD);
    const float* X1 = (const float*)(p.ws + WS_X1);
    bf16_t* hb = (bf16_t*)(p.ws + WS_HB);
    LAS float* hrow = (LAS float*)lds;
    LAS float* part = (LAS float*)(lds + 65536);
    LAS float* logit = (LAS float*)(lds + 81920);
    LAS int* sel_e = (LAS int*)(lds + 83968);
    LAS float* sel_g = (LAS float*)(lds + 84992);
    LAS int* sel_t = (LAS int*)(lds + 86016);
    LAS int* rank = (LAS int*)(lds + 86272);
    LAS int* hist = (LAS int*)(lds + 87296);
    LAS int* gbase = (LAS int*)(lds + 87424);
    int* idx = (int*)(p.ws + WS_IDX); float* gate = (float*)(p.ws + WS_GATE); int* slot = (int*)(p.ws + WS_SLOT);
    int* cnt = (int*)(p.ws + WS_CTL); int* list = (int*)(p.ws + WS_LIST);
    const int nit = (S / 8 + Gn - 1) / Gn;
    for (int it = 0; it < nit; ++it) {
        const int base = (it * Gn + bid) * 8, buf = it & 7;
        const bool live = base < S;
        if (live) {
            const int row = base + w;
            const f32x4* xr = (const f32x4*)(X1 + (size_t)row * D) + lane;
            f32x4 v[8]; float ss = 0.f;
#pragma unroll
            for (int j = 0; j < 8; ++j) { v[j] = xr[64 * j]; ss += (v[j].x * v[j].x + v[j].y * v[j].y) + (v[j].z * v[j].z + v[j].w * v[j].w); }
            const float rs = 1.0f / sqrtf(wave_sum(ss) * (1.0f / D) + EPS);
#pragma unroll
            for (int j = 0; j < 8; ++j) { const int c0 = 4 * lane + 256 * j;
                const f32x4 g = *(const f32x4*)(p.norm2_g + c0), sc = *(const f32x4*)(mod + 4 * D + c0), sh = *(const f32x4*)(mod + 3 * D + c0);
                const f32x4 o = v[j] * rs * g * (sc + 1.0f) + sh;
#if MOE_FP8
                *(unsigned*)((unsigned char*)hb + (size_t)row * D + c0) = pk4_fp8(o.x, o.y, o.z, o.w);
#else
                u32x2 wv; wv.x = cvt_pk_bf16(o.x, o.y); wv.y = cvt_pk_bf16(o.z, o.w);
                *(u32x2*)(hb + (size_t)row * D + c0) = wv;
#endif
                *(LAS f32x4*)(hrow + w * D + c0) = o; }
        }
        __syncthreads();
        if (live) {
            const int e = tid & 31, pt = tid >> 5;
            float acc[8];
#pragma unroll
            for (int r = 0; r < 8; ++r) acc[r] = 0.f;
            for (int k4 = 0; k4 < 32; ++k4) { const int kk = pt * 128 + 4 * k4;
                const float w0 = p.w_router[(size_t)(kk + 0) * NE + e], w1 = p.w_router[(size_t)(kk + 1) * NE + e], w2 = p.w_router[(size_t)(kk + 2) * NE + e], w3 = p.w_router[(size_t)(kk + 3) * NE + e];
#pragma unroll
                for (int r = 0; r < 8; ++r) { const f32x4 h4 = *(const LAS f32x4*)(hrow + r * D + kk); acc[r] += (h4.x * w0 + h4.y * w1) + (h4.z * w2 + h4.w * w3); } }
#pragma unroll
            for (int r = 0; r < 8; ++r) part[(pt * 8 + r) * 32 + e] = acc[r];
        }
        __syncthreads();
        if (live && tid < 256) { const int r = tid >> 5, e = tid & 31; float sacc = p.b_router[e];
#pragma unroll
            for (int q = 0; q < 16; ++q) sacc += part[(q * 8 + r) * 32 + e];
            logit[r * 32 + e] = sacc; }
        __syncthreads();
        if (live && tid < 8) {
            unsigned used = 0u; float tv[TOPK]; int ti[TOPK];
#pragma unroll
            for (int k = 0; k < TOPK; ++k) { float best = -INFINITY; int bi = 0;
                for (int j = 0; j < NE; ++j) { const float v = logit[tid * 32 + j]; if (!((used >> j) & 1u) && v > best) { best = v; bi = j; } }
                used |= 1u << bi; tv[k] = best; ti[k] = bi; }
            const float mx = tv[0]; float ex[TOPK], sum = 0.f;
#pragma unroll
            for (int k = 0; k < TOPK; ++k) { ex[k] = __expf(tv[k] - mx); sum += ex[k]; }
            const float inv = 1.0f / sum; const int br = buf * 8 + tid;
            sel_t[br] = base + tid;
#pragma unroll
            for (int k = 0; k < TOPK; ++k) { sel_e[br * 4 + k] = ti[k]; sel_g[br * 4 + k] = ex[k] * inv; }
        }
        if (!live && tid < 8) sel_t[buf * 8 + tid] = -1;
        if (buf == 7 || it == nit - 1) {
            const int nrow = (buf + 1) * 8;
            if (tid < NE) hist[tid] = 0;
            __syncthreads();
            int my_e = 0, my_t = -1;
            if (tid < nrow * 4) { my_t = sel_t[tid >> 2]; if (my_t >= 0) { my_e = sel_e[tid]; rank[tid] = __hip_atomic_fetch_add((int*)(hist + my_e), 1, __ATOMIC_RELAXED, __HIP_MEMORY_SCOPE_WORKGROUP); } }
            __syncthreads();
            if (tid < NE) gbase[tid] = atomicAdd(&cnt[tid], hist[tid]);
            __syncthreads();
            if (tid < nrow * 4 && my_t >= 0) { const int a = my_t * TOPK + (tid & 3), sl = gbase[my_e] + rank[tid];
                idx[a] = my_e; gate[a] = sel_g[tid]; slot[a] = sl; list[(size_t)my_e * S + sl] = a; }
        }
        __syncthreads();
    }
}

__device__ __forceinline__ void phase_final(const P& p, int bid, int Gn) {
    const int tid_ = otid(); const int lane = tid_ & 63, gw = bid * NWAVES + (tid_ >> 6), NGW = Gn * NWAVES;
    const int* cnt = (const int*)(p.ws + WS_CTL);
    const int* idx = (const int*)(p.ws + WS_IDX); const int* slot = (const int*)(p.ws + WS_SLOT);
    const float* mod = (const float*)(p.ws + WS_MOD);
    const float* X1 = (const float*)(p.ws + WS_X1);
    const bf16_t* YA = (const bf16_t*)(p.ws + WS_YA);
    for (int row = gw; row < S; row += NGW) {
        int prow[TOPK];
#pragma unroll
        for (int k = 0; k < TOPK; ++k) { const int e = idx[row * TOPK + k]; int off = 0;
            for (int j = 0; j < NE; ++j) off += (j < e) ? ((cnt[j] + 255) & ~255) : 0;
            prow[k] = off + slot[row * TOPK + k]; }
        f32x4 v[8]; float ss = 0.f;
#pragma unroll
        for (int j = 0; j < 8; ++j) { const int c0 = 4 * lane + 256 * j; f32x4 m = (f32x4){0.f, 0.f, 0.f, 0.f};
#pragma unroll
            for (int k = 0; k < TOPK; ++k) { const u32x2 yv = *(const u32x2*)(YA + (size_t)prow[k] * D + c0);
                m.x += __uint_as_float(yv.x << 16); m.y += __uint_as_float(yv.x & 0xffff0000u); m.z += __uint_as_float(yv.y << 16); m.w += __uint_as_float(yv.y & 0xffff0000u); }
            const f32x4 g2 = *(const f32x4*)(mod + 5 * D + c0);
            v[j] = *(const f32x4*)(X1 + (size_t)row * D + c0) + g2 * m;
            ss += (v[j].x * v[j].x + v[j].y * v[j].y) + (v[j].z * v[j].z + v[j].w * v[j].w); }
        const float rs = 1.0f / sqrtf(wave_sum(ss) * (1.0f / D) + EPS);
#pragma unroll
        for (int j = 0; j < 8; ++j) { const int c0 = 4 * lane + 256 * j; const f32x4 fg = *(const f32x4*)(p.final_g + c0);
            *(f32x4*)(p.out + (size_t)row * D + c0) = v[j] * rs * fg; }
    }
}


#define XB_TMO      128
#define XB_XCNT(j)  (256  + 64 * (j))
#define XB_XSUB(j)  (1280 + 64 * (j))
#define XB_XGEN(j)  (2304 + 64 * (j))
#define XB_TOP      3328
#define XB_TOPGEN   3392
#define XCD_BAR_WORDS 3456
#define XB_SPIN_CAP (1u << 18)

__device__ __forceinline__ unsigned xb_ld(unsigned* p)              { return __hip_atomic_load(p, __ATOMIC_RELAXED, __HIP_MEMORY_SCOPE_AGENT); }
__device__ __forceinline__ unsigned xb_add(unsigned* p, unsigned v) { return __hip_atomic_fetch_add(p, v, __ATOMIC_RELAXED, __HIP_MEMORY_SCOPE_AGENT); }
__device__ __forceinline__ unsigned xb_xcc_id() { return (unsigned)__builtin_amdgcn_s_getreg((3 << 11) | 20) & 0xFu; }
#define XB_SPIN(cond, bar) do { unsigned _sp = 0; while (cond) { __builtin_amdgcn_s_sleep(1); \
    if ((++_sp & 255u) == 0u) { if (xb_ld(&(bar)[XB_TMO])) break; if (_sp > XB_SPIN_CAP) { atomicAdd(&(bar)[XB_TMO], 1u); break; } } } } while (0)

struct XcdBarrier {
    unsigned* bar; unsigned x;
    volatile LAS unsigned* st;
};

__device__ __forceinline__ XcdBarrier xcd_barrier_post(unsigned* bar, volatile LAS unsigned* st) {
    XcdBarrier b; b.bar = bar; b.x = xb_xcc_id(); b.st = st;
    if (threadIdx.x == 0) (void)xb_add(&bar[XB_XCNT(b.x)], 1u);
    return b;
}
__device__ __forceinline__ void xcd_barrier_complete(unsigned* bar, unsigned x, unsigned& nloc, unsigned& nx) {
    const unsigned G = gridDim.x * gridDim.y * gridDim.z;
    unsigned sum, cnt, mine, sp = 0u;
    for (;;) {
        sum = 0u; cnt = 0u; mine = 0u;
#pragma unroll
        for (unsigned j = 0; j < 16; ++j) { const unsigned c = xb_ld(&bar[XB_XCNT(j)]); sum += c; cnt += (c > 0u) ? 1u : 0u; mine = (j == x) ? c : mine; }
        if (sum == G) break;
        __builtin_amdgcn_s_sleep(1);
        if ((++sp & 255u) == 0u) { if (xb_ld(&bar[XB_TMO])) break; if (sp > XB_SPIN_CAP) { atomicAdd(&bar[XB_TMO], 1u); break; } }
    }
    nloc = mine > 0u ? mine : 1u; nx = cnt > 0u ? cnt : 1u;
}

__device__ __forceinline__ void xcd_barrier(const XcdBarrier& b) {
    asm volatile("s_waitcnt vmcnt(0)" ::: "memory");
    __syncthreads();
    if (threadIdx.x == 0) {
        unsigned* bar = b.bar;
        __builtin_amdgcn_s_waitcnt(0);
        unsigned nloc = b.st[0], nx = b.st[1];
        if (nloc == 0u) { xcd_barrier_complete(bar, b.x, nloc, nx); b.st[0] = nloc; b.st[1] = nx; }
        const unsigned old = xb_add(&bar[XB_XSUB(b.x)], 1u);
        const unsigned gen = old / nloc;
        if (old + 1u == (gen + 1u) * nloc) {
            __builtin_amdgcn_fence(__ATOMIC_RELEASE, "agent");
            asm volatile("s_waitcnt vmcnt(0)" ::: "memory");
            const unsigned og = xb_add(&bar[XB_TOP], 1u);
            const unsigned tg = og / nx;
            if (og + 1u == (tg + 1u) * nx) xb_add(&bar[XB_TOPGEN], 1u);
            else XB_SPIN(xb_ld(&bar[XB_TOPGEN]) == tg, bar);
            __builtin_amdgcn_fence(__ATOMIC_ACQUIRE, "agent");
            xb_add(&bar[XB_XGEN(b.x)], 1u);
            asm volatile("s_waitcnt vmcnt(0)" ::: "memory");
        } else {
            XB_SPIN(xb_ld(&bar[XB_XGEN(b.x)]) == gen, bar);
            __builtin_amdgcn_fence(__ATOMIC_ACQUIRE, "agent");
            asm volatile("s_waitcnt vmcnt(0)" ::: "memory");
        }
    }
    __syncthreads();
}
constexpr int CW_BAR = 4096;
constexpr int MISC_OFF = 131072;

typedef __attribute__((address_space(4))) const Args CArgs;
__device__ __forceinline__ const Args* kargs() { CArgs* k = (CArgs*)__builtin_amdgcn_kernarg_segment_ptr(); asm volatile("" : "+s"(k)); return (const Args*)k; }
__device__ __forceinline__ const float* asg(const float* q) { return (const float*)(GAS const float*)q; }
__device__ __forceinline__ P globalize(const P& q) {
    P r;
#define GZ(m) r.m = asg(q.m)
    GZ(x); GZ(c); GZ(w_ada); GZ(b_ada); GZ(norm1_g); GZ(w_in); GZ(lam_re); GZ(lam_im); GZ(b_re); GZ(b_im); GZ(c_re); GZ(c_im); GZ(d_skip); GZ(log_dt);
    GZ(w_glu); GZ(b_glu); GZ(attn_g); GZ(ssm_g); GZ(w_out); GZ(norm2_g); GZ(w_router); GZ(b_router); GZ(w_gu); GZ(b_gu); GZ(w_down); GZ(b_down); GZ(final_g);
#undef GZ
    r.out = (float*)(GAS float*)q.out; r.ws = (unsigned char*)(GAS unsigned char*)q.ws;
    return r;
}
__global__ void __launch_bounds__(NWAVES * 64, 2) mk_fwd(Args args_unused) {
    extern __shared__ __attribute__((aligned(16))) unsigned char lds_raw[];
    LAS unsigned char* lds = (LAS unsigned char*)lds_raw;
    const int lo = kargs()->ph_lo, hi = kargs()->ph_hi;
    const int Gn = gridDim.x, bid = blockIdx.x;
    if (threadIdx.x == 0) *(LAS u32x4*)(lds + MISC_OFF) = (u32x4){0u, 0u, 0u, 0u};
    __syncthreads();
    XcdBarrier bar; bar.bar = nullptr; bar.x = 0; bar.st = nullptr;
    if (hi - lo > 1) { unsigned* bw = (unsigned*)((unsigned char*)(GAS unsigned char*)kargs()->p.ws + WS_CTL) + CW_BAR; bar = xcd_barrier_post(bw, (volatile LAS unsigned*)(lds + MISC_OFF)); }
#define SEAM(k) do { if (lo <= (k) && (k) + 1 < hi) xcd_barrier(bar); } while (0)
#ifndef PHMASK
#define PHMASK 0x1fff
#endif
#define IN(k) (((PHMASK >> (k)) & 1) && lo <= (k) && (k) < hi)
#ifndef REPMASK
#define REPMASK 0
#endif
#define REPS(k) for (int rep_ = 0; rep_ < ((((REPMASK) >> (k)) & 1) ? 2 : 1); ++rep_)
#define PHASE_P const P p = globalize(kargs()->p); unsigned char* ws = p.ws; (void)ws
    if (IN(0)) REPS(0) { __syncthreads(); PHASE_P; phase_prologue(p, lds, bid, Gn); }
    SEAM(0);
    if (IN(1)) REPS(1) { __syncthreads(); PHASE_P; phase_norm1(p, bid, Gn); }
    SEAM(1);
    if (IN(2)) REPS(2) { __syncthreads();
        PHASE_P;
        typedef pg8::DenseSched<WS_HB, WS_WIN, S, INW, D> Sch; Sch Sd; Sd.init(ws, Gn, bid);
        pg8::EpiProj E{(bf16_t*)(ws + WS_QKV), (bf16_t*)(ws + WS_UB2)};
        pg8::gemm_phase<pg8::EpiProj, Sch>(lds + RING_OFF, Sd, E);
    }
    SEAM(2);
    if (IN(3)) REPS(3) { __syncthreads();
        PHASE_P;
        {   typedef pg8::S5Sched<0> Sch; Sch Ss; Ss.init(ws, Gn, bid);
            pg8::EpiS5E E{(float*)(ws + WS_EF)};
            pg8::gemm_phase<pg8::EpiS5E, Sch>(lds + RING_OFF, Ss, E); }
        __syncthreads();
        phase_attn(p, lds, bid, Gn);
    }
    SEAM(3);
    if (IN(4)) REPS(4) { __syncthreads(); PHASE_P; phase_s5_carry(p, bid); }
    SEAM(4);
    if (IN(5)) REPS(5) { __syncthreads();
        PHASE_P;
        typedef pg8::S5Sched<1> Sch; Sch Ss; Ss.init(ws, Gn, bid);
        pg8::EpiS5Y E{(bf16_t*)(ws + WS_YGB)};
        pg8::gemm_phase<pg8::EpiS5Y, Sch>(lds + RING_OFF, Ss, E);
    }
    SEAM(5);
    if (IN(6)) REPS(6) { __syncthreads();
        PHASE_P;
        typedef pg8::DenseSched<WS_YGB, WS_WGLU, S, SW, SW> Sch; Sch Sd; Sd.init(ws, Gn, bid);
        pg8::EpiGlu E{(const bf16_t*)(ws + WS_YGB), p.b_glu, (float*)(ws + WS_Z)};
        pg8::gemm_phase<pg8::EpiGlu, Sch>(lds + RING_OFF, Sd, E);
    }
    SEAM(6);
    if (IN(7)) REPS(7) { __syncthreads(); PHASE_P; phase_mix(p, bid, Gn); }
    SEAM(7);
    if (IN(8)) REPS(8) { __syncthreads();
        PHASE_P;
        typedef pg8::DenseSched<WS_YMIXB, WS_WOUT, S, D, D> Sch; Sch Sd; Sd.init(ws, Gn, bid);
        pg8::EpiResid E{p.x, (const float*)(ws + WS_MOD) + 2 * D, (float*)(ws + WS_X1)};
        pg8::gemm_phase<pg8::EpiResid, Sch>(lds + RING_OFF, Sd, E);
    }
    SEAM(8);
    if (IN(9)) REPS(9) { __syncthreads(); PHASE_P; phase_norm2_router(p, lds, bid, Gn); }
    SEAM(9);
    if (IN(10)) REPS(10) { __syncthreads();
        PHASE_P;
        pg8::MoeSched<1> Sm; Sm.init(ws, Gn, bid);
        pg8::EpiMoe1 E{p.b_gu, ws + WS_ACT};
        pg8::gemm_phase<pg8::EpiMoe1, pg8::MoeSched<1>>(lds + RING_OFF, Sm, E);
    }
    SEAM(10);
    if (IN(11)) REPS(11) { __syncthreads();
        PHASE_P;
        pg8::MoeSched<2> Sm; Sm.init(ws, Gn, bid);
        pg8::EpiMoe2 E{p.b_down, ws};
        pg8::gemm_phase<pg8::EpiMoe2, pg8::MoeSched<2>>(lds + RING_OFF, Sm, E);
    }
    SEAM(11);
    if (IN(12)) REPS(12) { __syncthreads(); PHASE_P; phase_final(p, bid, Gn); }
#undef IN
#undef PHASE_P
#undef SEAM
}

extern "C" void kernel_launch(void* const* d_in, const int* in_sizes, int n_in, void* d_out, int out_size, void* d_ws, size_t ws_size, hipStream_t stream) {
    static int grid = 0;
    if (grid == 0) {
        if (n_in != 27 || ws_size < WS_END) { fprintf(stderr, "kernel_launch: unexpected n_in %d or ws_size %zu (< %zu)\n", n_in, ws_size, (size_t)WS_END); grid = -1; return; }
        int dev = 0, cus = 0;
        if (hipGetDevice(&dev) != hipSuccess || hipDeviceGetAttribute(&cus, hipDeviceAttributeMultiprocessorCount, dev) != hipSuccess) { grid = -1; return; }
        if (hipFuncSetAttribute((const void*)mk_fwd, hipFuncAttributeMaxDynamicSharedMemorySize, LDS_BYTES) != hipSuccess) { fprintf(stderr, "hipFuncSetAttribute failed\n"); grid = -1; return; }
        grid = cus;
    }
    if (grid < 0) return;
    Args a{};
    const float** f = (const float**)&a.p;
    for (int i = 0; i < 27; ++i) f[i] = (const float*)d_in[i];
    a.p.out = (float*)d_out; a.p.ws = (unsigned char*)d_ws;
    (void)hipMemsetAsync(a.p.ws + WS_CTL, 0, 1 * MiB, stream);
#ifndef MK_PER_PHASE
    a.ph_lo = 0; a.ph_hi = 13; hipLaunchKernelGGL(mk_fwd, dim3(grid), dim3(NWAVES * 64), LDS_BYTES, stream, a);
#else
    for (int ph = 0; ph < 13; ++ph) { a.ph_lo = ph; a.ph_hi = ph + 1; hipLaunchKernelGGL(mk_fwd, dim3(grid), dim3(NWAVES * 64), LDS_BYTES, stream, a); }
#endif
}
```

```cpp
#include <hip/hip_runtime.h>
#include <cstdio>
#include <cstdint>

#ifndef MOE_FP8
#define MOE_FP8 1
#endif
constexpr int S = 16384, D = 2048, AW = 1024, SW = 1024, INW = 4096, NH = 16, HD = 64;
constexpr int G = 64, NS = 64, PC = 16;
constexpr int NE = 32, TOPK = 4, FF = 2048;
constexpr int LCH = 32, NCH = S / LCH;
constexpr int CROWS = 40;
constexpr int KS5 = 640, KS5E = 512;
constexpr int NASSIGN = S * TOPK;
constexpr int PADROWS = NASSIGN + NE * 256;
constexpr float EPS = 1e-6f;

constexpr size_t MiB = 1ull << 20;
constexpr size_t WS_CTL = 0;
constexpr size_t WS_MOD = 1 * MiB;
constexpr size_t WS_S5P = 2 * MiB;
constexpr size_t WS_IDX = 4 * MiB;
constexpr size_t WS_GATE = 5 * MiB;
constexpr size_t WS_SLOT = 6 * MiB;
constexpr size_t WS_LIST = 8 * MiB;
constexpr size_t WS_ECH = 12 * MiB;
constexpr size_t WS_X0 = 16 * MiB;
constexpr size_t WS_WIN = 32 * MiB;
constexpr size_t WS_WGLU = 48 * MiB;
constexpr size_t WS_WOUT = 50 * MiB;
constexpr size_t WS_HB = 64 * MiB;
constexpr size_t WS_PROJ = 128 * MiB;
constexpr size_t WS_QKV = WS_PROJ;
constexpr size_t WS_UB2 = WS_PROJ + 96 * MiB;
constexpr size_t WS_OB = WS_PROJ + 160 * MiB;
constexpr size_t WS_LSE = 20 * MiB;
constexpr size_t WS_YATT = WS_PROJ + 256 * MiB;
constexpr size_t WS_S5E = WS_YATT;
constexpr size_t WS_EF = WS_YATT + 16 * MiB;
constexpr size_t WS_YG = WS_YATT + 64 * MiB;
constexpr size_t WS_S5T = WS_YG;
constexpr size_t WS_YGB = WS_YG + 64 * MiB;
constexpr size_t WS_Z = WS_YGB + 32 * MiB;
constexpr size_t WS_YMIXB = WS_Z + 64 * MiB;
constexpr size_t WS_X1 = WS_YMIXB + 64 * MiB;
constexpr size_t WS_H2 = WS_X1 + 128 * MiB;
constexpr size_t WS_ACT = WS_H2 + 128 * MiB;
constexpr size_t WS_YA = WS_ACT + 288 * MiB;
constexpr size_t WS_WGU = WS_YA + 288 * MiB;
constexpr size_t WS_WDN = WS_WGU + 512 * MiB;
constexpr size_t WS_END = WS_WDN + 256 * MiB;

struct P {
    const float *x, *c, *w_ada, *b_ada, *norm1_g, *w_in, *lam_re, *lam_im, *b_re, *b_im, *c_re, *c_im, *d_skip, *log_dt,
        *w_glu, *b_glu, *attn_g, *ssm_g, *w_out, *norm2_g, *w_router, *b_router, *w_gu, *b_gu, *w_down, *b_down, *final_g;
    float* out;
    unsigned char* ws;
};
struct Args { P p; int ph_lo, ph_hi; };

#define GAS __attribute__((address_space(1)))
#define LAS __attribute__((address_space(3)))
typedef unsigned short bf16_t;
typedef short bf16x8 __attribute__((ext_vector_type(8)));
typedef float f32x4 __attribute__((ext_vector_type(4)));
typedef float f32x2 __attribute__((ext_vector_type(2)));
typedef unsigned u32x4 __attribute__((ext_vector_type(4)));
typedef unsigned u32x2 __attribute__((ext_vector_type(2)));
typedef int v4i32 __attribute__((ext_vector_type(4)));
typedef int v8i32 __attribute__((ext_vector_type(8)));

__device__ __forceinline__ float wave_sum(float v) {
#pragma unroll
    for (int o = 1; o < 64; o <<= 1) v += __shfl_xor(v, o);
    return v;
}
__device__ __forceinline__ float block_sum256(float v, float* red) {
    v = wave_sum(v);
    __syncthreads();
    if ((threadIdx.x & 63) == 0) red[threadIdx.x >> 6] = v;
    __syncthreads();
    return red[0] + red[1] + red[2] + red[3];
}
__device__ __forceinline__ float sigmoidf_(float x) { return __builtin_amdgcn_rcpf(1.0f + __builtin_amdgcn_exp2f(-1.4426950408889634f * x)); }
__device__ __forceinline__ unsigned cvt_pk_bf16(float lo, float hi) { unsigned r; asm volatile("v_cvt_pk_bf16_f32 %0, %1, %2" : "=v"(r) : "v"(lo), "v"(hi)); return r; }
__device__ __forceinline__ unsigned pk4_fp8(float a, float b, float c, float d) { int w = 0; w = __builtin_amdgcn_cvt_pk_fp8_f32(a, b, w, false); w = __builtin_amdgcn_cvt_pk_fp8_f32(c, d, w, true); return (unsigned)w; }
__device__ __forceinline__ f32x4 bf4_to_f32(u32x2 v) { return (f32x4){__uint_as_float(v.x << 16), __uint_as_float(v.x & 0xffff0000u), __uint_as_float(v.y << 16), __uint_as_float(v.y & 0xffff0000u)}; }
__device__ __forceinline__ float bf2f(bf16_t b) { return __uint_as_float(((unsigned)b) << 16); }
__device__ __forceinline__ bf16_t f2bf(float f) { return (bf16_t)(cvt_pk_bf16(f, 0.f) & 0xffffu); }
__device__ __forceinline__ int otid() { int t = threadIdx.x; asm volatile("" : "+v"(t)); return t; }

namespace pg8 {
constexpr int BM = 256, BK = 64, HALF = 128, HTB = HALF * BK * 2  , STAGE_BYTES = 8 * HTB, NXCD = 8, WGM = 8;
__host__ __device__ __forceinline__ int lds_byte(int r, int c) { const int st = (r >> 4) * 2 + (c >> 5), rr = r & 15, cc = c & 31, ob = rr * 64 + cc * 2; return st * 1024 + (ob ^ (((ob >> 9) & 1) << 5)); }
__host__ __device__ __forceinline__ void stage_rc(int b, int& R, int& C) { const int st = b / 1024, sb = b % 1024, swz = sb ^ (((sb >> 9) & 1) << 5); R = (st >> 1) * 16 + swz / 64; C = (st & 1) * 32 + (swz % 64) / 2; }
__host__ __device__ __forceinline__ int perm32(int rho) { const int n = rho >> 4, i = rho & 15; return 8 * (i >> 2) + 4 * n + (i & 3); }

struct Unit { int pm, pn, e, mt; };

__device__ __forceinline__ bool flat_to_tile(long L, int nM, int nN, int& pm, int& pn) {
    const int nwg = nM * nN; if (L >= nwg) return false;
    int wgid = (int)L; { const int q = nwg / NXCD, r = nwg % NXCD, xcd = wgid % NXCD, off = wgid / NXCD; wgid = (xcd < r ? xcd * (q + 1) : r * (q + 1) + (xcd - r) * q) + off; }
    const int nig = WGM * nN, gid = wgid / nig, fm = gid * WGM, gsz = (nM - fm) < WGM ? (nM - fm) : WGM;
    pm = fm + ((wgid % nig) % gsz); pn = (wgid % nig) / gsz; return true;
}

template <size_t AOFF, size_t BOFF, int M_, int N_, int K_>
struct DenseSched {
    static constexpr bool GATHER = false, FP8 = false;
    static constexpr int K = K_, nM = M_ / BM, nN = N_ / BM, KSTEP_A = 128;
    const unsigned char* ws; int Gn, c;
    __device__ void init(const unsigned char* ws_, int G_, int c_) { ws = ws_; Gn = G_; c = c_; }
    __device__ __forceinline__ bool next(int i, Unit& u) const { u.e = 0; u.mt = 0; return flat_to_tile((long)i * Gn + c, nM, nN, u.pm, u.pn); }
    __device__ __forceinline__ const char* a_ptr(const Unit& u) const { return (const char*)ws + AOFF + (size_t)u.pm * BM * K * 2; }
    __device__ __forceinline__ const char* b_ptr(const Unit& u) const { return (const char*)ws + BOFF + (size_t)u.pn * BM * K * 2; }
    __device__ __forceinline__ void a_off(const Unit&, unsigned (&off)[2][2]) const {
        const int tid = otid();
#pragma unroll
        for (int i = 0; i < 2; ++i) { int R, C; stage_rc(tid * 16 + i * 8192, R, C);
#pragma unroll
            for (int h = 0; h < 2; ++h) off[h][i] = (unsigned)((h * HALF + R) * K + C) * 2u; }
    }
};

template <int STAGE>
struct MoeSched {
    static constexpr bool GATHER = true, FP8 = (MOE_FP8 != 0);
    static constexpr int K = (STAGE == 1) ? D : FF, N = (STAGE == 1) ? 2 * FF : D, nN = N / BM, KSTEP_A = 128, KB = FP8 ? K : 2 * K;
    static constexpr size_t AOFF = (STAGE == 1) ? WS_HB : WS_ACT, BOFF = (STAGE == 1) ? WS_WGU : WS_WDN;
    const unsigned char* ws; int nM, Gn, c;
    __device__ void init(const unsigned char* ws_, int G_, int c_) {
        ws = ws_; Gn = G_; c = c_;
        const int* cnt = (const int*)(ws + WS_CTL);
        int t = 0; for (int j = 0; j < NE; ++j) t += (cnt[j] + 255) >> 8; nM = __builtin_amdgcn_readfirstlane(t);
    }
    __device__ __forceinline__ bool next(int i, Unit& u) const {
        if (!flat_to_tile((long)i * Gn + c, nM, nN, u.pm, u.pn)) return false;
        const int* cnt = (const int*)(ws + WS_CTL);
        int acc = 0, e = 0, mt = 0;
        for (int j = 0; j < NE; ++j) { const int nt = (cnt[j] + 255) >> 8; if (u.pm >= acc && u.pm < acc + nt) { e = j; mt = u.pm - acc; } acc += nt; }
        u.e = __builtin_amdgcn_readfirstlane(e); u.mt = __builtin_amdgcn_readfirstlane(mt); return true;
    }
    __device__ __forceinline__ const char* a_ptr(const Unit& u) const { return (STAGE == 1) ? (const char*)ws + AOFF : (const char*)ws + AOFF + (size_t)u.pm * BM * KB; }
    __device__ __forceinline__ const char* b_ptr(const Unit& u) const { return (const char*)ws + BOFF + ((size_t)u.e * N + (size_t)u.pn * BM) * KB; }
    __device__ __forceinline__ void a_off(const Unit& u, unsigned (&off)[2][2]) const {
        const int tid = otid();
        if (STAGE == 1) {
            const int* cnt = (const int*)(ws + WS_CTL); const int* list = (const int*)(ws + WS_LIST);
            const int ce = __builtin_amdgcn_readfirstlane(cnt[u.e]);
#pragma unroll
            for (int i = 0; i < 2; ++i) { int R, C; stage_rc(tid * 16 + i * 8192, R, C);
#pragma unroll
                for (int h = 0; h < 2; ++h) { int lr = u.mt * BM + h * HALF + R; lr = lr < ce ? lr : ce - 1; const int tok = list[(size_t)u.e * S + lr] >> 2; off[h][i] = (unsigned)(tok * KB + C * 2); } }
        } else {
#pragma unroll
            for (int i = 0; i < 2; ++i) { int R, C; stage_rc(tid * 16 + i * 8192, R, C);
#pragma unroll
                for (int h = 0; h < 2; ++h) off[h][i] = (unsigned)((h * HALF + R) * KB + C * 2); }
        }
    }
};

template <int MODE>
struct S5Sched {
    static constexpr bool GATHER = true, FP8 = false;
    static constexpr int K = MODE ? KS5 : KS5E, KSTEP_A = 4 * 1024 * 2, NCT = MODE ? 2 : 1, NUNITS = G * 2 * NCT;
    const unsigned char* ws; int Gn, c;
    __device__ void init(const unsigned char* ws_, int G_, int c_) { ws = ws_; Gn = G_; c = c_; }
    __device__ __forceinline__ bool next(int i, Unit& u) const {
        const int L = i * Gn + c; if (L >= NUNITS) return false;
        u.e = L / (2 * NCT); const int rem = L % (2 * NCT); u.pm = rem / NCT; u.pn = rem % NCT; u.mt = 0; return true;
    }
    __device__ __forceinline__ const char* a_ptr(const Unit& u) const { return (const char*)ws + WS_UB2 + (size_t)u.e * (PC * 2); }
    __device__ __forceinline__ const char* b_ptr(const Unit& u) const { return (const char*)ws + (MODE ? WS_S5T : WS_S5E) + ((size_t)u.e * (MODE ? 512 : 256) + (size_t)u.pn * BM) * K * 2; }
    __device__ __forceinline__ void a_off(const Unit& u, unsigned (&off)[2][2]) const {
        const int tid = otid();
#pragma unroll
        for (int i = 0; i < 2; ++i) { int R, C; stage_rc(tid * 16 + i * 8192, R, C);
#pragma unroll
            for (int h = 0; h < 2; ++h) off[h][i] = (unsigned)(((u.pm * BM + h * HALF + R) * CROWS + (C >> 4)) * 2048 + (C & 15) * 2); }
    }
};

template <class Epi, class Sched>
__device__ __forceinline__ void gemm_phase(LAS unsigned char* lds, const Sched& S, const Epi& E) {
    const int tid = otid(), wid = __builtin_amdgcn_readfirstlane(tid >> 6), lane = tid & 63, wr = wid >> 2, wc = wid & 3, fr = lane & 15, fq = lane >> 4;
    constexpr int K = Sched::K, KB = Sched::FP8 ? K : 2 * K, nt = KB / (BK * 2);
    unsigned voffB[2];
#pragma unroll
    for (int i = 0; i < 2; ++i) { int sR, sC; stage_rc(tid * 16 + i * 8192, sR, sC); const int Rb = Epi::PERM ? ((sR & ~31) + perm32(sR & 31)) : sR; voffB[i] = (unsigned)(Rb * KB + sC * 2); }
    const size_t kstep = (size_t)(BK * 2);
    constexpr size_t kstepA = (size_t)Sched::KSTEP_A;
    const size_t hstep = (size_t)HALF * KB;
    const unsigned ldsw = (unsigned)wid * 1024u;
    const int aoff = lds_byte(wr * 64 + fr, fq * 8), boff = lds_byte(wc * 32 + fr, fq * 8);
#define PG8_SA(b, h) (((b) * 2 + (h)) * HTB)
#define PG8_SB(b, h) ((4 + (b) * 2 + (h)) * HTB)
#define PG8_STAGE(bufoff, gbase, voff) do { _Pragma("unroll") for (int _i = 0; _i < 2; ++_i) \
        __builtin_amdgcn_global_load_lds((const unsigned*)((const char*)(gbase) + (voff)[_i]), (LAS unsigned*)(lds + (bufoff) + ldsw + _i * 8192), 16, 0, 0); } while (0)
#define PG8_LDA(dst, b, h) do { _Pragma("unroll") for (int m = 0; m < 4; ++m) _Pragma("unroll") for (int k = 0; k < 2; ++k) dst[m][k] = *(const LAS bf16x8*)(lds + PG8_SA(b, h) + aoff + m * 2048 + k * 1024); } while (0)
#define PG8_LDB(dst, b, h) do { _Pragma("unroll") for (int n = 0; n < 2; ++n) _Pragma("unroll") for (int k = 0; k < 2; ++k) dst[n][k] = *(const LAS bf16x8*)(lds + PG8_SB(b, h) + boff + n * 2048 + k * 1024); } while (0)
#define PG8_MMA(ai, bj, At, Bt) do { __builtin_amdgcn_s_setprio(1); _Pragma("unroll") for (int m = 0; m < 4; ++m) _Pragma("unroll") for (int n = 0; n < 2; ++n) { \
        if constexpr (Sched::FP8) {   \
            const v8i32 a8_ = __builtin_shufflevector(__builtin_bit_cast(v4i32, At[m][0]), __builtin_bit_cast(v4i32, At[m][1]), 0, 1, 2, 3, 4, 5, 6, 7); \
            const v8i32 b8_ = __builtin_shufflevector(__builtin_bit_cast(v4i32, Bt[n][0]), __builtin_bit_cast(v4i32, Bt[n][1]), 0, 1, 2, 3, 4, 5, 6, 7); \
            acc[ai][bj][m][n] = __builtin_amdgcn_mfma_scale_f32_16x16x128_f8f6f4(b8_, a8_, acc[ai][bj][m][n], 0, 0, 0, 0x79797979  , 0, 0x7f7f7f7f); \
        } else { _Pragma("unroll") for (int k = 0; k < 2; ++k) acc[ai][bj][m][n] = __builtin_amdgcn_mfma_f32_16x16x32_bf16(Bt[n][k], At[m][k], acc[ai][bj][m][n], 0, 0, 0); } } \
        __builtin_amdgcn_s_setprio(0); } while (0)
#define PG8_WAIT_V(n) asm volatile("s_waitcnt vmcnt(" #n ")" ::: "memory")
#define PG8_WAIT_L(n) asm volatile("s_waitcnt lgkmcnt(" #n ")" ::: "memory")
#define PG8_BAR __builtin_amdgcn_s_barrier()
#define PG8_SCHED __builtin_amdgcn_sched_barrier(0)
    Unit cur, nxt; int ui = 0;
    if (!S.next(0, cur)) return;
    f32x4 acc[2][2][4][2];
#pragma unroll
    for (int a = 0; a < 2; ++a)
#pragma unroll
        for (int b = 0; b < 2; ++b)
#pragma unroll
            for (int m = 0; m < 4; ++m)
#pragma unroll
                for (int n = 0; n < 2; ++n) acc[a][b][m][n] = (f32x4){0.f, 0.f, 0.f, 0.f};
    bf16x8 At[4][2], B0[2][2], B1[2][2];
    const char* cA = S.a_ptr(cur); const char* cB = S.b_ptr(cur);
    unsigned ao[2][2]; S.a_off(cur, ao);
    PG8_STAGE(PG8_SB(0, 0), cB, voffB); PG8_STAGE(PG8_SB(0, 1), cB + hstep, voffB); PG8_STAGE(PG8_SA(0, 0), cA, ao[0]); PG8_STAGE(PG8_SA(0, 1), cA, ao[1]);
    if (wr == 1) PG8_BAR;
    PG8_WAIT_V(2); PG8_BAR;
    PG8_STAGE(PG8_SB(1, 0), cB + kstep, voffB); PG8_STAGE(PG8_SA(1, 0), cA + kstepA, ao[0]); PG8_STAGE(PG8_SB(1, 1), cB + hstep + kstep, voffB);
    PG8_WAIT_V(6); PG8_BAR;
    for (;;) {
        const bool has_next = S.next(ui + 1, nxt);
        const char* nA = has_next ? S.a_ptr(nxt) : cA; const char* nB = has_next ? S.b_ptr(nxt) : cB;
        for (int t = 0; t < nt; t += 2) {
            const bool last = (t == nt - 2);
            const char* a1 = cA + (size_t)(t + 1) * kstepA;
            const char* a2 = last ? nA : cA + (size_t)(t + 2) * kstepA; const char* b2 = last ? nB : cB + (size_t)(t + 2) * kstep;
            const char* a3 = a2 + kstepA; const char* b3 = b2 + kstep;
            asm volatile("" : "+v"(voffB[0]), "+v"(voffB[1]), "+v"(ao[0][0]), "+v"(ao[0][1]), "+v"(ao[1][0]), "+v"(ao[1][1]));

            PG8_LDB(B0, 0, 0); PG8_LDB(B1, 0, 1); PG8_SCHED; PG8_LDA(At, 0, 0); PG8_STAGE(PG8_SA(1, 1), a1, ao[1]);
            PG8_WAIT_V(8); PG8_WAIT_L(0); PG8_BAR; PG8_MMA(0, 0, At, B0); PG8_MMA(0, 1, At, B1); PG8_BAR; PG8_SCHED;
            if (Sched::GATHER) { if (last && has_next) S.a_off(nxt, ao); }
            PG8_LDA(At, 0, 1); PG8_STAGE(PG8_SB(0, 0), b2, voffB); PG8_STAGE(PG8_SB(0, 1), b2 + hstep, voffB); PG8_STAGE(PG8_SA(0, 0), a2, ao[0]);
            PG8_WAIT_V(8); PG8_WAIT_L(0); PG8_BAR; PG8_MMA(1, 0, At, B0); PG8_MMA(1, 1, At, B1); PG8_BAR; PG8_SCHED;
            PG8_LDB(B0, 1, 0); PG8_LDB(B1, 1, 1); PG8_SCHED; PG8_LDA(At, 1, 0); PG8_STAGE(PG8_SA(0, 1), a2, ao[1]);
            PG8_WAIT_V(8); PG8_WAIT_L(0); PG8_BAR; PG8_MMA(0, 0, At, B0); PG8_MMA(0, 1, At, B1); PG8_BAR; PG8_SCHED;
            PG8_LDA(At, 1, 1); PG8_STAGE(PG8_SB(1, 0), b3, voffB); PG8_STAGE(PG8_SB(1, 1), b3 + hstep, voffB); PG8_STAGE(PG8_SA(1, 0), a3, ao[0]);
            PG8_WAIT_V(8); PG8_WAIT_L(0); PG8_BAR; PG8_MMA(1, 0, At, B0); PG8_MMA(1, 1, At, B1); PG8_BAR; PG8_SCHED;
        }
        if (wr == 0) PG8_BAR;
        {
            const int t2 = otid(), wid2 = __builtin_amdgcn_readfirstlane(t2 >> 6), lane2 = t2 & 63;
            E(acc, cur, wid2 >> 2, wid2 & 3, lane2 & 15, lane2 >> 4); }
        if (!has_next) break;
#pragma unroll
        for (int a = 0; a < 2; ++a)
#pragma unroll
            for (int b = 0; b < 2; ++b)
#pragma unroll
                for (int m = 0; m < 4; ++m)
#pragma unroll
                    for (int n = 0; n < 2; ++n) acc[a][b][m][n] = (f32x4){0.f, 0.f, 0.f, 0.f};
        cur = nxt; cA = nA; cB = nB; ++ui;
        if (wr == 1) PG8_BAR;
    }
    PG8_WAIT_V(0);
    PG8_BAR;
#undef PG8_SA
#undef PG8_SB
#undef PG8_STAGE
#undef PG8_LDA
#undef PG8_LDB
#undef PG8_MMA
#undef PG8_WAIT_V
#undef PG8_WAIT_L
#undef PG8_BAR
#undef PG8_SCHED
}

struct EpiF32 {
    static constexpr bool PERM = false;
    float* C; int ldc;
    __device__ __forceinline__ void operator()(const f32x4 (&acc)[2][2][4][2], const Unit& u, int wr, int wc, int fr, int fq) const {
        const int row0 = u.pm * BM + wr * 64 + fr, col0 = u.pn * BM + wc * 32 + 4 * fq;
#pragma unroll
        for (int ai = 0; ai < 2; ++ai)
#pragma unroll
            for (int m = 0; m < 4; ++m) { float* rowp = C + (size_t)(row0 + ai * HALF + m * 16) * ldc + col0;
#pragma unroll
                for (int bj = 0; bj < 2; ++bj)
#pragma unroll
                    for (int n = 0; n < 2; ++n) *(f32x4*)(rowp + bj * HALF + n * 16) = acc[ai][bj][m][n]; }
    }
};
struct EpiGlu {
    static constexpr bool PERM = false;
    const bf16_t* yg; const float* bias; bf16_t* Z;
    __device__ __forceinline__ void operator()(const f32x4 (&acc)[2][2][4][2], const Unit& u, int wr, int wc, int fr, int fq) const {
        const int row0 = u.pm * BM + wr * 64 + fr, col0 = u.pn * BM + wc * 32 + 4 * fq;
#pragma unroll
        for (int ai = 0; ai < 2; ++ai)
#pragma unroll
            for (int m = 0; m < 4; ++m) { const size_t ro = (size_t)(row0 + ai * HALF + m * 16) * SW + col0;
#pragma unroll
                for (int bj = 0; bj < 2; ++bj)
#pragma unroll
                    for (int n = 0; n < 2; ++n) { const int co = bj * HALF + n * 16; const u32x2 yb = *(const u32x2*)(yg + ro + co); const f32x4 y = (f32x4){__uint_as_float(yb.x << 16), __uint_as_float(yb.x & 0xffff0000u), __uint_as_float(yb.y << 16), __uint_as_float(yb.y & 0xffff0000u)};
                        const f32x4 b = *(const f32x4*)(bias + col0 + co); f32x4 o;
#pragma unroll
                        for (int j = 0; j < 4; ++j) o[j] = y[j] * sigmoidf_(acc[ai][bj][m][n][j] + b[j]);
                        u32x2 zw; zw.x = cvt_pk_bf16(o[0], o[1]); zw.y = cvt_pk_bf16(o[2], o[3]); *(u32x2*)(Z + ro + co) = zw; } }
    }
};
struct EpiResid {
    static constexpr bool PERM = false;
    const float* x; const float* gate; bf16_t* X1;
    __device__ __forceinline__ void operator()(const f32x4 (&acc)[2][2][4][2], const Unit& u, int wr, int wc, int fr, int fq) const {
        const int row0 = u.pm * BM + wr * 64 + fr, col0 = u.pn * BM + wc * 32 + 4 * fq;
#pragma unroll
        for (int ai = 0; ai < 2; ++ai)
#pragma unroll
            for (int m = 0; m < 4; ++m) { const size_t ro = (size_t)(row0 + ai * HALF + m * 16) * D + col0;
#pragma unroll
                for (int bj = 0; bj < 2; ++bj)
#pragma unroll
                    for (int n = 0; n < 2; ++n) { const int co = bj * HALF + n * 16; const f32x4 xv = *(const f32x4*)(x + ro + co); const f32x4 g = *(const f32x4*)(gate + col0 + co);
                        const f32x4 o = xv + g * acc[ai][bj][m][n]; u32x2 ow; ow.x = cvt_pk_bf16(o[0], o[1]); ow.y = cvt_pk_bf16(o[2], o[3]); *(u32x2*)(X1 + ro + co) = ow; } }
    }
};
struct EpiMoe1 {
    static constexpr bool PERM = true;
    const float* b_gu; unsigned char* ACT;
    __device__ __forceinline__ void operator()(const f32x4 (&acc)[2][2][4][2], const Unit& u, int wr, int wc, int fr, int fq) const {
        const int row0 = u.pm * BM + wr * 64 + fr, j0 = u.pn * HALF + wc * 32 + 8 * fq;
        const float* bias = b_gu + (size_t)u.e * 2 * FF + 2 * j0;
        float bg[8], bl[8];
#pragma unroll
        for (int j = 0; j < 8; ++j) { bg[j] = bias[2 * j]; bl[j] = bias[2 * j + 1]; }
#pragma unroll
        for (int ai = 0; ai < 2; ++ai)
#pragma unroll
            for (int m = 0; m < 4; ++m) { const size_t eo = (size_t)(row0 + ai * HALF + m * 16) * FF + j0; float o[8];
#pragma unroll
                for (int n = 0; n < 2; ++n)
#pragma unroll
                    for (int j = 0; j < 4; ++j) { const float gl = fminf(acc[ai][0][m][n][j] + bg[4 * n + j], 7.0f); const float ln = fminf(fmaxf(acc[ai][1][m][n][j] + bl[4 * n + j], -7.0f), 7.0f);
                        o[4 * n + j] = gl * sigmoidf_(1.702f * gl) * (ln + 1.0f); }
#if MOE_FP8
                u32x2 w; w.x = pk4_fp8(o[0], o[1], o[2], o[3]); w.y = pk4_fp8(o[4], o[5], o[6], o[7]);
                *(u32x2*)(ACT + eo) = w; }
#else
                u32x4 w; w.x = cvt_pk_bf16(o[0], o[1]); w.y = cvt_pk_bf16(o[2], o[3]); w.z = cvt_pk_bf16(o[4], o[5]); w.w = cvt_pk_bf16(o[6], o[7]);
                *(u32x4*)(ACT + eo * 2) = w; }
#endif
    }
};
struct EpiMoe2 {
    static constexpr bool PERM = true;
    const float* b_down; const unsigned char* ws;
    __device__ __forceinline__ void operator()(const f32x4 (&acc)[2][2][4][2], const Unit& u, int wr, int wc, int fr, int fq) const {
        const int lr0 = u.mt * BM + wr * 64 + fr, row0 = u.pm * BM + wr * 64 + fr, col0 = u.pn * BM + wc * 32 + 8 * fq;
        const int* cnt = (const int*)(ws + WS_CTL); const int* list = (const int*)(ws + WS_LIST); const float* gate = (const float*)(ws + WS_GATE); bf16_t* YA = (bf16_t*)(ws + WS_YA);
        const int ce = __builtin_amdgcn_readfirstlane(cnt[u.e]);
        f32x4 bv[2][2];
#pragma unroll
        for (int bj = 0; bj < 2; ++bj)
#pragma unroll
            for (int n = 0; n < 2; ++n) bv[bj][n] = *(const f32x4*)(b_down + (size_t)u.e * D + col0 + bj * HALF + 4 * n);
#pragma unroll
        for (int ai = 0; ai < 2; ++ai)
#pragma unroll
            for (int m = 0; m < 4; ++m) { const int lr = lr0 + ai * HALF + m * 16; float g = 0.f; if (lr < ce) g = gate[list[(size_t)u.e * S + lr]];
                bf16_t* rowp = YA + (size_t)(row0 + ai * HALF + m * 16) * D + col0;
#pragma unroll
                for (int bj = 0; bj < 2; ++bj) { const f32x4 v0 = (acc[ai][bj][m][0] + bv[bj][0]) * g, v1 = (acc[ai][bj][m][1] + bv[bj][1]) * g;
                    u32x4 w; w.x = cvt_pk_bf16(v0[0], v0[1]); w.y = cvt_pk_bf16(v0[2], v0[3]); w.z = cvt_pk_bf16(v1[0], v1[1]); w.w = cvt_pk_bf16(v1[2], v1[3]);
                    *(u32x4*)(rowp + bj * HALF) = w; } }
    }
};
struct EpiS5E {
    static constexpr bool PERM = false;
    float* EF;
    __device__ __forceinline__ void operator()(const f32x4 (&acc)[2][2][4][2], const Unit& u, int wr, int wc, int fr, int fq) const {
        const int row0 = u.pm * BM + wr * 64 + fr, col0 = wc * 32 + 4 * fq;
#pragma unroll
        for (int ai = 0; ai < 2; ++ai)
#pragma unroll
            for (int m = 0; m < 4; ++m) { float* rowp = EF + ((size_t)u.e * NCH + row0 + ai * HALF + m * 16) * 128 + col0;
#pragma unroll
                for (int n = 0; n < 2; ++n) *(f32x4*)(rowp + n * 16) = acc[ai][0][m][n]; }
    }
};
struct EpiS5Y {
    static constexpr bool PERM = true;
    bf16_t* YGB;
    __device__ __forceinline__ void operator()(const f32x4 (&acc)[2][2][4][2], const Unit& u, int wr, int wc, int fr, int fq) const {
        const int c0 = u.pm * BM + wr * 64 + fr;
#pragma unroll
        for (int ai = 0; ai < 2; ++ai)
#pragma unroll
            for (int m = 0; m < 4; ++m) { const int c = c0 + ai * HALF + m * 16;
#pragma unroll
                for (int bj = 0; bj < 2; ++bj) { const int np = u.pn * BM + bj * HALF + wc * 32 + 8 * fq, i = np >> 4, p0 = np & 15; float o[8];
#pragma unroll
                    for (int n = 0; n < 2; ++n)
#pragma unroll
                        for (int j = 0; j < 4; ++j) { const float y = acc[ai][bj][m][n][j]; const float uu = 0.7978845608028654f * (y + 0.044715f * y * y * y);
                            o[4 * n + j] = y * __builtin_amdgcn_rcpf(1.0f + __builtin_amdgcn_exp2f(-2.885390081777927f * uu)); }
                    u32x4 w; w.x = cvt_pk_bf16(o[0], o[1]); w.y = cvt_pk_bf16(o[2], o[3]); w.z = cvt_pk_bf16(o[4], o[5]); w.w = cvt_pk_bf16(o[6], o[7]);
                    *(u32x4*)(YGB + (size_t)(c * LCH + i) * SW + u.e * PC + p0) = w; } }
    }
};
struct EpiProj {
    static constexpr bool PERM = false;
    bf16_t* QKV; bf16_t* UB2;
    __device__ __forceinline__ void operator()(const f32x4 (&acc)[2][2][4][2], const Unit& u, int wr, int wc, int fr, int fq) const {
        const int row0 = u.pm * BM + wr * 64 + fr, col0 = u.pn * BM + wc * 32 + 4 * fq;
        if (u.pn < 12) {
            const float sc = (u.pn < 4) ? 0.125f : 1.0f;
#pragma unroll
            for (int ai = 0; ai < 2; ++ai)
#pragma unroll
                for (int m = 0; m < 4; ++m) { bf16_t* rowp = QKV + (size_t)(row0 + ai * HALF + m * 16) * (3 * AW) + col0;
#pragma unroll
                    for (int bj = 0; bj < 2; ++bj)
#pragma unroll
                        for (int n = 0; n < 2; ++n) { const f32x4 v = acc[ai][bj][m][n] * sc; u32x2 w; w.x = cvt_pk_bf16(v[0], v[1]); w.y = cvt_pk_bf16(v[2], v[3]); *(u32x2*)(rowp + bj * HALF + n * 16) = w; } }
        } else {
#pragma unroll
            for (int ai = 0; ai < 2; ++ai)
#pragma unroll
                for (int m = 0; m < 4; ++m) { const int t = row0 + ai * HALF + m * 16; bf16_t* rowp = UB2 + (size_t)((t >> 5) * CROWS + (t & 31)) * SW + (col0 - 3 * AW);
#pragma unroll
                    for (int bj = 0; bj < 2; ++bj)
#pragma unroll
                        for (int n = 0; n < 2; ++n) { const f32x4 v = acc[ai][bj][m][n]; u32x2 w; w.x = cvt_pk_bf16(v[0], v[1]); w.y = cvt_pk_bf16(v[2], v[3]); *(u32x2*)(rowp + bj * HALF + n * 16) = w; } }
        }
    }
};
}

constexpr int NWAVES = 8;
constexpr int LDS_BYTES = 148480;
constexpr int RING_OFF = 0;
typedef short s16x4 __attribute__((ext_vector_type(4)));
typedef float f32x16 __attribute__((ext_vector_type(16)));

struct ConvTile { const float* W; unsigned char* WT; int K, N, tk, tn, deint, out8; };
__device__ __forceinline__ void conv_load(const ConvTile& t, f32x4 (&v)[8]) {
    const int tid = otid(), k0 = t.tk * 64, n0 = t.tn * 256;
#pragma unroll
    for (int j = 0; j < 8; ++j) { const int k = j * 8 + (tid >> 6), g = tid & 63;
        v[j] = __builtin_nontemporal_load((const f32x4*)(t.W + (size_t)(k0 + k) * t.N + n0 + 4 * g)); }
}
__device__ __forceinline__ void conv_store(const ConvTile& t, const f32x4 (&vin)[8], LAS float* scr) {
    const int tid = otid(), k0 = t.tk * 64, n0 = t.tn * 256;
    __syncthreads();
#pragma unroll
    for (int j = 0; j < 8; ++j) { const int k = j * 8 + (tid >> 6), g = tid & 63; *(LAS f32x4*)(scr + k * 256 + ((g ^ j) << 2)) = vin[j]; }
    __syncthreads();
#pragma unroll
    for (int jj = 0; jj < 4; ++jj) { const int n = jj * 64 + (tid >> 3), c = tid & 7; float v[8];
#pragma unroll
        for (int q = 0; q < 8; ++q) v[q] = scr[(8 * c + q) * 256 + ((((n >> 2) ^ c)) << 2) + (n & 3)];
        int row = n0 + n;
        if (t.deint) { const int sx = n & 1, jl = n >> 1; row = n0 + sx * 128 + jl; }
        if (t.out8) { u32x2 o8; o8.x = pk4_fp8(v[0] * 64.f, v[1] * 64.f, v[2] * 64.f, v[3] * 64.f); o8.y = pk4_fp8(v[4] * 64.f, v[5] * 64.f, v[6] * 64.f, v[7] * 64.f);
            *(u32x2*)(t.WT + (size_t)row * t.K + k0 + 8 * c) = o8; }
        else { u32x4 o; o.x = cvt_pk_bf16(v[0], v[1]); o.y = cvt_pk_bf16(v[2], v[3]); o.z = cvt_pk_bf16(v[4], v[5]); o.w = cvt_pk_bf16(v[6], v[7]);
            *(u32x4*)(t.WT + ((size_t)row * t.K + k0 + 8 * c) * 2) = o; } }
}
constexpr int CONV_NT_SMALL = 32 * 16 + 16 * 4 + 32 * 8, CONV_NT_EXP = NE * (32 * 16 + 32 * 8);
__device__ __forceinline__ ConvTile conv_tile_small(const P& p, int it) {
    unsigned char* ws = p.ws;
    constexpr int T_IN = 32 * 16, T_GLU = 16 * 4;
    ConvTile t; int r = it;
    if (r < T_IN) { t.W = p.w_in; t.WT = ws + WS_WIN; t.K = D; t.N = INW; t.tk = r / 16; t.tn = r % 16; t.deint = 0; t.out8 = 0; return t; } r -= T_IN;
    if (r < T_GLU) { t.W = p.w_glu; t.WT = ws + WS_WGLU; t.K = SW; t.N = SW; t.tk = r / 4; t.tn = r % 4; t.deint = 0; t.out8 = 0; return t; } r -= T_GLU;
    t.W = p.w_out; t.WT = ws + WS_WOUT; t.K = D; t.N = D; t.tk = r / 8; t.tn = r % 8; t.deint = 0; t.out8 = 0; return t;
}
__device__ __forceinline__ ConvTile conv_tile_exp(const P& p, int it) {
    unsigned char* ws = p.ws;
    constexpr int T_GU = 32 * 16, T_DN = 32 * 8;
    constexpr int E8 = (MOE_FP8 != 0) ? 1 : 0, EB = E8 ? 1 : 2;
    ConvTile t; int r = it;
    if (r < NE * T_GU) { const int e = r / T_GU, q = r % T_GU; t.W = p.w_gu + (size_t)e * D * 2 * FF; t.WT = ws + WS_WGU + (size_t)e * 2 * FF * D * EB; t.K = D; t.N = 2 * FF; t.tk = q / 16; t.tn = q % 16; t.deint = 1; t.out8 = E8; return t; } r -= NE * T_GU;
    { const int e = r / T_DN, q = r % T_DN; t.W = p.w_down + (size_t)e * FF * D; t.WT = ws + WS_WDN + (size_t)e * D * FF * EB; t.K = FF; t.N = D; t.tk = q / 8; t.tn = q % 8; t.deint = 0; t.out8 = E8; return t; }
}

__device__ __forceinline__ void phase_s5_tables(const P& p, LAS unsigned char* lds, int g);
__device__ __forceinline__ void phase_conv_experts(const P& p, LAS unsigned char* lds, int bid, int Gn);
__device__ __forceinline__ void phase_prologue(const P& p, LAS unsigned char* lds, int bid, int Gn) {
    unsigned char* ws = p.ws;
    const int tid = otid();
    if (bid < 192) {
        LAS f32x4* red = (LAS f32x4*)lds;
        const int cq = tid & 15, rg = tid >> 4;
        f32x4 acc = (f32x4){0.f, 0.f, 0.f, 0.f};
        for (int it = 0; it < 64; ++it) { const int i = rg + 32 * it; const float cv = p.c[i]; const float sv = cv / (1.0f + expf(-cv));
            const f32x4 w = *(const f32x4*)(p.w_ada + (size_t)i * 6 * D + 64 * bid + 4 * cq); acc += w * sv; }
        red[rg * 16 + cq] = acc;
        __syncthreads();
        if (tid < 64) { const LAS float* rf = (const LAS float*)lds; float s = p.b_ada[64 * bid + tid];
            for (int r = 0; r < 32; ++r) s += rf[r * 64 + tid];
            ((float*)(ws + WS_MOD))[64 * bid + tid] = s; }
    } else phase_s5_tables(p, lds, bid - 192);
    LAS float* scr = (LAS float*)(lds + RING_OFF);
    {
        f32x4 va[8];
        for (int it = bid; it < CONV_NT_SMALL; it += Gn) { const ConvTile ta = conv_tile_small(p, it); conv_load(ta, va); conv_store(ta, va, scr); }
    }
    __syncthreads();
    phase_conv_experts(p, lds, bid, Gn);
}

__device__ __forceinline__ void phase_norm1(const P& p, int bid, int Gn) {
    const int tid_ = otid(); const int lane = tid_ & 63, gw = bid * NWAVES + (tid_ >> 6), NGW = Gn * NWAVES;
    const float* mod = (const float*)(p.ws + WS_MOD);
    bf16_t* hb = (bf16_t*)(p.ws + WS_HB);
    f32x4 ga[8], sb[8];
#pragma unroll
    for (int j = 0; j < 8; ++j) { const int c0 = 4 * lane + 256 * j; ga[j] = *(const f32x4*)(p.norm1_g + c0) * (*(const f32x4*)(mod + D + c0) + 1.0f); sb[j] = *(const f32x4*)(mod + c0); }
    f32x4 v[8], vn[8];
    int row = gw;
    if (row < S) {
#pragma unroll
        for (int j = 0; j < 8; ++j) v[j] = ((const f32x4*)(p.x + (size_t)row * D) + lane)[64 * j]; }
    while (row < S) {
        const int nrow = row + NGW;
        if (nrow < S) {
#pragma unroll
            for (int j = 0; j < 8; ++j) vn[j] = ((const f32x4*)(p.x + (size_t)nrow * D) + lane)[64 * j]; }
        float ss = 0.f;
#pragma unroll
        for (int j = 0; j < 8; ++j) ss += (v[j].x * v[j].x + v[j].y * v[j].y) + (v[j].z * v[j].z + v[j].w * v[j].w);
        const float rs = 1.0f / sqrtf(wave_sum(ss) * (1.0f / D) + EPS);
#pragma unroll
        for (int j = 0; j < 8; ++j) { const int c0 = 4 * lane + 256 * j;
            const f32x4 o = v[j] * rs * ga[j] + sb[j];
            u32x2 w; w.x = cvt_pk_bf16(o.x, o.y); w.y = cvt_pk_bf16(o.z, o.w);
            *(u32x2*)(hb + (size_t)row * D + c0) = w; }
#pragma unroll
        for (int j = 0; j < 8; ++j) v[j] = vn[j];
        row = nrow;
    }
}

__device__ __forceinline__ void tr_read4(unsigned a0, unsigned a1, s16x4& r0, s16x4& r1, s16x4& r2, s16x4& r3) {
    asm volatile("ds_read_b64_tr_b16 %0, %4\n\tds_read_b64_tr_b16 %1, %4 offset:1024\n\tds_read_b64_tr_b16 %2, %5\n\tds_read_b64_tr_b16 %3, %5 offset:1024\n\ts_waitcnt lgkmcnt(0)"
                 : "=&v"(r0), "=&v"(r1), "=&v"(r2), "=&v"(r3) : "v"(a0), "v"(a1) : "memory");
}
__device__ __forceinline__ void attn_role(const P& p, LAS unsigned char* lds, int bid, int Gn, int w) {
    const bf16_t* QKV = (const bf16_t*)(p.ws + WS_QKV);
    bf16_t* OB = (bf16_t*)(p.ws + WS_OB);
    float* LSE = (float*)(p.ws + WS_LSE);
    const int lane = otid() & 63, aw = w & 3, us = w >> 2;
    const int l31 = lane & 31, hh = lane >> 5, i0 = 32 * aw;
    constexpr int RS = 3 * AW;
    LAS unsigned char* vl = lds + w * 8192;
    for (int u = 2 * bid + us; u < 3 * 128 * NH; u += 2 * Gn) {
        const int b = u >> 11, rem = u & 2047, blk = rem >> 4, h = rem & 15;
        const int dsh = 2 * b, d = 1 << dsh;
        const int n = blk >> dsh, r = blk & (d - 1);
        const int qbase = n * 128 * d + r, kbase = qbase - 128 * d;
        const int qp = qbase + (i0 + l31) * d;
        bf16x8 qf[4];
#pragma unroll
        for (int s = 0; s < 4; ++s) qf[s] = *(const bf16x8*)(QKV + (size_t)qp * RS + h * HD + 16 * s + 8 * hh);
        f32x16 sc[5];
#pragma unroll
        for (int kb = 0; kb < 5; ++kb) {
            const int j = i0 + 32 * kb + l31; int kp = kbase + j * d; kp = kp < 0 ? 0 : kp;
            bf16x8 kf[4];
#pragma unroll
            for (int s = 0; s < 4; ++s) kf[s] = *(const bf16x8*)(QKV + (size_t)kp * RS + AW + h * HD + 16 * s + 8 * hh);
            f32x16 a;
#pragma unroll
            for (int e = 0; e < 16; ++e) a[e] = 0.f;
#pragma unroll
            for (int s = 0; s < 4; ++s) a = __builtin_amdgcn_mfma_f32_32x32x16_bf16(kf[s], qf[s], a, 0, 0, 0);
            sc[kb] = a;
        }
        u32x4 vv[4], vn[4];
#define ATT_VLOAD(dst, kb_) do { _Pragma("unroll") for (int it = 0; it < 4; ++it) { const int id = it * 64 + lane, row = 32 * (kb_) + (id >> 3), ch = id & 7; const int vp = kbase + (i0 + row) * d; \
            dst[it] = (u32x4){0u, 0u, 0u, 0u}; if (vp >= 0) dst[it] = *(const u32x4*)(QKV + (size_t)vp * RS + 2 * AW + h * HD + ch * 8); } } while (0)
        ATT_VLOAD(vv, 0);
        float m = -INFINITY;
#pragma unroll
        for (int kb = 0; kb < 5; ++kb)
#pragma unroll
            for (int e = 0; e < 16; ++e) { const int jrel = 32 * kb + (e & 3) + 8 * (e >> 2) + 4 * hh;
                const bool valid = (jrel >= l31) && (jrel <= l31 + 128) && (n > 0 || (i0 + jrel) >= 128);
                const float sv = valid ? sc[kb][e] : -INFINITY; sc[kb][e] = sv; m = fmaxf(m, sv); }
        m = fmaxf(m, __shfl_xor(m, 32));
        float l = 0.f;
#pragma unroll
        for (int kb = 0; kb < 5; ++kb)
#pragma unroll
            for (int e = 0; e < 16; ++e) { const float pe = __expf(sc[kb][e] - m); sc[kb][e] = pe; l += pe; }
        l += __shfl_xor(l, 32);
        f32x16 o[2];
#pragma unroll
        for (int c = 0; c < 2; ++c)
#pragma unroll
            for (int e = 0; e < 16; ++e) o[c][e] = 0.f;
        const int q4 = (lane & 15) >> 2, pp = lane & 3, bk = (lane >> 4) & 1;
#pragma unroll
        for (int kb = 0; kb < 5; ++kb) {
            if (kb < 4) ATT_VLOAD(vn, kb + 1);
            LAS unsigned char* vb = vl + (kb & 1) * 4096;
#pragma unroll
            for (int it = 0; it < 4; ++it) { const int id = it * 64 + lane; *(LAS u32x4*)(vb + (id >> 3) * 128 + (id & 7) * 16) = vv[it]; }
            asm volatile("s_waitcnt lgkmcnt(0)" ::: "memory");
            const unsigned vbase = (unsigned)(size_t)vb;
#pragma unroll
            for (int s2 = 0; s2 < 2; ++s2) {
                u32x4 pw; pw.x = cvt_pk_bf16(sc[kb][8 * s2 + 0], sc[kb][8 * s2 + 1]); pw.y = cvt_pk_bf16(sc[kb][8 * s2 + 2], sc[kb][8 * s2 + 3]);
                pw.z = cvt_pk_bf16(sc[kb][8 * s2 + 4], sc[kb][8 * s2 + 5]); pw.w = cvt_pk_bf16(sc[kb][8 * s2 + 6], sc[kb][8 * s2 + 7]);
                const bf16x8 pf = __builtin_bit_cast(bf16x8, pw);
                const int rowb = 16 * s2 + 4 * hh + q4;
                const unsigned a0 = vbase + (unsigned)(rowb * 128 + 32 * bk + 8 * pp);
                s16x4 v00, v01, v10, v11;
                tr_read4(a0, a0 + 64, v00, v01, v10, v11);
                bf16x8 vf0, vf1;
                vf0[0] = v00[0]; vf0[1] = v00[1]; vf0[2] = v00[2]; vf0[3] = v00[3]; vf0[4] = v01[0]; vf0[5] = v01[1]; vf0[6] = v01[2]; vf0[7] = v01[3];
                vf1[0] = v10[0]; vf1[1] = v10[1]; vf1[2] = v10[2]; vf1[3] = v10[3]; vf1[4] = v11[0]; vf1[5] = v11[1]; vf1[6] = v11[2]; vf1[7] = v11[3];
                o[0] = __builtin_amdgcn_mfma_f32_32x32x16_bf16(vf0, pf, o[0], 0, 0, 0);
                o[1] = __builtin_amdgcn_mfma_f32_32x32x16_bf16(vf1, pf, o[1], 0, 0, 0);
            }
            if (kb < 4) {
#pragma unroll
                for (int it = 0; it < 4; ++it) vv[it] = vn[it]; }
        }
#undef ATT_VLOAD
        const float inv = 1.0f / l;
        bf16_t* orow = OB + ((size_t)b * S + qp) * AW + h * HD;
#pragma unroll
        for (int c = 0; c < 2; ++c)
#pragma unroll
            for (int rg = 0; rg < 4; ++rg) { u32x2 wv; wv.x = cvt_pk_bf16(o[c][4 * rg] * inv, o[c][4 * rg + 1] * inv); wv.y = cvt_pk_bf16(o[c][4 * rg + 2] * inv, o[c][4 * rg + 3] * inv);
                *(u32x2*)(orow + 32 * c + 8 * rg + 4 * hh) = wv; }
        if (hh == 0) LSE[((size_t)b * S + qp) * NH + h] = m + __logf(l);
    }
}
__device__ __forceinline__ void cw_load(const ConvTile& t, int half, int cw, int lane, f32x4 (&v)[16]) {
    const int kbase = t.tk * 128 + half * 64, n0 = t.tn * 256 + 64 * cw, g = lane & 15, kbl = lane >> 4;
#pragma unroll
    for (int t2 = 0; t2 < 2; ++t2)
#pragma unroll
        for (int kk = 0; kk < 8; ++kk) v[t2 * 8 + kk] = __builtin_nontemporal_load((const f32x4*)(t.W + (size_t)(kbase + (t2 * 4 + kbl) * 8 + kk) * t.N + n0 + 4 * g));
}
__device__ __forceinline__ void cw_park(int half, int lane, const f32x4 (&v)[16], LAS unsigned char* tl) {
    const int g = lane & 15, kbl = lane >> 4;
#pragma unroll
    for (int t2 = 0; t2 < 2; ++t2) { const int kb = half * 8 + t2 * 4 + kbl;
#pragma unroll
        for (int i = 0; i < 4; ++i) { const int n = 4 * g + i; u32x2 o8;
            o8.x = pk4_fp8(v[t2 * 8 + 0][i] * 64.f, v[t2 * 8 + 1][i] * 64.f, v[t2 * 8 + 2][i] * 64.f, v[t2 * 8 + 3][i] * 64.f);
            o8.y = pk4_fp8(v[t2 * 8 + 4][i] * 64.f, v[t2 * 8 + 5][i] * 64.f, v[t2 * 8 + 6][i] * 64.f, v[t2 * 8 + 7][i] * 64.f);
            *(LAS u32x2*)(tl + n * 128 + ((kb ^ (2 * (g & 7))) << 3)) = o8; } }
}
__device__ __forceinline__ void cw_flush(const ConvTile& t, int cw, int lane, LAS unsigned char* tl) {
#pragma unroll
    for (int jj = 0; jj < 8; ++jj) { const int n = jj * 8 + (lane >> 3), pc = lane & 7;
        const u32x4 o = *(const LAS u32x4*)(tl + n * 128 + (((2 * pc) ^ (2 * ((n >> 2) & 7))) << 3));
        const int nt = 64 * cw + n;
        int row = t.tn * 256 + nt;
        if (t.deint) row = t.tn * 256 + (nt & 1) * 128 + (nt >> 1);
        *(u32x4*)(t.WT + (size_t)row * t.K + t.tk * 128 + 16 * pc) = o; }
}
constexpr int CONV_NT_EXP128 = NE * (16 * 16 + 16 * 8);
__device__ __forceinline__ ConvTile conv_tile_exp128(const P& p, int it) {
    unsigned char* ws = p.ws;
    constexpr int T_GU = 16 * 16, T_DN = 16 * 8;
    ConvTile t; int r = it;
    if (r < NE * T_GU) { const int e = r / T_GU, q = r % T_GU; t.W = p.w_gu + (size_t)e * D * 2 * FF; t.WT = ws + WS_WGU + (size_t)e * 2 * FF * D; t.K = D; t.N = 2 * FF; t.tk = q / 16; t.tn = q % 16; t.deint = 1; t.out8 = 1; return t; } r -= NE * T_GU;
    { const int e = r / T_DN, q = r % T_DN; t.W = p.w_down + (size_t)e * FF * D; t.WT = ws + WS_WDN + (size_t)e * D * FF; t.K = FF; t.N = D; t.tk = q / 8; t.tn = q % 8; t.deint = 0; t.out8 = 1; return t; }
}
__device__ __forceinline__ void conv_role(const P& p, LAS unsigned char* lds, int bid, int Gn_, int w) {
    static_assert(MOE_FP8 != 0, "the conversion role writes fp8 expert weights");
    const int lane = otid() & 63, cw = w & 3, Gn = 2 * Gn_;
    LAS unsigned char* tl = lds + 65536 + w * 8192;
    f32x4 va[16], vb[16];
    int it = 2 * bid + (w >> 2);
    ConvTile t = conv_tile_exp128(p, it < CONV_NT_EXP128 ? it : 0);
    if (it < CONV_NT_EXP128) cw_load(t, 0, cw, lane, va);
    while (it < CONV_NT_EXP128) {
        cw_load(t, 1, cw, lane, vb);
        cw_park(0, lane, va, tl);
        const int nx = it + Gn; ConvTile tn = t;
        if (nx < CONV_NT_EXP128) { tn = conv_tile_exp128(p, nx); cw_load(tn, 0, cw, lane, va); }
        cw_park(1, lane, vb, tl);
        cw_flush(t, cw, lane, tl);
        t = tn; it = nx;
    }
}
__device__ __forceinline__ void phase_attn(const P& p, LAS unsigned char* lds, int bid, int Gn) {
    const int w = __builtin_amdgcn_readfirstlane(otid() >> 6);
    attn_role(p, lds, bid, Gn, w);
}
__device__ __forceinline__ void phase_conv_experts(const P& p, LAS unsigned char* lds, int bid, int Gn) {
    const int w = __builtin_amdgcn_readfirstlane(otid() >> 6);
    conv_role(p, lds, bid, Gn, w);
}

__device__ __forceinline__ void phase_s5_tables(const P& p, LAS unsigned char* lds, int g) {
    const int tid = otid();
    LAS float* pwr = (LAS float*)lds;
    LAS float* pwi = pwr + 33 * 64;
    LAS float* cre = pwi + 33 * 64;
    LAS float* cim = cre + 1024;
    LAS float* bbr = cim + 1024;
    LAS float* bbi = bbr + 1024;
    LAS float* Mt = bbi + 1024;
    __syncthreads();
    if (tid < NS) {
        const int n = tid, i = g * NS + n;
        const float dt = expf(p.log_dt[g]), lr = p.lam_re[i], li = p.lam_im[i];
        const float mag = expf(lr * dt), ar = mag * cosf(li * dt), ai = mag * sinf(li * dt);
        const float den = lr * lr + li * li, nr = ar - 1.0f, ni = ai;
        const float fr = (nr * lr + ni * li) / den, fi = (ni * lr - nr * li) / den;
        for (int q = 0; q < PC; ++q) { const float br = p.b_re[(size_t)i * PC + q], bi = p.b_im[(size_t)i * PC + q];
            bbr[n * PC + q] = fr * br - fi * bi; bbi[n * PC + q] = fr * bi + fi * br; }
        float xr = 1.0f, xi = 0.0f;
        for (int t = 0; t <= LCH; ++t) { pwr[t * NS + n] = xr; pwi[t * NS + n] = xi; const float yr = xr * ar - xi * ai, yi = xr * ai + xi * ar; xr = yr; xi = yi; }
        float* lamL = (float*)(p.ws + WS_S5P);
        lamL[(g * NS + n) * 2 + 0] = pwr[LCH * NS + n]; lamL[(g * NS + n) * 2 + 1] = pwi[LCH * NS + n];
    }
    for (int k = tid; k < PC * NS; k += NWAVES * 64) { cre[k] = p.c_re[(size_t)g * PC * NS + k]; cim[k] = p.c_im[(size_t)g * PC * NS + k]; }
    __syncthreads();
    for (int k = 0; k < 16; ++k) { const int idx = tid + 512 * k, tau = idx >> 8, pp = (idx >> 4) & 15, q = idx & 15;
        float acc = 0.f;
        for (int n = 0; n < NS; ++n) { const float cr = cre[pp * NS + n], ci = cim[pp * NS + n], pr = pwr[tau * NS + n], pi = pwi[tau * NS + n];
            const float xr = cr * pr - ci * pi, xi = cr * pi + ci * pr; acc += xr * bbr[n * PC + q] - xi * bbi[n * PC + q]; }
        if (tau == 0 && pp == q) acc += p.d_skip[g * PC + pp];
        Mt[idx] = acc; }
    __syncthreads();
    bf16_t* T = (bf16_t*)(p.ws + WS_S5T) + (size_t)g * 512 * KS5;
    for (int k = 0; k < 80; ++k) { const int ch = tid + 512 * k, row = ch / 80, cc = ch % 80, i = row >> 4, pp = row & 15; float v[8];
        if (cc < 64) { const int j = cc >> 1, q0 = (cc & 1) * 8;
#pragma unroll
            for (int e = 0; e < 8; ++e) v[e] = (j <= i) ? Mt[((i - j) * 16 + pp) * 16 + q0 + e] : 0.f;
        } else { const int m0 = (cc - 64) * 8;
#pragma unroll
            for (int e = 0; e < 8; ++e) { const int m = m0 + e, n = m & 63; const float cr = cre[pp * NS + n], ci = cim[pp * NS + n], pr = pwr[(i + 1) * NS + n], pi = pwi[(i + 1) * NS + n];
                v[e] = (m < 64) ? (cr * pr - ci * pi) : -(cr * pi + ci * pr); } }
        u32x4 o; o.x = cvt_pk_bf16(v[0], v[1]); o.y = cvt_pk_bf16(v[2], v[3]); o.z = cvt_pk_bf16(v[4], v[5]); o.w = cvt_pk_bf16(v[6], v[7]);
        *(u32x4*)(T + (size_t)row * KS5 + cc * 8) = o; }
    bf16_t* Eb = (bf16_t*)(p.ws + WS_S5E) + (size_t)g * 256 * KS5E;
    for (int k = 0; k < 32; ++k) { const int ch = tid + 512 * k, row = ch >> 6, cc = ch & 63, j = cc >> 1, q0 = (cc & 1) * 8, n = row & 63; float v[8];
#pragma unroll
        for (int e = 0; e < 8; ++e) { const float pr = pwr[(LCH - 1 - j) * NS + n], pi = pwi[(LCH - 1 - j) * NS + n], br = bbr[n * PC + q0 + e], bi = bbi[n * PC + q0 + e];
            v[e] = (row < 64) ? (pr * br - pi * bi) : ((row < 128) ? (pr * bi + pi * br) : 0.f); }
        u32x4 o; o.x = cvt_pk_bf16(v[0], v[1]); o.y = cvt_pk_bf16(v[2], v[3]); o.z = cvt_pk_bf16(v[4], v[5]); o.w = cvt_pk_bf16(v[6], v[7]);
        *(u32x4*)(Eb + (size_t)row * KS5E + cc * 8) = o; }
    __syncthreads();
}
__device__ __forceinline__ void phase_s5_carry(const P& p, int bid) {
    const int gt = bid * (NWAVES * 64) + otid();
    if (gt >= G * NS) return;
    const int g = gt >> 6, n = gt & 63;
    const float* lamL = (const float*)(p.ws + WS_S5P);
    const float* EF = (const float*)(p.ws + WS_EF) + (size_t)g * NCH * 128;
    bf16_t* UB2 = (bf16_t*)(p.ws + WS_UB2);
    const float lr = lamL[gt * 2], li = lamL[gt * 2 + 1];
    float xr = 0.f, xi = 0.f;
    for (int c0 = 0; c0 < NCH; c0 += 8) {
        float er[8], ei[8];
#pragma unroll
        for (int k = 0; k < 8; ++k) { er[k] = EF[(size_t)(c0 + k) * 128 + n]; ei[k] = EF[(size_t)(c0 + k) * 128 + 64 + n]; }
#pragma unroll
        for (int k = 0; k < 8; ++k) { const int c = c0 + k;
            bf16_t* xrow = UB2 + (size_t)(c * CROWS + LCH + (n >> 4)) * SW + g * PC + (n & 15);
            xrow[0] = f2bf(xr); xrow[4 * SW] = f2bf(xi);
            const float yr = lr * xr - li * xi + er[k], yi = lr * xi + li * xr + ei[k]; xr = yr; xi = yi; }
    }
}

__device__ __forceinline__ void phase_mix(const P& p, int bid, int Gn) {
    const int tid_ = otid(); const int lane = tid_ & 63, gw = bid * NWAVES + (tid_ >> 6), NGW = Gn * NWAVES;
    const bf16_t* OB = (const bf16_t*)(p.ws + WS_OB);
    const float* LSE = (const float*)(p.ws + WS_LSE);
    const bf16_t* Z = (const bf16_t*)(p.ws + WS_Z);
    bf16_t* YM = (bf16_t*)(p.ws + WS_YMIXB);
    float ls[4][3], lsn[4][3]; u32x2 ob[4][3], obn[4][3], zr[4], zrn[4];
#define MIX_LOAD(LS, OBR, ZR, row_) do { _Pragma("unroll") for (int j = 0; j < 4; ++j) { const int c0 = 4 * lane + 256 * j, hd = c0 >> 6; \
        _Pragma("unroll") for (int b = 0; b < 3; ++b) { LS[j][b] = LSE[((size_t)b * S + (row_)) * NH + hd]; OBR[j][b] = *(const u32x2*)(OB + ((size_t)b * S + (row_)) * AW + c0); } \
        ZR[j] = *(const u32x2*)(Z + (size_t)(row_) * SW + c0); } } while (0)
    int row = gw;
    if (row < S) MIX_LOAD(ls, ob, zr, row);
    while (row < S) {
        const int nrow = row + NGW;
        if (nrow < S) MIX_LOAD(lsn, obn, zrn, nrow);
        f32x4 a[4], z[4]; float sa = 0.f, sz = 0.f;
#pragma unroll
        for (int j = 0; j < 4; ++j) {
            const float mx = fmaxf(fmaxf(ls[j][0], ls[j][1]), ls[j][2]);
            float wsum = 0.f; f32x4 acc = (f32x4){0.f, 0.f, 0.f, 0.f};
#pragma unroll
            for (int b = 0; b < 3; ++b) { const float wb = __expf(ls[j][b] - mx); wsum += wb; acc += bf4_to_f32(ob[j][b]) * wb; }
            a[j] = acc * (1.0f / wsum); sa += (a[j].x * a[j].x + a[j].y * a[j].y) + (a[j].z * a[j].z + a[j].w * a[j].w);
            z[j] = bf4_to_f32(zr[j]); sz += (z[j].x * z[j].x + z[j].y * z[j].y) + (z[j].z * z[j].z + z[j].w * z[j].w); }
        const float ra = 1.0f / sqrtf(wave_sum(sa) * (1.0f / AW) + EPS), rz = 1.0f / sqrtf(wave_sum(sz) * (1.0f / SW) + EPS);
#pragma unroll
        for (int j = 0; j < 4; ++j) { const int c0 = 4 * lane + 256 * j;
            const f32x4 ga = *(const f32x4*)(p.attn_g + c0), gs = *(const f32x4*)(p.ssm_g + c0);
            const f32x4 oa = a[j] * ra * ga, oz = z[j] * rz * gs;
            u32x2 wa, wz; wa.x = cvt_pk_bf16(oa.x, oa.y); wa.y = cvt_pk_bf16(oa.z, oa.w); wz.x = cvt_pk_bf16(oz.x, oz.y); wz.y = cvt_pk_bf16(oz.z, oz.w);
            *(u32x2*)(YM + (size_t)row * D + c0) = wa; *(u32x2*)(YM + (size_t)row * D + AW + c0) = wz; }
#pragma unroll
        for (int j = 0; j < 4; ++j) { zr[j] = zrn[j];
#pragma unroll
            for (int b = 0; b < 3; ++b) { ls[j][b] = lsn[j][b]; ob[j][b] = obn[j][b]; } }
        row = nrow;
    }
#undef MIX_LOAD
}

__device__ __forceinline__ void phase_norm2_router(const P& p, LAS unsigned char* lds, int bid, int Gn) {
    const int tid = otid(), lane = tid & 63, w = tid >> 6;
    const float* mod = (const float*)(p.ws + WS_MOD);
    const bf16_t* X1 = (const bf16_t*)(p.ws + WS_X1);
    bf16_t* hb = (bf16_t*)(p.ws + WS_HB);
    LAS float* hrow = (LAS float*)lds;
    LAS float* part = (LAS float*)(lds + 65536);
    LAS float* logit = (LAS float*)(lds + 81920);
    LAS int* sel_e = (LAS int*)(lds + 83968);
    LAS float* sel_g = (LAS float*)(lds + 84992);
    LAS int* sel_t = (LAS int*)(lds + 86016);
    LAS int* rank = (LAS int*)(lds + 86272);
    LAS int* hist = (LAS int*)(lds + 87296);
    LAS int* gbase = (LAS int*)(lds + 87424);
    int* idx = (int*)(p.ws + WS_IDX); float* gate = (float*)(p.ws + WS_GATE); int* slot = (int*)(p.ws + WS_SLOT);
    int* cnt = (int*)(p.ws + WS_CTL); int* list = (int*)(p.ws + WS_LIST);
    const int nit = (S / 8 + Gn - 1) / Gn;
    float wreg[128];
    {   const int e = tid & 31, pt = tid >> 5;
#pragma unroll
        for (int k = 0; k < 128; ++k) wreg[k] = p.w_router[(size_t)(pt * 128 + k) * NE + e]; }
    for (int it = 0; it < nit; ++it) {
        const int base = (it * Gn + bid) * 8, buf = it & 7;
        const bool live = base < S;
        if (live) {
            const int row = base + w;
            const u32x2* xr = (const u32x2*)(X1 + (size_t)row * D) + lane;
            f32x4 v[8]; float ss = 0.f;
#pragma unroll
            for (int j = 0; j < 8; ++j) { v[j] = bf4_to_f32(xr[64 * j]); ss += (v[j].x * v[j].x + v[j].y * v[j].y) + (v[j].z * v[j].z + v[j].w * v[j].w); }
            const float rs = 1.0f / sqrtf(wave_sum(ss) * (1.0f / D) + EPS);
#pragma unroll
            for (int j = 0; j < 8; ++j) { const int c0 = 4 * lane + 256 * j;
                const f32x4 g = *(const f32x4*)(p.norm2_g + c0), sc = *(const f32x4*)(mod + 4 * D + c0), sh = *(const f32x4*)(mod + 3 * D + c0);
                const f32x4 o = v[j] * rs * g * (sc + 1.0f) + sh;
#if MOE_FP8
                *(unsigned*)((unsigned char*)hb + (size_t)row * D + c0) = pk4_fp8(o.x, o.y, o.z, o.w);
#else
                u32x2 wv; wv.x = cvt_pk_bf16(o.x, o.y); wv.y = cvt_pk_bf16(o.z, o.w);
                *(u32x2*)(hb + (size_t)row * D + c0) = wv;
#endif
                *(LAS f32x4*)(hrow + w * D + c0) = o; }
        }
        __syncthreads();
        if (live) {
            const int e = tid & 31, pt = tid >> 5;
            float acc[8];
#pragma unroll
            for (int r = 0; r < 8; ++r) acc[r] = 0.f;
#pragma unroll
            for (int k4 = 0; k4 < 32; ++k4) { const int kk = pt * 128 + 4 * k4;
                const float w0 = wreg[4 * k4], w1 = wreg[4 * k4 + 1], w2 = wreg[4 * k4 + 2], w3 = wreg[4 * k4 + 3];
#pragma unroll
                for (int r = 0; r < 8; ++r) { const f32x4 h4 = *(const LAS f32x4*)(hrow + r * D + kk); acc[r] += (h4.x * w0 + h4.y * w1) + (h4.z * w2 + h4.w * w3); } }
#pragma unroll
            for (int r = 0; r < 8; ++r) part[(pt * 8 + r) * 32 + e] = acc[r];
        }
        __syncthreads();
        if (live && tid < 256) { const int r = tid >> 5, e = tid & 31; float sacc = p.b_router[e];
#pragma unroll
            for (int q = 0; q < 16; ++q) sacc += part[(q * 8 + r) * 32 + e];
            logit[r * 32 + e] = sacc; }
        __syncthreads();
        if (live && tid < 8) {
            unsigned used = 0u; float tv[TOPK]; int ti[TOPK];
#pragma unroll
            for (int k = 0; k < TOPK; ++k) { float best = -INFINITY; int bi = 0;
                for (int j = 0; j < NE; ++j) { const float v = logit[tid * 32 + j]; if (!((used >> j) & 1u) && v > best) { best = v; bi = j; } }
                used |= 1u << bi; tv[k] = best; ti[k] = bi; }
            const float mx = tv[0]; float ex[TOPK], sum = 0.f;
#pragma unroll
            for (int k = 0; k < TOPK; ++k) { ex[k] = __expf(tv[k] - mx); sum += ex[k]; }
            const float inv = 1.0f / sum; const int br = buf * 8 + tid;
            sel_t[br] = base + tid;
#pragma unroll
            for (int k = 0; k < TOPK; ++k) { sel_e[br * 4 + k] = ti[k]; sel_g[br * 4 + k] = ex[k] * inv; }
        }
        if (!live && tid < 8) sel_t[buf * 8 + tid] = -1;
        if (buf == 7 || it == nit - 1) {
            const int nrow = (buf + 1) * 8;
            if (tid < NE) hist[tid] = 0;
            __syncthreads();
            int my_e = 0, my_t = -1;
            if (tid < nrow * 4) { my_t = sel_t[tid >> 2]; if (my_t >= 0) { my_e = sel_e[tid]; rank[tid] = __hip_atomic_fetch_add((int*)(hist + my_e), 1, __ATOMIC_RELAXED, __HIP_MEMORY_SCOPE_WORKGROUP); } }
            __syncthreads();
            if (tid < NE) gbase[tid] = atomicAdd(&cnt[tid], hist[tid]);
            __syncthreads();
            if (tid < nrow * 4 && my_t >= 0) { const int a = my_t * TOPK + (tid & 3), sl = gbase[my_e] + rank[tid];
                idx[a] = my_e; gate[a] = sel_g[tid]; slot[a] = sl; list[(size_t)my_e * S + sl] = a; }
        }
        __syncthreads();
    }
}

__device__ __forceinline__ void phase_final(const P& p, int bid, int Gn) {
    const int tid_ = otid(); const int lane = tid_ & 63, gw = bid * NWAVES + (tid_ >> 6), NGW = Gn * NWAVES;
    const int* cnt = (const int*)(p.ws + WS_CTL);
    const int* idx = (const int*)(p.ws + WS_IDX); const int* slot = (const int*)(p.ws + WS_SLOT);
    const float* mod = (const float*)(p.ws + WS_MOD);
    const bf16_t* X1 = (const bf16_t*)(p.ws + WS_X1);
    const bf16_t* YA = (const bf16_t*)(p.ws + WS_YA);
    int poff_l = 0;
    { int acc = 0; for (int j = 0; j < NE; ++j) { const int cj = (cnt[j] + 255) & ~255; if (lane == j) poff_l = acc; acc += cj; } }
    u32x2 ya[4][8], yan[4][8], xa[8], xan[8];
    int pr[TOPK], prn[TOPK];
#define FIN_IDS(PR, row_) do { _Pragma("unroll") for (int k = 0; k < TOPK; ++k) { const int e = idx[(row_) * TOPK + k]; PR[k] = __shfl(poff_l, e) + slot[(row_) * TOPK + k]; } } while (0)
#define FIN_LOAD(YAR, XAR, PR, row_) do { _Pragma("unroll") for (int j = 0; j < 8; ++j) { const int c0 = 4 * lane + 256 * j; \
        _Pragma("unroll") for (int k = 0; k < TOPK; ++k) YAR[k][j] = *(const u32x2*)(YA + (size_t)PR[k] * D + c0); \
        XAR[j] = *(const u32x2*)(X1 + (size_t)(row_) * D + c0); } } while (0)
    int row = gw;
    if (row < S) { FIN_IDS(pr, row); FIN_LOAD(ya, xa, pr, row); }
    if (row + NGW < S) FIN_IDS(prn, row + NGW);
    while (row < S) {
        const int nrow = row + NGW;
        if (nrow < S) FIN_LOAD(yan, xan, prn, nrow);
        if (nrow + NGW < S) FIN_IDS(pr, nrow + NGW);
        f32x4 v[8]; float ss = 0.f;
#pragma unroll
        for (int j = 0; j < 8; ++j) { const int c0 = 4 * lane + 256 * j; f32x4 m = (f32x4){0.f, 0.f, 0.f, 0.f};
#pragma unroll
            for (int k = 0; k < TOPK; ++k) m += bf4_to_f32(ya[k][j]);
            const f32x4 g2 = *(const f32x4*)(mod + 5 * D + c0);
            v[j] = bf4_to_f32(xa[j]) + g2 * m;
            ss += (v[j].x * v[j].x + v[j].y * v[j].y) + (v[j].z * v[j].z + v[j].w * v[j].w); }
        const float rs = 1.0f / sqrtf(wave_sum(ss) * (1.0f / D) + EPS);
#pragma unroll
        for (int j = 0; j < 8; ++j) { const int c0 = 4 * lane + 256 * j; const f32x4 fg = *(const f32x4*)(p.final_g + c0);
            *(f32x4*)(p.out + (size_t)row * D + c0) = v[j] * rs * fg; }
#pragma unroll
        for (int j = 0; j < 8; ++j) { xa[j] = xan[j];
#pragma unroll
            for (int k = 0; k < TOPK; ++k) ya[k][j] = yan[k][j]; }
#pragma unroll
        for (int k = 0; k < TOPK; ++k) { const int t = prn[k]; prn[k] = pr[k]; pr[k] = t; }
        row = nrow;
    }
#undef FIN_IDS
#undef FIN_LOAD
}

#define XB_TMO      128
#define XB_XCNT(j)  (256  + 64 * (j))
#define XB_XSUB(j)  (1280 + 64 * (j))
#define XB_XGEN(j)  (2304 + 64 * (j))
#define XB_TOP      3328
#define XB_TOPGEN   3392
#define XCD_BAR_WORDS 3456
#define XB_SPIN_CAP (1u << 18)

__device__ __forceinline__ unsigned xb_ld(unsigned* p)              { return __hip_atomic_load(p, __ATOMIC_RELAXED, __HIP_MEMORY_SCOPE_AGENT); }
__device__ __forceinline__ unsigned xb_add(unsigned* p, unsigned v) { return __hip_atomic_fetch_add(p, v, __ATOMIC_RELAXED, __HIP_MEMORY_SCOPE_AGENT); }
__device__ __forceinline__ unsigned xb_xcc_id() { return (unsigned)__builtin_amdgcn_s_getreg((3 << 11) | 20) & 0xFu; }
#define XB_SPIN(cond, bar) do { unsigned _sp = 0; while (cond) { __builtin_amdgcn_s_sleep(1); \
    if ((++_sp & 255u) == 0u) { if (xb_ld(&(bar)[XB_TMO])) break; if (_sp > XB_SPIN_CAP) { atomicAdd(&(bar)[XB_TMO], 1u); break; } } } } while (0)

struct XcdBarrier {
    unsigned* bar; unsigned x;
    volatile LAS unsigned* st;
};

__device__ __forceinline__ XcdBarrier xcd_barrier_post(unsigned* bar, volatile LAS unsigned* st) {
    XcdBarrier b; b.bar = bar; b.x = xb_xcc_id(); b.st = st;
    if (threadIdx.x == 0) (void)xb_add(&bar[XB_XCNT(b.x)], 1u);
    return b;
}
__device__ __forceinline__ void xcd_barrier_complete(unsigned* bar, unsigned x, unsigned& nloc, unsigned& nx) {
    const unsigned G = gridDim.x * gridDim.y * gridDim.z;
    unsigned sum, cnt, mine, sp = 0u;
    for (;;) {
        sum = 0u; cnt = 0u; mine = 0u;
#pragma unroll
        for (unsigned j = 0; j < 16; ++j) { const unsigned c = xb_ld(&bar[XB_XCNT(j)]); sum += c; cnt += (c > 0u) ? 1u : 0u; mine = (j == x) ? c : mine; }
        if (sum == G) break;
        __builtin_amdgcn_s_sleep(1);
        if ((++sp & 255u) == 0u) { if (xb_ld(&bar[XB_TMO])) break; if (sp > XB_SPIN_CAP) { atomicAdd(&bar[XB_TMO], 1u); break; } }
    }
    nloc = mine > 0u ? mine : 1u; nx = cnt > 0u ? cnt : 1u;
}

__device__ __forceinline__ void xcd_barrier(const XcdBarrier& b) {
    asm volatile("s_waitcnt vmcnt(0)" ::: "memory");
    __syncthreads();
    if (threadIdx.x == 0) {
        unsigned* bar = b.bar;
        __builtin_amdgcn_s_waitcnt(0);
        unsigned nloc = b.st[0], nx = b.st[1];
        if (nloc == 0u) { xcd_barrier_complete(bar, b.x, nloc, nx); b.st[0] = nloc; b.st[1] = nx; }
        const unsigned old = xb_add(&bar[XB_XSUB(b.x)], 1u);
        const unsigned gen = old / nloc;
        if (old + 1u == (gen + 1u) * nloc) {
            __builtin_amdgcn_fence(__ATOMIC_RELEASE, "agent");
            asm volatile("s_waitcnt vmcnt(0)" ::: "memory");
            const unsigned og = xb_add(&bar[XB_TOP], 1u);
            const unsigned tg = og / nx;
            if (og + 1u == (tg + 1u) * nx) xb_add(&bar[XB_TOPGEN], 1u);
            else XB_SPIN(xb_ld(&bar[XB_TOPGEN]) == tg, bar);
            __builtin_amdgcn_fence(__ATOMIC_ACQUIRE, "agent");
            xb_add(&bar[XB_XGEN(b.x)], 1u);
            asm volatile("s_waitcnt vmcnt(0)" ::: "memory");
        } else {
            XB_SPIN(xb_ld(&bar[XB_XGEN(b.x)]) == gen, bar);
            __builtin_amdgcn_fence(__ATOMIC_ACQUIRE, "agent");
            asm volatile("s_waitcnt vmcnt(0)" ::: "memory");
        }
    }
    __syncthreads();
}
constexpr int CW_BAR = 4096;
constexpr int MISC_OFF = 147456;

typedef __attribute__((address_space(4))) const Args CArgs;
__device__ __forceinline__ const Args* kargs() { CArgs* k = (CArgs*)__builtin_amdgcn_kernarg_segment_ptr(); asm volatile("" : "+s"(k)); return (const Args*)k; }
__device__ __forceinline__ const float* asg(const float* q) { return (const float*)(GAS const float*)q; }
__device__ __forceinline__ P globalize(const P& q) {
    P r;
#define GZ(m) r.m = asg(q.m)
    GZ(x); GZ(c); GZ(w_ada); GZ(b_ada); GZ(norm1_g); GZ(w_in); GZ(lam_re); GZ(lam_im); GZ(b_re); GZ(b_im); GZ(c_re); GZ(c_im); GZ(d_skip); GZ(log_dt);
    GZ(w_glu); GZ(b_glu); GZ(attn_g); GZ(ssm_g); GZ(w_out); GZ(norm2_g); GZ(w_router); GZ(b_router); GZ(w_gu); GZ(b_gu); GZ(w_down); GZ(b_down); GZ(final_g);
#undef GZ
    r.out = (float*)(GAS float*)q.out; r.ws = (unsigned char*)(GAS unsigned char*)q.ws;
    return r;
}
__global__ void __launch_bounds__(NWAVES * 64, 2) mk_fwd(Args args_unused) {
    extern __shared__ __attribute__((aligned(16))) unsigned char lds_raw[];
    LAS unsigned char* lds = (LAS unsigned char*)lds_raw;
    const int lo = kargs()->ph_lo, hi = kargs()->ph_hi;
    const int Gn = gridDim.x, bid = blockIdx.x;
    if (threadIdx.x == 0) *(LAS u32x4*)(lds + MISC_OFF) = (u32x4){0u, 0u, 0u, 0u};
    __syncthreads();
    XcdBarrier bar; bar.bar = nullptr; bar.x = 0; bar.st = nullptr;
    if (hi - lo > 1) { unsigned* bw = (unsigned*)((unsigned char*)(GAS unsigned char*)kargs()->p.ws + WS_CTL) + CW_BAR; bar = xcd_barrier_post(bw, (volatile LAS unsigned*)(lds + MISC_OFF)); }
#define SEAM(k) do { if (lo <= (k) && (k) + 1 < hi) xcd_barrier(bar); } while (0)
#ifndef PHMASK
#define PHMASK 0x1fff
#endif
#define IN(k) (((PHMASK >> (k)) & 1) && lo <= (k) && (k) < hi)
#ifndef REPMASK
#define REPMASK 0
#endif
#define REPS(k) for (int rep_ = 0; rep_ < ((((REPMASK) >> (k)) & 1) ? 2 : 1); ++rep_)
#define PHASE_P const P p = globalize(kargs()->p); unsigned char* ws = p.ws; (void)ws
    if (IN(0)) REPS(0) { __syncthreads(); PHASE_P; phase_prologue(p, lds, bid, Gn); }
    SEAM(0);
    if (IN(1)) REPS(1) { __syncthreads(); PHASE_P; phase_norm1(p, bid, Gn); }
    SEAM(1);
    if (IN(2)) REPS(2) { __syncthreads();
        PHASE_P;
        typedef pg8::DenseSched<WS_HB, WS_WIN, S, INW, D> Sch; Sch Sd; Sd.init(ws, Gn, bid);
        pg8::EpiProj E{(bf16_t*)(ws + WS_QKV), (bf16_t*)(ws + WS_UB2)};
        pg8::gemm_phase<pg8::EpiProj, Sch>(lds + RING_OFF, Sd, E);
    }
    SEAM(2);
    if (IN(3)) REPS(3) { __syncthreads();
        PHASE_P;
        {   typedef pg8::S5Sched<0> Sch; Sch Ss; Ss.init(ws, Gn, bid);
            pg8::EpiS5E E{(float*)(ws + WS_EF)};
            pg8::gemm_phase<pg8::EpiS5E, Sch>(lds + RING_OFF, Ss, E); }
        __syncthreads();
        phase_attn(p, lds, bid, Gn);
    }
    SEAM(3);
    if (IN(4)) REPS(4) { __syncthreads(); PHASE_P; phase_s5_carry(p, bid); }
    SEAM(4);
    if (IN(5)) REPS(5) { __syncthreads();
        PHASE_P;
        typedef pg8::S5Sched<1> Sch; Sch Ss; Ss.init(ws, Gn, bid);
        pg8::EpiS5Y E{(bf16_t*)(ws + WS_YGB)};
        pg8::gemm_phase<pg8::EpiS5Y, Sch>(lds + RING_OFF, Ss, E);
    }
    SEAM(5);
    if (IN(6)) REPS(6) { __syncthreads();
        PHASE_P;
        typedef pg8::DenseSched<WS_YGB, WS_WGLU, S, SW, SW> Sch; Sch Sd; Sd.init(ws, Gn, bid);
        pg8::EpiGlu E{(const bf16_t*)(ws + WS_YGB), p.b_glu, (bf16_t*)(ws + WS_Z)};
        pg8::gemm_phase<pg8::EpiGlu, Sch>(lds + RING_OFF, Sd, E);
    }
    SEAM(6);
    if (IN(7)) REPS(7) { __syncthreads(); PHASE_P; phase_mix(p, bid, Gn); }
    SEAM(7);
    if (IN(8)) REPS(8) { __syncthreads();
        PHASE_P;
        typedef pg8::DenseSched<WS_YMIXB, WS_WOUT, S, D, D> Sch; Sch Sd; Sd.init(ws, Gn, bid);
        pg8::EpiResid E{p.x, (const float*)(ws + WS_MOD) + 2 * D, (bf16_t*)(ws + WS_X1)};
        pg8::gemm_phase<pg8::EpiResid, Sch>(lds + RING_OFF, Sd, E);
    }
    SEAM(8);
    if (IN(9)) REPS(9) { __syncthreads(); PHASE_P; phase_norm2_router(p, lds, bid, Gn); }
    SEAM(9);
    if (IN(10)) REPS(10) { __syncthreads();
        PHASE_P;
        pg8::MoeSched<1> Sm; Sm.init(ws, Gn, bid);
        pg8::EpiMoe1 E{p.b_gu, ws + WS_ACT};
        pg8::gemm_phase<pg8::EpiMoe1, pg8::MoeSched<1>>(lds + RING_OFF, Sm, E);
    }
    SEAM(10);
    if (IN(11)) REPS(11) { __syncthreads();
        PHASE_P;
        pg8::MoeSched<2> Sm; Sm.init(ws, Gn, bid);
        pg8::EpiMoe2 E{p.b_down, ws};
        pg8::gemm_phase<pg8::EpiMoe2, pg8::MoeSched<2>>(lds + RING_OFF, Sm, E);
    }
    SEAM(11);
    if (IN(12)) REPS(12) { __syncthreads(); PHASE_P; phase_final(p, bid, Gn); }
#undef IN
#undef PHASE_P
#undef SEAM
}

extern "C" void kernel_launch(void* const* d_in, const int* in_sizes, int n_in, void* d_out, int out_size, void* d_ws, size_t ws_size, hipStream_t stream) {
    static int grid = 0;
    if (grid == 0) {
        if (n_in != 27 || ws_size < WS_END) { fprintf(stderr, "kernel_launch: unexpected n_in %d or ws_size %zu (< %zu)\n", n_in, ws_size, (size_t)WS_END); grid = -1; return; }
        int dev = 0, cus = 0;
        if (hipGetDevice(&dev) != hipSuccess || hipDeviceGetAttribute(&cus, hipDeviceAttributeMultiprocessorCount, dev) != hipSuccess) { grid = -1; return; }
        if (hipFuncSetAttribute((const void*)mk_fwd, hipFuncAttributeMaxDynamicSharedMemorySize, LDS_BYTES) != hipSuccess) { fprintf(stderr, "hipFuncSetAttribute failed\n"); grid = -1; return; }
        grid = cus;
    }
    if (grid < 0) return;
    Args a{};
    const float** f = (const float**)&a.p;
    for (int i = 0; i < 27; ++i) f[i] = (const float*)d_in[i];
    a.p.out = (float*)d_out; a.p.ws = (unsigned char*)d_ws;
    (void)hipMemsetAsync(a.p.ws + WS_CTL, 0, 1 * MiB, stream);
#ifndef MK_PER_PHASE
    a.ph_lo = 0; a.ph_hi = 13; hipLaunchKernelGGL(mk_fwd, dim3(grid), dim3(NWAVES * 64), LDS_BYTES, stream, a);
#else
    for (int ph = 0; ph < 13; ++ph) { a.ph_lo = ph; a.ph_hi = ph + 1; hipLaunchKernelGGL(mk_fwd, dim3(grid), dim3(NWAVES * 64), LDS_BYTES, stream, a); }
#endif
}
```

```cpp
#include <hip/hip_runtime.h>
#include <cstdio>
#include <cstdint>

#ifndef MOE_FP8
#define MOE_FP8 1
#endif
constexpr int S = 16384, D = 2048, AW = 1024, SW = 1024, INW = 4096, NH = 16, HD = 64;
constexpr int G = 64, NS = 64, PC = 16;
constexpr int NE = 32, TOPK = 4, FF = 2048;
constexpr int LCH = 32, NCH = S / LCH;
constexpr int CROWS = 40;
constexpr int KS5 = 640, KS5E = 512;
constexpr int NASSIGN = S * TOPK;
constexpr int PADROWS = NASSIGN + NE * 256;
constexpr float EPS = 1e-6f;

constexpr size_t MiB = 1ull << 20;
constexpr size_t WS_CTL = 0;
constexpr size_t WS_MOD = 1 * MiB;
constexpr size_t WS_S5P = 2 * MiB;
constexpr size_t WS_IDX = 4 * MiB;
constexpr size_t WS_GATE = 5 * MiB;
constexpr size_t WS_SLOT = 6 * MiB;
constexpr size_t WS_LIST = 8 * MiB;
constexpr size_t WS_ECH = 12 * MiB;
constexpr size_t WS_X0 = 16 * MiB;
constexpr size_t WS_WIN = 32 * MiB;
constexpr size_t WS_WGLU = 48 * MiB;
constexpr size_t WS_WOUT = 50 * MiB;
constexpr size_t WS_HB = 64 * MiB;
constexpr size_t WS_PROJ = 128 * MiB;
constexpr size_t WS_QKV = WS_PROJ;
constexpr size_t WS_UB2 = WS_PROJ + 96 * MiB;
constexpr size_t WS_OB = WS_PROJ + 160 * MiB;
constexpr size_t WS_LSE = 20 * MiB;
constexpr size_t WS_YATT = WS_PROJ + 256 * MiB;
constexpr size_t WS_S5E = WS_YATT;
constexpr size_t WS_EF = WS_YATT + 16 * MiB;
constexpr size_t WS_YG = WS_YATT + 64 * MiB;
constexpr size_t WS_S5T = WS_YG;
constexpr size_t WS_YGB = WS_YG + 64 * MiB;
constexpr size_t WS_Z = WS_YGB + 32 * MiB;
constexpr size_t WS_YMIXB = WS_Z + 64 * MiB;
constexpr size_t WS_X1 = WS_YMIXB + 64 * MiB;
constexpr size_t WS_H2 = WS_X1 + 128 * MiB;
constexpr size_t WS_ACT = WS_H2 + 128 * MiB;
constexpr size_t WS_YA = WS_ACT + 288 * MiB;
constexpr size_t WS_WGU = WS_YA + 288 * MiB;
constexpr size_t WS_WDN = WS_WGU + 512 * MiB;
constexpr size_t WS_END = WS_WDN + 256 * MiB;

struct P {
    const float *x, *c, *w_ada, *b_ada, *norm1_g, *w_in, *lam_re, *lam_im, *b_re, *b_im, *c_re, *c_im, *d_skip, *log_dt,
        *w_glu, *b_glu, *attn_g, *ssm_g, *w_out, *norm2_g, *w_router, *b_router, *w_gu, *b_gu, *w_down, *b_down, *final_g;
    float* out;
    unsigned char* ws;
};
struct Args { P p; int ph_lo, ph_hi; };

#define GAS __attribute__((address_space(1)))
#define LAS __attribute__((address_space(3)))
typedef unsigned short bf16_t;
typedef short bf16x8 __attribute__((ext_vector_type(8)));
typedef float f32x4 __attribute__((ext_vector_type(4)));
typedef float f32x2 __attribute__((ext_vector_type(2)));
typedef unsigned u32x4 __attribute__((ext_vector_type(4)));
typedef unsigned u32x2 __attribute__((ext_vector_type(2)));
typedef int v4i32 __attribute__((ext_vector_type(4)));
typedef int v8i32 __attribute__((ext_vector_type(8)));

__device__ __forceinline__ float wave_sum(float v) {
#pragma unroll
    for (int o = 1; o < 64; o <<= 1) v += __shfl_xor(v, o);
    return v;
}
__device__ __forceinline__ float block_sum256(float v, float* red) {
    v = wave_sum(v);
    __syncthreads();
    if ((threadIdx.x & 63) == 0) red[threadIdx.x >> 6] = v;
    __syncthreads();
    return red[0] + red[1] + red[2] + red[3];
}
__device__ __forceinline__ float sigmoidf_(float x) { return __builtin_amdgcn_rcpf(1.0f + __builtin_amdgcn_exp2f(-1.4426950408889634f * x)); }
__device__ __forceinline__ unsigned cvt_pk_bf16(float lo, float hi) { unsigned r; asm volatile("v_cvt_pk_bf16_f32 %0, %1, %2" : "=v"(r) : "v"(lo), "v"(hi)); return r; }
__device__ __forceinline__ unsigned pk4_fp8(float a, float b, float c, float d) { int w = 0; w = __builtin_amdgcn_cvt_pk_fp8_f32(a, b, w, false); w = __builtin_amdgcn_cvt_pk_fp8_f32(c, d, w, true); return (unsigned)w; }
__device__ __forceinline__ f32x4 bf4_to_f32(u32x2 v) { return (f32x4){__uint_as_float(v.x << 16), __uint_as_float(v.x & 0xffff0000u), __uint_as_float(v.y << 16), __uint_as_float(v.y & 0xffff0000u)}; }
__device__ __forceinline__ float bf2f(bf16_t b) { return __uint_as_float(((unsigned)b) << 16); }
__device__ __forceinline__ bf16_t f2bf(float f) { return (bf16_t)(cvt_pk_bf16(f, 0.f) & 0xffffu); }
__device__ __forceinline__ int otid() { int t = threadIdx.x; asm volatile("" : "+v"(t)); return t; }

namespace pg8 {
constexpr int BM = 256, BK = 64, HALF = 128, HTB = HALF * BK * 2  , STAGE_BYTES = 8 * HTB, NXCD = 8, WGM = 8;
__host__ __device__ __forceinline__ int lds_byte(int r, int c) { const int st = (r >> 4) * 2 + (c >> 5), rr = r & 15, cc = c & 31, ob = rr * 64 + cc * 2; return st * 1024 + (ob ^ (((ob >> 9) & 1) << 5)); }
__host__ __device__ __forceinline__ void stage_rc(int b, int& R, int& C) { const int st = b / 1024, sb = b % 1024, swz = sb ^ (((sb >> 9) & 1) << 5); R = (st >> 1) * 16 + swz / 64; C = (st & 1) * 32 + (swz % 64) / 2; }
__host__ __device__ __forceinline__ int perm32(int rho) { const int n = rho >> 4, i = rho & 15; return 8 * (i >> 2) + 4 * n + (i & 3); }

struct Unit { int pm, pn, e, mt; };

__device__ __forceinline__ bool flat_to_tile(long L, int nM, int nN, int& pm, int& pn) {
    const int nwg = nM * nN; if (L >= nwg) return false;
    int wgid = (int)L; { const int q = nwg / NXCD, r = nwg % NXCD, xcd = wgid % NXCD, off = wgid / NXCD; wgid = (xcd < r ? xcd * (q + 1) : r * (q + 1) + (xcd - r) * q) + off; }
    const int nig = WGM * nN, gid = wgid / nig, fm = gid * WGM, gsz = (nM - fm) < WGM ? (nM - fm) : WGM;
    pm = fm + ((wgid % nig) % gsz); pn = (wgid % nig) / gsz; return true;
}

template <size_t AOFF, size_t BOFF, int M_, int N_, int K_>
struct DenseSched {
    static constexpr bool GATHER = false, FP8 = false;
    static constexpr int K = K_, nM = M_ / BM, nN = N_ / BM, KSTEP_A = 128;
    const unsigned char* ws; int Gn, c;
    __device__ void init(const unsigned char* ws_, int G_, int c_) { ws = ws_; Gn = G_; c = c_; }
    __device__ __forceinline__ bool next(int i, Unit& u) const { u.e = 0; u.mt = 0; return flat_to_tile((long)i * Gn + c, nM, nN, u.pm, u.pn); }
    __device__ __forceinline__ const char* a_ptr(const Unit& u) const { return (const char*)ws + AOFF + (size_t)u.pm * BM * K * 2; }
    __device__ __forceinline__ const char* b_ptr(const Unit& u) const { return (const char*)ws + BOFF + (size_t)u.pn * BM * K * 2; }
    __device__ __forceinline__ void a_off(const Unit&, unsigned (&off)[2][2]) const {
        const int tid = otid();
#pragma unroll
        for (int i = 0; i < 2; ++i) { int R, C; stage_rc(tid * 16 + i * 8192, R, C);
#pragma unroll
            for (int h = 0; h < 2; ++h) off[h][i] = (unsigned)((h * HALF + R) * K + C) * 2u; }
    }
};

template <int STAGE>
struct MoeSched {
    static constexpr bool GATHER = true, FP8 = (MOE_FP8 != 0);
    static constexpr int K = (STAGE == 1) ? D : FF, N = (STAGE == 1) ? 2 * FF : D, nN = N / BM, KSTEP_A = 128, KB = FP8 ? K : 2 * K;
    static constexpr size_t AOFF = (STAGE == 1) ? WS_HB : WS_ACT, BOFF = (STAGE == 1) ? WS_WGU : WS_WDN;
    const unsigned char* ws; int nM, Gn, c;
    __device__ void init(const unsigned char* ws_, int G_, int c_) {
        ws = ws_; Gn = G_; c = c_;
        const int* cnt = (const int*)(ws + WS_CTL);
        int t = 0; for (int j = 0; j < NE; ++j) t += (cnt[j] + 255) >> 8; nM = __builtin_amdgcn_readfirstlane(t);
    }
    __device__ __forceinline__ bool next(int i, Unit& u) const {
        if (!flat_to_tile((long)i * Gn + c, nM, nN, u.pm, u.pn)) return false;
        const int* cnt = (const int*)(ws + WS_CTL);
        int acc = 0, e = 0, mt = 0;
        for (int j = 0; j < NE; ++j) { const int nt = (cnt[j] + 255) >> 8; if (u.pm >= acc && u.pm < acc + nt) { e = j; mt = u.pm - acc; } acc += nt; }
        u.e = __builtin_amdgcn_readfirstlane(e); u.mt = __builtin_amdgcn_readfirstlane(mt); return true;
    }
    __device__ __forceinline__ const char* a_ptr(const Unit& u) const { return (STAGE == 1) ? (const char*)ws + AOFF : (const char*)ws + AOFF + (size_t)u.pm * BM * KB; }
    __device__ __forceinline__ const char* b_ptr(const Unit& u) const { return (const char*)ws + BOFF + ((size_t)u.e * N + (size_t)u.pn * BM) * KB; }
    __device__ __forceinline__ void a_off(const Unit& u, unsigned (&off)[2][2]) const {
        const int tid = otid();
        if (STAGE == 1) {
            const int* cnt = (const int*)(ws + WS_CTL); const int* list = (const int*)(ws + WS_LIST);
            const int ce = __builtin_amdgcn_readfirstlane(cnt[u.e]);
#pragma unroll
            for (int i = 0; i < 2; ++i) { int R, C; stage_rc(tid * 16 + i * 8192, R, C);
#pragma unroll
                for (int h = 0; h < 2; ++h) { int lr = u.mt * BM + h * HALF + R; lr = lr < ce ? lr : ce - 1; const int tok = list[(size_t)u.e * S + lr] >> 2; off[h][i] = (unsigned)(tok * KB + C * 2); } }
        } else {
#pragma unroll
            for (int i = 0; i < 2; ++i) { int R, C; stage_rc(tid * 16 + i * 8192, R, C);
#pragma unroll
                for (int h = 0; h < 2; ++h) off[h][i] = (unsigned)((h * HALF + R) * KB + C * 2); }
        }
    }
};

template <int MODE>
struct S5Sched {
    static constexpr bool GATHER = true, FP8 = false;
    static constexpr int K = MODE ? KS5 : KS5E, KSTEP_A = 4 * 1024 * 2, NCT = MODE ? 2 : 1, NUNITS = G * 2 * NCT;
    const unsigned char* ws; int Gn, c;
    __device__ void init(const unsigned char* ws_, int G_, int c_) { ws = ws_; Gn = G_; c = c_; }
    __device__ __forceinline__ bool next(int i, Unit& u) const {
        const int L = i * Gn + c; if (L >= NUNITS) return false;
        u.e = L / (2 * NCT); const int rem = L % (2 * NCT); u.pm = rem / NCT; u.pn = rem % NCT; u.mt = 0; return true;
    }
    __device__ __forceinline__ const char* a_ptr(const Unit& u) const { return (const char*)ws + WS_UB2 + (size_t)u.e * (PC * 2); }
    __device__ __forceinline__ const char* b_ptr(const Unit& u) const { return (const char*)ws + (MODE ? WS_S5T : WS_S5E) + ((size_t)u.e * (MODE ? 512 : 256) + (size_t)u.pn * BM) * K * 2; }
    __device__ __forceinline__ void a_off(const Unit& u, unsigned (&off)[2][2]) const {
        const int tid = otid();
#pragma unroll
        for (int i = 0; i < 2; ++i) { int R, C; stage_rc(tid * 16 + i * 8192, R, C);
#pragma unroll
            for (int h = 0; h < 2; ++h) off[h][i] = (unsigned)(((u.pm * BM + h * HALF + R) * CROWS + (C >> 4)) * 2048 + (C & 15) * 2); }
    }
};

template <class Epi, class Sched>
__device__ __forceinline__ void gemm_phase(LAS unsigned char* lds, const Sched& S, const Epi& E) {
    const int tid = otid(), wid = __builtin_amdgcn_readfirstlane(tid >> 6), lane = tid & 63, wr = wid >> 2, wc = wid & 3, fr = lane & 15, fq = lane >> 4;
    constexpr int K = Sched::K, KB = Sched::FP8 ? K : 2 * K, nt = KB / (BK * 2);
    unsigned voffB[2];
#pragma unroll
    for (int i = 0; i < 2; ++i) { int sR, sC; stage_rc(tid * 16 + i * 8192, sR, sC); const int Rb = Epi::PERM ? ((sR & ~31) + perm32(sR & 31)) : sR; voffB[i] = (unsigned)(Rb * KB + sC * 2); }
    const size_t kstep = (size_t)(BK * 2);
    constexpr size_t kstepA = (size_t)Sched::KSTEP_A;
    const size_t hstep = (size_t)HALF * KB;
    const unsigned ldsw = (unsigned)wid * 1024u;
    const int aoff = lds_byte(wr * 64 + fr, fq * 8), boff = lds_byte(wc * 32 + fr, fq * 8);
#define PG8_SA(b, h) (((b) * 2 + (h)) * HTB)
#define PG8_SB(b, h) ((4 + (b) * 2 + (h)) * HTB)
#define PG8_STAGE(bufoff, gbase, voff) do { _Pragma("unroll") for (int _i = 0; _i < 2; ++_i) \
        __builtin_amdgcn_global_load_lds((const unsigned*)((const char*)(gbase) + (voff)[_i]), (LAS unsigned*)(lds + (bufoff) + ldsw + _i * 8192), 16, 0, 0); } while (0)
#define PG8_LDA(dst, b, h) do { _Pragma("unroll") for (int m = 0; m < 4; ++m) _Pragma("unroll") for (int k = 0; k < 2; ++k) dst[m][k] = *(const LAS bf16x8*)(lds + PG8_SA(b, h) + aoff + m * 2048 + k * 1024); } while (0)
#define PG8_LDB(dst, b, h) do { _Pragma("unroll") for (int n = 0; n < 2; ++n) _Pragma("unroll") for (int k = 0; k < 2; ++k) dst[n][k] = *(const LAS bf16x8*)(lds + PG8_SB(b, h) + boff + n * 2048 + k * 1024); } while (0)
#define PG8_MMA(ai, bj, At, Bt) do { __builtin_amdgcn_s_setprio(1); _Pragma("unroll") for (int m = 0; m < 4; ++m) _Pragma("unroll") for (int n = 0; n < 2; ++n) { \
        if constexpr (Sched::FP8) {   \
            const v8i32 a8_ = __builtin_shufflevector(__builtin_bit_cast(v4i32, At[m][0]), __builtin_bit_cast(v4i32, At[m][1]), 0, 1, 2, 3, 4, 5, 6, 7); \
            const v8i32 b8_ = __builtin_shufflevector(__builtin_bit_cast(v4i32, Bt[n][0]), __builtin_bit_cast(v4i32, Bt[n][1]), 0, 1, 2, 3, 4, 5, 6, 7); \
            acc[ai][bj][m][n] = __builtin_amdgcn_mfma_scale_f32_16x16x128_f8f6f4(b8_, a8_, acc[ai][bj][m][n], 0, 0, 0, 0x79797979  , 0, 0x7f7f7f7f); \
        } else { _Pragma("unroll") for (int k = 0; k < 2; ++k) acc[ai][bj][m][n] = __builtin_amdgcn_mfma_f32_16x16x32_bf16(Bt[n][k], At[m][k], acc[ai][bj][m][n], 0, 0, 0); } } \
        __builtin_amdgcn_s_setprio(0); } while (0)
#define PG8_WAIT_V(n) asm volatile("s_waitcnt vmcnt(" #n ")" ::: "memory")
#define PG8_WAIT_L(n) asm volatile("s_waitcnt lgkmcnt(" #n ")" ::: "memory")
#define PG8_BAR __builtin_amdgcn_s_barrier()
#define PG8_SCHED __builtin_amdgcn_sched_barrier(0)
    Unit cur, nxt; int ui = 0;
    if (!S.next(0, cur)) return;
    f32x4 acc[2][2][4][2];
#pragma unroll
    for (int a = 0; a < 2; ++a)
#pragma unroll
        for (int b = 0; b < 2; ++b)
#pragma unroll
            for (int m = 0; m < 4; ++m)
#pragma unroll
                for (int n = 0; n < 2; ++n) acc[a][b][m][n] = (f32x4){0.f, 0.f, 0.f, 0.f};
    bf16x8 At[4][2], B0[2][2], B1[2][2];
    const char* cA = S.a_ptr(cur); const char* cB = S.b_ptr(cur);
    unsigned ao[2][2]; S.a_off(cur, ao);
    PG8_STAGE(PG8_SB(0, 0), cB, voffB); PG8_STAGE(PG8_SB(0, 1), cB + hstep, voffB); PG8_STAGE(PG8_SA(0, 0), cA, ao[0]); PG8_STAGE(PG8_SA(0, 1), cA, ao[1]);
    if (wr == 1) PG8_BAR;
    PG8_WAIT_V(2); PG8_BAR;
    PG8_STAGE(PG8_SB(1, 0), cB + kstep, voffB); PG8_STAGE(PG8_SA(1, 0), cA + kstepA, ao[0]); PG8_STAGE(PG8_SB(1, 1), cB + hstep + kstep, voffB);
    PG8_WAIT_V(6); PG8_BAR;
    for (;;) {
        const bool has_next = S.next(ui + 1, nxt);
        const char* nA = has_next ? S.a_ptr(nxt) : cA; const char* nB = has_next ? S.b_ptr(nxt) : cB;
        for (int t = 0; t < nt; t += 2) {
            const bool last = (t == nt - 2);
            const char* a1 = cA + (size_t)(t + 1) * kstepA;
            const char* a2 = last ? nA : cA + (size_t)(t + 2) * kstepA; const char* b2 = last ? nB : cB + (size_t)(t + 2) * kstep;
            const char* a3 = a2 + kstepA; const char* b3 = b2 + kstep;
            asm volatile("" : "+v"(voffB[0]), "+v"(voffB[1]), "+v"(ao[0][0]), "+v"(ao[0][1]), "+v"(ao[1][0]), "+v"(ao[1][1]));

            PG8_LDB(B0, 0, 0); PG8_LDB(B1, 0, 1); PG8_SCHED; PG8_LDA(At, 0, 0); PG8_STAGE(PG8_SA(1, 1), a1, ao[1]);
            PG8_WAIT_V(8); PG8_WAIT_L(0); PG8_BAR; PG8_MMA(0, 0, At, B0); PG8_MMA(0, 1, At, B1); PG8_BAR; PG8_SCHED;
            if (Sched::GATHER) { if (last && has_next) S.a_off(nxt, ao); }
            PG8_LDA(At, 0, 1); PG8_STAGE(PG8_SB(0, 0), b2, voffB); PG8_STAGE(PG8_SB(0, 1), b2 + hstep, voffB); PG8_STAGE(PG8_SA(0, 0), a2, ao[0]);
            PG8_WAIT_V(8); PG8_WAIT_L(0); PG8_BAR; PG8_MMA(1, 0, At, B0); PG8_MMA(1, 1, At, B1); PG8_BAR; PG8_SCHED;
            PG8_LDB(B0, 1, 0); PG8_LDB(B1, 1, 1); PG8_SCHED; PG8_LDA(At, 1, 0); PG8_STAGE(PG8_SA(0, 1), a2, ao[1]);
            PG8_WAIT_V(8); PG8_WAIT_L(0); PG8_BAR; PG8_MMA(0, 0, At, B0); PG8_MMA(0, 1, At, B1); PG8_BAR; PG8_SCHED;
            PG8_LDA(At, 1, 1); PG8_STAGE(PG8_SB(1, 0), b3, voffB); PG8_STAGE(PG8_SB(1, 1), b3 + hstep, voffB); PG8_STAGE(PG8_SA(1, 0), a3, ao[0]);
            PG8_WAIT_V(8); PG8_WAIT_L(0); PG8_BAR; PG8_MMA(1, 0, At, B0); PG8_MMA(1, 1, At, B1); PG8_BAR; PG8_SCHED;
        }
        if (wr == 0) PG8_BAR;
        {
            const int t2 = otid(), wid2 = __builtin_amdgcn_readfirstlane(t2 >> 6), lane2 = t2 & 63;
            E(acc, cur, wid2 >> 2, wid2 & 3, lane2 & 15, lane2 >> 4); }
        if (!has_next) break;
#pragma unroll
        for (int a = 0; a < 2; ++a)
#pragma unroll
            for (int b = 0; b < 2; ++b)
#pragma unroll
                for (int m = 0; m < 4; ++m)
#pragma unroll
                    for (int n = 0; n < 2; ++n) acc[a][b][m][n] = (f32x4){0.f, 0.f, 0.f, 0.f};
        cur = nxt; cA = nA; cB = nB; ++ui;
        if (wr == 1) PG8_BAR;
    }
    PG8_WAIT_V(0);
    PG8_BAR;
#undef PG8_SA
#undef PG8_SB
#undef PG8_STAGE
#undef PG8_LDA
#undef PG8_LDB
#undef PG8_MMA
#undef PG8_WAIT_V
#undef PG8_WAIT_L
#undef PG8_BAR
#undef PG8_SCHED
}

struct EpiF32 {
    static constexpr bool PERM = false;
    float* C; int ldc;
    __device__ __forceinline__ void operator()(const f32x4 (&acc)[2][2][4][2], const Unit& u, int wr, int wc, int fr, int fq) const {
        const int row0 = u.pm * BM + wr * 64 + fr, col0 = u.pn * BM + wc * 32 + 4 * fq;
#pragma unroll
        for (int ai = 0; ai < 2; ++ai)
#pragma unroll
            for (int m = 0; m < 4; ++m) { float* rowp = C + (size_t)(row0 + ai * HALF + m * 16) * ldc + col0;
#pragma unroll
                for (int bj = 0; bj < 2; ++bj)
#pragma unroll
                    for (int n = 0; n < 2; ++n) *(f32x4*)(rowp + bj * HALF + n * 16) = acc[ai][bj][m][n]; }
    }
};
struct EpiGlu {
    static constexpr bool PERM = false;
    const bf16_t* yg; const float* bias; bf16_t* Z;
    __device__ __forceinline__ void operator()(const f32x4 (&acc)[2][2][4][2], const Unit& u, int wr, int wc, int fr, int fq) const {
        const int row0 = u.pm * BM + wr * 64 + fr, col0 = u.pn * BM + wc * 32 + 4 * fq;
#pragma unroll
        for (int ai = 0; ai < 2; ++ai)
#pragma unroll
            for (int m = 0; m < 4; ++m) { const size_t ro = (size_t)(row0 + ai * HALF + m * 16) * SW + col0;
#pragma unroll
                for (int bj = 0; bj < 2; ++bj)
#pragma unroll
                    for (int n = 0; n < 2; ++n) { const int co = bj * HALF + n * 16; const u32x2 yb = *(const u32x2*)(yg + ro + co); const f32x4 y = (f32x4){__uint_as_float(yb.x << 16), __uint_as_float(yb.x & 0xffff0000u), __uint_as_float(yb.y << 16), __uint_as_float(yb.y & 0xffff0000u)};
                        const f32x4 b = *(const f32x4*)(bias + col0 + co); f32x4 o;
#pragma unroll
                        for (int j = 0; j < 4; ++j) o[j] = y[j] * sigmoidf_(acc[ai][bj][m][n][j] + b[j]);
                        u32x2 zw; zw.x = cvt_pk_bf16(o[0], o[1]); zw.y = cvt_pk_bf16(o[2], o[3]); *(u32x2*)(Z + ro + co) = zw; } }
    }
};
struct EpiResid {
    static constexpr bool PERM = false;
    const float* x; const float* gate; bf16_t* X1;
    __device__ __forceinline__ void operator()(const f32x4 (&acc)[2][2][4][2], const Unit& u, int wr, int wc, int fr, int fq) const {
        const int row0 = u.pm * BM + wr * 64 + fr, col0 = u.pn * BM + wc * 32 + 4 * fq;
#pragma unroll
        for (int ai = 0; ai < 2; ++ai)
#pragma unroll
            for (int m = 0; m < 4; ++m) { const size_t ro = (size_t)(row0 + ai * HALF + m * 16) * D + col0;
#pragma unroll
                for (int bj = 0; bj < 2; ++bj)
#pragma unroll
                    for (int n = 0; n < 2; ++n) { const int co = bj * HALF + n * 16; const f32x4 xv = *(const f32x4*)(x + ro + co); const f32x4 g = *(const f32x4*)(gate + col0 + co);
                        const f32x4 o = xv + g * acc[ai][bj][m][n]; u32x2 ow; ow.x = cvt_pk_bf16(o[0], o[1]); ow.y = cvt_pk_bf16(o[2], o[3]); *(u32x2*)(X1 + ro + co) = ow; } }
    }
};
struct EpiMoe1 {
    static constexpr bool PERM = true;
    const float* b_gu; unsigned char* ACT;
    __device__ __forceinline__ void operator()(const f32x4 (&acc)[2][2][4][2], const Unit& u, int wr, int wc, int fr, int fq) const {
        const int row0 = u.pm * BM + wr * 64 + fr, j0 = u.pn * HALF + wc * 32 + 8 * fq;
        const float* bias = b_gu + (size_t)u.e * 2 * FF + 2 * j0;
        float bg[8], bl[8];
#pragma unroll
        for (int j = 0; j < 8; ++j) { bg[j] = bias[2 * j]; bl[j] = bias[2 * j + 1]; }
#pragma unroll
        for (int ai = 0; ai < 2; ++ai)
#pragma unroll
            for (int m = 0; m < 4; ++m) { const size_t eo = (size_t)(row0 + ai * HALF + m * 16) * FF + j0; float o[8];
#pragma unroll
                for (int n = 0; n < 2; ++n)
#pragma unroll
                    for (int j = 0; j < 4; ++j) { const float gl = fminf(acc[ai][0][m][n][j] + bg[4 * n + j], 7.0f); const float ln = fminf(fmaxf(acc[ai][1][m][n][j] + bl[4 * n + j], -7.0f), 7.0f);
                        o[4 * n + j] = gl * sigmoidf_(1.702f * gl) * (ln + 1.0f); }
#if MOE_FP8
                u32x2 w; w.x = pk4_fp8(o[0], o[1], o[2], o[3]); w.y = pk4_fp8(o[4], o[5], o[6], o[7]);
                *(u32x2*)(ACT + eo) = w; }
#else
                u32x4 w; w.x = cvt_pk_bf16(o[0], o[1]); w.y = cvt_pk_bf16(o[2], o[3]); w.z = cvt_pk_bf16(o[4], o[5]); w.w = cvt_pk_bf16(o[6], o[7]);
                *(u32x4*)(ACT + eo * 2) = w; }
#endif
    }
};
struct EpiMoe2 {
    static constexpr bool PERM = true;
    const float* b_down; const unsigned char* ws;
    __device__ __forceinline__ void operator()(const f32x4 (&acc)[2][2][4][2], const Unit& u, int wr, int wc, int fr, int fq) const {
        const int lr0 = u.mt * BM + wr * 64 + fr, row0 = u.pm * BM + wr * 64 + fr, col0 = u.pn * BM + wc * 32 + 8 * fq;
        const int* cnt = (const int*)(ws + WS_CTL); const int* list = (const int*)(ws + WS_LIST); const float* gate = (const float*)(ws + WS_GATE); bf16_t* YA = (bf16_t*)(ws + WS_YA);
        const int ce = __builtin_amdgcn_readfirstlane(cnt[u.e]);
        f32x4 bv[2][2];
#pragma unroll
        for (int bj = 0; bj < 2; ++bj)
#pragma unroll
            for (int n = 0; n < 2; ++n) bv[bj][n] = *(const f32x4*)(b_down + (size_t)u.e * D + col0 + bj * HALF + 4 * n);
#pragma unroll
        for (int ai = 0; ai < 2; ++ai)
#pragma unroll
            for (int m = 0; m < 4; ++m) { const int lr = lr0 + ai * HALF + m * 16; float g = 0.f; if (lr < ce) g = gate[list[(size_t)u.e * S + lr]];
                bf16_t* rowp = YA + (size_t)(row0 + ai * HALF + m * 16) * D + col0;
#pragma unroll
                for (int bj = 0; bj < 2; ++bj) { const f32x4 v0 = (acc[ai][bj][m][0] + bv[bj][0]) * g, v1 = (acc[ai][bj][m][1] + bv[bj][1]) * g;
                    u32x4 w; w.x = cvt_pk_bf16(v0[0], v0[1]); w.y = cvt_pk_bf16(v0[2], v0[3]); w.z = cvt_pk_bf16(v1[0], v1[1]); w.w = cvt_pk_bf16(v1[2], v1[3]);
                    *(u32x4*)(rowp + bj * HALF) = w; } }
    }
};
struct EpiS5E {
    static constexpr bool PERM = false;
    float* EF;
    __device__ __forceinline__ void operator()(const f32x4 (&acc)[2][2][4][2], const Unit& u, int wr, int wc, int fr, int fq) const {
        const int row0 = u.pm * BM + wr * 64 + fr, col0 = wc * 32 + 4 * fq;
#pragma unroll
        for (int ai = 0; ai < 2; ++ai)
#pragma unroll
            for (int m = 0; m < 4; ++m) { float* rowp = EF + ((size_t)u.e * NCH + row0 + ai * HALF + m * 16) * 128 + col0;
#pragma unroll
                for (int n = 0; n < 2; ++n) *(f32x4*)(rowp + n * 16) = acc[ai][0][m][n]; }
    }
};
struct EpiS5Y {
    static constexpr bool PERM = true;
    bf16_t* YGB;
    __device__ __forceinline__ void operator()(const f32x4 (&acc)[2][2][4][2], const Unit& u, int wr, int wc, int fr, int fq) const {
        const int c0 = u.pm * BM + wr * 64 + fr;
#pragma unroll
        for (int ai = 0; ai < 2; ++ai)
#pragma unroll
            for (int m = 0; m < 4; ++m) { const int c = c0 + ai * HALF + m * 16;
#pragma unroll
                for (int bj = 0; bj < 2; ++bj) { const int np = u.pn * BM + bj * HALF + wc * 32 + 8 * fq, i = np >> 4, p0 = np & 15; float o[8];
#pragma unroll
                    for (int n = 0; n < 2; ++n)
#pragma unroll
                        for (int j = 0; j < 4; ++j) { const float y = acc[ai][bj][m][n][j]; const float uu = 0.7978845608028654f * (y + 0.044715f * y * y * y);
                            o[4 * n + j] = y * __builtin_amdgcn_rcpf(1.0f + __builtin_amdgcn_exp2f(-2.885390081777927f * uu)); }
                    u32x4 w; w.x = cvt_pk_bf16(o[0], o[1]); w.y = cvt_pk_bf16(o[2], o[3]); w.z = cvt_pk_bf16(o[4], o[5]); w.w = cvt_pk_bf16(o[6], o[7]);
                    *(u32x4*)(YGB + (size_t)(c * LCH + i) * SW + u.e * PC + p0) = w; } }
    }
};
struct EpiProj {
    static constexpr bool PERM = false;
    bf16_t* QKV; bf16_t* UB2;
    __device__ __forceinline__ void operator()(const f32x4 (&acc)[2][2][4][2], const Unit& u, int wr, int wc, int fr, int fq) const {
        const int row0 = u.pm * BM + wr * 64 + fr, col0 = u.pn * BM + wc * 32 + 4 * fq;
        if (u.pn < 12) {
            const float sc = (u.pn < 4) ? 0.125f : 1.0f;
#pragma unroll
            for (int ai = 0; ai < 2; ++ai)
#pragma unroll
                for (int m = 0; m < 4; ++m) { bf16_t* rowp = QKV + (size_t)(row0 + ai * HALF + m * 16) * (3 * AW) + col0;
#pragma unroll
                    for (int bj = 0; bj < 2; ++bj)
#pragma unroll
                        for (int n = 0; n < 2; ++n) { const f32x4 v = acc[ai][bj][m][n] * sc; u32x2 w; w.x = cvt_pk_bf16(v[0], v[1]); w.y = cvt_pk_bf16(v[2], v[3]); *(u32x2*)(rowp + bj * HALF + n * 16) = w; } }
        } else {
#pragma unroll
            for (int ai = 0; ai < 2; ++ai)
#pragma unroll
                for (int m = 0; m < 4; ++m) { const int t = row0 + ai * HALF + m * 16; bf16_t* rowp = UB2 + (size_t)((t >> 5) * CROWS + (t & 31)) * SW + (col0 - 3 * AW);
#pragma unroll
                    for (int bj = 0; bj < 2; ++bj)
#pragma unroll
                        for (int n = 0; n < 2; ++n) { const f32x4 v = acc[ai][bj][m][n]; u32x2 w; w.x = cvt_pk_bf16(v[0], v[1]); w.y = cvt_pk_bf16(v[2], v[3]); *(u32x2*)(rowp + bj * HALF + n * 16) = w; } }
        }
    }
};
}

constexpr int NWAVES = 8;
constexpr int LDS_BYTES = 148480;
constexpr int RING_OFF = 0;
typedef short s16x4 __attribute__((ext_vector_type(4)));
typedef float f32x16 __attribute__((ext_vector_type(16)));

struct ConvTile { const float* W; unsigned char* WT; int K, N, tk, tn, deint, out8; };
__device__ __forceinline__ void conv_load(const ConvTile& t, f32x4 (&v)[8]) {
    const int tid = otid(), k0 = t.tk * 64, n0 = t.tn * 256;
#pragma unroll
    for (int j = 0; j < 8; ++j) { const int k = j * 8 + (tid >> 6), g = tid & 63;
        v[j] = __builtin_nontemporal_load((const f32x4*)(t.W + (size_t)(k0 + k) * t.N + n0 + 4 * g)); }
}
__device__ __forceinline__ void conv_store(const ConvTile& t, const f32x4 (&vin)[8], LAS float* scr) {
    const int tid = otid(), k0 = t.tk * 64, n0 = t.tn * 256;
    __syncthreads();
#pragma unroll
    for (int j = 0; j < 8; ++j) { const int k = j * 8 + (tid >> 6), g = tid & 63; *(LAS f32x4*)(scr + k * 256 + ((g ^ j) << 2)) = vin[j]; }
    __syncthreads();
#pragma unroll
    for (int jj = 0; jj < 4; ++jj) { const int n = jj * 64 + (tid >> 3), c = tid & 7; float v[8];
#pragma unroll
        for (int q = 0; q < 8; ++q) v[q] = scr[(8 * c + q) * 256 + ((((n >> 2) ^ c)) << 2) + (n & 3)];
        int row = n0 + n;
        if (t.deint) { const int sx = n & 1, jl = n >> 1; row = n0 + sx * 128 + jl; }
        if (t.out8) { u32x2 o8; o8.x = pk4_fp8(v[0] * 64.f, v[1] * 64.f, v[2] * 64.f, v[3] * 64.f); o8.y = pk4_fp8(v[4] * 64.f, v[5] * 64.f, v[6] * 64.f, v[7] * 64.f);
            *(u32x2*)(t.WT + (size_t)row * t.K + k0 + 8 * c) = o8; }
        else { u32x4 o; o.x = cvt_pk_bf16(v[0], v[1]); o.y = cvt_pk_bf16(v[2], v[3]); o.z = cvt_pk_bf16(v[4], v[5]); o.w = cvt_pk_bf16(v[6], v[7]);
            *(u32x4*)(t.WT + ((size_t)row * t.K + k0 + 8 * c) * 2) = o; } }
}
constexpr int CONV_NT_SMALL = 32 * 16 + 16 * 4 + 32 * 8, CONV_NT_EXP = NE * (32 * 16 + 32 * 8);
__device__ __forceinline__ ConvTile conv_tile_small(const P& p, int it) {
    unsigned char* ws = p.ws;
    constexpr int T_IN = 32 * 16, T_GLU = 16 * 4;
    ConvTile t; int r = it;
    if (r < T_IN) { t.W = p.w_in; t.WT = ws + WS_WIN; t.K = D; t.N = INW; t.tk = r / 16; t.tn = r % 16; t.deint = 0; t.out8 = 0; return t; } r -= T_IN;
    if (r < T_GLU) { t.W = p.w_glu; t.WT = ws + WS_WGLU; t.K = SW; t.N = SW; t.tk = r / 4; t.tn = r % 4; t.deint = 0; t.out8 = 0; return t; } r -= T_GLU;
    t.W = p.w_out; t.WT = ws + WS_WOUT; t.K = D; t.N = D; t.tk = r / 8; t.tn = r % 8; t.deint = 0; t.out8 = 0; return t;
}
__device__ __forceinline__ ConvTile conv_tile_exp(const P& p, int it) {
    unsigned char* ws = p.ws;
    constexpr int T_GU = 32 * 16, T_DN = 32 * 8;
    constexpr int E8 = (MOE_FP8 != 0) ? 1 : 0, EB = E8 ? 1 : 2;
    ConvTile t; int r = it;
    if (r < NE * T_GU) { const int e = r / T_GU, q = r % T_GU; t.W = p.w_gu + (size_t)e * D * 2 * FF; t.WT = ws + WS_WGU + (size_t)e * 2 * FF * D * EB; t.K = D; t.N = 2 * FF; t.tk = q / 16; t.tn = q % 16; t.deint = 1; t.out8 = E8; return t; } r -= NE * T_GU;
    { const int e = r / T_DN, q = r % T_DN; t.W = p.w_down + (size_t)e * FF * D; t.WT = ws + WS_WDN + (size_t)e * D * FF * EB; t.K = FF; t.N = D; t.tk = q / 8; t.tn = q % 8; t.deint = 0; t.out8 = E8; return t; }
}

__device__ __forceinline__ void phase_s5_tables(const P& p, LAS unsigned char* lds, int g);
__device__ __forceinline__ void phase_conv_experts(const P& p, LAS unsigned char* lds, int bid, int Gn);
__device__ __forceinline__ void phase_prologue(const P& p, LAS unsigned char* lds, int bid, int Gn) {
    unsigned char* ws = p.ws;
    const int tid = otid();
    if (bid < 192) {
        LAS f32x4* red = (LAS f32x4*)lds;
        const int cq = tid & 15, rg = tid >> 4;
        f32x4 acc = (f32x4){0.f, 0.f, 0.f, 0.f};
        for (int it = 0; it < 64; ++it) { const int i = rg + 32 * it; const float cv = p.c[i]; const float sv = cv / (1.0f + expf(-cv));
            const f32x4 w = *(const f32x4*)(p.w_ada + (size_t)i * 6 * D + 64 * bid + 4 * cq); acc += w * sv; }
        red[rg * 16 + cq] = acc;
        __syncthreads();
        if (tid < 64) { const LAS float* rf = (const LAS float*)lds; float s = p.b_ada[64 * bid + tid];
            for (int r = 0; r < 32; ++r) s += rf[r * 64 + tid];
            ((float*)(ws + WS_MOD))[64 * bid + tid] = s; }
    } else phase_s5_tables(p, lds, bid - 192);
    LAS float* scr = (LAS float*)(lds + RING_OFF);
    {
        f32x4 va[8];
        for (int it = bid; it < CONV_NT_SMALL; it += Gn) { const ConvTile ta = conv_tile_small(p, it); conv_load(ta, va); conv_store(ta, va, scr); }
    }
    __syncthreads();
    phase_conv_experts(p, lds, bid, Gn);
}

__device__ __forceinline__ void phase_norm1(const P& p, int bid, int Gn) {
    const int tid_ = otid(); const int lane = tid_ & 63, gw = bid * NWAVES + (tid_ >> 6), NGW = Gn * NWAVES;
    const float* mod = (const float*)(p.ws + WS_MOD);
    bf16_t* hb = (bf16_t*)(p.ws + WS_HB);
    f32x4 ga[8], sb[8];
#pragma unroll
    for (int j = 0; j < 8; ++j) { const int c0 = 4 * lane + 256 * j; ga[j] = *(const f32x4*)(p.norm1_g + c0) * (*(const f32x4*)(mod + D + c0) + 1.0f); sb[j] = *(const f32x4*)(mod + c0); }
    f32x4 v[8], vn[8];
    int row = gw;
    if (row < S) {
#pragma unroll
        for (int j = 0; j < 8; ++j) v[j] = ((const f32x4*)(p.x + (size_t)row * D) + lane)[64 * j]; }
    while (row < S) {
        const int nrow = row + NGW;
        if (nrow < S) {
#pragma unroll
            for (int j = 0; j < 8; ++j) vn[j] = ((const f32x4*)(p.x + (size_t)nrow * D) + lane)[64 * j]; }
        float ss = 0.f;
#pragma unroll
        for (int j = 0; j < 8; ++j) ss += (v[j].x * v[j].x + v[j].y * v[j].y) + (v[j].z * v[j].z + v[j].w * v[j].w);
        const float rs = 1.0f / sqrtf(wave_sum(ss) * (1.0f / D) + EPS);
#pragma unroll
        for (int j = 0; j < 8; ++j) { const int c0 = 4 * lane + 256 * j;
            const f32x4 o = v[j] * rs * ga[j] + sb[j];
            u32x2 w; w.x = cvt_pk_bf16(o.x, o.y); w.y = cvt_pk_bf16(o.z, o.w);
            *(u32x2*)(hb + (size_t)row * D + c0) = w; }
#pragma unroll
        for (int j = 0; j < 8; ++j) v[j] = vn[j];
        row = nrow;
    }
}

__device__ __forceinline__ void tr_read4(unsigned a0, unsigned a1, s16x4& r0, s16x4& r1, s16x4& r2, s16x4& r3) {
    asm volatile("ds_read_b64_tr_b16 %0, %4\n\tds_read_b64_tr_b16 %1, %4 offset:1024\n\tds_read_b64_tr_b16 %2, %5\n\tds_read_b64_tr_b16 %3, %5 offset:1024\n\ts_waitcnt lgkmcnt(0)"
                 : "=&v"(r0), "=&v"(r1), "=&v"(r2), "=&v"(r3) : "v"(a0), "v"(a1) : "memory");
}
__device__ __forceinline__ void attn_role(const P& p, LAS unsigned char* lds, int bid, int Gn, int w) {
    const bf16_t* QKV = (const bf16_t*)(p.ws + WS_QKV);
    bf16_t* OB = (bf16_t*)(p.ws + WS_OB);
    float* LSE = (float*)(p.ws + WS_LSE);
    const int lane = otid() & 63, aw = w & 3, us = w >> 2;
    const int l31 = lane & 31, hh = lane >> 5, i0 = 32 * aw;
    constexpr int RS = 3 * AW;
    LAS unsigned char* vl = lds + w * 8192;
    for (int u = 2 * bid + us; u < 3 * 128 * NH; u += 2 * Gn) {
        const int b = u >> 11, rem = u & 2047, blk = rem >> 4, h = rem & 15;
        const int dsh = 2 * b, d = 1 << dsh;
        const int n = blk >> dsh, r = blk & (d - 1);
        const int qbase = n * 128 * d + r, kbase = qbase - 128 * d;
        const int qp = qbase + (i0 + l31) * d;
        bf16x8 qf[4];
#pragma unroll
        for (int s = 0; s < 4; ++s) qf[s] = *(const bf16x8*)(QKV + (size_t)qp * RS + h * HD + 16 * s + 8 * hh);
        f32x16 sc[5];
#pragma unroll
        for (int kb = 0; kb < 5; ++kb) {
            const int j = i0 + 32 * kb + l31; int kp = kbase + j * d; kp = kp < 0 ? 0 : kp;
            bf16x8 kf[4];
#pragma unroll
            for (int s = 0; s < 4; ++s) kf[s] = *(const bf16x8*)(QKV + (size_t)kp * RS + AW + h * HD + 16 * s + 8 * hh);
            f32x16 a;
#pragma unroll
            for (int e = 0; e < 16; ++e) a[e] = 0.f;
#pragma unroll
            for (int s = 0; s < 4; ++s) a = __builtin_amdgcn_mfma_f32_32x32x16_bf16(kf[s], qf[s], a, 0, 0, 0);
            sc[kb] = a;
        }
        u32x4 vv[4], vn[4];
#define ATT_VLOAD(dst, kb_) do { _Pragma("unroll") for (int it = 0; it < 4; ++it) { const int id = it * 64 + lane, row = 32 * (kb_) + (id >> 3), ch = id & 7; const int vp = kbase + (i0 + row) * d; \
            dst[it] = (u32x4){0u, 0u, 0u, 0u}; if (vp >= 0) dst[it] = *(const u32x4*)(QKV + (size_t)vp * RS + 2 * AW + h * HD + ch * 8); } } while (0)
        ATT_VLOAD(vv, 0);
        float m = -INFINITY;
#pragma unroll
        for (int kb = 0; kb < 5; ++kb)
#pragma unroll
            for (int e = 0; e < 16; ++e) { const int jrel = 32 * kb + (e & 3) + 8 * (e >> 2) + 4 * hh;
                const bool valid = (jrel >= l31) && (jrel <= l31 + 128) && (n > 0 || (i0 + jrel) >= 128);
                const float sv = valid ? sc[kb][e] : -INFINITY; sc[kb][e] = sv; m = fmaxf(m, sv); }
        m = fmaxf(m, __shfl_xor(m, 32));
        float l = 0.f;
#pragma unroll
        for (int kb = 0; kb < 5; ++kb)
#pragma unroll
            for (int e = 0; e < 16; ++e) { const float pe = __expf(sc[kb][e] - m); sc[kb][e] = pe; l += pe; }
        l += __shfl_xor(l, 32);
        f32x16 o[2];
#pragma unroll
        for (int c = 0; c < 2; ++c)
#pragma unroll
            for (int e = 0; e < 16; ++e) o[c][e] = 0.f;
        const int q4 = (lane & 15) >> 2, pp = lane & 3, bk = (lane >> 4) & 1;
#pragma unroll
        for (int kb = 0; kb < 5; ++kb) {
            if (kb < 4) ATT_VLOAD(vn, kb + 1);
            LAS unsigned char* vb = vl + (kb & 1) * 4096;
#pragma unroll
            for (int it = 0; it < 4; ++it) { const int id = it * 64 + lane; *(LAS u32x4*)(vb + (id >> 3) * 128 + (id & 7) * 16) = vv[it]; }
            asm volatile("s_waitcnt lgkmcnt(0)" ::: "memory");
            const unsigned vbase = (unsigned)(size_t)vb;
#pragma unroll
            for (int s2 = 0; s2 < 2; ++s2) {
                u32x4 pw; pw.x = cvt_pk_bf16(sc[kb][8 * s2 + 0], sc[kb][8 * s2 + 1]); pw.y = cvt_pk_bf16(sc[kb][8 * s2 + 2], sc[kb][8 * s2 + 3]);
                pw.z = cvt_pk_bf16(sc[kb][8 * s2 + 4], sc[kb][8 * s2 + 5]); pw.w = cvt_pk_bf16(sc[kb][8 * s2 + 6], sc[kb][8 * s2 + 7]);
                const bf16x8 pf = __builtin_bit_cast(bf16x8, pw);
                const int rowb = 16 * s2 + 4 * hh + q4;
                const unsigned a0 = vbase + (unsigned)(rowb * 128 + 32 * bk + 8 * pp);
                s16x4 v00, v01, v10, v11;
                tr_read4(a0, a0 + 64, v00, v01, v10, v11);
                bf16x8 vf0, vf1;
                vf0[0] = v00[0]; vf0[1] = v00[1]; vf0[2] = v00[2]; vf0[3] = v00[3]; vf0[4] = v01[0]; vf0[5] = v01[1]; vf0[6] = v01[2]; vf0[7] = v01[3];
                vf1[0] = v10[0]; vf1[1] = v10[1]; vf1[2] = v10[2]; vf1[3] = v10[3]; vf1[4] = v11[0]; vf1[5] = v11[1]; vf1[6] = v11[2]; vf1[7] = v11[3];
                o[0] = __builtin_amdgcn_mfma_f32_32x32x16_bf16(vf0, pf, o[0], 0, 0, 0);
                o[1] = __builtin_amdgcn_mfma_f32_32x32x16_bf16(vf1, pf, o[1], 0, 0, 0);
            }
            if (kb < 4) {
#pragma unroll
                for (int it = 0; it < 4; ++it) vv[it] = vn[it]; }
        }
#undef ATT_VLOAD
        const float inv = 1.0f / l;
        bf16_t* orow = OB + ((size_t)b * S + qp) * AW + h * HD;
#pragma unroll
        for (int c = 0; c < 2; ++c)
#pragma unroll
            for (int rg = 0; rg < 4; ++rg) { u32x2 wv; wv.x = cvt_pk_bf16(o[c][4 * rg] * inv, o[c][4 * rg + 1] * inv); wv.y = cvt_pk_bf16(o[c][4 * rg + 2] * inv, o[c][4 * rg + 3] * inv);
                *(u32x2*)(orow + 32 * c + 8 * rg + 4 * hh) = wv; }
        if (hh == 0) LSE[((size_t)b * S + qp) * NH + h] = m + __logf(l);
    }
}
__device__ __forceinline__ void cw_load(const ConvTile& t, int half, int cw, int lane, f32x4 (&v)[16]) {
    const int kbase = t.tk * 128 + half * 64, n0 = t.tn * 256 + 64 * cw, g = lane & 15, kbl = lane >> 4;
#pragma unroll
    for (int t2 = 0; t2 < 2; ++t2)
#pragma unroll
        for (int kk = 0; kk < 8; ++kk) v[t2 * 8 + kk] = __builtin_nontemporal_load((const f32x4*)(t.W + (size_t)(kbase + (t2 * 4 + kbl) * 8 + kk) * t.N + n0 + 4 * g));
}
__device__ __forceinline__ void cw_park(int half, int lane, const f32x4 (&v)[16], LAS unsigned char* tl) {
    const int g = lane & 15, kbl = lane >> 4;
#pragma unroll
    for (int t2 = 0; t2 < 2; ++t2) { const int kb = half * 8 + t2 * 4 + kbl;
#pragma unroll
        for (int i = 0; i < 4; ++i) { const int n = 4 * g + i; u32x2 o8;
            o8.x = pk4_fp8(v[t2 * 8 + 0][i] * 64.f, v[t2 * 8 + 1][i] * 64.f, v[t2 * 8 + 2][i] * 64.f, v[t2 * 8 + 3][i] * 64.f);
            o8.y = pk4_fp8(v[t2 * 8 + 4][i] * 64.f, v[t2 * 8 + 5][i] * 64.f, v[t2 * 8 + 6][i] * 64.f, v[t2 * 8 + 7][i] * 64.f);
            *(LAS u32x2*)(tl + n * 128 + ((kb ^ (2 * (g & 7))) << 3)) = o8; } }
}
__device__ __forceinline__ void cw_flush(const ConvTile& t, int cw, int lane, LAS unsigned char* tl) {
#pragma unroll
    for (int jj = 0; jj < 8; ++jj) { const int n = jj * 8 + (lane >> 3), pc = lane & 7;
        const u32x4 o = *(const LAS u32x4*)(tl + n * 128 + (((2 * pc) ^ (2 * ((n >> 2) & 7))) << 3));
        const int nt = 64 * cw + n;
        int row = t.tn * 256 + nt;
        if (t.deint) row = t.tn * 256 + (nt & 1) * 128 + (nt >> 1);
        *(u32x4*)(t.WT + (size_t)row * t.K + t.tk * 128 + 16 * pc) = o; }
}
constexpr int CONV_NT_EXP128 = NE * (16 * 16 + 16 * 8);
__device__ __forceinline__ ConvTile conv_tile_exp128(const P& p, int it) {
    unsigned char* ws = p.ws;
    constexpr int T_GU = 16 * 16, T_DN = 16 * 8;
    ConvTile t; int r = it;
    if (r < NE * T_GU) { const int e = r / T_GU, q = r % T_GU; t.W = p.w_gu + (size_t)e * D * 2 * FF; t.WT = ws + WS_WGU + (size_t)e * 2 * FF * D; t.K = D; t.N = 2 * FF; t.tk = q / 16; t.tn = q % 16; t.deint = 1; t.out8 = 1; return t; } r -= NE * T_GU;
    { const int e = r / T_DN, q = r % T_DN; t.W = p.w_down + (size_t)e * FF * D; t.WT = ws + WS_WDN + (size_t)e * D * FF; t.K = FF; t.N = D; t.tk = q / 8; t.tn = q % 8; t.deint = 0; t.out8 = 1; return t; }
}
__device__ __forceinline__ void conv_role(const P& p, LAS unsigned char* lds, int bid, int Gn_, int w) {
    static_assert(MOE_FP8 != 0, "the conversion role writes fp8 expert weights");
    const int lane = otid() & 63, cw = w & 3, Gn = 2 * Gn_;
    LAS unsigned char* tl = lds + 65536 + w * 8192;
    f32x4 va[16], vb[16];
    int it = 2 * bid + (w >> 2);
    ConvTile t = conv_tile_exp128(p, it < CONV_NT_EXP128 ? it : 0);
    if (it < CONV_NT_EXP128) cw_load(t, 0, cw, lane, va);
    while (it < CONV_NT_EXP128) {
        cw_load(t, 1, cw, lane, vb);
        cw_park(0, lane, va, tl);
        const int nx = it + Gn; ConvTile tn = t;
        if (nx < CONV_NT_EXP128) { tn = conv_tile_exp128(p, nx); cw_load(tn, 0, cw, lane, va); }
        cw_park(1, lane, vb, tl);
        cw_flush(t, cw, lane, tl);
        t = tn; it = nx;
    }
}
__device__ __forceinline__ void phase_attn(const P& p, LAS unsigned char* lds, int bid, int Gn) {
    const int w = __builtin_amdgcn_readfirstlane(otid() >> 6);
    attn_role(p, lds, bid, Gn, w);
}
__device__ __forceinline__ void phase_conv_experts(const P& p, LAS unsigned char* lds, int bid, int Gn) {
    const int w = __builtin_amdgcn_readfirstlane(otid() >> 6);
    conv_role(p, lds, bid, Gn, w);
}

__device__ __forceinline__ void phase_s5_tables(const P& p, LAS unsigned char* lds, int g) {
    const int tid = otid();
    LAS float* pwr = (LAS float*)lds;
    LAS float* pwi = pwr + 33 * 64;
    LAS float* cre = pwi + 33 * 64;
    LAS float* cim = cre + 1024;
    LAS float* bbr = cim + 1024;
    LAS float* bbi = bbr + 1024;
    LAS float* Mt = bbi + 1024;
    __syncthreads();
    if (tid < NS) {
        const int n = tid, i = g * NS + n;
        const float dt = expf(p.log_dt[g]), lr = p.lam_re[i], li = p.lam_im[i];
        const float mag = expf(lr * dt), ar = mag * cosf(li * dt), ai = mag * sinf(li * dt);
        const float den = lr * lr + li * li, nr = ar - 1.0f, ni = ai;
        const float fr = (nr * lr + ni * li) / den, fi = (ni * lr - nr * li) / den;
        for (int q = 0; q < PC; ++q) { const float br = p.b_re[(size_t)i * PC + q], bi = p.b_im[(size_t)i * PC + q];
            bbr[n * PC + q] = fr * br - fi * bi; bbi[n * PC + q] = fr * bi + fi * br; }
        float xr = 1.0f, xi = 0.0f;
        for (int t = 0; t <= LCH; ++t) { pwr[t * NS + n] = xr; pwi[t * NS + n] = xi; const float yr = xr * ar - xi * ai, yi = xr * ai + xi * ar; xr = yr; xi = yi; }
        float* lamL = (float*)(p.ws + WS_S5P);
        lamL[(g * NS + n) * 2 + 0] = pwr[LCH * NS + n]; lamL[(g * NS + n) * 2 + 1] = pwi[LCH * NS + n];
    }
    for (int k = tid; k < PC * NS; k += NWAVES * 64) { cre[k] = p.c_re[(size_t)g * PC * NS + k]; cim[k] = p.c_im[(size_t)g * PC * NS + k]; }
    __syncthreads();
    for (int k = 0; k < 16; ++k) { const int idx = tid + 512 * k, tau = idx >> 8, pp = (idx >> 4) & 15, q = idx & 15;
        float acc = 0.f;
        for (int n = 0; n < NS; ++n) { const float cr = cre[pp * NS + n], ci = cim[pp * NS + n], pr = pwr[tau * NS + n], pi = pwi[tau * NS + n];
            const float xr = cr * pr - ci * pi, xi = cr * pi + ci * pr; acc += xr * bbr[n * PC + q] - xi * bbi[n * PC + q]; }
        if (tau == 0 && pp == q) acc += p.d_skip[g * PC + pp];
        Mt[idx] = acc; }
    __syncthreads();
    bf16_t* T = (bf16_t*)(p.ws + WS_S5T) + (size_t)g * 512 * KS5;
    for (int k = 0; k < 80; ++k) { const int ch = tid + 512 * k, row = ch / 80, cc = ch % 80, i = row >> 4, pp = row & 15; float v[8];
        if (cc < 64) { const int j = cc >> 1, q0 = (cc & 1) * 8;
#pragma unroll
            for (int e = 0; e < 8; ++e) v[e] = (j <= i) ? Mt[((i - j) * 16 + pp) * 16 + q0 + e] : 0.f;
        } else { const int m0 = (cc - 64) * 8;
#pragma unroll
            for (int e = 0; e < 8; ++e) { const int m = m0 + e, n = m & 63; const float cr = cre[pp * NS + n], ci = cim[pp * NS + n], pr = pwr[(i + 1) * NS + n], pi = pwi[(i + 1) * NS + n];
                v[e] = (m < 64) ? (cr * pr - ci * pi) : -(cr * pi + ci * pr); } }
        u32x4 o; o.x = cvt_pk_bf16(v[0], v[1]); o.y = cvt_pk_bf16(v[2], v[3]); o.z = cvt_pk_bf16(v[4], v[5]); o.w = cvt_pk_bf16(v[6], v[7]);
        *(u32x4*)(T + (size_t)row * KS5 + cc * 8) = o; }
    bf16_t* Eb = (bf16_t*)(p.ws + WS_S5E) + (size_t)g * 256 * KS5E;
    for (int k = 0; k < 32; ++k) { const int ch = tid + 512 * k, row = ch >> 6, cc = ch & 63, j = cc >> 1, q0 = (cc & 1) * 8, n = row & 63; float v[8];
#pragma unroll
        for (int e = 0; e < 8; ++e) { const float pr = pwr[(LCH - 1 - j) * NS + n], pi = pwi[(LCH - 1 - j) * NS + n], br = bbr[n * PC + q0 + e], bi = bbi[n * PC + q0 + e];
            v[e] = (row < 64) ? (pr * br - pi * bi) : ((row < 128) ? (pr * bi + pi * br) : 0.f); }
        u32x4 o; o.x = cvt_pk_bf16(v[0], v[1]); o.y = cvt_pk_bf16(v[2], v[3]); o.z = cvt_pk_bf16(v[4], v[5]); o.w = cvt_pk_bf16(v[6], v[7]);
        *(u32x4*)(Eb + (size_t)row * KS5E + cc * 8) = o; }
    __syncthreads();
}
__device__ __forceinline__ void phase_s5_carry(const P& p, int bid) {
    const int gt = bid * (NWAVES * 64) + otid();
    if (gt >= G * NS) return;
    const int g = gt >> 6, n = gt & 63;
    const float* lamL = (const float*)(p.ws + WS_S5P);
    const float* EF = (const float*)(p.ws + WS_EF) + (size_t)g * NCH * 128;
    bf16_t* UB2 = (bf16_t*)(p.ws + WS_UB2);
    const float lr = lamL[gt * 2], li = lamL[gt * 2 + 1];
    float xr = 0.f, xi = 0.f;
    for (int c0 = 0; c0 < NCH; c0 += 8) {
        float er[8], ei[8];
#pragma unroll
        for (int k = 0; k < 8; ++k) { er[k] = EF[(size_t)(c0 + k) * 128 + n]; ei[k] = EF[(size_t)(c0 + k) * 128 + 64 + n]; }
#pragma unroll
        for (int k = 0; k < 8; ++k) { const int c = c0 + k;
            bf16_t* xrow = UB2 + (size_t)(c * CROWS + LCH + (n >> 4)) * SW + g * PC + (n & 15);
            xrow[0] = f2bf(xr); xrow[4 * SW] = f2bf(xi);
            const float yr = lr * xr - li * xi + er[k], yi = lr * xi + li * xr + ei[k]; xr = yr; xi = yi; }
    }
}

__device__ __forceinline__ void phase_mix(const P& p, int bid, int Gn) {
    const int tid_ = otid(); const int lane = tid_ & 63, gw = bid * NWAVES + (tid_ >> 6), NGW = Gn * NWAVES;
    const bf16_t* OB = (const bf16_t*)(p.ws + WS_OB);
    const float* LSE = (const float*)(p.ws + WS_LSE);
    const bf16_t* Z = (const bf16_t*)(p.ws + WS_Z);
    bf16_t* YM = (bf16_t*)(p.ws + WS_YMIXB);
    float ls[4][3], lsn[4][3]; u32x2 ob[4][3], obn[4][3], zr[4], zrn[4];
#define MIX_LOAD(LS, OBR, ZR, row_) do { _Pragma("unroll") for (int j = 0; j < 4; ++j) { const int c0 = 4 * lane + 256 * j, hd = c0 >> 6; \
        _Pragma("unroll") for (int b = 0; b < 3; ++b) { LS[j][b] = LSE[((size_t)b * S + (row_)) * NH + hd]; OBR[j][b] = *(const u32x2*)(OB + ((size_t)b * S + (row_)) * AW + c0); } \
        ZR[j] = *(const u32x2*)(Z + (size_t)(row_) * SW + c0); } } while (0)
    int row = gw;
    if (row < S) MIX_LOAD(ls, ob, zr, row);
    while (row < S) {
        const int nrow = row + NGW;
        if (nrow < S) MIX_LOAD(lsn, obn, zrn, nrow);
        f32x4 a[4], z[4]; float sa = 0.f, sz = 0.f;
#pragma unroll
        for (int j = 0; j < 4; ++j) {
            const float mx = fmaxf(fmaxf(ls[j][0], ls[j][1]), ls[j][2]);
            float wsum = 0.f; f32x4 acc = (f32x4){0.f, 0.f, 0.f, 0.f};
#pragma unroll
            for (int b = 0; b < 3; ++b) { const float wb = __expf(ls[j][b] - mx); wsum += wb; acc += bf4_to_f32(ob[j][b]) * wb; }
            a[j] = acc * (1.0f / wsum); sa += (a[j].x * a[j].x + a[j].y * a[j].y) + (a[j].z * a[j].z + a[j].w * a[j].w);
            z[j] = bf4_to_f32(zr[j]); sz += (z[j].x * z[j].x + z[j].y * z[j].y) + (z[j].z * z[j].z + z[j].w * z[j].w); }
        const float ra = 1.0f / sqrtf(wave_sum(sa) * (1.0f / AW) + EPS), rz = 1.0f / sqrtf(wave_sum(sz) * (1.0f / SW) + EPS);
#pragma unroll
        for (int j = 0; j < 4; ++j) { const int c0 = 4 * lane + 256 * j;
            const f32x4 ga = *(const f32x4*)(p.attn_g + c0), gs = *(const f32x4*)(p.ssm_g + c0);
            const f32x4 oa = a[j] * ra * ga, oz = z[j] * rz * gs;
            u32x2 wa, wz; wa.x = cvt_pk_bf16(oa.x, oa.y); wa.y = cvt_pk_bf16(oa.z, oa.w); wz.x = cvt_pk_bf16(oz.x, oz.y); wz.y = cvt_pk_bf16(oz.z, oz.w);
            *(u32x2*)(YM + (size_t)row * D + c0) = wa; *(u32x2*)(YM + (size_t)row * D + AW + c0) = wz; }
#pragma unroll
        for (int j = 0; j < 4; ++j) { zr[j] = zrn[j];
#pragma unroll
            for (int b = 0; b < 3; ++b) { ls[j][b] = lsn[j][b]; ob[j][b] = obn[j][b]; } }
        row = nrow;
    }
#undef MIX_LOAD
}

__device__ __forceinline__ void phase_norm2_router(const P& p, LAS unsigned char* lds, int bid, int Gn) {
    const int tid = otid(), lane = tid & 63, w = tid >> 6;
    const float* mod = (const float*)(p.ws + WS_MOD);
    const bf16_t* X1 = (const bf16_t*)(p.ws + WS_X1);
    bf16_t* hb = (bf16_t*)(p.ws + WS_HB);
    LAS float* hrow = (LAS float*)lds;
    LAS float* part = (LAS float*)(lds + 65536);
    LAS float* logit = (LAS float*)(lds + 81920);
    LAS int* sel_e = (LAS int*)(lds + 83968);
    LAS float* sel_g = (LAS float*)(lds + 84992);
    LAS int* sel_t = (LAS int*)(lds + 86016);
    LAS int* rank = (LAS int*)(lds + 86272);
    LAS int* hist = (LAS int*)(lds + 87296);
    LAS int* gbase = (LAS int*)(lds + 87424);
    int* idx = (int*)(p.ws + WS_IDX); float* gate = (float*)(p.ws + WS_GATE); int* slot = (int*)(p.ws + WS_SLOT);
    int* cnt = (int*)(p.ws + WS_CTL); int* list = (int*)(p.ws + WS_LIST);
    const int nit = (S / 8 + Gn - 1) / Gn;
    float wreg[128];
    {   const int e = tid & 31, pt = tid >> 5;
#pragma unroll
        for (int k = 0; k < 128; ++k) wreg[k] = p.w_router[(size_t)(pt * 128 + k) * NE + e]; }
    for (int it = 0; it < nit; ++it) {
        const int base = (it * Gn + bid) * 8, buf = it & 7;
        const bool live = base < S;
        if (live) {
            const int row = base + w;
            f32x4 v[8]; float ss = 0.f;
#pragma unroll
            for (int j = 0; j < 8; ++j) { v[j] = bf4_to_f32(((const u32x2*)(X1 + (size_t)row * D) + lane)[64 * j]); ss += (v[j].x * v[j].x + v[j].y * v[j].y) + (v[j].z * v[j].z + v[j].w * v[j].w); }
            const float rs = 1.0f / sqrtf(wave_sum(ss) * (1.0f / D) + EPS);
#pragma unroll
            for (int j = 0; j < 8; ++j) { const int c0 = 4 * lane + 256 * j;
                const f32x4 g = *(const f32x4*)(p.norm2_g + c0), sc = *(const f32x4*)(mod + 4 * D + c0), sh = *(const f32x4*)(mod + 3 * D + c0);
                const f32x4 o = v[j] * rs * g * (sc + 1.0f) + sh;
#if MOE_FP8
                *(unsigned*)((unsigned char*)hb + (size_t)row * D + c0) = pk4_fp8(o.x, o.y, o.z, o.w);
#else
                u32x2 wv; wv.x = cvt_pk_bf16(o.x, o.y); wv.y = cvt_pk_bf16(o.z, o.w);
                *(u32x2*)(hb + (size_t)row * D + c0) = wv;
#endif
                *(LAS f32x4*)(hrow + w * D + c0) = o; }
        }
        __syncthreads();
        if (live) {
            const int e = tid & 31, pt = tid >> 5;
            float acc[8];
#pragma unroll
            for (int r = 0; r < 8; ++r) acc[r] = 0.f;
#pragma unroll
            for (int k4 = 0; k4 < 32; ++k4) { const int kk = pt * 128 + 4 * k4;
                const float w0 = wreg[4 * k4], w1 = wreg[4 * k4 + 1], w2 = wreg[4 * k4 + 2], w3 = wreg[4 * k4 + 3];
#pragma unroll
                for (int r = 0; r < 8; ++r) { const f32x4 h4 = *(const LAS f32x4*)(hrow + r * D + kk); acc[r] += (h4.x * w0 + h4.y * w1) + (h4.z * w2 + h4.w * w3); } }
#pragma unroll
            for (int r = 0; r < 8; ++r) part[(pt * 8 + r) * 32 + e] = acc[r];
        }
        __syncthreads();
        if (live) {
            const int e = lane & 31; float lg = p.b_router[e];
#pragma unroll
            for (int q = 0; q < 16; ++q) lg += part[(q * 8 + w) * 32 + e];
            float tv[TOPK]; int ti[TOPK];
#pragma unroll
            for (int k = 0; k < TOPK; ++k) { float bv = lg; int bi = e;
#pragma unroll
                for (int o = 1; o < 32; o <<= 1) { const float ov = __shfl_xor(bv, o); const int oi = __shfl_xor(bi, o); const bool take = (ov > bv) || (ov == bv && oi < bi); bv = take ? ov : bv; bi = take ? oi : bi; }
                tv[k] = bv; ti[k] = bi; if (e == bi) lg = -INFINITY; }
            if (lane == 0) {
                const float mx = tv[0]; float ex[TOPK], sum = 0.f;
#pragma unroll
                for (int k = 0; k < TOPK; ++k) { ex[k] = __expf(tv[k] - mx); sum += ex[k]; }
                const float inv = 1.0f / sum; const int br = buf * 8 + w;
                sel_t[br] = base + w;
#pragma unroll
                for (int k = 0; k < TOPK; ++k) { sel_e[br * 4 + k] = ti[k]; sel_g[br * 4 + k] = ex[k] * inv; }
            }
        }
        if (!live && lane == 0) sel_t[buf * 8 + w] = -1;
        if (buf == 7 || it == nit - 1) {
            const int nrow = (buf + 1) * 8;
            if (tid < NE) hist[tid] = 0;
            __syncthreads();
            int my_e = 0, my_t = -1;
            if (tid < nrow * 4) { my_t = sel_t[tid >> 2]; if (my_t >= 0) { my_e = sel_e[tid]; rank[tid] = __hip_atomic_fetch_add((int*)(hist + my_e), 1, __ATOMIC_RELAXED, __HIP_MEMORY_SCOPE_WORKGROUP); } }
            __syncthreads();
            if (tid < NE) gbase[tid] = atomicAdd(&cnt[tid], hist[tid]);
            __syncthreads();
            if (tid < nrow * 4 && my_t >= 0) { const int a = my_t * TOPK + (tid & 3), sl = gbase[my_e] + rank[tid];
                idx[a] = my_e; gate[a] = sel_g[tid]; slot[a] = sl; list[(size_t)my_e * S + sl] = a; }
        }
        __syncthreads();
    }
}

__device__ __forceinline__ void phase_final(const P& p, int bid, int Gn) {
    const int tid_ = otid(); const int lane = tid_ & 63, gw = bid * NWAVES + (tid_ >> 6), NGW = Gn * NWAVES;
    const int* cnt = (const int*)(p.ws + WS_CTL);
    const int* idx = (const int*)(p.ws + WS_IDX); const int* slot = (const int*)(p.ws + WS_SLOT);
    const float* mod = (const float*)(p.ws + WS_MOD);
    const bf16_t* X1 = (const bf16_t*)(p.ws + WS_X1);
    const bf16_t* YA = (const bf16_t*)(p.ws + WS_YA);
    int poff_l = 0;
    { int acc = 0; for (int j = 0; j < NE; ++j) { const int cj = (cnt[j] + 255) & ~255; if (lane == j) poff_l = acc; acc += cj; } }
    u32x2 ya[4][8], yan[4][8], xa[8], xan[8];
    int pr[TOPK], prn[TOPK];
#define FIN_IDS(PR, row_) do { _Pragma("unroll") for (int k = 0; k < TOPK; ++k) { const int e = idx[(row_) * TOPK + k]; PR[k] = __shfl(poff_l, e) + slot[(row_) * TOPK + k]; } } while (0)
#define FIN_LOAD(YAR, XAR, PR, row_) do { _Pragma("unroll") for (int j = 0; j < 8; ++j) { const int c0 = 4 * lane + 256 * j; \
        _Pragma("unroll") for (int k = 0; k < TOPK; ++k) YAR[k][j] = *(const u32x2*)(YA + (size_t)PR[k] * D + c0); \
        XAR[j] = *(const u32x2*)(X1 + (size_t)(row_) * D + c0); } } while (0)
    int row = gw;
    if (row < S) { FIN_IDS(pr, row); FIN_LOAD(ya, xa, pr, row); }
    if (row + NGW < S) FIN_IDS(prn, row + NGW);
    while (row < S) {
        const int nrow = row + NGW;
        if (nrow < S) FIN_LOAD(yan, xan, prn, nrow);
        if (nrow + NGW < S) FIN_IDS(pr, nrow + NGW);
        f32x4 v[8]; float ss = 0.f;
#pragma unroll
        for (int j = 0; j < 8; ++j) { const int c0 = 4 * lane + 256 * j; f32x4 m = (f32x4){0.f, 0.f, 0.f, 0.f};
#pragma unroll
            for (int k = 0; k < TOPK; ++k) m += bf4_to_f32(ya[k][j]);
            const f32x4 g2 = *(const f32x4*)(mod + 5 * D + c0);
            v[j] = bf4_to_f32(xa[j]) + g2 * m;
            ss += (v[j].x * v[j].x + v[j].y * v[j].y) + (v[j].z * v[j].z + v[j].w * v[j].w); }
        const float rs = 1.0f / sqrtf(wave_sum(ss) * (1.0f / D) + EPS);
#pragma unroll
        for (int j = 0; j < 8; ++j) { const int c0 = 4 * lane + 256 * j; const f32x4 fg = *(const f32x4*)(p.final_g + c0);
            *(f32x4*)(p.out + (size_t)row * D + c0) = v[j] * rs * fg; }
#pragma unroll
        for (int j = 0; j < 8; ++j) { xa[j] = xan[j];
#pragma unroll
            for (int k = 0; k < TOPK; ++k) ya[k][j] = yan[k][j]; }
#pragma unroll
        for (int k = 0; k < TOPK; ++k) { const int t = prn[k]; prn[k] = pr[k]; pr[k] = t; }
        row = nrow;
    }
#undef FIN_IDS
#undef FIN_LOAD
}

#define XB_TMO      128
#define XB_XCNT(j)  (256  + 64 * (j))
#define XB_XSUB(j)  (1280 + 64 * (j))
#define XB_XGEN(j)  (2304 + 64 * (j))
#define XB_TOP      3328
#define XB_TOPGEN   3392
#define XCD_BAR_WORDS 3456
#define XB_SPIN_CAP (1u << 18)

__device__ __forceinline__ unsigned xb_ld(unsigned* p)              { return __hip_atomic_load(p, __ATOMIC_RELAXED, __HIP_MEMORY_SCOPE_AGENT); }
__device__ __forceinline__ unsigned xb_add(unsigned* p, unsigned v) { return __hip_atomic_fetch_add(p, v, __ATOMIC_RELAXED, __HIP_MEMORY_SCOPE_AGENT); }
__device__ __forceinline__ unsigned xb_xcc_id() { return (unsigned)__builtin_amdgcn_s_getreg((3 << 11) | 20) & 0xFu; }
#define XB_SPIN(cond, bar) do { unsigned _sp = 0; while (cond) { __builtin_amdgcn_s_sleep(1); \
    if ((++_sp & 255u) == 0u) { if (xb_ld(&(bar)[XB_TMO])) break; if (_sp > XB_SPIN_CAP) { atomicAdd(&(bar)[XB_TMO], 1u); break; } } } } while (0)

struct XcdBarrier {
    unsigned* bar; unsigned x;
    volatile LAS unsigned* st;
};

__device__ __forceinline__ XcdBarrier xcd_barrier_post(unsigned* bar, volatile LAS unsigned* st) {
    XcdBarrier b; b.bar = bar; b.x = xb_xcc_id(); b.st = st;
    if (threadIdx.x == 0) (void)xb_add(&bar[XB_XCNT(b.x)], 1u);
    return b;
}
__device__ __forceinline__ void xcd_barrier_complete(unsigned* bar, unsigned x, unsigned& nloc, unsigned& nx) {
    const unsigned G = gridDim.x * gridDim.y * gridDim.z;
    unsigned sum, cnt, mine, sp = 0u;
    for (;;) {
        sum = 0u; cnt = 0u; mine = 0u;
#pragma unroll
        for (unsigned j = 0; j < 16; ++j) { const unsigned c = xb_ld(&bar[XB_XCNT(j)]); sum += c; cnt += (c > 0u) ? 1u : 0u; mine = (j == x) ? c : mine; }
        if (sum == G) break;
        __builtin_amdgcn_s_sleep(1);
        if ((++sp & 255u) == 0u) { if (xb_ld(&bar[XB_TMO])) break; if (sp > XB_SPIN_CAP) { atomicAdd(&bar[XB_TMO], 1u); break; } }
    }
    nloc = mine > 0u ? mine : 1u; nx = cnt > 0u ? cnt : 1u;
}

__device__ __forceinline__ void xcd_barrier(const XcdBarrier& b) {
    asm volatile("s_waitcnt vmcnt(0)" ::: "memory");
    __syncthreads();
    if (threadIdx.x == 0) {
        unsigned* bar = b.bar;
        __builtin_amdgcn_s_waitcnt(0);
        unsigned nloc = b.st[0], nx = b.st[1];
        if (nloc == 0u) { xcd_barrier_complete(bar, b.x, nloc, nx); b.st[0] = nloc; b.st[1] = nx; }
        const unsigned old = xb_add(&bar[XB_XSUB(b.x)], 1u);
        const unsigned gen = old / nloc;
        if (old + 1u == (gen + 1u) * nloc) {
            __builtin_amdgcn_fence(__ATOMIC_RELEASE, "agent");
            asm volatile("s_waitcnt vmcnt(0)" ::: "memory");
            const unsigned og = xb_add(&bar[XB_TOP], 1u);
            const unsigned tg = og / nx;
            if (og + 1u == (tg + 1u) * nx) xb_add(&bar[XB_TOPGEN], 1u);
            else XB_SPIN(xb_ld(&bar[XB_TOPGEN]) == tg, bar);
            __builtin_amdgcn_fence(__ATOMIC_ACQUIRE, "agent");
            xb_add(&bar[XB_XGEN(b.x)], 1u);
            asm volatile("s_waitcnt vmcnt(0)" ::: "memory");
        } else {
            XB_SPIN(xb_ld(&bar[XB_XGEN(b.x)]) == gen, bar);
            __builtin_amdgcn_fence(__ATOMIC_ACQUIRE, "agent");
            asm volatile("s_waitcnt vmcnt(0)" ::: "memory");
        }
    }
    __syncthreads();
}
constexpr int CW_BAR = 4096;
constexpr int MISC_OFF = 147456;

typedef __attribute__((address_space(4))) const Args CArgs;
__device__ __forceinline__ const Args* kargs() { CArgs* k = (CArgs*)__builtin_amdgcn_kernarg_segment_ptr(); asm volatile("" : "+s"(k)); return (const Args*)k; }
__device__ __forceinline__ const float* asg(const float* q) { return (const float*)(GAS const float*)q; }
__device__ __forceinline__ P globalize(const P& q) {
    P r;
#define GZ(m) r.m = asg(q.m)
    GZ(x); GZ(c); GZ(w_ada); GZ(b_ada); GZ(norm1_g); GZ(w_in); GZ(lam_re); GZ(lam_im); GZ(b_re); GZ(b_im); GZ(c_re); GZ(c_im); GZ(d_skip); GZ(log_dt);
    GZ(w_glu); GZ(b_glu); GZ(attn_g); GZ(ssm_g); GZ(w_out); GZ(norm2_g); GZ(w_router); GZ(b_router); GZ(w_gu); GZ(b_gu); GZ(w_down); GZ(b_down); GZ(final_g);
#undef GZ
    r.out = (float*)(GAS float*)q.out; r.ws = (unsigned char*)(GAS unsigned char*)q.ws;
    return r;
}
__global__ void __launch_bounds__(NWAVES * 64, 2) mk_fwd(Args args_unused) {
    extern __shared__ __attribute__((aligned(16))) unsigned char lds_raw[];
    LAS unsigned char* lds = (LAS unsigned char*)lds_raw;
    const int lo = kargs()->ph_lo, hi = kargs()->ph_hi;
    const int Gn = gridDim.x, bid = blockIdx.x;
    if (threadIdx.x == 0) *(LAS u32x4*)(lds + MISC_OFF) = (u32x4){0u, 0u, 0u, 0u};
    __syncthreads();
    XcdBarrier bar; bar.bar = nullptr; bar.x = 0; bar.st = nullptr;
    if (hi - lo > 1) { unsigned* bw = (unsigned*)((unsigned char*)(GAS unsigned char*)kargs()->p.ws + WS_CTL) + CW_BAR; bar = xcd_barrier_post(bw, (volatile LAS unsigned*)(lds + MISC_OFF)); }
#define SEAM(k) do { if (lo <= (k) && (k) + 1 < hi) xcd_barrier(bar); } while (0)
#ifndef PHMASK
#define PHMASK 0x1fff
#endif
#define IN(k) (((PHMASK >> (k)) & 1) && lo <= (k) && (k) < hi)
#ifndef REPMASK
#define REPMASK 0
#endif
#define REPS(k) for (int rep_ = 0; rep_ < ((((REPMASK) >> (k)) & 1) ? 2 : 1); ++rep_)
#define PHASE_P const P p = globalize(kargs()->p); unsigned char* ws = p.ws; (void)ws
    if (IN(0)) REPS(0) { __syncthreads(); PHASE_P; phase_prologue(p, lds, bid, Gn); }
    SEAM(0);
    if (IN(1)) REPS(1) { __syncthreads(); PHASE_P; phase_norm1(p, bid, Gn); }
    SEAM(1);
    if (IN(2)) REPS(2) { __syncthreads();
        PHASE_P;
        typedef pg8::DenseSched<WS_HB, WS_WIN, S, INW, D> Sch; Sch Sd; Sd.init(ws, Gn, bid);
        pg8::EpiProj E{(bf16_t*)(ws + WS_QKV), (bf16_t*)(ws + WS_UB2)};
        pg8::gemm_phase<pg8::EpiProj, Sch>(lds + RING_OFF, Sd, E);
    }
    SEAM(2);
    if (IN(3)) REPS(3) { __syncthreads();
        PHASE_P;
        {   typedef pg8::S5Sched<0> Sch; Sch Ss; Ss.init(ws, Gn, bid);
            pg8::EpiS5E E{(float*)(ws + WS_EF)};
            pg8::gemm_phase<pg8::EpiS5E, Sch>(lds + RING_OFF, Ss, E); }
        __syncthreads();
        phase_attn(p, lds, bid, Gn);
    }
    SEAM(3);
    if (IN(4)) REPS(4) { __syncthreads(); PHASE_P; phase_s5_carry(p, bid); }
    SEAM(4);
    if (IN(5)) REPS(5) { __syncthreads();
        PHASE_P;
        typedef pg8::S5Sched<1> Sch; Sch Ss; Ss.init(ws, Gn, bid);
        pg8::EpiS5Y E{(bf16_t*)(ws + WS_YGB)};
        pg8::gemm_phase<pg8::EpiS5Y, Sch>(lds + RING_OFF, Ss, E);
    }
    SEAM(5);
    if (IN(6)) REPS(6) { __syncthreads();
        PHASE_P;
        typedef pg8::DenseSched<WS_YGB, WS_WGLU, S, SW, SW> Sch; Sch Sd; Sd.init(ws, Gn, bid);
        pg8::EpiGlu E{(const bf16_t*)(ws + WS_YGB), p.b_glu, (bf16_t*)(ws + WS_Z)};
        pg8::gemm_phase<pg8::EpiGlu, Sch>(lds + RING_OFF, Sd, E);
    }
    SEAM(6);
    if (IN(7)) REPS(7) { __syncthreads(); PHASE_P; phase_mix(p, bid, Gn); }
    SEAM(7);
    if (IN(8)) REPS(8) { __syncthreads();
        PHASE_P;
        typedef pg8::DenseSched<WS_YMIXB, WS_WOUT, S, D, D> Sch; Sch Sd; Sd.init(ws, Gn, bid);
        pg8::EpiResid E{p.x, (const float*)(ws + WS_MOD) + 2 * D, (bf16_t*)(ws + WS_X1)};
        pg8::gemm_phase<pg8::EpiResid, Sch>(lds + RING_OFF, Sd, E);
    }
    SEAM(8);
    if (IN(9)) REPS(9) { __syncthreads(); PHASE_P; phase_norm2_router(p, lds, bid, Gn); }
    SEAM(9);
    if (IN(10)) REPS(10) { __syncthreads();
        PHASE_P;
        pg8::MoeSched<1> Sm; Sm.init(ws, Gn, bid);
        pg8::EpiMoe1 E{p.b_gu, ws + WS_ACT};
        pg8::gemm_phase<pg8::EpiMoe1, pg8::MoeSched<1>>(lds + RING_OFF, Sm, E);
    }
    SEAM(10);
    if (IN(11)) REPS(11) { __syncthreads();
        PHASE_P;
        pg8::MoeSched<2> Sm; Sm.init(ws, Gn, bid);
        pg8::EpiMoe2 E{p.b_down, ws};
        pg8::gemm_phase<pg8::EpiMoe2, pg8::MoeSched<2>>(lds + RING_OFF, Sm, E);
    }
    SEAM(11);
    if (IN(12)) REPS(12) { __syncthreads(); PHASE_P; phase_final(p, bid, Gn); }
#undef IN
#undef PHASE_P
#undef SEAM
}

extern "C" void kernel_launch(void* const* d_in, const int* in_sizes, int n_in, void* d_out, int out_size, void* d_ws, size_t ws_size, hipStream_t stream) {
    static int grid = 0;
    if (grid == 0) {
        if (n_in != 27 || ws_size < WS_END) { fprintf(stderr, "kernel_launch: unexpected n_in %d or ws_size %zu (< %zu)\n", n_in, ws_size, (size_t)WS_END); grid = -1; return; }
        int dev = 0, cus = 0;
        if (hipGetDevice(&dev) != hipSuccess || hipDeviceGetAttribute(&cus, hipDeviceAttributeMultiprocessorCount, dev) != hipSuccess) { grid = -1; return; }
        if (hipFuncSetAttribute((const void*)mk_fwd, hipFuncAttributeMaxDynamicSharedMemorySize, LDS_BYTES) != hipSuccess) { fprintf(stderr, "hipFuncSetAttribute failed\n"); grid = -1; return; }
        grid = cus;
    }
    if (grid < 0) return;
    Args a{};
    const float** f = (const float**)&a.p;
    for (int i = 0; i < 27; ++i) f[i] = (const float*)d_in[i];
    a.p.out = (float*)d_out; a.p.ws = (unsigned char*)d_ws;
    (void)hipMemsetAsync(a.p.ws + WS_CTL, 0, 1 * MiB, stream);
#ifndef MK_PER_PHASE
    a.ph_lo = 0; a.ph_hi = 13; hipLaunchKernelGGL(mk_fwd, dim3(grid), dim3(NWAVES * 64), LDS_BYTES, stream, a);
#else
    for (int ph = 0; ph < 13; ++ph) { a.ph_lo = ph; a.ph_hi = ph + 1; hipLaunchKernelGGL(mk_fwd, dim3(grid), dim3(NWAVES * 64), LDS_BYTES, stream, a); }
#endif
}
```

```cpp
#include <hip/hip_runtime.h>
#include <cstdio>
#include <cstdint>

#ifndef MOE_FP8
#define MOE_FP8 1
#endif
constexpr int S = 16384, D = 2048, AW = 1024, SW = 1024, INW = 4096, NH = 16, HD = 64;
constexpr int G = 64, NS = 64, PC = 16;
constexpr int NE = 32, TOPK = 4, FF = 2048;
constexpr int LCH = 32, NCH = S / LCH;
constexpr int CROWS = 40;
constexpr int KS5 = 640, KS5E = 512;
constexpr int NASSIGN = S * TOPK;
constexpr int PADROWS = NASSIGN + NE * 256;
constexpr float EPS = 1e-6f;

constexpr size_t MiB = 1ull << 20;
constexpr size_t WS_CTL = 0;
constexpr size_t WS_MOD = 1 * MiB;
constexpr size_t WS_S5P = 2 * MiB;
constexpr size_t WS_IDX = 4 * MiB;
constexpr size_t WS_GATE = 5 * MiB;
constexpr size_t WS_SLOT = 6 * MiB;
constexpr size_t WS_LIST = 8 * MiB;
constexpr size_t WS_ECH = 12 * MiB;
constexpr size_t WS_X0 = 16 * MiB;
constexpr size_t WS_WIN = 32 * MiB;
constexpr size_t WS_WGLU = 48 * MiB;
constexpr size_t WS_WOUT = 50 * MiB;
constexpr size_t WS_HB = 64 * MiB;
constexpr size_t WS_PROJ = 128 * MiB;
constexpr size_t WS_QKV = WS_PROJ;
constexpr size_t WS_UB2 = WS_PROJ + 96 * MiB;
constexpr size_t WS_OB = WS_PROJ + 160 * MiB;
constexpr size_t WS_LSE = 20 * MiB;
constexpr size_t WS_YATT = WS_PROJ + 256 * MiB;
constexpr size_t WS_S5E = WS_YATT;
constexpr size_t WS_EF = WS_YATT + 16 * MiB;
constexpr size_t WS_YG = WS_YATT + 64 * MiB;
constexpr size_t WS_S5T = WS_YG;
constexpr size_t WS_YGB = WS_YG + 64 * MiB;
constexpr size_t WS_Z = WS_YGB + 32 * MiB;
constexpr size_t WS_YMIXB = WS_Z + 64 * MiB;
constexpr size_t WS_X1 = WS_YMIXB + 64 * MiB;
constexpr size_t WS_H2 = WS_X1 + 128 * MiB;
constexpr size_t WS_ACT = WS_H2 + 128 * MiB;
constexpr size_t WS_YA = WS_ACT + 288 * MiB;
constexpr size_t WS_WGU = WS_YA + 288 * MiB;
constexpr size_t WS_WDN = WS_WGU + 512 * MiB;
constexpr size_t WS_END = WS_WDN + 256 * MiB;

struct P {
    const float *x, *c, *w_ada, *b_ada, *norm1_g, *w_in, *lam_re, *lam_im, *b_re, *b_im, *c_re, *c_im, *d_skip, *log_dt,
        *w_glu, *b_glu, *attn_g, *ssm_g, *w_out, *norm2_g, *w_router, *b_router, *w_gu, *b_gu, *w_down, *b_down, *final_g;
    float* out;
    unsigned char* ws;
};
struct Args { P p; int ph_lo, ph_hi; };

#define GAS __attribute__((address_space(1)))
#define LAS __attribute__((address_space(3)))
typedef unsigned short bf16_t;
typedef short bf16x8 __attribute__((ext_vector_type(8)));
typedef float f32x4 __attribute__((ext_vector_type(4)));
typedef float f32x2 __attribute__((ext_vector_type(2)));
typedef unsigned u32x4 __attribute__((ext_vector_type(4)));
typedef unsigned u32x2 __attribute__((ext_vector_type(2)));
typedef int v4i32 __attribute__((ext_vector_type(4)));
typedef int v8i32 __attribute__((ext_vector_type(8)));

__device__ __forceinline__ float wave_sum(float v) {
#pragma unroll
    for (int o = 1; o < 64; o <<= 1) v += __shfl_xor(v, o);
    return v;
}
__device__ __forceinline__ float block_sum256(float v, float* red) {
    v = wave_sum(v);
    __syncthreads();
    if ((threadIdx.x & 63) == 0) red[threadIdx.x >> 6] = v;
    __syncthreads();
    return red[0] + red[1] + red[2] + red[3];
}
__device__ __forceinline__ float sigmoidf_(float x) { return __builtin_amdgcn_rcpf(1.0f + __builtin_amdgcn_exp2f(-1.4426950408889634f * x)); }
__device__ __forceinline__ unsigned cvt_pk_bf16(float lo, float hi) { unsigned r; asm volatile("v_cvt_pk_bf16_f32 %0, %1, %2" : "=v"(r) : "v"(lo), "v"(hi)); return r; }
__device__ __forceinline__ unsigned pk4_fp8(float a, float b, float c, float d) { int w = 0; w = __builtin_amdgcn_cvt_pk_fp8_f32(a, b, w, false); w = __builtin_amdgcn_cvt_pk_fp8_f32(c, d, w, true); return (unsigned)w; }
__device__ __forceinline__ f32x4 bf4_to_f32(u32x2 v) { return (f32x4){__uint_as_float(v.x << 16), __uint_as_float(v.x & 0xffff0000u), __uint_as_float(v.y << 16), __uint_as_float(v.y & 0xffff0000u)}; }
__device__ __forceinline__ float bf2f(bf16_t b) { return __uint_as_float(((unsigned)b) << 16); }
__device__ __forceinline__ bf16_t f2bf(float f) { return (bf16_t)(cvt_pk_bf16(f, 0.f) & 0xffffu); }
__device__ __forceinline__ int otid() { int t = threadIdx.x; asm volatile("" : "+v"(t)); return t; }

namespace pg8 {
constexpr int BM = 256, BK = 64, HALF = 128, HTB = HALF * BK * 2  , STAGE_BYTES = 8 * HTB, NXCD = 8, WGM = 8;
__host__ __device__ __forceinline__ int lds_byte(int r, int c) { const int st = (r >> 4) * 2 + (c >> 5), rr = r & 15, cc = c & 31, ob = rr * 64 + cc * 2; return st * 1024 + (ob ^ (((ob >> 9) & 1) << 5)); }
__host__ __device__ __forceinline__ void stage_rc(int b, int& R, int& C) { const int st = b / 1024, sb = b % 1024, swz = sb ^ (((sb >> 9) & 1) << 5); R = (st >> 1) * 16 + swz / 64; C = (st & 1) * 32 + (swz % 64) / 2; }
__host__ __device__ __forceinline__ int perm32(int rho) { const int n = rho >> 4, i = rho & 15; return 8 * (i >> 2) + 4 * n + (i & 3); }

struct Unit { int pm, pn, e, mt; };

__device__ __forceinline__ bool flat_to_tile(long L, int nM, int nN, int& pm, int& pn) {
    const int nwg = nM * nN; if (L >= nwg) return false;
    int wgid = (int)L; { const int q = nwg / NXCD, r = nwg % NXCD, xcd = wgid % NXCD, off = wgid / NXCD; wgid = (xcd < r ? xcd * (q + 1) : r * (q + 1) + (xcd - r) * q) + off; }
    const int nig = WGM * nN, gid = wgid / nig, fm = gid * WGM, gsz = (nM - fm) < WGM ? (nM - fm) : WGM;
    pm = fm + ((wgid % nig) % gsz); pn = (wgid % nig) / gsz; return true;
}

template <size_t AOFF, size_t BOFF, int M_, int N_, int K_>
struct DenseSched {
    static constexpr bool GATHER = false, FP8 = false;
    static constexpr int K = K_, nM = M_ / BM, nN = N_ / BM, KSTEP_A = 128;
    const unsigned char* ws; int Gn, c;
    __device__ void init(const unsigned char* ws_, int G_, int c_) { ws = ws_; Gn = G_; c = c_; }
    __device__ __forceinline__ bool next(int i, Unit& u) const { u.e = 0; u.mt = 0; return flat_to_tile((long)i * Gn + c, nM, nN, u.pm, u.pn); }
    __device__ __forceinline__ const char* a_ptr(const Unit& u) const { return (const char*)ws + AOFF + (size_t)u.pm * BM * K * 2; }
    __device__ __forceinline__ const char* b_ptr(const Unit& u) const { return (const char*)ws + BOFF + (size_t)u.pn * BM * K * 2; }
    __device__ __forceinline__ void a_off(const Unit&, unsigned (&off)[2][2]) const {
        const int tid = otid();
#pragma unroll
        for (int i = 0; i < 2; ++i) { int R, C; stage_rc(tid * 16 + i * 8192, R, C);
#pragma unroll
            for (int h = 0; h < 2; ++h) off[h][i] = (unsigned)((h * HALF + R) * K + C) * 2u; }
    }
};

template <int STAGE>
struct MoeSched {
    static constexpr bool GATHER = true, FP8 = (MOE_FP8 != 0);
    static constexpr int K = (STAGE == 1) ? D : FF, N = (STAGE == 1) ? 2 * FF : D, nN = N / BM, KSTEP_A = 128, KB = FP8 ? K : 2 * K;
    static constexpr size_t AOFF = (STAGE == 1) ? WS_HB : WS_ACT, BOFF = (STAGE == 1) ? WS_WGU : WS_WDN;
    const unsigned char* ws; int nM, Gn, c;
    __device__ void init(const unsigned char* ws_, int G_, int c_) {
        ws = ws_; Gn = G_; c = c_;
        const int* cnt = (const int*)(ws + WS_CTL);
        int t = 0; for (int j = 0; j < NE; ++j) t += (cnt[j] + 255) >> 8; nM = __builtin_amdgcn_readfirstlane(t);
    }
    __device__ __forceinline__ bool next(int i, Unit& u) const {
        if (!flat_to_tile((long)i * Gn + c, nM, nN, u.pm, u.pn)) return false;
        const int* cnt = (const int*)(ws + WS_CTL);
        int acc = 0, e = 0, mt = 0;
        for (int j = 0; j < NE; ++j) { const int nt = (cnt[j] + 255) >> 8; if (u.pm >= acc && u.pm < acc + nt) { e = j; mt = u.pm - acc; } acc += nt; }
        u.e = __builtin_amdgcn_readfirstlane(e); u.mt = __builtin_amdgcn_readfirstlane(mt); return true;
    }
    __device__ __forceinline__ const char* a_ptr(const Unit& u) const { return (STAGE == 1) ? (const char*)ws + AOFF : (const char*)ws + AOFF + (size_t)u.pm * BM * KB; }
    __device__ __forceinline__ const char* b_ptr(const Unit& u) const { return (const char*)ws + BOFF + ((size_t)u.e * N + (size_t)u.pn * BM) * KB; }
    __device__ __forceinline__ void a_off(const Unit& u, unsigned (&off)[2][2]) const {
        const int tid = otid();
        if (STAGE == 1) {
            const int* cnt = (const int*)(ws + WS_CTL); const int* list = (const int*)(ws + WS_LIST);
            const int ce = __builtin_amdgcn_readfirstlane(cnt[u.e]);
#pragma unroll
            for (int i = 0; i < 2; ++i) { int R, C; stage_rc(tid * 16 + i * 8192, R, C);
#pragma unroll
                for (int h = 0; h < 2; ++h) { int lr = u.mt * BM + h * HALF + R; lr = lr < ce ? lr : ce - 1; const int tok = list[(size_t)u.e * S + lr] >> 2; off[h][i] = (unsigned)(tok * KB + C * 2); } }
        } else {
#pragma unroll
            for (int i = 0; i < 2; ++i) { int R, C; stage_rc(tid * 16 + i * 8192, R, C);
#pragma unroll
                for (int h = 0; h < 2; ++h) off[h][i] = (unsigned)((h * HALF + R) * KB + C * 2); }
        }
    }
};

template <int MODE>
struct S5Sched {
    static constexpr bool GATHER = true, FP8 = false;
    static constexpr int K = MODE ? KS5 : KS5E, KSTEP_A = 4 * 1024 * 2, NCT = MODE ? 2 : 1, NUNITS = G * 2 * NCT;
    const unsigned char* ws; int Gn, c;
    __device__ void init(const unsigned char* ws_, int G_, int c_) { ws = ws_; Gn = G_; c = c_; }
    __device__ __forceinline__ bool next(int i, Unit& u) const {
        const int L = i * Gn + c; if (L >= NUNITS) return false;
        u.e = L / (2 * NCT); const int rem = L % (2 * NCT); u.pm = rem / NCT; u.pn = rem % NCT; u.mt = 0; return true;
    }
    __device__ __forceinline__ const char* a_ptr(const Unit& u) const { return (const char*)ws + WS_UB2 + (size_t)u.e * (PC * 2); }
    __device__ __forceinline__ const char* b_ptr(const Unit& u) const { return (const char*)ws + (MODE ? WS_S5T : WS_S5E) + ((size_t)u.e * (MODE ? 512 : 256) + (size_t)u.pn * BM) * K * 2; }
    __device__ __forceinline__ void a_off(const Unit& u, unsigned (&off)[2][2]) const {
        const int tid = otid();
#pragma unroll
        for (int i = 0; i < 2; ++i) { int R, C; stage_rc(tid * 16 + i * 8192, R, C);
#pragma unroll
            for (int h = 0; h < 2; ++h) off[h][i] = (unsigned)(((u.pm * BM + h * HALF + R) * CROWS + (C >> 4)) * 2048 + (C & 15) * 2); }
    }
};

template <class Epi, class Sched>
__device__ __forceinline__ void gemm_phase(LAS unsigned char* lds, const Sched& S, const Epi& E) {
    const int tid = otid(), wid = __builtin_amdgcn_readfirstlane(tid >> 6), lane = tid & 63, wr = wid >> 2, wc = wid & 3, fr = lane & 15, fq = lane >> 4;
    constexpr int K = Sched::K, KB = Sched::FP8 ? K : 2 * K, nt = KB / (BK * 2);
    unsigned voffB[2];
#pragma unroll
    for (int i = 0; i < 2; ++i) { int sR, sC; stage_rc(tid * 16 + i * 8192, sR, sC); const int Rb = Epi::PERM ? ((sR & ~31) + perm32(sR & 31)) : sR; voffB[i] = (unsigned)(Rb * KB + sC * 2); }
    const size_t kstep = (size_t)(BK * 2);
    constexpr size_t kstepA = (size_t)Sched::KSTEP_A;
    const size_t hstep = (size_t)HALF * KB;
    const unsigned ldsw = (unsigned)wid * 1024u;
    const int aoff = lds_byte(wr * 64 + fr, fq * 8), boff = lds_byte(wc * 32 + fr, fq * 8);
#define PG8_SA(b, h) (((b) * 2 + (h)) * HTB)
#define PG8_SB(b, h) ((4 + (b) * 2 + (h)) * HTB)
#define PG8_STAGE(bufoff, gbase, voff) do { _Pragma("unroll") for (int _i = 0; _i < 2; ++_i) \
        __builtin_amdgcn_global_load_lds((const unsigned*)((const char*)(gbase) + (voff)[_i]), (LAS unsigned*)(lds + (bufoff) + ldsw + _i * 8192), 16, 0, 0); } while (0)
#define PG8_LDA(dst, b, h) do { _Pragma("unroll") for (int m = 0; m < 4; ++m) _Pragma("unroll") for (int k = 0; k < 2; ++k) dst[m][k] = *(const LAS bf16x8*)(lds + PG8_SA(b, h) + aoff + m * 2048 + k * 1024); } while (0)
#define PG8_LDB(dst, b, h) do { _Pragma("unroll") for (int n = 0; n < 2; ++n) _Pragma("unroll") for (int k = 0; k < 2; ++k) dst[n][k] = *(const LAS bf16x8*)(lds + PG8_SB(b, h) + boff + n * 2048 + k * 1024); } while (0)
#define PG8_MMA(ai, bj, At, Bt) do { __builtin_amdgcn_s_setprio(1); _Pragma("unroll") for (int m = 0; m < 4; ++m) _Pragma("unroll") for (int n = 0; n < 2; ++n) { \
        if constexpr (Sched::FP8) {   \
            const v8i32 a8_ = __builtin_shufflevector(__builtin_bit_cast(v4i32, At[m][0]), __builtin_bit_cast(v4i32, At[m][1]), 0, 1, 2, 3, 4, 5, 6, 7); \
            const v8i32 b8_ = __builtin_shufflevector(__builtin_bit_cast(v4i32, Bt[n][0]), __builtin_bit_cast(v4i32, Bt[n][1]), 0, 1, 2, 3, 4, 5, 6, 7); \
            acc[ai][bj][m][n] = __builtin_amdgcn_mfma_scale_f32_16x16x128_f8f6f4(b8_, a8_, acc[ai][bj][m][n], 0, 0, 0, 0x79797979  , 0, 0x7f7f7f7f); \
        } else { _Pragma("unroll") for (int k = 0; k < 2; ++k) acc[ai][bj][m][n] = __builtin_amdgcn_mfma_f32_16x16x32_bf16(Bt[n][k], At[m][k], acc[ai][bj][m][n], 0, 0, 0); } } \
        __builtin_amdgcn_s_setprio(0); } while (0)
#define PG8_WAIT_V(n) asm volatile("s_waitcnt vmcnt(" #n ")" ::: "memory")
#define PG8_WAIT_L(n) asm volatile("s_waitcnt lgkmcnt(" #n ")" ::: "memory")
#define PG8_BAR __builtin_amdgcn_s_barrier()
#define PG8_SCHED __builtin_amdgcn_sched_barrier(0)
    Unit cur, nxt; int ui = 0;
    if (!S.next(0, cur)) return;
    f32x4 acc[2][2][4][2];
#pragma unroll
    for (int a = 0; a < 2; ++a)
#pragma unroll
        for (int b = 0; b < 2; ++b)
#pragma unroll
            for (int m = 0; m < 4; ++m)
#pragma unroll
                for (int n = 0; n < 2; ++n) acc[a][b][m][n] = (f32x4){0.f, 0.f, 0.f, 0.f};
    bf16x8 At[4][2], B0[2][2], B1[2][2];
    const char* cA = S.a_ptr(cur); const char* cB = S.b_ptr(cur);
    unsigned ao[2][2]; S.a_off(cur, ao);
    PG8_STAGE(PG8_SB(0, 0), cB, voffB); PG8_STAGE(PG8_SB(0, 1), cB + hstep, voffB); PG8_STAGE(PG8_SA(0, 0), cA, ao[0]); PG8_STAGE(PG8_SA(0, 1), cA, ao[1]);
    if (wr == 1) PG8_BAR;
    PG8_WAIT_V(2); PG8_BAR;
    PG8_STAGE(PG8_SB(1, 0), cB + kstep, voffB); PG8_STAGE(PG8_SA(1, 0), cA + kstepA, ao[0]); PG8_STAGE(PG8_SB(1, 1), cB + hstep + kstep, voffB);
    PG8_WAIT_V(6); PG8_BAR;
    for (;;) {
        const bool has_next = S.next(ui + 1, nxt);
        const char* nA = has_next ? S.a_ptr(nxt) : cA; const char* nB = has_next ? S.b_ptr(nxt) : cB;
        for (int t = 0; t < nt; t += 2) {
            const bool last = (t == nt - 2);
            const char* a1 = cA + (size_t)(t + 1) * kstepA;
            const char* a2 = last ? nA : cA + (size_t)(t + 2) * kstepA; const char* b2 = last ? nB : cB + (size_t)(t + 2) * kstep;
            const char* a3 = a2 + kstepA; const char* b3 = b2 + kstep;
            asm volatile("" : "+v"(voffB[0]), "+v"(voffB[1]), "+v"(ao[0][0]), "+v"(ao[0][1]), "+v"(ao[1][0]), "+v"(ao[1][1]));

            PG8_LDB(B0, 0, 0); PG8_LDB(B1, 0, 1); PG8_SCHED; PG8_LDA(At, 0, 0); PG8_STAGE(PG8_SA(1, 1), a1, ao[1]);
            PG8_WAIT_V(8); PG8_WAIT_L(0); PG8_BAR; PG8_MMA(0, 0, At, B0); PG8_MMA(0, 1, At, B1); PG8_BAR; PG8_SCHED;
            if (Sched::GATHER) { if (last && has_next) S.a_off(nxt, ao); }
            PG8_LDA(At, 0, 1); PG8_STAGE(PG8_SB(0, 0), b2, voffB); PG8_STAGE(PG8_SB(0, 1), b2 + hstep, voffB); PG8_STAGE(PG8_SA(0, 0), a2, ao[0]);
            PG8_WAIT_V(8); PG8_WAIT_L(0); PG8_BAR; PG8_MMA(1, 0, At, B0); PG8_MMA(1, 1, At, B1); PG8_BAR; PG8_SCHED;
            PG8_LDB(B0, 1, 0); PG8_LDB(B1, 1, 1); PG8_SCHED; PG8_LDA(At, 1, 0); PG8_STAGE(PG8_SA(0, 1), a2, ao[1]);
            PG8_WAIT_V(8); PG8_WAIT_L(0); PG8_BAR; PG8_MMA(0, 0, At, B0); PG8_MMA(0, 1, At, B1); PG8_BAR; PG8_SCHED;
            PG8_LDA(At, 1, 1); PG8_STAGE(PG8_SB(1, 0), b3, voffB); PG8_STAGE(PG8_SB(1, 1), b3 + hstep, voffB); PG8_STAGE(PG8_SA(1, 0), a3, ao[0]);
            PG8_WAIT_V(8); PG8_WAIT_L(0); PG8_BAR; PG8_MMA(1, 0, At, B0); PG8_MMA(1, 1, At, B1); PG8_BAR; PG8_SCHED;
        }
        if (wr == 0) PG8_BAR;
        {
            const int t2 = otid(), wid2 = __builtin_amdgcn_readfirstlane(t2 >> 6), lane2 = t2 & 63;
            E(acc, cur, wid2 >> 2, wid2 & 3, lane2 & 15, lane2 >> 4); }
        if (!has_next) break;
#pragma unroll
        for (int a = 0; a < 2; ++a)
#pragma unroll
            for (int b = 0; b < 2; ++b)
#pragma unroll
                for (int m = 0; m < 4; ++m)
#pragma unroll
                    for (int n = 0; n < 2; ++n) acc[a][b][m][n] = (f32x4){0.f, 0.f, 0.f, 0.f};
        cur = nxt; cA = nA; cB = nB; ++ui;
        if (wr == 1) PG8_BAR;
    }
    PG8_WAIT_V(0);
    PG8_BAR;
#undef PG8_SA
#undef PG8_SB
#undef PG8_STAGE
#undef PG8_LDA
#undef PG8_LDB
#undef PG8_MMA
#undef PG8_WAIT_V
#undef PG8_WAIT_L
#undef PG8_BAR
#undef PG8_SCHED
}

struct EpiF32 {
    static constexpr bool PERM = false;
    float* C; int ldc;
    __device__ __forceinline__ void operator()(const f32x4 (&acc)[2][2][4][2], const Unit& u, int wr, int wc, int fr, int fq) const {
        const int row0 = u.pm * BM + wr * 64 + fr, col0 = u.pn * BM + wc * 32 + 4 * fq;
#pragma unroll
        for (int ai = 0; ai < 2; ++ai)
#pragma unroll
            for (int m = 0; m < 4; ++m) { float* rowp = C + (size_t)(row0 + ai * HALF + m * 16) * ldc + col0;
#pragma unroll
                for (int bj = 0; bj < 2; ++bj)
#pragma unroll
                    for (int n = 0; n < 2; ++n) *(f32x4*)(rowp + bj * HALF + n * 16) = acc[ai][bj][m][n]; }
    }
};
struct EpiGlu {
    static constexpr bool PERM = false;
    const bf16_t* yg; const float* bias; bf16_t* Z;
    __device__ __forceinline__ void operator()(const f32x4 (&acc)[2][2][4][2], const Unit& u, int wr, int wc, int fr, int fq) const {
        const int row0 = u.pm * BM + wr * 64 + fr, col0 = u.pn * BM + wc * 32 + 4 * fq;
#pragma unroll
        for (int ai = 0; ai < 2; ++ai)
#pragma unroll
            for (int m = 0; m < 4; ++m) { const size_t ro = (size_t)(row0 + ai * HALF + m * 16) * SW + col0;
#pragma unroll
                for (int bj = 0; bj < 2; ++bj)
#pragma unroll
                    for (int n = 0; n < 2; ++n) { const int co = bj * HALF + n * 16; const u32x2 yb = *(const u32x2*)(yg + ro + co); const f32x4 y = (f32x4){__uint_as_float(yb.x << 16), __uint_as_float(yb.x & 0xffff0000u), __uint_as_float(yb.y << 16), __uint_as_float(yb.y & 0xffff0000u)};
                        const f32x4 b = *(const f32x4*)(bias + col0 + co); f32x4 o;
#pragma unroll
                        for (int j = 0; j < 4; ++j) o[j] = y[j] * sigmoidf_(acc[ai][bj][m][n][j] + b[j]);
                        u32x2 zw; zw.x = cvt_pk_bf16(o[0], o[1]); zw.y = cvt_pk_bf16(o[2], o[3]); *(u32x2*)(Z + ro + co) = zw; } }
    }
};
struct EpiResid {
    static constexpr bool PERM = false;
    const float* x; const float* gate; bf16_t* X1;
    __device__ __forceinline__ void operator()(const f32x4 (&acc)[2][2][4][2], const Unit& u, int wr, int wc, int fr, int fq) const {
        const int row0 = u.pm * BM + wr * 64 + fr, col0 = u.pn * BM + wc * 32 + 4 * fq;
#pragma unroll
        for (int ai = 0; ai < 2; ++ai)
#pragma unroll
            for (int m = 0; m < 4; ++m) { const size_t ro = (size_t)(row0 + ai * HALF + m * 16) * D + col0;
#pragma unroll
                for (int bj = 0; bj < 2; ++bj)
#pragma unroll
                    for (int n = 0; n < 2; ++n) { const int co = bj * HALF + n * 16; const f32x4 xv = *(const f32x4*)(x + ro + co); const f32x4 g = *(const f32x4*)(gate + col0 + co);
                        const f32x4 o = xv + g * acc[ai][bj][m][n]; u32x2 ow; ow.x = cvt_pk_bf16(o[0], o[1]); ow.y = cvt_pk_bf16(o[2], o[3]); *(u32x2*)(X1 + ro + co) = ow; } }
    }
};
struct EpiMoe1 {
    static constexpr bool PERM = true;
    const float* b_gu; unsigned char* ACT;
    __device__ __forceinline__ void operator()(const f32x4 (&acc)[2][2][4][2], const Unit& u, int wr, int wc, int fr, int fq) const {
        const int row0 = u.pm * BM + wr * 64 + fr, j0 = u.pn * HALF + wc * 32 + 8 * fq;
        const float* bias = b_gu + (size_t)u.e * 2 * FF + 2 * j0;
        float bg[8], bl[8];
#pragma unroll
        for (int j = 0; j < 8; ++j) { bg[j] = bias[2 * j]; bl[j] = bias[2 * j + 1]; }
#pragma unroll
        for (int ai = 0; ai < 2; ++ai)
#pragma unroll
            for (int m = 0; m < 4; ++m) { const size_t eo = (size_t)(row0 + ai * HALF + m * 16) * FF + j0; float o[8];
#pragma unroll
                for (int n = 0; n < 2; ++n)
#pragma unroll
                    for (int j = 0; j < 4; ++j) { const float gl = fminf(acc[ai][0][m][n][j] + bg[4 * n + j], 7.0f); const float ln = fminf(fmaxf(acc[ai][1][m][n][j] + bl[4 * n + j], -7.0f), 7.0f);
                        o[4 * n + j] = gl * sigmoidf_(1.702f * gl) * (ln + 1.0f); }
#if MOE_FP8
                u32x2 w; w.x = pk4_fp8(o[0], o[1], o[2], o[3]); w.y = pk4_fp8(o[4], o[5], o[6], o[7]);
                *(u32x2*)(ACT + eo) = w; }
#else
                u32x4 w; w.x = cvt_pk_bf16(o[0], o[1]); w.y = cvt_pk_bf16(o[2], o[3]); w.z = cvt_pk_bf16(o[4], o[5]); w.w = cvt_pk_bf16(o[6], o[7]);
                *(u32x4*)(ACT + eo * 2) = w; }
#endif
    }
};
struct EpiMoe2 {
    static constexpr bool PERM = true;
    const float* b_down; const unsigned char* ws;
    __device__ __forceinline__ void operator()(const f32x4 (&acc)[2][2][4][2], const Unit& u, int wr, int wc, int fr, int fq) const {
        const int lr0 = u.mt * BM + wr * 64 + fr, row0 = u.pm * BM + wr * 64 + fr, col0 = u.pn * BM + wc * 32 + 8 * fq;
        const int* cnt = (const int*)(ws + WS_CTL); const int* list = (const int*)(ws + WS_LIST); const float* gate = (const float*)(ws + WS_GATE); bf16_t* YA = (bf16_t*)(ws + WS_YA);
        const int ce = __builtin_amdgcn_readfirstlane(cnt[u.e]);
        f32x4 bv[2][2];
#pragma unroll
        for (int bj = 0; bj < 2; ++bj)
#pragma unroll
            for (int n = 0; n < 2; ++n) bv[bj][n] = *(const f32x4*)(b_down + (size_t)u.e * D + col0 + bj * HALF + 4 * n);
#pragma unroll
        for (int ai = 0; ai < 2; ++ai)
#pragma unroll
            for (int m = 0; m < 4; ++m) { const int lr = lr0 + ai * HALF + m * 16; float g = 0.f; if (lr < ce) g = gate[list[(size_t)u.e * S + lr]];
                bf16_t* rowp = YA + (size_t)(row0 + ai * HALF + m * 16) * D + col0;
#pragma unroll
                for (int bj = 0; bj < 2; ++bj) { const f32x4 v0 = (acc[ai][bj][m][0] + bv[bj][0]) * g, v1 = (acc[ai][bj][m][1] + bv[bj][1]) * g;
                    u32x4 w; w.x = cvt_pk_bf16(v0[0], v0[1]); w.y = cvt_pk_bf16(v0[2], v0[3]); w.z = cvt_pk_bf16(v1[0], v1[1]); w.w = cvt_pk_bf16(v1[2], v1[3]);
                    *(u32x4*)(rowp + bj * HALF) = w; } }
    }
};
struct EpiS5E {
    static constexpr bool PERM = false;
    float* EF;
    __device__ __forceinline__ void operator()(const f32x4 (&acc)[2][2][4][2], const Unit& u, int wr, int wc, int fr, int fq) const {
        const int row0 = u.pm * BM + wr * 64 + fr, col0 = wc * 32 + 4 * fq;
#pragma unroll
        for (int ai = 0; ai < 2; ++ai)
#pragma unroll
            for (int m = 0; m < 4; ++m) { float* rowp = EF + ((size_t)u.e * NCH + row0 + ai * HALF + m * 16) * 128 + col0;
#pragma unroll
                for (int n = 0; n < 2; ++n) *(f32x4*)(rowp + n * 16) = acc[ai][0][m][n]; }
    }
};
struct EpiS5Y {
    static constexpr bool PERM = true;
    bf16_t* YGB;
    __device__ __forceinline__ void operator()(const f32x4 (&acc)[2][2][4][2], const Unit& u, int wr, int wc, int fr, int fq) const {
        const int c0 = u.pm * BM + wr * 64 + fr;
#pragma unroll
        for (int ai = 0; ai < 2; ++ai)
#pragma unroll
            for (int m = 0; m < 4; ++m) { const int c = c0 + ai * HALF + m * 16;
#pragma unroll
                for (int bj = 0; bj < 2; ++bj) { const int np = u.pn * BM + bj * HALF + wc * 32 + 8 * fq, i = np >> 4, p0 = np & 15; float o[8];
#pragma unroll
                    for (int n = 0; n < 2; ++n)
#pragma unroll
                        for (int j = 0; j < 4; ++j) { const float y = acc[ai][bj][m][n][j]; const float uu = 0.7978845608028654f * (y + 0.044715f * y * y * y);
                            o[4 * n + j] = y * __builtin_amdgcn_rcpf(1.0f + __builtin_amdgcn_exp2f(-2.885390081777927f * uu)); }
                    u32x4 w; w.x = cvt_pk_bf16(o[0], o[1]); w.y = cvt_pk_bf16(o[2], o[3]); w.z = cvt_pk_bf16(o[4], o[5]); w.w = cvt_pk_bf16(o[6], o[7]);
                    *(u32x4*)(YGB + (size_t)(c * LCH + i) * SW + u.e * PC + p0) = w; } }
    }
};
struct EpiProj {
    static constexpr bool PERM = false;
    bf16_t* QKV; bf16_t* UB2;
    __device__ __forceinline__ void operator()(const f32x4 (&acc)[2][2][4][2], const Unit& u, int wr, int wc, int fr, int fq) const {
        const int row0 = u.pm * BM + wr * 64 + fr, col0 = u.pn * BM + wc * 32 + 4 * fq;
        if (u.pn < 12) {
            const float sc = (u.pn < 4) ? 0.125f : 1.0f;
#pragma unroll
            for (int ai = 0; ai < 2; ++ai)
#pragma unroll
                for (int m = 0; m < 4; ++m) { bf16_t* rowp = QKV + (size_t)(row0 + ai * HALF + m * 16) * (3 * AW) + col0;
#pragma unroll
                    for (int bj = 0; bj < 2; ++bj)
#pragma unroll
                        for (int n = 0; n < 2; ++n) { const f32x4 v = acc[ai][bj][m][n] * sc; u32x2 w; w.x = cvt_pk_bf16(v[0], v[1]); w.y = cvt_pk_bf16(v[2], v[3]); *(u32x2*)(rowp + bj * HALF + n * 16) = w; } }
        } else {
#pragma unroll
            for (int ai = 0; ai < 2; ++ai)
#pragma unroll
                for (int m = 0; m < 4; ++m) { const int t = row0 + ai * HALF + m * 16; bf16_t* rowp = UB2 + (size_t)((t >> 5) * CROWS + (t & 31)) * SW + (col0 - 3 * AW);
#pragma unroll
                    for (int bj = 0; bj < 2; ++bj)
#pragma unroll
                        for (int n = 0; n < 2; ++n) { const f32x4 v = acc[ai][bj][m][n]; u32x2 w; w.x = cvt_pk_bf16(v[0], v[1]); w.y = cvt_pk_bf16(v[2], v[3]); *(u32x2*)(rowp + bj * HALF + n * 16) = w; } }
        }
    }
};
}

constexpr int NWAVES = 8;
constexpr int LDS_BYTES = 148480;
constexpr int RING_OFF = 0;
typedef short s16x4 __attribute__((ext_vector_type(4)));
typedef float f32x16 __attribute__((ext_vector_type(16)));

struct ConvTile { const float* W; unsigned char* WT; int K, N, tk, tn, deint, out8; };
__device__ __forceinline__ void conv_load(const ConvTile& t, f32x4 (&v)[8]) {
    const int tid = otid(), k0 = t.tk * 64, n0 = t.tn * 256;
#pragma unroll
    for (int j = 0; j < 8; ++j) { const int k = j * 8 + (tid >> 6), g = tid & 63;
        v[j] = __builtin_nontemporal_load((const f32x4*)(t.W + (size_t)(k0 + k) * t.N + n0 + 4 * g)); }
}
__device__ __forceinline__ void conv_store(const ConvTile& t, const f32x4 (&vin)[8], LAS float* scr) {
    const int tid = otid(), k0 = t.tk * 64, n0 = t.tn * 256;
    __syncthreads();
#pragma unroll
    for (int j = 0; j < 8; ++j) { const int k = j * 8 + (tid >> 6), g = tid & 63; *(LAS f32x4*)(scr + k * 256 + ((g ^ j) << 2)) = vin[j]; }
    __syncthreads();
#pragma unroll
    for (int jj = 0; jj < 4; ++jj) { const int n = jj * 64 + (tid >> 3), c = tid & 7; float v[8];
#pragma unroll
        for (int q = 0; q < 8; ++q) v[q] = scr[(8 * c + q) * 256 + ((((n >> 2) ^ c)) << 2) + (n & 3)];
        int row = n0 + n;
        if (t.deint) { const int sx = n & 1, jl = n >> 1; row = n0 + sx * 128 + jl; }
        if (t.out8) { u32x2 o8; o8.x = pk4_fp8(v[0] * 64.f, v[1] * 64.f, v[2] * 64.f, v[3] * 64.f); o8.y = pk4_fp8(v[4] * 64.f, v[5] * 64.f, v[6] * 64.f, v[7] * 64.f);
            *(u32x2*)(t.WT + (size_t)row * t.K + k0 + 8 * c) = o8; }
        else { u32x4 o; o.x = cvt_pk_bf16(v[0], v[1]); o.y = cvt_pk_bf16(v[2], v[3]); o.z = cvt_pk_bf16(v[4], v[5]); o.w = cvt_pk_bf16(v[6], v[7]);
            *(u32x4*)(t.WT + ((size_t)row * t.K + k0 + 8 * c) * 2) = o; } }
}
constexpr int CONV_NT_SMALL = 32 * 16 + 16 * 4 + 32 * 8, CONV_NT_EXP = NE * (32 * 16 + 32 * 8);
__device__ __forceinline__ ConvTile conv_tile_small(const P& p, int it) {
    unsigned char* ws = p.ws;
    constexpr int T_IN = 32 * 16, T_GLU = 16 * 4;
    ConvTile t; int r = it;
    if (r < T_IN) { t.W = p.w_in; t.WT = ws + WS_WIN; t.K = D; t.N = INW; t.tk = r / 16; t.tn = r % 16; t.deint = 0; t.out8 = 0; return t; } r -= T_IN;
    if (r < T_GLU) { t.W = p.w_glu; t.WT = ws + WS_WGLU; t.K = SW; t.N = SW; t.tk = r / 4; t.tn = r % 4; t.deint = 0; t.out8 = 0; return t; } r -= T_GLU;
    t.W = p.w_out; t.WT = ws + WS_WOUT; t.K = D; t.N = D; t.tk = r / 8; t.tn = r % 8; t.deint = 0; t.out8 = 0; return t;
}
__device__ __forceinline__ ConvTile conv_tile_exp(const P& p, int it) {
    unsigned char* ws = p.ws;
    constexpr int T_GU = 32 * 16, T_DN = 32 * 8;
    constexpr int E8 = (MOE_FP8 != 0) ? 1 : 0, EB = E8 ? 1 : 2;
    ConvTile t; int r = it;
    if (r < NE * T_GU) { const int e = r / T_GU, q = r % T_GU; t.W = p.w_gu + (size_t)e * D * 2 * FF; t.WT = ws + WS_WGU + (size_t)e * 2 * FF * D * EB; t.K = D; t.N = 2 * FF; t.tk = q / 16; t.tn = q % 16; t.deint = 1; t.out8 = E8; return t; } r -= NE * T_GU;
    { const int e = r / T_DN, q = r % T_DN; t.W = p.w_down + (size_t)e * FF * D; t.WT = ws + WS_WDN + (size_t)e * D * FF * EB; t.K = FF; t.N = D; t.tk = q / 8; t.tn = q % 8; t.deint = 0; t.out8 = E8; return t; }
}

__device__ __forceinline__ void phase_s5_tables(const P& p, LAS unsigned char* lds, int g);
__device__ __forceinline__ void phase_conv_experts(const P& p, LAS unsigned char* lds, int bid, int Gn);
__device__ __forceinline__ void phase_prologue(const P& p, LAS unsigned char* lds, int bid, int Gn) {
    unsigned char* ws = p.ws;
    const int tid = otid();
    if (bid < 192) {
        LAS float* sil = (LAS float*)(lds + 16384);
        for (int i = tid; i < D; i += NWAVES * 64) { const float cv = p.c[i]; sil[i] = cv * __builtin_amdgcn_rcpf(1.0f + __expf(-cv)); }
        __syncthreads();
        LAS f32x4* red = (LAS f32x4*)lds;
        const int cq = tid & 15, rg = tid >> 4;
        f32x4 acc = (f32x4){0.f, 0.f, 0.f, 0.f};
        for (int it0 = 0; it0 < 64; it0 += 8) { f32x4 wv[8];
#pragma unroll
            for (int k = 0; k < 8; ++k) wv[k] = __builtin_nontemporal_load((const f32x4*)(p.w_ada + (size_t)(rg + 32 * (it0 + k)) * 6 * D + 64 * bid + 4 * cq));
#pragma unroll
            for (int k = 0; k < 8; ++k) acc += wv[k] * sil[rg + 32 * (it0 + k)]; }
        red[rg * 16 + cq] = acc;
        __syncthreads();
        if (tid < 64) { const LAS float* rf = (const LAS float*)lds; float sacc = p.b_ada[64 * bid + tid];
            for (int r = 0; r < 32; ++r) sacc += rf[r * 64 + tid];
            ((float*)(ws + WS_MOD))[64 * bid + tid] = sacc; }
    } else phase_s5_tables(p, lds, bid - 192);
    LAS float* scr = (LAS float*)(lds + RING_OFF);
    {
        f32x4 va[8];
        for (int it = bid; it < CONV_NT_SMALL; it += Gn) { const ConvTile ta = conv_tile_small(p, it); conv_load(ta, va); conv_store(ta, va, scr); }
    }
    __syncthreads();
    phase_conv_experts(p, lds, bid, Gn);
}

__device__ __forceinline__ void phase_norm1(const P& p, int bid, int Gn) {
    const int tid_ = otid(); const int lane = tid_ & 63, gw = bid * NWAVES + (tid_ >> 6), NGW = Gn * NWAVES;
    const float* mod = (const float*)(p.ws + WS_MOD);
    bf16_t* hb = (bf16_t*)(p.ws + WS_HB);
    f32x4 ga[8], sb[8];
#pragma unroll
    for (int j = 0; j < 8; ++j) { const int c0 = 4 * lane + 256 * j; ga[j] = *(const f32x4*)(p.norm1_g + c0) * (*(const f32x4*)(mod + D + c0) + 1.0f); sb[j] = *(const f32x4*)(mod + c0); }
    f32x4 v[8], vn[8];
    int row = gw;
    if (row < S) {
#pragma unroll
        for (int j = 0; j < 8; ++j) v[j] = ((const f32x4*)(p.x + (size_t)row * D) + lane)[64 * j]; }
    while (row < S) {
        const int nrow = row + NGW;
        if (nrow < S) {
#pragma unroll
            for (int j = 0; j < 8; ++j) vn[j] = ((const f32x4*)(p.x + (size_t)nrow * D) + lane)[64 * j]; }
        float ss = 0.f;
#pragma unroll
        for (int j = 0; j < 8; ++j) ss += (v[j].x * v[j].x + v[j].y * v[j].y) + (v[j].z * v[j].z + v[j].w * v[j].w);
        const float rs = 1.0f / sqrtf(wave_sum(ss) * (1.0f / D) + EPS);
#pragma unroll
        for (int j = 0; j < 8; ++j) { const int c0 = 4 * lane + 256 * j;
            const f32x4 o = v[j] * rs * ga[j] + sb[j];
            u32x2 w; w.x = cvt_pk_bf16(o.x, o.y); w.y = cvt_pk_bf16(o.z, o.w);
            *(u32x2*)(hb + (size_t)row * D + c0) = w; }
#pragma unroll
        for (int j = 0; j < 8; ++j) v[j] = vn[j];
        row = nrow;
    }
}

__device__ __forceinline__ void tr_read4(unsigned a0, unsigned a1, s16x4& r0, s16x4& r1, s16x4& r2, s16x4& r3) {
    asm volatile("ds_read_b64_tr_b16 %0, %4\n\tds_read_b64_tr_b16 %1, %4 offset:1024\n\tds_read_b64_tr_b16 %2, %5\n\tds_read_b64_tr_b16 %3, %5 offset:1024\n\ts_waitcnt lgkmcnt(0)"
                 : "=&v"(r0), "=&v"(r1), "=&v"(r2), "=&v"(r3) : "v"(a0), "v"(a1) : "memory");
}
__device__ __forceinline__ void attn_role(const P& p, LAS unsigned char* lds, int bid, int Gn, int w) {
    const bf16_t* QKV = (const bf16_t*)(p.ws + WS_QKV);
    bf16_t* OB = (bf16_t*)(p.ws + WS_OB);
    float* LSE = (float*)(p.ws + WS_LSE);
    const int lane = otid() & 63, aw = w & 3, us = w >> 2;
    const int l31 = lane & 31, hh = lane >> 5, i0 = 32 * aw;
    constexpr int RS = 3 * AW;
    LAS unsigned char* vl = lds + w * 16384;
    LAS unsigned char* kl = vl + 8192;
    for (int u = 2 * bid + us; u < 3 * 128 * NH; u += 2 * Gn) {
        const int b = u >> 11, rem = u & 2047, blk = rem >> 4, h = rem & 15;
        const int dsh = 2 * b, d = 1 << dsh;
        const int n = blk >> dsh, r = blk & (d - 1);
        const int qbase = n * 128 * d + r, kbase = qbase - 128 * d;
        const int qp = qbase + (i0 + l31) * d;
        bf16x8 qf[4];
#pragma unroll
        for (int s = 0; s < 4; ++s) qf[s] = *(const bf16x8*)(QKV + (size_t)qp * RS + h * HD + 16 * s + 8 * hh);
        u32x4 kr[4], krn[4];
#define ATT_KLOAD(dst, kb_) do { _Pragma("unroll") for (int it = 0; it < 4; ++it) { const int id = it * 64 + lane, row = 32 * (kb_) + (id >> 3), ch = id & 7; int kp = kbase + (i0 + row) * d; kp = kp < 0 ? 0 : kp; \
            dst[it] = *(const u32x4*)(QKV + (size_t)kp * RS + AW + h * HD + ch * 8); } } while (0)
        ATT_KLOAD(kr, 0);
        f32x16 sc[5];
#pragma unroll
        for (int kb = 0; kb < 5; ++kb) {
            if (kb < 4) ATT_KLOAD(krn, kb + 1);
            LAS unsigned char* kbuf = kl + (kb & 1) * 4096;
#pragma unroll
            for (int it = 0; it < 4; ++it) { const int id = it * 64 + lane, row = id >> 3, ch = id & 7; *(LAS u32x4*)(kbuf + row * 128 + ((ch ^ (row & 7)) << 4)) = kr[it]; }
            bf16x8 kf[4];
#pragma unroll
            for (int s = 0; s < 4; ++s) kf[s] = *(const LAS bf16x8*)(kbuf + l31 * 128 + (((2 * s + hh) ^ (l31 & 7)) << 4));
            f32x16 a;
#pragma unroll
            for (int e = 0; e < 16; ++e) a[e] = 0.f;
#pragma unroll
            for (int s = 0; s < 4; ++s) a = __builtin_amdgcn_mfma_f32_32x32x16_bf16(kf[s], qf[s], a, 0, 0, 0);
            sc[kb] = a;
            if (kb < 4) {
#pragma unroll
                for (int it = 0; it < 4; ++it) kr[it] = krn[it]; }
        }
#undef ATT_KLOAD
        u32x4 vv[4], vn[4];
#define ATT_VLOAD(dst, kb_) do { _Pragma("unroll") for (int it = 0; it < 4; ++it) { const int id = it * 64 + lane, row = 32 * (kb_) + (id >> 3), ch = id & 7; const int vp = kbase + (i0 + row) * d; \
            dst[it] = (u32x4){0u, 0u, 0u, 0u}; if (vp >= 0) dst[it] = *(const u32x4*)(QKV + (size_t)vp * RS + 2 * AW + h * HD + ch * 8); } } while (0)
        ATT_VLOAD(vv, 0);
        float m = -INFINITY;
#pragma unroll
        for (int kb = 0; kb < 5; ++kb)
#pragma unroll
            for (int e = 0; e < 16; ++e) { const int jrel = 32 * kb + (e & 3) + 8 * (e >> 2) + 4 * hh;
                const bool valid = (jrel >= l31) && (jrel <= l31 + 128) && (n > 0 || (i0 + jrel) >= 128);
                const float sv = valid ? sc[kb][e] : -INFINITY; sc[kb][e] = sv; m = fmaxf(m, sv); }
        m = fmaxf(m, __shfl_xor(m, 32));
        float l = 0.f;
#pragma unroll
        for (int kb = 0; kb < 5; ++kb)
#pragma unroll
            for (int e = 0; e < 16; ++e) { const float pe = __expf(sc[kb][e] - m); sc[kb][e] = pe; l += pe; }
        l += __shfl_xor(l, 32);
        f32x16 o[2];
#pragma unroll
        for (int c = 0; c < 2; ++c)
#pragma unroll
            for (int e = 0; e < 16; ++e) o[c][e] = 0.f;
        const int q4 = (lane & 15) >> 2, pp = lane & 3, bk = (lane >> 4) & 1;
#pragma unroll
        for (int kb = 0; kb < 5; ++kb) {
            if (kb < 4) ATT_VLOAD(vn, kb + 1);
            LAS unsigned char* vb = vl + (kb & 1) * 4096;
#pragma unroll
            for (int it = 0; it < 4; ++it) { const int id = it * 64 + lane; *(LAS u32x4*)(vb + (id >> 3) * 128 + (id & 7) * 16) = vv[it]; }
            asm volatile("s_waitcnt lgkmcnt(0)" ::: "memory");
            const unsigned vbase = (unsigned)(size_t)vb;
#pragma unroll
            for (int s2 = 0; s2 < 2; ++s2) {
                u32x4 pw; pw.x = cvt_pk_bf16(sc[kb][8 * s2 + 0], sc[kb][8 * s2 + 1]); pw.y = cvt_pk_bf16(sc[kb][8 * s2 + 2], sc[kb][8 * s2 + 3]);
                pw.z = cvt_pk_bf16(sc[kb][8 * s2 + 4], sc[kb][8 * s2 + 5]); pw.w = cvt_pk_bf16(sc[kb][8 * s2 + 6], sc[kb][8 * s2 + 7]);
                const bf16x8 pf = __builtin_bit_cast(bf16x8, pw);
                const int rowb = 16 * s2 + 4 * hh + q4;
                const unsigned a0 = vbase + (unsigned)(rowb * 128 + 32 * bk + 8 * pp);
                s16x4 v00, v01, v10, v11;
                tr_read4(a0, a0 + 64, v00, v01, v10, v11);
                bf16x8 vf0, vf1;
                vf0[0] = v00[0]; vf0[1] = v00[1]; vf0[2] = v00[2]; vf0[3] = v00[3]; vf0[4] = v01[0]; vf0[5] = v01[1]; vf0[6] = v01[2]; vf0[7] = v01[3];
                vf1[0] = v10[0]; vf1[1] = v10[1]; vf1[2] = v10[2]; vf1[3] = v10[3]; vf1[4] = v11[0]; vf1[5] = v11[1]; vf1[6] = v11[2]; vf1[7] = v11[3];
                o[0] = __builtin_amdgcn_mfma_f32_32x32x16_bf16(vf0, pf, o[0], 0, 0, 0);
                o[1] = __builtin_amdgcn_mfma_f32_32x32x16_bf16(vf1, pf, o[1], 0, 0, 0);
            }
            if (kb < 4) {
#pragma unroll
                for (int it = 0; it < 4; ++it) vv[it] = vn[it]; }
        }
#undef ATT_VLOAD
        const float inv = 1.0f / l;
        bf16_t* orow = OB + ((size_t)b * S + qp) * AW + h * HD;
#pragma unroll
        for (int c = 0; c < 2; ++c)
#pragma unroll
            for (int rg = 0; rg < 4; ++rg) { u32x2 wv; wv.x = cvt_pk_bf16(o[c][4 * rg] * inv, o[c][4 * rg + 1] * inv); wv.y = cvt_pk_bf16(o[c][4 * rg + 2] * inv, o[c][4 * rg + 3] * inv);
                *(u32x2*)(orow + 32 * c + 8 * rg + 4 * hh) = wv; }
        if (hh == 0) LSE[((size_t)b * S + qp) * NH + h] = m + __logf(l);
    }
}
__device__ __forceinline__ void cw_load(const ConvTile& t, int half, int cw, int lane, f32x4 (&v)[16]) {
    const int kbase = t.tk * 128 + half * 64, n0 = t.tn * 256 + 64 * cw, g = lane & 15, kbl = lane >> 4;
#pragma unroll
    for (int t2 = 0; t2 < 2; ++t2)
#pragma unroll
        for (int kk = 0; kk < 8; ++kk) v[t2 * 8 + kk] = __builtin_nontemporal_load((const f32x4*)(t.W + (size_t)(kbase + (t2 * 4 + kbl) * 8 + kk) * t.N + n0 + 4 * g));
}
__device__ __forceinline__ void cw_park(int half, int lane, const f32x4 (&v)[16], LAS unsigned char* tl) {
    const int g = lane & 15, kbl = lane >> 4;
#pragma unroll
    for (int t2 = 0; t2 < 2; ++t2) { const int kb = half * 8 + t2 * 4 + kbl;
#pragma unroll
        for (int i = 0; i < 4; ++i) { const int n = 4 * g + i; u32x2 o8;
            o8.x = pk4_fp8(v[t2 * 8 + 0][i] * 64.f, v[t2 * 8 + 1][i] * 64.f, v[t2 * 8 + 2][i] * 64.f, v[t2 * 8 + 3][i] * 64.f);
            o8.y = pk4_fp8(v[t2 * 8 + 4][i] * 64.f, v[t2 * 8 + 5][i] * 64.f, v[t2 * 8 + 6][i] * 64.f, v[t2 * 8 + 7][i] * 64.f);
            *(LAS u32x2*)(tl + n * 128 + ((kb ^ (2 * (g & 7))) << 3)) = o8; } }
}
__device__ __forceinline__ void cw_flush(const ConvTile& t, int cw, int lane, LAS unsigned char* tl) {
#pragma unroll
    for (int jj = 0; jj < 8; ++jj) { const int n = jj * 8 + (lane >> 3), pc = lane & 7;
        const u32x4 o = *(const LAS u32x4*)(tl + n * 128 + (((2 * pc) ^ (2 * ((n >> 2) & 7))) << 3));
        const int nt = 64 * cw + n;
        int row = t.tn * 256 + nt;
        if (t.deint) row = t.tn * 256 + (nt & 1) * 128 + (nt >> 1);
        *(u32x4*)(t.WT + (size_t)row * t.K + t.tk * 128 + 16 * pc) = o; }
}
constexpr int CONV_NT_EXP128 = NE * (16 * 16 + 16 * 8);
__device__ __forceinline__ ConvTile conv_tile_exp128(const P& p, int it) {
    unsigned char* ws = p.ws;
    constexpr int T_GU = 16 * 16, T_DN = 16 * 8;
    ConvTile t; int r = it;
    if (r < NE * T_GU) { const int e = r / T_GU, q = r % T_GU; t.W = p.w_gu + (size_t)e * D * 2 * FF; t.WT = ws + WS_WGU + (size_t)e * 2 * FF * D; t.K = D; t.N = 2 * FF; t.tk = q / 16; t.tn = q % 16; t.deint = 1; t.out8 = 1; return t; } r -= NE * T_GU;
    { const int e = r / T_DN, q = r % T_DN; t.W = p.w_down + (size_t)e * FF * D; t.WT = ws + WS_WDN + (size_t)e * D * FF; t.K = FF; t.N = D; t.tk = q / 8; t.tn = q % 8; t.deint = 0; t.out8 = 1; return t; }
}
__device__ __forceinline__ void conv_role(const P& p, LAS unsigned char* lds, int bid, int Gn_, int w) {
    static_assert(MOE_FP8 != 0, "the conversion role writes fp8 expert weights");
    const int lane = otid() & 63, cw = w & 3, Gn = 2 * Gn_;
    LAS unsigned char* tl = lds + 65536 + w * 8192;
    f32x4 va[16], vb[16];
    int it = 2 * bid + (w >> 2);
    ConvTile t = conv_tile_exp128(p, it < CONV_NT_EXP128 ? it : 0);
    if (it < CONV_NT_EXP128) cw_load(t, 0, cw, lane, va);
    while (it < CONV_NT_EXP128) {
        cw_load(t, 1, cw, lane, vb);
        cw_park(0, lane, va, tl);
        const int nx = it + Gn; ConvTile tn = t;
        if (nx < CONV_NT_EXP128) { tn = conv_tile_exp128(p, nx); cw_load(tn, 0, cw, lane, va); }
        cw_park(1, lane, vb, tl);
        cw_flush(t, cw, lane, tl);
        t = tn; it = nx;
    }
}
__device__ __forceinline__ void phase_attn(const P& p, LAS unsigned char* lds, int bid, int Gn) {
    const int w = __builtin_amdgcn_readfirstlane(otid() >> 6);
    attn_role(p, lds, bid, Gn, w);
}
__device__ __forceinline__ void phase_conv_experts(const P& p, LAS unsigned char* lds, int bid, int Gn) {
    const int w = __builtin_amdgcn_readfirstlane(otid() >> 6);
    conv_role(p, lds, bid, Gn, w);
}

__device__ __forceinline__ void phase_s5_tables(const P& p, LAS unsigned char* lds, int g) {
    const int tid = otid();
    LAS float* pwr = (LAS float*)lds;
    LAS float* pwi = pwr + 33 * 64;
    LAS float* cre = pwi + 33 * 64;
    LAS float* cim = cre + 1024;
    LAS float* bbr = cim + 1024;
    LAS float* bbi = bbr + 1024;
    LAS float* Mt = bbi + 1024;
    __syncthreads();
    if (tid < NS) {
        const int n = tid, i = g * NS + n;
        const float dt = expf(p.log_dt[g]), lr = p.lam_re[i], li = p.lam_im[i];
        const float mag = expf(lr * dt), ar = mag * cosf(li * dt), ai = mag * sinf(li * dt);
        const float den = lr * lr + li * li, nr = ar - 1.0f, ni = ai;
        const float fr = (nr * lr + ni * li) / den, fi = (ni * lr - nr * li) / den;
        for (int q = 0; q < PC; ++q) { const float br = p.b_re[(size_t)i * PC + q], bi = p.b_im[(size_t)i * PC + q];
            bbr[n * PC + q] = fr * br - fi * bi; bbi[n * PC + q] = fr * bi + fi * br; }
        float xr = 1.0f, xi = 0.0f;
        for (int t = 0; t <= LCH; ++t) { pwr[t * NS + n] = xr; pwi[t * NS + n] = xi; const float yr = xr * ar - xi * ai, yi = xr * ai + xi * ar; xr = yr; xi = yi; }
        float* lamL = (float*)(p.ws + WS_S5P);
        lamL[(g * NS + n) * 2 + 0] = pwr[LCH * NS + n]; lamL[(g * NS + n) * 2 + 1] = pwi[LCH * NS + n];
    }
    for (int k = tid; k < PC * NS; k += NWAVES * 64) { cre[k] = p.c_re[(size_t)g * PC * NS + k]; cim[k] = p.c_im[(size_t)g * PC * NS + k]; }
    __syncthreads();
    for (int k = 0; k < 16; ++k) { const int idx = tid + 512 * k, tau = idx >> 8, pp = (idx >> 4) & 15, q = idx & 15;
        float acc = 0.f;
        for (int n = 0; n < NS; ++n) { const float cr = cre[pp * NS + n], ci = cim[pp * NS + n], pr = pwr[tau * NS + n], pi = pwi[tau * NS + n];
            const float xr = cr * pr - ci * pi, xi = cr * pi + ci * pr; acc += xr * bbr[n * PC + q] - xi * bbi[n * PC + q]; }
        if (tau == 0 && pp == q) acc += p.d_skip[g * PC + pp];
        Mt[idx] = acc; }
    __syncthreads();
    bf16_t* T = (bf16_t*)(p.ws + WS_S5T) + (size_t)g * 512 * KS5;
    for (int k = 0; k < 80; ++k) { const int ch = tid + 512 * k, row = ch / 80, cc = ch % 80, i = row >> 4, pp = row & 15; float v[8];
        if (cc < 64) { const int j = cc >> 1, q0 = (cc & 1) * 8;
#pragma unroll
            for (int e = 0; e < 8; ++e) v[e] = (j <= i) ? Mt[((i - j) * 16 + pp) * 16 + q0 + e] : 0.f;
        } else { const int m0 = (cc - 64) * 8;
#pragma unroll
            for (int e = 0; e < 8; ++e) { const int m = m0 + e, n = m & 63; const float cr = cre[pp * NS + n], ci = cim[pp * NS + n], pr = pwr[(i + 1) * NS + n], pi = pwi[(i + 1) * NS + n];
                v[e] = (m < 64) ? (cr * pr - ci * pi) : -(cr * pi + ci * pr); } }
        u32x4 o; o.x = cvt_pk_bf16(v[0], v[1]); o.y = cvt_pk_bf16(v[2], v[3]); o.z = cvt_pk_bf16(v[4], v[5]); o.w = cvt_pk_bf16(v[6], v[7]);
        *(u32x4*)(T + (size_t)row * KS5 + cc * 8) = o; }
    bf16_t* Eb = (bf16_t*)(p.ws + WS_S5E) + (size_t)g * 256 * KS5E;
    for (int k = 0; k < 32; ++k) { const int ch = tid + 512 * k, row = ch >> 6, cc = ch & 63, j = cc >> 1, q0 = (cc & 1) * 8, n = row & 63; float v[8];
#pragma unroll
        for (int e = 0; e < 8; ++e) { const float pr = pwr[(LCH - 1 - j) * NS + n], pi = pwi[(LCH - 1 - j) * NS + n], br = bbr[n * PC + q0 + e], bi = bbi[n * PC + q0 + e];
            v[e] = (row < 64) ? (pr * br - pi * bi) : ((row < 128) ? (pr * bi + pi * br) : 0.f); }
        u32x4 o; o.x = cvt_pk_bf16(v[0], v[1]); o.y = cvt_pk_bf16(v[2], v[3]); o.z = cvt_pk_bf16(v[4], v[5]); o.w = cvt_pk_bf16(v[6], v[7]);
        *(u32x4*)(Eb + (size_t)row * KS5E + cc * 8) = o; }
    __syncthreads();
}
__device__ __forceinline__ void phase_s5_carry(const P& p, int bid) {
    const int gt = bid * (NWAVES * 64) + otid();
    if (gt >= G * NS) return;
    const int g = gt >> 6, n = gt & 63;
    const float* lamL = (const float*)(p.ws + WS_S5P);
    const float* EF = (const float*)(p.ws + WS_EF) + (size_t)g * NCH * 128;
    bf16_t* UB2 = (bf16_t*)(p.ws + WS_UB2);
    const float lr = lamL[gt * 2], li = lamL[gt * 2 + 1];
    float xr = 0.f, xi = 0.f;
    float er[8], ei[8], ern[8], ein[8];
#pragma unroll
    for (int k = 0; k < 8; ++k) { er[k] = EF[(size_t)k * 128 + n]; ei[k] = EF[(size_t)k * 128 + 64 + n]; }
    for (int c0 = 0; c0 < NCH; c0 += 8) {
        if (c0 + 8 < NCH) {
#pragma unroll
            for (int k = 0; k < 8; ++k) { ern[k] = EF[(size_t)(c0 + 8 + k) * 128 + n]; ein[k] = EF[(size_t)(c0 + 8 + k) * 128 + 64 + n]; } }
#pragma unroll
        for (int k = 0; k < 8; ++k) { const int c = c0 + k;
            bf16_t* xrow = UB2 + (size_t)(c * CROWS + LCH + (n >> 4)) * SW + g * PC + (n & 15);
            xrow[0] = f2bf(xr); xrow[4 * SW] = f2bf(xi);
            const float yr = lr * xr - li * xi + er[k], yi = lr * xi + li * xr + ei[k]; xr = yr; xi = yi; }
#pragma unroll
        for (int k = 0; k < 8; ++k) { er[k] = ern[k]; ei[k] = ein[k]; }
    }
}

__device__ __forceinline__ void phase_mix(const P& p, int bid, int Gn) {
    const int tid_ = otid(); const int lane = tid_ & 63, gw = bid * NWAVES + (tid_ >> 6), NGW = Gn * NWAVES;
    const bf16_t* OB = (const bf16_t*)(p.ws + WS_OB);
    const float* LSE = (const float*)(p.ws + WS_LSE);
    const bf16_t* Z = (const bf16_t*)(p.ws + WS_Z);
    bf16_t* YM = (bf16_t*)(p.ws + WS_YMIXB);
    float ls[4][3], lsn[4][3]; u32x2 ob[4][3], obn[4][3], zr[4], zrn[4];
#define MIX_LOAD(LS, OBR, ZR, row_) do { _Pragma("unroll") for (int j = 0; j < 4; ++j) { const int c0 = 4 * lane + 256 * j, hd = c0 >> 6; \
        _Pragma("unroll") for (int b = 0; b < 3; ++b) { LS[j][b] = LSE[((size_t)b * S + (row_)) * NH + hd]; OBR[j][b] = *(const u32x2*)(OB + ((size_t)b * S + (row_)) * AW + c0); } \
        ZR[j] = *(const u32x2*)(Z + (size_t)(row_) * SW + c0); } } while (0)
    int row = gw;
    if (row < S) MIX_LOAD(ls, ob, zr, row);
    while (row < S) {
        const int nrow = row + NGW;
        if (nrow < S) MIX_LOAD(lsn, obn, zrn, nrow);
        f32x4 a[4], z[4]; float sa = 0.f, sz = 0.f;
#pragma unroll
        for (int j = 0; j < 4; ++j) {
            const float mx = fmaxf(fmaxf(ls[j][0], ls[j][1]), ls[j][2]);
            float wsum = 0.f; f32x4 acc = (f32x4){0.f, 0.f, 0.f, 0.f};
#pragma unroll
            for (int b = 0; b < 3; ++b) { const float wb = __expf(ls[j][b] - mx); wsum += wb; acc += bf4_to_f32(ob[j][b]) * wb; }
            a[j] = acc * (1.0f / wsum); sa += (a[j].x * a[j].x + a[j].y * a[j].y) + (a[j].z * a[j].z + a[j].w * a[j].w);
            z[j] = bf4_to_f32(zr[j]); sz += (z[j].x * z[j].x + z[j].y * z[j].y) + (z[j].z * z[j].z + z[j].w * z[j].w); }
        const float ra = 1.0f / sqrtf(wave_sum(sa) * (1.0f / AW) + EPS), rz = 1.0f / sqrtf(wave_sum(sz) * (1.0f / SW) + EPS);
#pragma unroll
        for (int j = 0; j < 4; ++j) { const int c0 = 4 * lane + 256 * j;
            const f32x4 ga = *(const f32x4*)(p.attn_g + c0), gs = *(const f32x4*)(p.ssm_g + c0);
            const f32x4 oa = a[j] * ra * ga, oz = z[j] * rz * gs;
            u32x2 wa, wz; wa.x = cvt_pk_bf16(oa.x, oa.y); wa.y = cvt_pk_bf16(oa.z, oa.w); wz.x = cvt_pk_bf16(oz.x, oz.y); wz.y = cvt_pk_bf16(oz.z, oz.w);
            *(u32x2*)(YM + (size_t)row * D + c0) = wa; *(u32x2*)(YM + (size_t)row * D + AW + c0) = wz; }
#pragma unroll
        for (int j = 0; j < 4; ++j) { zr[j] = zrn[j];
#pragma unroll
            for (int b = 0; b < 3; ++b) { ls[j][b] = lsn[j][b]; ob[j][b] = obn[j][b]; } }
        row = nrow;
    }
#undef MIX_LOAD
}

__device__ __forceinline__ void phase_norm2_router(const P& p, LAS unsigned char* lds, int bid, int Gn) {
    const int tid = otid(), lane = tid & 63, w = tid >> 6;
    const float* mod = (const float*)(p.ws + WS_MOD);
    const bf16_t* X1 = (const bf16_t*)(p.ws + WS_X1);
    bf16_t* hb = (bf16_t*)(p.ws + WS_HB);
    LAS float* hrow = (LAS float*)lds;
    LAS float* part = (LAS float*)(lds + 65536);
    LAS float* logit = (LAS float*)(lds + 81920);
    LAS int* sel_e = (LAS int*)(lds + 83968);
    LAS float* sel_g = (LAS float*)(lds + 84992);
    LAS int* sel_t = (LAS int*)(lds + 86016);
    LAS int* rank = (LAS int*)(lds + 86272);
    LAS int* hist = (LAS int*)(lds + 87296);
    LAS int* gbase = (LAS int*)(lds + 87424);
    int* idx = (int*)(p.ws + WS_IDX); float* gate = (float*)(p.ws + WS_GATE); int* slot = (int*)(p.ws + WS_SLOT);
    int* cnt = (int*)(p.ws + WS_CTL); int* list = (int*)(p.ws + WS_LIST);
    const int nit = (S / 8 + Gn - 1) / Gn;
    float wreg[128];
    {   const int e = tid & 31, pt = tid >> 5;
#pragma unroll
        for (int k = 0; k < 128; ++k) wreg[k] = p.w_router[(size_t)(pt * 128 + k) * NE + e]; }
    for (int it = 0; it < nit; ++it) {
        const int base = (it * Gn + bid) * 8, buf = it & 7;
        const bool live = base < S;
        if (live) {
            const int row = base + w;
            f32x4 v[8]; float ss = 0.f;
#pragma unroll
            for (int j = 0; j < 8; ++j) { v[j] = bf4_to_f32(((const u32x2*)(X1 + (size_t)row * D) + lane)[64 * j]); ss += (v[j].x * v[j].x + v[j].y * v[j].y) + (v[j].z * v[j].z + v[j].w * v[j].w); }
            const float rs = 1.0f / sqrtf(wave_sum(ss) * (1.0f / D) + EPS);
#pragma unroll
            for (int j = 0; j < 8; ++j) { const int c0 = 4 * lane + 256 * j;
                const f32x4 g = *(const f32x4*)(p.norm2_g + c0), sc = *(const f32x4*)(mod + 4 * D + c0), sh = *(const f32x4*)(mod + 3 * D + c0);
                const f32x4 o = v[j] * rs * g * (sc + 1.0f) + sh;
#if MOE_FP8
                *(unsigned*)((unsigned char*)hb + (size_t)row * D + c0) = pk4_fp8(o.x, o.y, o.z, o.w);
#else
                u32x2 wv; wv.x = cvt_pk_bf16(o.x, o.y); wv.y = cvt_pk_bf16(o.z, o.w);
                *(u32x2*)(hb + (size_t)row * D + c0) = wv;
#endif
                *(LAS f32x4*)(hrow + w * D + c0) = o; }
        }
        __syncthreads();
        if (live) {
            const int e = tid & 31, pt = tid >> 5;
            float acc[8];
#pragma unroll
            for (int r = 0; r < 8; ++r) acc[r] = 0.f;
#pragma unroll
            for (int k4 = 0; k4 < 32; ++k4) { const int kk = pt * 128 + 4 * k4;
                const float w0 = wreg[4 * k4], w1 = wreg[4 * k4 + 1], w2 = wreg[4 * k4 + 2], w3 = wreg[4 * k4 + 3];
#pragma unroll
                for (int r = 0; r < 8; ++r) { const f32x4 h4 = *(const LAS f32x4*)(hrow + r * D + kk); acc[r] += (h4.x * w0 + h4.y * w1) + (h4.z * w2 + h4.w * w3); } }
#pragma unroll
            for (int r = 0; r < 8; ++r) part[(pt * 8 + r) * 32 + e] = acc[r];
        }
        __syncthreads();
        if (live) {
            const int e = lane & 31; float lg = p.b_router[e];
#pragma unroll
            for (int q = 0; q < 16; ++q) lg += part[(q * 8 + w) * 32 + e];
            float tv[TOPK]; int ti[TOPK];
#pragma unroll
            for (int k = 0; k < TOPK; ++k) { float bv = lg; int bi = e;
#pragma unroll
                for (int o = 1; o < 32; o <<= 1) { const float ov = __shfl_xor(bv, o); const int oi = __shfl_xor(bi, o); const bool take = (ov > bv) || (ov == bv && oi < bi); bv = take ? ov : bv; bi = take ? oi : bi; }
                tv[k] = bv; ti[k] = bi; if (e == bi) lg = -INFINITY; }
            if (lane == 0) {
                const float mx = tv[0]; float ex[TOPK], sum = 0.f;
#pragma unroll
                for (int k = 0; k < TOPK; ++k) { ex[k] = __expf(tv[k] - mx); sum += ex[k]; }
                const float inv = 1.0f / sum; const int br = buf * 8 + w;
                sel_t[br] = base + w;
#pragma unroll
                for (int k = 0; k < TOPK; ++k) { sel_e[br * 4 + k] = ti[k]; sel_g[br * 4 + k] = ex[k] * inv; }
            }
        }
        if (!live && lane == 0) sel_t[buf * 8 + w] = -1;
        if (buf == 7 || it == nit - 1) {
            const int nrow = (buf + 1) * 8;
            if (tid < NE) hist[tid] = 0;
            __syncthreads();
            int my_e = 0, my_t = -1;
            if (tid < nrow * 4) { my_t = sel_t[tid >> 2]; if (my_t >= 0) { my_e = sel_e[tid]; rank[tid] = __hip_atomic_fetch_add((int*)(hist + my_e), 1, __ATOMIC_RELAXED, __HIP_MEMORY_SCOPE_WORKGROUP); } }
            __syncthreads();
            if (tid < NE) gbase[tid] = atomicAdd(&cnt[tid], hist[tid]);
            __syncthreads();
            if (tid < nrow * 4 && my_t >= 0) { const int a = my_t * TOPK + (tid & 3), sl = gbase[my_e] + rank[tid];
                idx[a] = my_e; gate[a] = sel_g[tid]; slot[a] = sl; list[(size_t)my_e * S + sl] = a; }
        }
        __syncthreads();
    }
}

__device__ __forceinline__ void phase_final(const P& p, int bid, int Gn) {
    const int tid_ = otid(); const int lane = tid_ & 63, gw = bid * NWAVES + (tid_ >> 6), NGW = Gn * NWAVES;
    const int* cnt = (const int*)(p.ws + WS_CTL);
    const int* idx = (const int*)(p.ws + WS_IDX); const int* slot = (const int*)(p.ws + WS_SLOT);
    const float* mod = (const float*)(p.ws + WS_MOD);
    const bf16_t* X1 = (const bf16_t*)(p.ws + WS_X1);
    const bf16_t* YA = (const bf16_t*)(p.ws + WS_YA);
    int poff_l = 0;
    { int acc = 0; for (int j = 0; j < NE; ++j) { const int cj = (cnt[j] + 255) & ~255; if (lane == j) poff_l = acc; acc += cj; } }
    u32x2 ya[4][8], yan[4][8], xa[8], xan[8];
    int pr[TOPK], prn[TOPK];
#define FIN_IDS(PR, row_) do { _Pragma("unroll") for (int k = 0; k < TOPK; ++k) { const int e = idx[(row_) * TOPK + k]; PR[k] = __shfl(poff_l, e) + slot[(row_) * TOPK + k]; } } while (0)
#define FIN_LOAD(YAR, XAR, PR, row_) do { _Pragma("unroll") for (int j = 0; j < 8; ++j) { const int c0 = 4 * lane + 256 * j; \
        _Pragma("unroll") for (int k = 0; k < TOPK; ++k) YAR[k][j] = *(const u32x2*)(YA + (size_t)PR[k] * D + c0); \
        XAR[j] = *(const u32x2*)(X1 + (size_t)(row_) * D + c0); } } while (0)
    int row = gw;
    if (row < S) { FIN_IDS(pr, row); FIN_LOAD(ya, xa, pr, row); }
    if (row + NGW < S) FIN_IDS(prn, row + NGW);
    while (row < S) {
        const int nrow = row + NGW;
        if (nrow < S) FIN_LOAD(yan, xan, prn, nrow);
        if (nrow + NGW < S) FIN_IDS(pr, nrow + NGW);
        f32x4 v[8]; float ss = 0.f;
#pragma unroll
        for (int j = 0; j < 8; ++j) { const int c0 = 4 * lane + 256 * j; f32x4 m = (f32x4){0.f, 0.f, 0.f, 0.f};
#pragma unroll
            for (int k = 0; k < TOPK; ++k) m += bf4_to_f32(ya[k][j]);
            const f32x4 g2 = *(const f32x4*)(mod + 5 * D + c0);
            v[j] = bf4_to_f32(xa[j]) + g2 * m;
            ss += (v[j].x * v[j].x + v[j].y * v[j].y) + (v[j].z * v[j].z + v[j].w * v[j].w); }
        const float rs = 1.0f / sqrtf(wave_sum(ss) * (1.0f / D) + EPS);
#pragma unroll
        for (int j = 0; j < 8; ++j) { const int c0 = 4 * lane + 256 * j; const f32x4 fg = *(const f32x4*)(p.final_g + c0);
            *(f32x4*)(p.out + (size_t)row * D + c0) = v[j] * rs * fg; }
#pragma unroll
        for (int j = 0; j < 8; ++j) { xa[j] = xan[j];
#pragma unroll
            for (int k = 0; k < TOPK; ++k) ya[k][j] = yan[k][j]; }
#pragma unroll
        for (int k = 0; k < TOPK; ++k) { const int t = prn[k]; prn[k] = pr[k]; pr[k] = t; }
        row = nrow;
    }
#undef FIN_IDS
#undef FIN_LOAD
}

#define XB_TMO      128
#define XB_XCNT(j)  (256  + 64 * (j))
#define XB_XSUB(j)  (1280 + 64 * (j))
#define XB_XGEN(j)  (2304 + 64 * (j))
#define XB_TOP      3328
#define XB_TOPGEN   3392
#define XCD_BAR_WORDS 3456
#define XB_SPIN_CAP (1u << 18)

__device__ __forceinline__ unsigned xb_ld(unsigned* p)              { return __hip_atomic_load(p, __ATOMIC_RELAXED, __HIP_MEMORY_SCOPE_AGENT); }
__device__ __forceinline__ unsigned xb_add(unsigned* p, unsigned v) { return __hip_atomic_fetch_add(p, v, __ATOMIC_RELAXED, __HIP_MEMORY_SCOPE_AGENT); }
__device__ __forceinline__ unsigned xb_xcc_id() { return (unsigned)__builtin_amdgcn_s_getreg((3 << 11) | 20) & 0xFu; }
#define XB_SPIN(cond, bar) do { unsigned _sp = 0; while (cond) { __builtin_amdgcn_s_sleep(1); \
    if ((++_sp & 255u) == 0u) { if (xb_ld(&(bar)[XB_TMO])) break; if (_sp > XB_SPIN_CAP) { atomicAdd(&(bar)[XB_TMO], 1u); break; } } } } while (0)

struct XcdBarrier {
    unsigned* bar; unsigned x;
    volatile LAS unsigned* st;
};

__device__ __forceinline__ XcdBarrier xcd_barrier_post(unsigned* bar, volatile LAS unsigned* st) {
    XcdBarrier b; b.bar = bar; b.x = xb_xcc_id(); b.st = st;
    if (threadIdx.x == 0) (void)xb_add(&bar[XB_XCNT(b.x)], 1u);
    return b;
}
__device__ __forceinline__ void xcd_barrier_complete(unsigned* bar, unsigned x, unsigned& nloc, unsigned& nx) {
    const unsigned G = gridDim.x * gridDim.y * gridDim.z;
    unsigned sum, cnt, mine, sp = 0u;
    for (;;) {
        sum = 0u; cnt = 0u; mine = 0u;
#pragma unroll
        for (unsigned j = 0; j < 16; ++j) { const unsigned c = xb_ld(&bar[XB_XCNT(j)]); sum += c; cnt += (c > 0u) ? 1u : 0u; mine = (j == x) ? c : mine; }
        if (sum == G) break;
        __builtin_amdgcn_s_sleep(1);
        if ((++sp & 255u) == 0u) { if (xb_ld(&bar[XB_TMO])) break; if (sp > XB_SPIN_CAP) { atomicAdd(&bar[XB_TMO], 1u); break; } }
    }
    nloc = mine > 0u ? mine : 1u; nx = cnt > 0u ? cnt : 1u;
}

__device__ __forceinline__ void xcd_barrier(const XcdBarrier& b) {
    asm volatile("s_waitcnt vmcnt(0)" ::: "memory");
    __syncthreads();
    if (threadIdx.x == 0) {
        unsigned* bar = b.bar;
        __builtin_amdgcn_s_waitcnt(0);
        unsigned nloc = b.st[0], nx = b.st[1];
        if (nloc == 0u) { xcd_barrier_complete(bar, b.x, nloc, nx); b.st[0] = nloc; b.st[1] = nx; }
        const unsigned old = xb_add(&bar[XB_XSUB(b.x)], 1u);
        const unsigned gen = old / nloc;
        if (old + 1u == (gen + 1u) * nloc) {
            __builtin_amdgcn_fence(__ATOMIC_RELEASE, "agent");
            asm volatile("s_waitcnt vmcnt(0)" ::: "memory");
            const unsigned og = xb_add(&bar[XB_TOP], 1u);
            const unsigned tg = og / nx;
            if (og + 1u == (tg + 1u) * nx) xb_add(&bar[XB_TOPGEN], 1u);
            else XB_SPIN(xb_ld(&bar[XB_TOPGEN]) == tg, bar);
            __builtin_amdgcn_fence(__ATOMIC_ACQUIRE, "agent");
            xb_add(&bar[XB_XGEN(b.x)], 1u);
            asm volatile("s_waitcnt vmcnt(0)" ::: "memory");
        } else {
            XB_SPIN(xb_ld(&bar[XB_XGEN(b.x)]) == gen, bar);
            __builtin_amdgcn_fence(__ATOMIC_ACQUIRE, "agent");
            asm volatile("s_waitcnt vmcnt(0)" ::: "memory");
        }
    }
    __syncthreads();
}
constexpr int CW_BAR = 4096;
constexpr int MISC_OFF = 147456;

typedef __attribute__((address_space(4))) const Args CArgs;
__device__ __forceinline__ const Args* kargs() { CArgs* k = (CArgs*)__builtin_amdgcn_kernarg_segment_ptr(); asm volatile("" : "+s"(k)); return (const Args*)k; }
__device__ __forceinline__ const float* asg(const float* q) { return (const float*)(GAS const float*)q; }
__device__ __forceinline__ P globalize(const P& q) {
    P r;
#define GZ(m) r.m = asg(q.m)
    GZ(x); GZ(c); GZ(w_ada); GZ(b_ada); GZ(norm1_g); GZ(w_in); GZ(lam_re); GZ(lam_im); GZ(b_re); GZ(b_im); GZ(c_re); GZ(c_im); GZ(d_skip); GZ(log_dt);
    GZ(w_glu); GZ(b_glu); GZ(attn_g); GZ(ssm_g); GZ(w_out); GZ(norm2_g); GZ(w_router); GZ(b_router); GZ(w_gu); GZ(b_gu); GZ(w_down); GZ(b_down); GZ(final_g);
#undef GZ
    r.out = (float*)(GAS float*)q.out; r.ws = (unsigned char*)(GAS unsigned char*)q.ws;
    return r;
}
__global__ void __launch_bounds__(NWAVES * 64, 2) mk_fwd(Args args_unused) {
    extern __shared__ __attribute__((aligned(16))) unsigned char lds_raw[];
    LAS unsigned char* lds = (LAS unsigned char*)lds_raw;
    const int lo = kargs()->ph_lo, hi = kargs()->ph_hi;
    const int Gn = gridDim.x, bid = blockIdx.x;
    if (threadIdx.x == 0) *(LAS u32x4*)(lds + MISC_OFF) = (u32x4){0u, 0u, 0u, 0u};
    __syncthreads();
    XcdBarrier bar; bar.bar = nullptr; bar.x = 0; bar.st = nullptr;
    if (hi - lo > 1) { unsigned* bw = (unsigned*)((unsigned char*)(GAS unsigned char*)kargs()->p.ws + WS_CTL) + CW_BAR; bar = xcd_barrier_post(bw, (volatile LAS unsigned*)(lds + MISC_OFF)); }
#define SEAM(k) do { if (lo <= (k) && (k) + 1 < hi) xcd_barrier(bar); } while (0)
#ifndef PHMASK
#define PHMASK 0x1fff
#endif
#define IN(k) (((PHMASK >> (k)) & 1) && lo <= (k) && (k) < hi)
#ifndef REPMASK
#define REPMASK 0
#endif
#define REPS(k) for (int rep_ = 0; rep_ < ((((REPMASK) >> (k)) & 1) ? 2 : 1); ++rep_)
#define PHASE_P const P p = globalize(kargs()->p); unsigned char* ws = p.ws; (void)ws
    if (IN(0)) REPS(0) { __syncthreads(); PHASE_P; phase_prologue(p, lds, bid, Gn); }
    SEAM(0);
    if (IN(1)) REPS(1) { __syncthreads(); PHASE_P; phase_norm1(p, bid, Gn); }
    SEAM(1);
    if (IN(2)) REPS(2) { __syncthreads();
        PHASE_P;
        typedef pg8::DenseSched<WS_HB, WS_WIN, S, INW, D> Sch; Sch Sd; Sd.init(ws, Gn, bid);
        pg8::EpiProj E{(bf16_t*)(ws + WS_QKV), (bf16_t*)(ws + WS_UB2)};
        pg8::gemm_phase<pg8::EpiProj, Sch>(lds + RING_OFF, Sd, E);
    }
    SEAM(2);
    if (IN(3)) REPS(3) { __syncthreads();
        PHASE_P;
        {   typedef pg8::S5Sched<0> Sch; Sch Ss; Ss.init(ws, Gn, bid);
            pg8::EpiS5E E{(float*)(ws + WS_EF)};
            pg8::gemm_phase<pg8::EpiS5E, Sch>(lds + RING_OFF, Ss, E); }
        __syncthreads();
        phase_attn(p, lds, bid, Gn);
    }
    SEAM(3);
    if (IN(4)) REPS(4) { __syncthreads(); PHASE_P; phase_s5_carry(p, bid); }
    SEAM(4);
    if (IN(5)) REPS(5) { __syncthreads();
        PHASE_P;
        typedef pg8::S5Sched<1> Sch; Sch Ss; Ss.init(ws, Gn, bid);
        pg8::EpiS5Y E{(bf16_t*)(ws + WS_YGB)};
        pg8::gemm_phase<pg8::EpiS5Y, Sch>(lds + RING_OFF, Ss, E);
    }
    SEAM(5);
    if (IN(6)) REPS(6) { __syncthreads();
        PHASE_P;
        typedef pg8::DenseSched<WS_YGB, WS_WGLU, S, SW, SW> Sch; Sch Sd; Sd.init(ws, Gn, bid);
        pg8::EpiGlu E{(const bf16_t*)(ws + WS_YGB), p.b_glu, (bf16_t*)(ws + WS_Z)};
        pg8::gemm_phase<pg8::EpiGlu, Sch>(lds + RING_OFF, Sd, E);
    }
    SEAM(6);
    if (IN(7)) REPS(7) { __syncthreads(); PHASE_P; phase_mix(p, bid, Gn); }
    SEAM(7);
    if (IN(8)) REPS(8) { __syncthreads();
        PHASE_P;
        typedef pg8::DenseSched<WS_YMIXB, WS_WOUT, S, D, D> Sch; Sch Sd; Sd.init(ws, Gn, bid);
        pg8::EpiResid E{p.x, (const float*)(ws + WS_MOD) + 2 * D, (bf16_t*)(ws + WS_X1)};
        pg8::gemm_phase<pg8::EpiResid, Sch>(lds + RING_OFF, Sd, E);
    }
    SEAM(8);
    if (IN(9)) REPS(9) { __syncthreads(); PHASE_P; phase_norm2_router(p, lds, bid, Gn); }
    SEAM(9);
    if (IN(10)) REPS(10) { __syncthreads();
        PHASE_P;
        pg8::MoeSched<1> Sm; Sm.init(ws, Gn, bid);
        pg8::EpiMoe1 E{p.b_gu, ws + WS_ACT};
        pg8::gemm_phase<pg8::EpiMoe1, pg8::MoeSched<1>>(lds + RING_OFF, Sm, E);
    }
    SEAM(10);
    if (IN(11)) REPS(11) { __syncthreads();
        PHASE_P;
        pg8::MoeSched<2> Sm; Sm.init(ws, Gn, bid);
        pg8::EpiMoe2 E{p.b_down, ws};
        pg8::gemm_phase<pg8::EpiMoe2, pg8::MoeSched<2>>(lds + RING_OFF, Sm, E);
    }
    SEAM(11);
    if (IN(12)) REPS(12) { __syncthreads(); PHASE_P; phase_final(p, bid, Gn); }
#undef IN
#undef PHASE_P
#undef SEAM
}

extern "C" void kernel_launch(void* const* d_in, const int* in_sizes, int n_in, void* d_out, int out_size, void* d_ws, size_t ws_size, hipStream_t stream) {
    static int grid = 0;
    if (grid == 0) {
        if (n_in != 27 || ws_size < WS_END) { fprintf(stderr, "kernel_launch: unexpected n_in %d or ws_size %zu (< %zu)\n", n_in, ws_size, (size_t)WS_END); grid = -1; return; }
        int dev = 0, cus = 0;
        if (hipGetDevice(&dev) != hipSuccess || hipDeviceGetAttribute(&cus, hipDeviceAttributeMultiprocessorCount, dev) != hipSuccess) { grid = -1; return; }
        if (hipFuncSetAttribute((const void*)mk_fwd, hipFuncAttributeMaxDynamicSharedMemorySize, LDS_BYTES) != hipSuccess) { fprintf(stderr, "hipFuncSetAttribute failed\n"); grid = -1; return; }
        grid = cus;
    }
    if (grid < 0) return;
    Args a{};
    const float** f = (const float**)&a.p;
    for (int i = 0; i < 27; ++i) f[i] = (const float*)d_in[i];
    a.p.out = (float*)d_out; a.p.ws = (unsigned char*)d_ws;
    (void)hipMemsetAsync(a.p.ws + WS_CTL, 0, 1 * MiB, stream);
#ifndef MK_PER_PHASE
    a.ph_lo = 0; a.ph_hi = 13; hipLaunchKernelGGL(mk_fwd, dim3(grid), dim3(NWAVES * 64), LDS_BYTES, stream, a);
#else
    for (int ph = 0; ph < 13; ++ph) { a.ph_lo = ph; a.ph_hi = ph + 1; hipLaunchKernelGGL(mk_fwd, dim3(grid), dim3(NWAVES * 64), LDS_BYTES, stream, a); }
#endif
}
```

```cpp
#include <hip/hip_runtime.h>
#include <cstdio>
#include <cstdint>

#ifndef MOE_FP8
#define MOE_FP8 1
#endif
constexpr int S = 16384, D = 2048, AW = 1024, SW = 1024, INW = 4096, NH = 16, HD = 64;
constexpr int G = 64, NS = 64, PC = 16;
constexpr int NE = 32, TOPK = 4, FF = 2048;
constexpr int LCH = 32, NCH = S / LCH;
constexpr int CROWS = 40;
constexpr int KS5 = 640, KS5E = 512;
constexpr int NASSIGN = S * TOPK;
constexpr int PADROWS = NASSIGN + NE * 256;
constexpr float EPS = 1e-6f;

constexpr size_t MiB = 1ull << 20;
constexpr size_t WS_CTL = 0;
constexpr size_t WS_MOD = 1 * MiB;
constexpr size_t WS_S5P = 2 * MiB;
constexpr size_t WS_IDX = 4 * MiB;
constexpr size_t WS_GATE = 5 * MiB;
constexpr size_t WS_SLOT = 6 * MiB;
constexpr size_t WS_LIST = 8 * MiB;
constexpr size_t WS_ECH = 12 * MiB;
constexpr size_t WS_X0 = 16 * MiB;
constexpr size_t WS_WIN = 32 * MiB;
constexpr size_t WS_WGLU = 48 * MiB;
constexpr size_t WS_WOUT = 50 * MiB;
constexpr size_t WS_HB = 64 * MiB;
constexpr size_t WS_PROJ = 128 * MiB;
constexpr size_t WS_QKV = WS_PROJ;
constexpr size_t WS_UB2 = WS_PROJ + 96 * MiB;
constexpr size_t WS_OB = WS_PROJ + 160 * MiB;
constexpr size_t WS_LSE = 20 * MiB;
constexpr size_t WS_YATT = WS_PROJ + 256 * MiB;
constexpr size_t WS_S5E = WS_YATT;
constexpr size_t WS_EF = WS_YATT + 16 * MiB;
constexpr size_t WS_YG = WS_YATT + 64 * MiB;
constexpr size_t WS_S5T = WS_YG;
constexpr size_t WS_YGB = WS_YG + 64 * MiB;
constexpr size_t WS_Z = WS_YGB + 32 * MiB;
constexpr size_t WS_YMIXB = WS_Z + 64 * MiB;
constexpr size_t WS_X1 = WS_YMIXB + 64 * MiB;
constexpr size_t WS_H2 = WS_X1 + 128 * MiB;
constexpr size_t WS_ACT = WS_H2 + 128 * MiB;
constexpr size_t WS_YA = WS_ACT + 288 * MiB;
constexpr size_t WS_WGU = WS_YA + 288 * MiB;
constexpr size_t WS_WDN = WS_WGU + 512 * MiB;
constexpr size_t WS_END = WS_WDN + 256 * MiB;

struct P {
    const float *x, *c, *w_ada, *b_ada, *norm1_g, *w_in, *lam_re, *lam_im, *b_re, *b_im, *c_re, *c_im, *d_skip, *log_dt,
        *w_glu, *b_glu, *attn_g, *ssm_g, *w_out, *norm2_g, *w_router, *b_router, *w_gu, *b_gu, *w_down, *b_down, *final_g;
    float* out;
    unsigned char* ws;
};
struct Args { P p; int ph_lo, ph_hi; };

#define GAS __attribute__((address_space(1)))
#define LAS __attribute__((address_space(3)))
typedef unsigned short bf16_t;
typedef short bf16x8 __attribute__((ext_vector_type(8)));
typedef float f32x4 __attribute__((ext_vector_type(4)));
typedef float f32x2 __attribute__((ext_vector_type(2)));
typedef unsigned u32x4 __attribute__((ext_vector_type(4)));
typedef unsigned u32x2 __attribute__((ext_vector_type(2)));
typedef int v4i32 __attribute__((ext_vector_type(4)));
typedef int v8i32 __attribute__((ext_vector_type(8)));

__device__ __forceinline__ float wave_sum(float v) {
#pragma unroll
    for (int o = 1; o < 64; o <<= 1) v += __shfl_xor(v, o);
    return v;
}
__device__ __forceinline__ float block_sum256(float v, float* red) {
    v = wave_sum(v);
    __syncthreads();
    if ((threadIdx.x & 63) == 0) red[threadIdx.x >> 6] = v;
    __syncthreads();
    return red[0] + red[1] + red[2] + red[3];
}
__device__ __forceinline__ float sigmoidf_(float x) { return __builtin_amdgcn_rcpf(1.0f + __builtin_amdgcn_exp2f(-1.4426950408889634f * x)); }
__device__ __forceinline__ unsigned cvt_pk_bf16(float lo, float hi) { unsigned r; asm volatile("v_cvt_pk_bf16_f32 %0, %1, %2" : "=v"(r) : "v"(lo), "v"(hi)); return r; }
__device__ __forceinline__ unsigned pk4_fp8(float a, float b, float c, float d) { int w = 0; w = __builtin_amdgcn_cvt_pk_fp8_f32(a, b, w, false); w = __builtin_amdgcn_cvt_pk_fp8_f32(c, d, w, true); return (unsigned)w; }
__device__ __forceinline__ f32x4 bf4_to_f32(u32x2 v) { return (f32x4){__uint_as_float(v.x << 16), __uint_as_float(v.x & 0xffff0000u), __uint_as_float(v.y << 16), __uint_as_float(v.y & 0xffff0000u)}; }
__device__ __forceinline__ float bf2f(bf16_t b) { return __uint_as_float(((unsigned)b) << 16); }
__device__ __forceinline__ bf16_t f2bf(float f) { return (bf16_t)(cvt_pk_bf16(f, 0.f) & 0xffffu); }
__device__ __forceinline__ int otid() { int t = threadIdx.x; asm volatile("" : "+v"(t)); return t; }

namespace pg8 {
constexpr int BM = 256, BK = 64, HALF = 128, HTB = HALF * BK * 2  , STAGE_BYTES = 8 * HTB, NXCD = 8, WGM = 8;
__host__ __device__ __forceinline__ int lds_byte(int r, int c) { const int st = (r >> 4) * 2 + (c >> 5), rr = r & 15, cc = c & 31, ob = rr * 64 + cc * 2; return st * 1024 + (ob ^ (((ob >> 9) & 1) << 5)); }
__host__ __device__ __forceinline__ void stage_rc(int b, int& R, int& C) { const int st = b / 1024, sb = b % 1024, swz = sb ^ (((sb >> 9) & 1) << 5); R = (st >> 1) * 16 + swz / 64; C = (st & 1) * 32 + (swz % 64) / 2; }
__host__ __device__ __forceinline__ int perm32(int rho) { const int n = rho >> 4, i = rho & 15; return 8 * (i >> 2) + 4 * n + (i & 3); }

struct Unit { int pm, pn, e, mt; };

__device__ __forceinline__ bool flat_to_tile(long L, int nM, int nN, int& pm, int& pn) {
    const int nwg = nM * nN; if (L >= nwg) return false;
    int wgid = (int)L; { const int q = nwg / NXCD, r = nwg % NXCD, xcd = wgid % NXCD, off = wgid / NXCD; wgid = (xcd < r ? xcd * (q + 1) : r * (q + 1) + (xcd - r) * q) + off; }
    const int nig = WGM * nN, gid = wgid / nig, fm = gid * WGM, gsz = (nM - fm) < WGM ? (nM - fm) : WGM;
    pm = fm + ((wgid % nig) % gsz); pn = (wgid % nig) / gsz; return true;
}

template <size_t AOFF, size_t BOFF, int M_, int N_, int K_>
struct DenseSched {
    static constexpr bool GATHER = false, FP8 = false;
    static constexpr int K = K_, nM = M_ / BM, nN = N_ / BM, KSTEP_A = 128;
    const unsigned char* ws; int Gn, c;
    __device__ void init(const unsigned char* ws_, int G_, int c_) { ws = ws_; Gn = G_; c = c_; }
    __device__ __forceinline__ bool next(int i, Unit& u) const { u.e = 0; u.mt = 0; return flat_to_tile((long)i * Gn + c, nM, nN, u.pm, u.pn); }
    __device__ __forceinline__ const char* a_ptr(const Unit& u) const { return (const char*)ws + AOFF + (size_t)u.pm * BM * K * 2; }
    __device__ __forceinline__ const char* b_ptr(const Unit& u) const { return (const char*)ws + BOFF + (size_t)u.pn * BM * K * 2; }
    __device__ __forceinline__ void a_off(const Unit&, unsigned (&off)[2][2]) const {
        const int tid = otid();
#pragma unroll
        for (int i = 0; i < 2; ++i) { int R, C; stage_rc(tid * 16 + i * 8192, R, C);
#pragma unroll
            for (int h = 0; h < 2; ++h) off[h][i] = (unsigned)((h * HALF + R) * K + C) * 2u; }
    }
};

template <int STAGE>
struct MoeSched {
    static constexpr bool GATHER = true, FP8 = (MOE_FP8 != 0);
    static constexpr int K = (STAGE == 1) ? D : FF, N = (STAGE == 1) ? 2 * FF : D, nN = N / BM, KSTEP_A = 128, KB = FP8 ? K : 2 * K;
    static constexpr size_t AOFF = (STAGE == 1) ? WS_HB : WS_ACT, BOFF = (STAGE == 1) ? WS_WGU : WS_WDN;
    const unsigned char* ws; int nM, Gn, c;
    __device__ void init(const unsigned char* ws_, int G_, int c_) {
        ws = ws_; Gn = G_; c = c_;
        const int* cnt = (const int*)(ws + WS_CTL);
        int t = 0; for (int j = 0; j < NE; ++j) t += (cnt[j] + 255) >> 8; nM = __builtin_amdgcn_readfirstlane(t);
    }
    __device__ __forceinline__ bool next(int i, Unit& u) const {
        if (!flat_to_tile((long)i * Gn + c, nM, nN, u.pm, u.pn)) return false;
        const int* cnt = (const int*)(ws + WS_CTL);
        int acc = 0, e = 0, mt = 0;
        for (int j = 0; j < NE; ++j) { const int nt = (cnt[j] + 255) >> 8; if (u.pm >= acc && u.pm < acc + nt) { e = j; mt = u.pm - acc; } acc += nt; }
        u.e = __builtin_amdgcn_readfirstlane(e); u.mt = __builtin_amdgcn_readfirstlane(mt); return true;
    }
    __device__ __forceinline__ const char* a_ptr(const Unit& u) const { return (STAGE == 1) ? (const char*)ws + AOFF : (const char*)ws + AOFF + (size_t)u.pm * BM * KB; }
    __device__ __forceinline__ const char* b_ptr(const Unit& u) const { return (const char*)ws + BOFF + ((size_t)u.e * N + (size_t)u.pn * BM) * KB; }
    __device__ __forceinline__ void a_off(const Unit& u, unsigned (&off)[2][2]) const {
        const int tid = otid();
        if (STAGE == 1) {
            const int* cnt = (const int*)(ws + WS_CTL); const int* list = (const int*)(ws + WS_LIST);
            const int ce = __builtin_amdgcn_readfirstlane(cnt[u.e]);
#pragma unroll
            for (int i = 0; i < 2; ++i) { int R, C; stage_rc(tid * 16 + i * 8192, R, C);
#pragma unroll
                for (int h = 0; h < 2; ++h) { int lr = u.mt * BM + h * HALF + R; lr = lr < ce ? lr : ce - 1; const int tok = list[(size_t)u.e * S + lr] >> 2; off[h][i] = (unsigned)(tok * KB + C * 2); } }
        } else {
#pragma unroll
            for (int i = 0; i < 2; ++i) { int R, C; stage_rc(tid * 16 + i * 8192, R, C);
#pragma unroll
                for (int h = 0; h < 2; ++h) off[h][i] = (unsigned)((h * HALF + R) * KB + C * 2); }
        }
    }
};

template <int MODE>
struct S5Sched {
    static constexpr bool GATHER = true, FP8 = false;
    static constexpr int K = MODE ? KS5 : KS5E, KSTEP_A = 4 * 1024 * 2, NCT = MODE ? 2 : 1, NUNITS = G * 2 * NCT;
    const unsigned char* ws; int Gn, c;
    __device__ void init(const unsigned char* ws_, int G_, int c_) { ws = ws_; Gn = G_; c = c_; }
    __device__ __forceinline__ bool next(int i, Unit& u) const {
        const int L = i * Gn + c; if (L >= NUNITS) return false;
        u.e = L / (2 * NCT); const int rem = L % (2 * NCT); u.pm = rem / NCT; u.pn = rem % NCT; u.mt = 0; return true;
    }
    __device__ __forceinline__ const char* a_ptr(const Unit& u) const { return (const char*)ws + WS_UB2 + (size_t)u.e * (PC * 2); }
    __device__ __forceinline__ const char* b_ptr(const Unit& u) const { return (const char*)ws + (MODE ? WS_S5T : WS_S5E) + ((size_t)u.e * (MODE ? 512 : 256) + (size_t)u.pn * BM) * K * 2; }
    __device__ __forceinline__ void a_off(const Unit& u, unsigned (&off)[2][2]) const {
        const int tid = otid();
#pragma unroll
        for (int i = 0; i < 2; ++i) { int R, C; stage_rc(tid * 16 + i * 8192, R, C);
#pragma unroll
            for (int h = 0; h < 2; ++h) off[h][i] = (unsigned)(((u.pm * BM + h * HALF + R) * CROWS + (C >> 4)) * 2048 + (C & 15) * 2); }
    }
};

template <class Epi, class Sched>
__device__ __forceinline__ void gemm_phase(LAS unsigned char* lds, const Sched& S, const Epi& E) {
    const int tid = otid(), wid = __builtin_amdgcn_readfirstlane(tid >> 6), lane = tid & 63, wr = wid >> 2, wc = wid & 3, fr = lane & 15, fq = lane >> 4;
    constexpr int K = Sched::K, KB = Sched::FP8 ? K : 2 * K, nt = KB / (BK * 2);
    unsigned voffB[2];
#pragma unroll
    for (int i = 0; i < 2; ++i) { int sR, sC; stage_rc(tid * 16 + i * 8192, sR, sC); const int Rb = Epi::PERM ? ((sR & ~31) + perm32(sR & 31)) : sR; voffB[i] = (unsigned)(Rb * KB + sC * 2); }
    const size_t kstep = (size_t)(BK * 2);
    constexpr size_t kstepA = (size_t)Sched::KSTEP_A;
    const size_t hstep = (size_t)HALF * KB;
    const unsigned ldsw = (unsigned)wid * 1024u;
    const int aoff = lds_byte(wr * 64 + fr, fq * 8), boff = lds_byte(wc * 32 + fr, fq * 8);
#define PG8_SA(b, h) (((b) * 2 + (h)) * HTB)
#define PG8_SB(b, h) ((4 + (b) * 2 + (h)) * HTB)
#define PG8_STAGE(bufoff, gbase, voff) do { _Pragma("unroll") for (int _i = 0; _i < 2; ++_i) \
        __builtin_amdgcn_global_load_lds((const unsigned*)((const char*)(gbase) + (voff)[_i]), (LAS unsigned*)(lds + (bufoff) + ldsw + _i * 8192), 16, 0, 0); } while (0)
#define PG8_LDA(dst, b, h) do { _Pragma("unroll") for (int m = 0; m < 4; ++m) _Pragma("unroll") for (int k = 0; k < 2; ++k) dst[m][k] = *(const LAS bf16x8*)(lds + PG8_SA(b, h) + aoff + m * 2048 + k * 1024); } while (0)
#define PG8_LDB(dst, b, h) do { _Pragma("unroll") for (int n = 0; n < 2; ++n) _Pragma("unroll") for (int k = 0; k < 2; ++k) dst[n][k] = *(const LAS bf16x8*)(lds + PG8_SB(b, h) + boff + n * 2048 + k * 1024); } while (0)
#define PG8_MMA(ai, bj, At, Bt) do { __builtin_amdgcn_s_setprio(1); _Pragma("unroll") for (int m = 0; m < 4; ++m) _Pragma("unroll") for (int n = 0; n < 2; ++n) { \
        if constexpr (Sched::FP8) {   \
            const v8i32 a8_ = __builtin_shufflevector(__builtin_bit_cast(v4i32, At[m][0]), __builtin_bit_cast(v4i32, At[m][1]), 0, 1, 2, 3, 4, 5, 6, 7); \
            const v8i32 b8_ = __builtin_shufflevector(__builtin_bit_cast(v4i32, Bt[n][0]), __builtin_bit_cast(v4i32, Bt[n][1]), 0, 1, 2, 3, 4, 5, 6, 7); \
            acc[ai][bj][m][n] = __builtin_amdgcn_mfma_scale_f32_16x16x128_f8f6f4(b8_, a8_, acc[ai][bj][m][n], 0, 0, 0, 0x79797979  , 0, 0x7f7f7f7f); \
        } else { _Pragma("unroll") for (int k = 0; k < 2; ++k) acc[ai][bj][m][n] = __builtin_amdgcn_mfma_f32_16x16x32_bf16(Bt[n][k], At[m][k], acc[ai][bj][m][n], 0, 0, 0); } } \
        __builtin_amdgcn_s_setprio(0); } while (0)
#define PG8_WAIT_V(n) asm volatile("s_waitcnt vmcnt(" #n ")" ::: "memory")
#define PG8_WAIT_L(n) asm volatile("s_waitcnt lgkmcnt(" #n ")" ::: "memory")
#define PG8_BAR __builtin_amdgcn_s_barrier()
#define PG8_SCHED __builtin_amdgcn_sched_barrier(0)
    Unit cur, nxt; int ui = 0;
    if (!S.next(0, cur)) return;
    f32x4 acc[2][2][4][2];
#pragma unroll
    for (int a = 0; a < 2; ++a)
#pragma unroll
        for (int b = 0; b < 2; ++b)
#pragma unroll
            for (int m = 0; m < 4; ++m)
#pragma unroll
                for (int n = 0; n < 2; ++n) acc[a][b][m][n] = (f32x4){0.f, 0.f, 0.f, 0.f};
    bf16x8 At[4][2], B0[2][2], B1[2][2];
    const char* cA = S.a_ptr(cur); const char* cB = S.b_ptr(cur);
    unsigned ao[2][2]; S.a_off(cur, ao);
    PG8_STAGE(PG8_SB(0, 0), cB, voffB); PG8_STAGE(PG8_SB(0, 1), cB + hstep, voffB); PG8_STAGE(PG8_SA(0, 0), cA, ao[0]); PG8_STAGE(PG8_SA(0, 1), cA, ao[1]);
    if (wr == 1) PG8_BAR;
    PG8_WAIT_V(2); PG8_BAR;
    PG8_STAGE(PG8_SB(1, 0), cB + kstep, voffB); PG8_STAGE(PG8_SA(1, 0), cA + kstepA, ao[0]); PG8_STAGE(PG8_SB(1, 1), cB + hstep + kstep, voffB);
    PG8_WAIT_V(6); PG8_BAR;
    for (;;) {
        const bool has_next = S.next(ui + 1, nxt);
        const char* nA = has_next ? S.a_ptr(nxt) : cA; const char* nB = has_next ? S.b_ptr(nxt) : cB;
        for (int t = 0; t < nt; t += 2) {
            const bool last = (t == nt - 2);
            const char* a1 = cA + (size_t)(t + 1) * kstepA;
            const char* a2 = last ? nA : cA + (size_t)(t + 2) * kstepA; const char* b2 = last ? nB : cB + (size_t)(t + 2) * kstep;
            const char* a3 = a2 + kstepA; const char* b3 = b2 + kstep;
            asm volatile("" : "+v"(voffB[0]), "+v"(voffB[1]), "+v"(ao[0][0]), "+v"(ao[0][1]), "+v"(ao[1][0]), "+v"(ao[1][1]));

            PG8_LDB(B0, 0, 0); PG8_LDB(B1, 0, 1); PG8_SCHED; PG8_LDA(At, 0, 0); PG8_STAGE(PG8_SA(1, 1), a1, ao[1]);
            PG8_WAIT_V(8); PG8_WAIT_L(0); PG8_BAR; PG8_MMA(0, 0, At, B0); PG8_MMA(0, 1, At, B1); PG8_BAR; PG8_SCHED;
            if (Sched::GATHER) { if (last && has_next) S.a_off(nxt, ao); }
            PG8_LDA(At, 0, 1); PG8_STAGE(PG8_SB(0, 0), b2, voffB); PG8_STAGE(PG8_SB(0, 1), b2 + hstep, voffB); PG8_STAGE(PG8_SA(0, 0), a2, ao[0]);
            PG8_WAIT_V(8); PG8_WAIT_L(0); PG8_BAR; PG8_MMA(1, 0, At, B0); PG8_MMA(1, 1, At, B1); PG8_BAR; PG8_SCHED;
            PG8_LDB(B0, 1, 0); PG8_LDB(B1, 1, 1); PG8_SCHED; PG8_LDA(At, 1, 0); PG8_STAGE(PG8_SA(0, 1), a2, ao[1]);
            PG8_WAIT_V(8); PG8_WAIT_L(0); PG8_BAR; PG8_MMA(0, 0, At, B0); PG8_MMA(0, 1, At, B1); PG8_BAR; PG8_SCHED;
            PG8_LDA(At, 1, 1); PG8_STAGE(PG8_SB(1, 0), b3, voffB); PG8_STAGE(PG8_SB(1, 1), b3 + hstep, voffB); PG8_STAGE(PG8_SA(1, 0), a3, ao[0]);
            PG8_WAIT_V(8); PG8_WAIT_L(0); PG8_BAR; PG8_MMA(1, 0, At, B0); PG8_MMA(1, 1, At, B1); PG8_BAR; PG8_SCHED;
        }
        if (wr == 0) PG8_BAR;
        {
            const int t2 = otid(), wid2 = __builtin_amdgcn_readfirstlane(t2 >> 6), lane2 = t2 & 63;
            E(acc, cur, wid2 >> 2, wid2 & 3, lane2 & 15, lane2 >> 4); }
        if (!has_next) break;
#pragma unroll
        for (int a = 0; a < 2; ++a)
#pragma unroll
            for (int b = 0; b < 2; ++b)
#pragma unroll
                for (int m = 0; m < 4; ++m)
#pragma unroll
                    for (int n = 0; n < 2; ++n) acc[a][b][m][n] = (f32x4){0.f, 0.f, 0.f, 0.f};
        cur = nxt; cA = nA; cB = nB; ++ui;
        if (wr == 1) PG8_BAR;
    }
    PG8_WAIT_V(0);
    PG8_BAR;
#undef PG8_SA
#undef PG8_SB
#undef PG8_STAGE
#undef PG8_LDA
#undef PG8_LDB
#undef PG8_MMA
#undef PG8_WAIT_V
#undef PG8_WAIT_L
#undef PG8_BAR
#undef PG8_SCHED
}

struct EpiF32 {
    static constexpr bool PERM = false;
    float* C; int ldc;
    __device__ __forceinline__ void operator()(const f32x4 (&acc)[2][2][4][2], const Unit& u, int wr, int wc, int fr, int fq) const {
        const int row0 = u.pm * BM + wr * 64 + fr, col0 = u.pn * BM + wc * 32 + 4 * fq;
#pragma unroll
        for (int ai = 0; ai < 2; ++ai)
#pragma unroll
            for (int m = 0; m < 4; ++m) { float* rowp = C + (size_t)(row0 + ai * HALF + m * 16) * ldc + col0;
#pragma unroll
                for (int bj = 0; bj < 2; ++bj)
#pragma unroll
                    for (int n = 0; n < 2; ++n) *(f32x4*)(rowp + bj * HALF + n * 16) = acc[ai][bj][m][n]; }
    }
};
struct EpiGlu {
    static constexpr bool PERM = false;
    const bf16_t* yg; const float* bias; bf16_t* Z;
    __device__ __forceinline__ void operator()(const f32x4 (&acc)[2][2][4][2], const Unit& u, int wr, int wc, int fr, int fq) const {
        const int row0 = u.pm * BM + wr * 64 + fr, col0 = u.pn * BM + wc * 32 + 4 * fq;
#pragma unroll
        for (int ai = 0; ai < 2; ++ai)
#pragma unroll
            for (int m = 0; m < 4; ++m) { const size_t ro = (size_t)(row0 + ai * HALF + m * 16) * SW + col0;
#pragma unroll
                for (int bj = 0; bj < 2; ++bj)
#pragma unroll
                    for (int n = 0; n < 2; ++n) { const int co = bj * HALF + n * 16; const u32x2 yb = *(const u32x2*)(yg + ro + co); const f32x4 y = (f32x4){__uint_as_float(yb.x << 16), __uint_as_float(yb.x & 0xffff0000u), __uint_as_float(yb.y << 16), __uint_as_float(yb.y & 0xffff0000u)};
                        const f32x4 b = *(const f32x4*)(bias + col0 + co); f32x4 o;
#pragma unroll
                        for (int j = 0; j < 4; ++j) o[j] = y[j] * sigmoidf_(acc[ai][bj][m][n][j] + b[j]);
                        u32x2 zw; zw.x = cvt_pk_bf16(o[0], o[1]); zw.y = cvt_pk_bf16(o[2], o[3]); *(u32x2*)(Z + ro + co) = zw; } }
    }
};
struct EpiResid {
    static constexpr bool PERM = false;
    const float* x; const float* gate; bf16_t* X1;
    __device__ __forceinline__ void operator()(const f32x4 (&acc)[2][2][4][2], const Unit& u, int wr, int wc, int fr, int fq) const {
        const int row0 = u.pm * BM + wr * 64 + fr, col0 = u.pn * BM + wc * 32 + 4 * fq;
#pragma unroll
        for (int ai = 0; ai < 2; ++ai)
#pragma unroll
            for (int m = 0; m < 4; ++m) { const size_t ro = (size_t)(row0 + ai * HALF + m * 16) * D + col0;
#pragma unroll
                for (int bj = 0; bj < 2; ++bj)
#pragma unroll
                    for (int n = 0; n < 2; ++n) { const int co = bj * HALF + n * 16; const f32x4 xv = *(const f32x4*)(x + ro + co); const f32x4 g = *(const f32x4*)(gate + col0 + co);
                        const f32x4 o = xv + g * acc[ai][bj][m][n]; u32x2 ow; ow.x = cvt_pk_bf16(o[0], o[1]); ow.y = cvt_pk_bf16(o[2], o[3]); *(u32x2*)(X1 + ro + co) = ow; } }
    }
};
struct EpiMoe1 {
    static constexpr bool PERM = true;
    const float* b_gu; unsigned char* ACT;
    __device__ __forceinline__ void operator()(const f32x4 (&acc)[2][2][4][2], const Unit& u, int wr, int wc, int fr, int fq) const {
        const int row0 = u.pm * BM + wr * 64 + fr, j0 = u.pn * HALF + wc * 32 + 8 * fq;
        const float* bias = b_gu + (size_t)u.e * 2 * FF + 2 * j0;
        float bg[8], bl[8];
#pragma unroll
        for (int j = 0; j < 8; ++j) { bg[j] = bias[2 * j]; bl[j] = bias[2 * j + 1]; }
#pragma unroll
        for (int ai = 0; ai < 2; ++ai)
#pragma unroll
            for (int m = 0; m < 4; ++m) { const size_t eo = (size_t)(row0 + ai * HALF + m * 16) * FF + j0; float o[8];
#pragma unroll
                for (int n = 0; n < 2; ++n)
#pragma unroll
                    for (int j = 0; j < 4; ++j) { const float gl = fminf(acc[ai][0][m][n][j] + bg[4 * n + j], 7.0f); const float ln = fminf(fmaxf(acc[ai][1][m][n][j] + bl[4 * n + j], -7.0f), 7.0f);
                        o[4 * n + j] = gl * sigmoidf_(1.702f * gl) * (ln + 1.0f); }
#if MOE_FP8
                u32x2 w; w.x = pk4_fp8(o[0], o[1], o[2], o[3]); w.y = pk4_fp8(o[4], o[5], o[6], o[7]);
                *(u32x2*)(ACT + eo) = w; }
#else
                u32x4 w; w.x = cvt_pk_bf16(o[0], o[1]); w.y = cvt_pk_bf16(o[2], o[3]); w.z = cvt_pk_bf16(o[4], o[5]); w.w = cvt_pk_bf16(o[6], o[7]);
                *(u32x4*)(ACT + eo * 2) = w; }
#endif
    }
};
struct EpiMoe2 {
    static constexpr bool PERM = true;
    const float* b_down; const unsigned char* ws;
    __device__ __forceinline__ void operator()(const f32x4 (&acc)[2][2][4][2], const Unit& u, int wr, int wc, int fr, int fq) const {
        const int lr0 = u.mt * BM + wr * 64 + fr, row0 = u.pm * BM + wr * 64 + fr, col0 = u.pn * BM + wc * 32 + 8 * fq;
        const int* cnt = (const int*)(ws + WS_CTL); const int* list = (const int*)(ws + WS_LIST); const float* gate = (const float*)(ws + WS_GATE); bf16_t* YA = (bf16_t*)(ws + WS_YA);
        const int ce = __builtin_amdgcn_readfirstlane(cnt[u.e]);
        f32x4 bv[2][2];
#pragma unroll
        for (int bj = 0; bj < 2; ++bj)
#pragma unroll
            for (int n = 0; n < 2; ++n) bv[bj][n] = *(const f32x4*)(b_down + (size_t)u.e * D + col0 + bj * HALF + 4 * n);
#pragma unroll
        for (int ai = 0; ai < 2; ++ai)
#pragma unroll
            for (int m = 0; m < 4; ++m) { const int lr = lr0 + ai * HALF + m * 16; float g = 0.f; if (lr < ce) g = gate[list[(size_t)u.e * S + lr]];
                bf16_t* rowp = YA + (size_t)(row0 + ai * HALF + m * 16) * D + col0;
#pragma unroll
                for (int bj = 0; bj < 2; ++bj) { const f32x4 v0 = (acc[ai][bj][m][0] + bv[bj][0]) * g, v1 = (acc[ai][bj][m][1] + bv[bj][1]) * g;
                    u32x4 w; w.x = cvt_pk_bf16(v0[0], v0[1]); w.y = cvt_pk_bf16(v0[2], v0[3]); w.z = cvt_pk_bf16(v1[0], v1[1]); w.w = cvt_pk_bf16(v1[2], v1[3]);
                    *(u32x4*)(rowp + bj * HALF) = w; } }
    }
};
struct EpiS5E {
    static constexpr bool PERM = false;
    float* EF;
    __device__ __forceinline__ void operator()(const f32x4 (&acc)[2][2][4][2], const Unit& u, int wr, int wc, int fr, int fq) const {
        const int row0 = u.pm * BM + wr * 64 + fr, col0 = wc * 32 + 4 * fq;
#pragma unroll
        for (int ai = 0; ai < 2; ++ai)
#pragma unroll
            for (int m = 0; m < 4; ++m) { float* rowp = EF + ((size_t)u.e * NCH + row0 + ai * HALF + m * 16) * 128 + col0;
#pragma unroll
                for (int n = 0; n < 2; ++n) *(f32x4*)(rowp + n * 16) = acc[ai][0][m][n]; }
    }
};
struct EpiS5Y {
    static constexpr bool PERM = true;
    bf16_t* YGB;
    __device__ __forceinline__ void operator()(const f32x4 (&acc)[2][2][4][2], const Unit& u, int wr, int wc, int fr, int fq) const {
        const int c0 = u.pm * BM + wr * 64 + fr;
#pragma unroll
        for (int ai = 0; ai < 2; ++ai)
#pragma unroll
            for (int m = 0; m < 4; ++m) { const int c = c0 + ai * HALF + m * 16;
#pragma unroll
                for (int bj = 0; bj < 2; ++bj) { const int np = u.pn * BM + bj * HALF + wc * 32 + 8 * fq, i = np >> 4, p0 = np & 15; float o[8];
#pragma unroll
                    for (int n = 0; n < 2; ++n)
#pragma unroll
                        for (int j = 0; j < 4; ++j) { const float y = acc[ai][bj][m][n][j]; const float uu = 0.7978845608028654f * (y + 0.044715f * y * y * y);
                            o[4 * n + j] = y * __builtin_amdgcn_rcpf(1.0f + __builtin_amdgcn_exp2f(-2.885390081777927f * uu)); }
                    u32x4 w; w.x = cvt_pk_bf16(o[0], o[1]); w.y = cvt_pk_bf16(o[2], o[3]); w.z = cvt_pk_bf16(o[4], o[5]); w.w = cvt_pk_bf16(o[6], o[7]);
                    *(u32x4*)(YGB + (size_t)(c * LCH + i) * SW + u.e * PC + p0) = w; } }
    }
};
struct EpiProj {
    static constexpr bool PERM = false;
    bf16_t* QKV; bf16_t* UB2;
    __device__ __forceinline__ void operator()(const f32x4 (&acc)[2][2][4][2], const Unit& u, int wr, int wc, int fr, int fq) const {
        const int row0 = u.pm * BM + wr * 64 + fr, col0 = u.pn * BM + wc * 32 + 4 * fq;
        if (u.pn < 12) {
            const float sc = (u.pn < 4) ? 0.125f : 1.0f;
#pragma unroll
            for (int ai = 0; ai < 2; ++ai)
#pragma unroll
                for (int m = 0; m < 4; ++m) { bf16_t* rowp = QKV + (size_t)(row0 + ai * HALF + m * 16) * (3 * AW) + col0;
#pragma unroll
                    for (int bj = 0; bj < 2; ++bj)
#pragma unroll
                        for (int n = 0; n < 2; ++n) { const f32x4 v = acc[ai][bj][m][n] * sc; u32x2 w; w.x = cvt_pk_bf16(v[0], v[1]); w.y = cvt_pk_bf16(v[2], v[3]); *(u32x2*)(rowp + bj * HALF + n * 16) = w; } }
        } else {
#pragma unroll
            for (int ai = 0; ai < 2; ++ai)
#pragma unroll
                for (int m = 0; m < 4; ++m) { const int t = row0 + ai * HALF + m * 16; bf16_t* rowp = UB2 + (size_t)((t >> 5) * CROWS + (t & 31)) * SW + (col0 - 3 * AW);
#pragma unroll
                    for (int bj = 0; bj < 2; ++bj)
#pragma unroll
                        for (int n = 0; n < 2; ++n) { const f32x4 v = acc[ai][bj][m][n]; u32x2 w; w.x = cvt_pk_bf16(v[0], v[1]); w.y = cvt_pk_bf16(v[2], v[3]); *(u32x2*)(rowp + bj * HALF + n * 16) = w; } }
        }
    }
};
}

constexpr int NWAVES = 8;
constexpr int LDS_BYTES = 148480;
constexpr int RING_OFF = 0;
typedef short s16x4 __attribute__((ext_vector_type(4)));
typedef float f32x16 __attribute__((ext_vector_type(16)));

struct ConvTile { const float* W; unsigned char* WT; int K, N, tk, tn, deint, out8; };
__device__ __forceinline__ void conv_load(const ConvTile& t, f32x4 (&v)[8]) {
    const int tid = otid(), k0 = t.tk * 64, n0 = t.tn * 256;
#pragma unroll
    for (int j = 0; j < 8; ++j) { const int k = j * 8 + (tid >> 6), g = tid & 63;
        v[j] = __builtin_nontemporal_load((const f32x4*)(t.W + (size_t)(k0 + k) * t.N + n0 + 4 * g)); }
}
__device__ __forceinline__ void conv_store(const ConvTile& t, const f32x4 (&vin)[8], LAS float* scr) {
    const int tid = otid(), k0 = t.tk * 64, n0 = t.tn * 256;
    __syncthreads();
#pragma unroll
    for (int j = 0; j < 8; ++j) { const int k = j * 8 + (tid >> 6), g = tid & 63; *(LAS f32x4*)(scr + k * 256 + ((g ^ j) << 2)) = vin[j]; }
    __syncthreads();
#pragma unroll
    for (int jj = 0; jj < 4; ++jj) { const int n = jj * 64 + (tid >> 3), c = tid & 7; float v[8];
#pragma unroll
        for (int q = 0; q < 8; ++q) v[q] = scr[(8 * c + q) * 256 + ((((n >> 2) ^ c)) << 2) + (n & 3)];
        int row = n0 + n;
        if (t.deint) { const int sx = n & 1, jl = n >> 1; row = n0 + sx * 128 + jl; }
        if (t.out8) { u32x2 o8; o8.x = pk4_fp8(v[0] * 64.f, v[1] * 64.f, v[2] * 64.f, v[3] * 64.f); o8.y = pk4_fp8(v[4] * 64.f, v[5] * 64.f, v[6] * 64.f, v[7] * 64.f);
            *(u32x2*)(t.WT + (size_t)row * t.K + k0 + 8 * c) = o8; }
        else { u32x4 o; o.x = cvt_pk_bf16(v[0], v[1]); o.y = cvt_pk_bf16(v[2], v[3]); o.z = cvt_pk_bf16(v[4], v[5]); o.w = cvt_pk_bf16(v[6], v[7]);
            *(u32x4*)(t.WT + ((size_t)row * t.K + k0 + 8 * c) * 2) = o; } }
}
constexpr int CONV_NT_SMALL = 32 * 16 + 16 * 4 + 32 * 8, CONV_NT_EXP = NE * (32 * 16 + 32 * 8);
__device__ __forceinline__ ConvTile conv_tile_small(const P& p, int it) {
    unsigned char* ws = p.ws;
    constexpr int T_IN = 32 * 16, T_GLU = 16 * 4;
    ConvTile t; int r = it;
    if (r < T_IN) { t.W = p.w_in; t.WT = ws + WS_WIN; t.K = D; t.N = INW; t.tk = r / 16; t.tn = r % 16; t.deint = 0; t.out8 = 0; return t; } r -= T_IN;
    if (r < T_GLU) { t.W = p.w_glu; t.WT = ws + WS_WGLU; t.K = SW; t.N = SW; t.tk = r / 4; t.tn = r % 4; t.deint = 0; t.out8 = 0; return t; } r -= T_GLU;
    t.W = p.w_out; t.WT = ws + WS_WOUT; t.K = D; t.N = D; t.tk = r / 8; t.tn = r % 8; t.deint = 0; t.out8 = 0; return t;
}
__device__ __forceinline__ ConvTile conv_tile_exp(const P& p, int it) {
    unsigned char* ws = p.ws;
    constexpr int T_GU = 32 * 16, T_DN = 32 * 8;
    constexpr int E8 = (MOE_FP8 != 0) ? 1 : 0, EB = E8 ? 1 : 2;
    ConvTile t; int r = it;
    if (r < NE * T_GU) { const int e = r / T_GU, q = r % T_GU; t.W = p.w_gu + (size_t)e * D * 2 * FF; t.WT = ws + WS_WGU + (size_t)e * 2 * FF * D * EB; t.K = D; t.N = 2 * FF; t.tk = q / 16; t.tn = q % 16; t.deint = 1; t.out8 = E8; return t; } r -= NE * T_GU;
    { const int e = r / T_DN, q = r % T_DN; t.W = p.w_down + (size_t)e * FF * D; t.WT = ws + WS_WDN + (size_t)e * D * FF * EB; t.K = FF; t.N = D; t.tk = q / 8; t.tn = q % 8; t.deint = 0; t.out8 = E8; return t; }
}

__device__ __forceinline__ void phase_s5_tables(const P& p, LAS unsigned char* lds, int g);
__device__ __forceinline__ void phase_conv_experts(const P& p, LAS unsigned char* lds, int bid, int Gn);
__device__ __forceinline__ void phase_prologue(const P& p, LAS unsigned char* lds, int bid, int Gn) {
    unsigned char* ws = p.ws;
    const int tid = otid();
    if (bid < 192) {
        LAS float* sil = (LAS float*)(lds + 16384);
        for (int i = tid; i < D; i += NWAVES * 64) { const float cv = p.c[i]; sil[i] = cv * __builtin_amdgcn_rcpf(1.0f + __expf(-cv)); }
        __syncthreads();
        LAS f32x4* red = (LAS f32x4*)lds;
        const int cq = tid & 15, rg = tid >> 4;
        f32x4 acc = (f32x4){0.f, 0.f, 0.f, 0.f};
        for (int it0 = 0; it0 < 64; it0 += 8) { f32x4 wv[8];
#pragma unroll
            for (int k = 0; k < 8; ++k) wv[k] = __builtin_nontemporal_load((const f32x4*)(p.w_ada + (size_t)(rg + 32 * (it0 + k)) * 6 * D + 64 * bid + 4 * cq));
#pragma unroll
            for (int k = 0; k < 8; ++k) acc += wv[k] * sil[rg + 32 * (it0 + k)]; }
        red[rg * 16 + cq] = acc;
        __syncthreads();
        if (tid < 64) { const LAS float* rf = (const LAS float*)lds; float sacc = p.b_ada[64 * bid + tid];
            for (int r = 0; r < 32; ++r) sacc += rf[r * 64 + tid];
            ((float*)(ws + WS_MOD))[64 * bid + tid] = sacc; }
    } else phase_s5_tables(p, lds, bid - 192);
    LAS float* scr = (LAS float*)(lds + RING_OFF);
    {
        f32x4 va[8];
        for (int it = bid; it < CONV_NT_SMALL; it += Gn) { const ConvTile ta = conv_tile_small(p, it); conv_load(ta, va); conv_store(ta, va, scr); }
    }
    __syncthreads();
    phase_conv_experts(p, lds, bid, Gn);
}

__device__ __forceinline__ void phase_norm1(const P& p, int bid, int Gn) {
    const int tid_ = otid(); const int lane = tid_ & 63, gw = bid * NWAVES + (tid_ >> 6), NGW = Gn * NWAVES;
    const float* mod = (const float*)(p.ws + WS_MOD);
    bf16_t* hb = (bf16_t*)(p.ws + WS_HB);
    f32x4 ga[8], sb[8];
#pragma unroll
    for (int j = 0; j < 8; ++j) { const int c0 = 4 * lane + 256 * j; ga[j] = *(const f32x4*)(p.norm1_g + c0) * (*(const f32x4*)(mod + D + c0) + 1.0f); sb[j] = *(const f32x4*)(mod + c0); }
    f32x4 v[8], vn[8];
    int row = gw;
    if (row < S) {
#pragma unroll
        for (int j = 0; j < 8; ++j) v[j] = ((const f32x4*)(p.x + (size_t)row * D) + lane)[64 * j]; }
    while (row < S) {
        const int nrow = row + NGW;
        if (nrow < S) {
#pragma unroll
            for (int j = 0; j < 8; ++j) vn[j] = ((const f32x4*)(p.x + (size_t)nrow * D) + lane)[64 * j]; }
        float ss = 0.f;
#pragma unroll
        for (int j = 0; j < 8; ++j) ss += (v[j].x * v[j].x + v[j].y * v[j].y) + (v[j].z * v[j].z + v[j].w * v[j].w);
        const float rs = 1.0f / sqrtf(wave_sum(ss) * (1.0f / D) + EPS);
#pragma unroll
        for (int j = 0; j < 8; ++j) { const int c0 = 4 * lane + 256 * j;
            const f32x4 o = v[j] * rs * ga[j] + sb[j];
            u32x2 w; w.x = cvt_pk_bf16(o.x, o.y); w.y = cvt_pk_bf16(o.z, o.w);
            *(u32x2*)(hb + (size_t)row * D + c0) = w; }
#pragma unroll
        for (int j = 0; j < 8; ++j) v[j] = vn[j];
        row = nrow;
    }
}

__device__ __forceinline__ void tr_read4(unsigned a0, unsigned a1, s16x4& r0, s16x4& r1, s16x4& r2, s16x4& r3) {
    asm volatile("ds_read_b64_tr_b16 %0, %4\n\tds_read_b64_tr_b16 %1, %4 offset:1024\n\tds_read_b64_tr_b16 %2, %5\n\tds_read_b64_tr_b16 %3, %5 offset:1024\n\ts_waitcnt lgkmcnt(0)"
                 : "=&v"(r0), "=&v"(r1), "=&v"(r2), "=&v"(r3) : "v"(a0), "v"(a1) : "memory");
}
__device__ __forceinline__ void attn_role(const P& p, LAS unsigned char* lds, int bid, int Gn, int w) {
    const bf16_t* QKV = (const bf16_t*)(p.ws + WS_QKV);
    bf16_t* OB = (bf16_t*)(p.ws + WS_OB);
    float* LSE = (float*)(p.ws + WS_LSE);
    const int lane = otid() & 63, aw = w & 3, us = w >> 2;
    const int l31 = lane & 31, hh = lane >> 5, i0 = 32 * aw;
    constexpr int RS = 3 * AW;
    LAS unsigned char* vl = lds + w * 16384;
    LAS unsigned char* kl = vl + 8192;
    for (int u = 2 * bid + us; u < 3 * 128 * NH; u += 2 * Gn) {
        const int b = u >> 11, rem = u & 2047, blk = rem >> 4, h = rem & 15;
        const int dsh = 2 * b, d = 1 << dsh;
        const int n = blk >> dsh, r = blk & (d - 1);
        const int qbase = n * 128 * d + r, kbase = qbase - 128 * d;
        const int qp = qbase + (i0 + l31) * d;
        bf16x8 qf[4];
#pragma unroll
        for (int s = 0; s < 4; ++s) qf[s] = *(const bf16x8*)(QKV + (size_t)qp * RS + h * HD + 16 * s + 8 * hh);
        u32x4 kr[4], krn[4];
#define ATT_KLOAD(dst, kb_) do { _Pragma("unroll") for (int it = 0; it < 4; ++it) { const int id = it * 64 + lane, row = 32 * (kb_) + (id >> 3), ch = id & 7; int kp = kbase + (i0 + row) * d; kp = kp < 0 ? 0 : kp; \
            dst[it] = *(const u32x4*)(QKV + (size_t)kp * RS + AW + h * HD + ch * 8); } } while (0)
        ATT_KLOAD(kr, 0);
        f32x16 sc[5];
#pragma unroll
        for (int kb = 0; kb < 5; ++kb) {
            if (kb < 4) ATT_KLOAD(krn, kb + 1);
            LAS unsigned char* kbuf = kl + (kb & 1) * 4096;
#pragma unroll
            for (int it = 0; it < 4; ++it) { const int id = it * 64 + lane, row = id >> 3, ch = id & 7; *(LAS u32x4*)(kbuf + row * 128 + ((ch ^ (row & 7)) << 4)) = kr[it]; }
            bf16x8 kf[4];
#pragma unroll
            for (int s = 0; s < 4; ++s) kf[s] = *(const LAS bf16x8*)(kbuf + l31 * 128 + (((2 * s + hh) ^ (l31 & 7)) << 4));
            f32x16 a;
#pragma unroll
            for (int e = 0; e < 16; ++e) a[e] = 0.f;
#pragma unroll
            for (int s = 0; s < 4; ++s) a = __builtin_amdgcn_mfma_f32_32x32x16_bf16(kf[s], qf[s], a, 0, 0, 0);
            sc[kb] = a;
            if (kb < 4) {
#pragma unroll
                for (int it = 0; it < 4; ++it) kr[it] = krn[it]; }
        }
#undef ATT_KLOAD
        u32x4 vv[4], vn[4];
#define ATT_VLOAD(dst, kb_) do { _Pragma("unroll") for (int it = 0; it < 4; ++it) { const int id = it * 64 + lane, row = 32 * (kb_) + (id >> 3), ch = id & 7; const int vp = kbase + (i0 + row) * d; \
            dst[it] = (u32x4){0u, 0u, 0u, 0u}; if (vp >= 0) dst[it] = *(const u32x4*)(QKV + (size_t)vp * RS + 2 * AW + h * HD + ch * 8); } } while (0)
        ATT_VLOAD(vv, 0);
        float m = -INFINITY;
#pragma unroll
        for (int kb = 0; kb < 5; ++kb)
#pragma unroll
            for (int e = 0; e < 16; ++e) { const int jrel = 32 * kb + (e & 3) + 8 * (e >> 2) + 4 * hh;
                const bool valid = (jrel >= l31) && (jrel <= l31 + 128) && (n > 0 || (i0 + jrel) >= 128);
                const float sv = valid ? sc[kb][e] : -INFINITY; sc[kb][e] = sv; m = fmaxf(m, sv); }
        m = fmaxf(m, __shfl_xor(m, 32));
        float l = 0.f;
#pragma unroll
        for (int kb = 0; kb < 5; ++kb)
#pragma unroll
            for (int e = 0; e < 16; ++e) { const float pe = __expf(sc[kb][e] - m); sc[kb][e] = pe; l += pe; }
        l += __shfl_xor(l, 32);
        f32x16 o[2];
#pragma unroll
        for (int c = 0; c < 2; ++c)
#pragma unroll
            for (int e = 0; e < 16; ++e) o[c][e] = 0.f;
        const int q4 = (lane & 15) >> 2, pp = lane & 3, bk = (lane >> 4) & 1;
#pragma unroll
        for (int kb = 0; kb < 5; ++kb) {
            if (kb < 4) ATT_VLOAD(vn, kb + 1);
            LAS unsigned char* vb = vl + (kb & 1) * 4096;
#pragma unroll
            for (int it = 0; it < 4; ++it) { const int id = it * 64 + lane; *(LAS u32x4*)(vb + (id >> 3) * 128 + (id & 7) * 16) = vv[it]; }
            asm volatile("s_waitcnt lgkmcnt(0)" ::: "memory");
            const unsigned vbase = (unsigned)(size_t)vb;
#pragma unroll
            for (int s2 = 0; s2 < 2; ++s2) {
                u32x4 pw; pw.x = cvt_pk_bf16(sc[kb][8 * s2 + 0], sc[kb][8 * s2 + 1]); pw.y = cvt_pk_bf16(sc[kb][8 * s2 + 2], sc[kb][8 * s2 + 3]);
                pw.z = cvt_pk_bf16(sc[kb][8 * s2 + 4], sc[kb][8 * s2 + 5]); pw.w = cvt_pk_bf16(sc[kb][8 * s2 + 6], sc[kb][8 * s2 + 7]);
                const bf16x8 pf = __builtin_bit_cast(bf16x8, pw);
                const int rowb = 16 * s2 + 4 * hh + q4;
                const unsigned a0 = vbase + (unsigned)(rowb * 128 + 32 * bk + 8 * pp);
                s16x4 v00, v01, v10, v11;
                tr_read4(a0, a0 + 64, v00, v01, v10, v11);
                bf16x8 vf0, vf1;
                vf0[0] = v00[0]; vf0[1] = v00[1]; vf0[2] = v00[2]; vf0[3] = v00[3]; vf0[4] = v01[0]; vf0[5] = v01[1]; vf0[6] = v01[2]; vf0[7] = v01[3];
                vf1[0] = v10[0]; vf1[1] = v10[1]; vf1[2] = v10[2]; vf1[3] = v10[3]; vf1[4] = v11[0]; vf1[5] = v11[1]; vf1[6] = v11[2]; vf1[7] = v11[3];
                o[0] = __builtin_amdgcn_mfma_f32_32x32x16_bf16(vf0, pf, o[0], 0, 0, 0);
                o[1] = __builtin_amdgcn_mfma_f32_32x32x16_bf16(vf1, pf, o[1], 0, 0, 0);
            }
            if (kb < 4) {
#pragma unroll
                for (int it = 0; it < 4; ++it) vv[it] = vn[it]; }
        }
#undef ATT_VLOAD
        const float inv = 1.0f / l;
        bf16_t* orow = OB + ((size_t)b * S + qp) * AW + h * HD;
#pragma unroll
        for (int c = 0; c < 2; ++c)
#pragma unroll
            for (int rg = 0; rg < 4; ++rg) { u32x2 wv; wv.x = cvt_pk_bf16(o[c][4 * rg] * inv, o[c][4 * rg + 1] * inv); wv.y = cvt_pk_bf16(o[c][4 * rg + 2] * inv, o[c][4 * rg + 3] * inv);
                *(u32x2*)(orow + 32 * c + 8 * rg + 4 * hh) = wv; }
        if (hh == 0) LSE[((size_t)b * S + qp) * NH + h] = m + __logf(l);
    }
}
__device__ __forceinline__ void cw_load(const ConvTile& t, int half, int cw, int lane, f32x4 (&v)[16]) {
    const int kbase = t.tk * 128 + half * 64, n0 = t.tn * 256 + 64 * cw, g = lane & 15, kbl = lane >> 4;
#pragma unroll
    for (int t2 = 0; t2 < 2; ++t2)
#pragma unroll
        for (int kk = 0; kk < 8; ++kk) v[t2 * 8 + kk] = __builtin_nontemporal_load((const f32x4*)(t.W + (size_t)(kbase + (t2 * 4 + kbl) * 8 + kk) * t.N + n0 + 4 * g));
}
__device__ __forceinline__ void cw_park(int half, int lane, const f32x4 (&v)[16], LAS unsigned char* tl) {
    const int g = lane & 15, kbl = lane >> 4;
#pragma unroll
    for (int t2 = 0; t2 < 2; ++t2) { const int kb = half * 8 + t2 * 4 + kbl;
#pragma unroll
        for (int i = 0; i < 4; ++i) { const int n = 4 * g + i; u32x2 o8;
            o8.x = pk4_fp8(v[t2 * 8 + 0][i] * 64.f, v[t2 * 8 + 1][i] * 64.f, v[t2 * 8 + 2][i] * 64.f, v[t2 * 8 + 3][i] * 64.f);
            o8.y = pk4_fp8(v[t2 * 8 + 4][i] * 64.f, v[t2 * 8 + 5][i] * 64.f, v[t2 * 8 + 6][i] * 64.f, v[t2 * 8 + 7][i] * 64.f);
            *(LAS u32x2*)(tl + n * 128 + ((kb ^ (2 * (g & 7))) << 3)) = o8; } }
}
__device__ __forceinline__ void cw_flush(const ConvTile& t, int cw, int lane, LAS unsigned char* tl) {
#pragma unroll
    for (int jj = 0; jj < 8; ++jj) { const int n = jj * 8 + (lane >> 3), pc = lane & 7;
        const u32x4 o = *(const LAS u32x4*)(tl + n * 128 + (((2 * pc) ^ (2 * ((n >> 2) & 7))) << 3));
        const int nt = 64 * cw + n;
        int row = t.tn * 256 + nt;
        if (t.deint) row = t.tn * 256 + (nt & 1) * 128 + (nt >> 1);
        *(u32x4*)(t.WT + (size_t)row * t.K + t.tk * 128 + 16 * pc) = o; }
}
constexpr int CONV_NT_EXP128 = NE * (16 * 16 + 16 * 8);
__device__ __forceinline__ ConvTile conv_tile_exp128(const P& p, int it) {
    unsigned char* ws = p.ws;
    constexpr int T_GU = 16 * 16, T_DN = 16 * 8;
    ConvTile t; int r = it;
    if (r < NE * T_GU) { const int e = r / T_GU, q = r % T_GU; t.W = p.w_gu + (size_t)e * D * 2 * FF; t.WT = ws + WS_WGU + (size_t)e * 2 * FF * D; t.K = D; t.N = 2 * FF; t.tk = q / 16; t.tn = q % 16; t.deint = 1; t.out8 = 1; return t; } r -= NE * T_GU;
    { const int e = r / T_DN, q = r % T_DN; t.W = p.w_down + (size_t)e * FF * D; t.WT = ws + WS_WDN + (size_t)e * D * FF; t.K = FF; t.N = D; t.tk = q / 8; t.tn = q % 8; t.deint = 0; t.out8 = 1; return t; }
}
constexpr int CW_CONV = 64;
__device__ __forceinline__ int conv_grab(int* ctr) { int v = 0; if ((otid() & 63) == 0) v = __hip_atomic_fetch_add(ctr, 1, __ATOMIC_RELAXED, __HIP_MEMORY_SCOPE_AGENT); return __builtin_amdgcn_readfirstlane(v); }
__device__ __forceinline__ void conv_role(const P& p, LAS unsigned char* lds, int bid, int Gn_, int w) {
    static_assert(MOE_FP8 != 0, "the conversion role writes fp8 expert weights");
    const int lane = otid() & 63;
    int* ctr = (int*)(p.ws + WS_CTL) + CW_CONV;
    LAS unsigned char* tl = lds + 65536 + w * 8192;
    f32x4 va[16], vb[16];
    int it = conv_grab(ctr);
    int itn = conv_grab(ctr);
    ConvTile t = conv_tile_exp128(p, it < CONV_NT_EXP128 ? it : 0);
    if (it < CONV_NT_EXP128) cw_load(t, 0, 0, lane, va);
    while (it < CONV_NT_EXP128) {
        ConvTile tn = conv_tile_exp128(p, itn < CONV_NT_EXP128 ? itn : 0);
        const int itnn = conv_grab(ctr);
#pragma unroll
        for (int cw = 0; cw < 4; ++cw) {
            cw_load(t, 1, cw, lane, vb);
            cw_park(0, lane, va, tl);
            if (cw < 3) cw_load(t, 0, cw + 1, lane, va);
            else if (itn < CONV_NT_EXP128) cw_load(tn, 0, 0, lane, va);
            cw_park(1, lane, vb, tl);
            cw_flush(t, cw, lane, tl);
        }
        t = tn; it = itn; itn = itnn;
    }
}
__device__ __forceinline__ void phase_attn(const P& p, LAS unsigned char* lds, int bid, int Gn) {
    const int w = __builtin_amdgcn_readfirstlane(otid() >> 6);
    attn_role(p, lds, bid, Gn, w);
}
__device__ __forceinline__ void phase_conv_experts(const P& p, LAS unsigned char* lds, int bid, int Gn) {
    const int w = __builtin_amdgcn_readfirstlane(otid() >> 6);
    conv_role(p, lds, bid, Gn, w);
}

__device__ __forceinline__ void phase_s5_tables(const P& p, LAS unsigned char* lds, int g) {
    const int tid = otid();
    LAS float* pwr = (LAS float*)lds;
    LAS float* pwi = pwr + 33 * 64;
    LAS float* cre = pwi + 33 * 64;
    LAS float* cim = cre + 1024;
    LAS float* bbr = cim + 1024;
    LAS float* bbi = bbr + 1024;
    LAS float* Mt = bbi + 1024;
    __syncthreads();
    if (tid < NS) {
        const int n = tid, i = g * NS + n;
        const float dt = expf(p.log_dt[g]), lr = p.lam_re[i], li = p.lam_im[i];
        const float mag = expf(lr * dt), ar = mag * cosf(li * dt), ai = mag * sinf(li * dt);
        const float den = lr * lr + li * li, nr = ar - 1.0f, ni = ai;
        const float fr = (nr * lr + ni * li) / den, fi = (ni * lr - nr * li) / den;
        for (int q = 0; q < PC; ++q) { const float br = p.b_re[(size_t)i * PC + q], bi = p.b_im[(size_t)i * PC + q];
            bbr[n * PC + q] = fr * br - fi * bi; bbi[n * PC + q] = fr * bi + fi * br; }
        float xr = 1.0f, xi = 0.0f;
        for (int t = 0; t <= LCH; ++t) { pwr[t * NS + n] = xr; pwi[t * NS + n] = xi; const float yr = xr * ar - xi * ai, yi = xr * ai + xi * ar; xr = yr; xi = yi; }
        float* lamL = (float*)(p.ws + WS_S5P);
        lamL[(g * NS + n) * 2 + 0] = pwr[LCH * NS + n]; lamL[(g * NS + n) * 2 + 1] = pwi[LCH * NS + n];
    }
    for (int k = tid; k < PC * NS; k += NWAVES * 64) { cre[k] = p.c_re[(size_t)g * PC * NS + k]; cim[k] = p.c_im[(size_t)g * PC * NS + k]; }
    __syncthreads();
    for (int k = 0; k < 16; ++k) { const int idx = tid + 512 * k, tau = idx >> 8, pp = (idx >> 4) & 15, q = idx & 15;
        float acc = 0.f;
        for (int n = 0; n < NS; ++n) { const float cr = cre[pp * NS + n], ci = cim[pp * NS + n], pr = pwr[tau * NS + n], pi = pwi[tau * NS + n];
            const float xr = cr * pr - ci * pi, xi = cr * pi + ci * pr; acc += xr * bbr[n * PC + q] - xi * bbi[n * PC + q]; }
        if (tau == 0 && pp == q) acc += p.d_skip[g * PC + pp];
        Mt[idx] = acc; }
    __syncthreads();
    bf16_t* T = (bf16_t*)(p.ws + WS_S5T) + (size_t)g * 512 * KS5;
    for (int k = 0; k < 80; ++k) { const int ch = tid + 512 * k, row = ch / 80, cc = ch % 80, i = row >> 4, pp = row & 15; float v[8];
        if (cc < 64) { const int j = cc >> 1, q0 = (cc & 1) * 8;
#pragma unroll
            for (int e = 0; e < 8; ++e) v[e] = (j <= i) ? Mt[((i - j) * 16 + pp) * 16 + q0 + e] : 0.f;
        } else { const int m0 = (cc - 64) * 8;
#pragma unroll
            for (int e = 0; e < 8; ++e) { const int m = m0 + e, n = m & 63; const float cr = cre[pp * NS + n], ci = cim[pp * NS + n], pr = pwr[(i + 1) * NS + n], pi = pwi[(i + 1) * NS + n];
                v[e] = (m < 64) ? (cr * pr - ci * pi) : -(cr * pi + ci * pr); } }
        u32x4 o; o.x = cvt_pk_bf16(v[0], v[1]); o.y = cvt_pk_bf16(v[2], v[3]); o.z = cvt_pk_bf16(v[4], v[5]); o.w = cvt_pk_bf16(v[6], v[7]);
        *(u32x4*)(T + (size_t)row * KS5 + cc * 8) = o; }
    bf16_t* Eb = (bf16_t*)(p.ws + WS_S5E) + (size_t)g * 256 * KS5E;
    for (int k = 0; k < 32; ++k) { const int ch = tid + 512 * k, row = ch >> 6, cc = ch & 63, j = cc >> 1, q0 = (cc & 1) * 8, n = row & 63; float v[8];
#pragma unroll
        for (int e = 0; e < 8; ++e) { const float pr = pwr[(LCH - 1 - j) * NS + n], pi = pwi[(LCH - 1 - j) * NS + n], br = bbr[n * PC + q0 + e], bi = bbi[n * PC + q0 + e];
            v[e] = (row < 64) ? (pr * br - pi * bi) : ((row < 128) ? (pr * bi + pi * br) : 0.f); }
        u32x4 o; o.x = cvt_pk_bf16(v[0], v[1]); o.y = cvt_pk_bf16(v[2], v[3]); o.z = cvt_pk_bf16(v[4], v[5]); o.w = cvt_pk_bf16(v[6], v[7]);
        *(u32x4*)(Eb + (size_t)row * KS5E + cc * 8) = o; }
    __syncthreads();
}
__device__ __forceinline__ void phase_s5_carry(const P& p, int bid) {
    const int gt = bid * (NWAVES * 64) + otid();
    if (gt >= G * NS) return;
    const int g = gt >> 6, n = gt & 63;
    const float* lamL = (const float*)(p.ws + WS_S5P);
    const float* EF = (const float*)(p.ws + WS_EF) + (size_t)g * NCH * 128;
    bf16_t* UB2 = (bf16_t*)(p.ws + WS_UB2);
    const float lr = lamL[gt * 2], li = lamL[gt * 2 + 1];
    float xr = 0.f, xi = 0.f;
    float er[8], ei[8], ern[8], ein[8];
#pragma unroll
    for (int k = 0; k < 8; ++k) { er[k] = EF[(size_t)k * 128 + n]; ei[k] = EF[(size_t)k * 128 + 64 + n]; }
    for (int c0 = 0; c0 < NCH; c0 += 8) {
        if (c0 + 8 < NCH) {
#pragma unroll
            for (int k = 0; k < 8; ++k) { ern[k] = EF[(size_t)(c0 + 8 + k) * 128 + n]; ein[k] = EF[(size_t)(c0 + 8 + k) * 128 + 64 + n]; } }
#pragma unroll
        for (int k = 0; k < 8; ++k) { const int c = c0 + k;
            bf16_t* xrow = UB2 + (size_t)(c * CROWS + LCH + (n >> 4)) * SW + g * PC + (n & 15);
            xrow[0] = f2bf(xr); xrow[4 * SW] = f2bf(xi);
            const float yr = lr * xr - li * xi + er[k], yi = lr * xi + li * xr + ei[k]; xr = yr; xi = yi; }
#pragma unroll
        for (int k = 0; k < 8; ++k) { er[k] = ern[k]; ei[k] = ein[k]; }
    }
}

__device__ __forceinline__ void phase_mix(const P& p, int bid, int Gn) {
    const int tid_ = otid(); const int lane = tid_ & 63, gw = bid * NWAVES + (tid_ >> 6), NGW = Gn * NWAVES;
    const bf16_t* OB = (const bf16_t*)(p.ws + WS_OB);
    const float* LSE = (const float*)(p.ws + WS_LSE);
    const bf16_t* Z = (const bf16_t*)(p.ws + WS_Z);
    bf16_t* YM = (bf16_t*)(p.ws + WS_YMIXB);
    float ls[4][3], lsn[4][3]; u32x2 ob[4][3], obn[4][3], zr[4], zrn[4];
#define MIX_LOAD(LS, OBR, ZR, row_) do { _Pragma("unroll") for (int j = 0; j < 4; ++j) { const int c0 = 4 * lane + 256 * j, hd = c0 >> 6; \
        _Pragma("unroll") for (int b = 0; b < 3; ++b) { LS[j][b] = LSE[((size_t)b * S + (row_)) * NH + hd]; OBR[j][b] = *(const u32x2*)(OB + ((size_t)b * S + (row_)) * AW + c0); } \
        ZR[j] = *(const u32x2*)(Z + (size_t)(row_) * SW + c0); } } while (0)
    int row = gw;
    if (row < S) MIX_LOAD(ls, ob, zr, row);
    while (row < S) {
        const int nrow = row + NGW;
        if (nrow < S) MIX_LOAD(lsn, obn, zrn, nrow);
        f32x4 a[4], z[4]; float sa = 0.f, sz = 0.f;
#pragma unroll
        for (int j = 0; j < 4; ++j) {
            const float mx = fmaxf(fmaxf(ls[j][0], ls[j][1]), ls[j][2]);
            float wsum = 0.f; f32x4 acc = (f32x4){0.f, 0.f, 0.f, 0.f};
#pragma unroll
            for (int b = 0; b < 3; ++b) { const float wb = __expf(ls[j][b] - mx); wsum += wb; acc += bf4_to_f32(ob[j][b]) * wb; }
            a[j] = acc * (1.0f / wsum); sa += (a[j].x * a[j].x + a[j].y * a[j].y) + (a[j].z * a[j].z + a[j].w * a[j].w);
            z[j] = bf4_to_f32(zr[j]); sz += (z[j].x * z[j].x + z[j].y * z[j].y) + (z[j].z * z[j].z + z[j].w * z[j].w); }
        const float ra = 1.0f / sqrtf(wave_sum(sa) * (1.0f / AW) + EPS), rz = 1.0f / sqrtf(wave_sum(sz) * (1.0f / SW) + EPS);
#pragma unroll
        for (int j = 0; j < 4; ++j) { const int c0 = 4 * lane + 256 * j;
            const f32x4 ga = *(const f32x4*)(p.attn_g + c0), gs = *(const f32x4*)(p.ssm_g + c0);
            const f32x4 oa = a[j] * ra * ga, oz = z[j] * rz * gs;
            u32x2 wa, wz; wa.x = cvt_pk_bf16(oa.x, oa.y); wa.y = cvt_pk_bf16(oa.z, oa.w); wz.x = cvt_pk_bf16(oz.x, oz.y); wz.y = cvt_pk_bf16(oz.z, oz.w);
            *(u32x2*)(YM + (size_t)row * D + c0) = wa; *(u32x2*)(YM + (size_t)row * D + AW + c0) = wz; }
#pragma unroll
        for (int j = 0; j < 4; ++j) { zr[j] = zrn[j];
#pragma unroll
            for (int b = 0; b < 3; ++b) { ls[j][b] = lsn[j][b]; ob[j][b] = obn[j][b]; } }
        row = nrow;
    }
#undef MIX_LOAD
}

__device__ __forceinline__ void phase_norm2_router(const P& p, LAS unsigned char* lds, int bid, int Gn) {
    const int tid = otid(), lane = tid & 63, w = tid >> 6;
    const float* mod = (const float*)(p.ws + WS_MOD);
    const bf16_t* X1 = (const bf16_t*)(p.ws + WS_X1);
    bf16_t* hb = (bf16_t*)(p.ws + WS_HB);
    LAS float* hrow = (LAS float*)lds;
    LAS float* part = (LAS float*)(lds + 65536);
    LAS float* logit = (LAS float*)(lds + 81920);
    LAS int* sel_e = (LAS int*)(lds + 83968);
    LAS float* sel_g = (LAS float*)(lds + 84992);
    LAS int* sel_t = (LAS int*)(lds + 86016);
    LAS int* rank = (LAS int*)(lds + 86272);
    LAS int* hist = (LAS int*)(lds + 87296);
    LAS int* gbase = (LAS int*)(lds + 87424);
    int* idx = (int*)(p.ws + WS_IDX); float* gate = (float*)(p.ws + WS_GATE); int* slot = (int*)(p.ws + WS_SLOT);
    int* cnt = (int*)(p.ws + WS_CTL); int* list = (int*)(p.ws + WS_LIST);
    const int nit = (S / 8 + Gn - 1) / Gn;
    float wreg[128];
    {   const int e = tid & 31, pt = tid >> 5;
#pragma unroll
        for (int k = 0; k < 128; ++k) wreg[k] = p.w_router[(size_t)(pt * 128 + k) * NE + e]; }
    for (int it = 0; it < nit; ++it) {
        const int base = (it * Gn + bid) * 8, buf = it & 7;
        const bool live = base < S;
        if (live) {
            const int row = base + w;
            f32x4 v[8]; float ss = 0.f;
#pragma unroll
            for (int j = 0; j < 8; ++j) { v[j] = bf4_to_f32(((const u32x2*)(X1 + (size_t)row * D) + lane)[64 * j]); ss += (v[j].x * v[j].x + v[j].y * v[j].y) + (v[j].z * v[j].z + v[j].w * v[j].w); }
            const float rs = 1.0f / sqrtf(wave_sum(ss) * (1.0f / D) + EPS);
#pragma unroll
            for (int j = 0; j < 8; ++j) { const int c0 = 4 * lane + 256 * j;
                const f32x4 g = *(const f32x4*)(p.norm2_g + c0), sc = *(const f32x4*)(mod + 4 * D + c0), sh = *(const f32x4*)(mod + 3 * D + c0);
                const f32x4 o = v[j] * rs * g * (sc + 1.0f) + sh;
#if MOE_FP8
                *(unsigned*)((unsigned char*)hb + (size_t)row * D + c0) = pk4_fp8(o.x, o.y, o.z, o.w);
#else
                u32x2 wv; wv.x = cvt_pk_bf16(o.x, o.y); wv.y = cvt_pk_bf16(o.z, o.w);
                *(u32x2*)(hb + (size_t)row * D + c0) = wv;
#endif
                *(LAS f32x4*)(hrow + w * D + c0) = o; }
        }
        __syncthreads();
        if (live) {
            const int e = tid & 31, pt = tid >> 5;
            float acc[8];
#pragma unroll
            for (int r = 0; r < 8; ++r) acc[r] = 0.f;
#pragma unroll
            for (int k4 = 0; k4 < 32; ++k4) { const int kk = pt * 128 + 4 * k4;
                const float w0 = wreg[4 * k4], w1 = wreg[4 * k4 + 1], w2 = wreg[4 * k4 + 2], w3 = wreg[4 * k4 + 3];
#pragma unroll
                for (int r = 0; r < 8; ++r) { const f32x4 h4 = *(const LAS f32x4*)(hrow + r * D + kk); acc[r] += (h4.x * w0 + h4.y * w1) + (h4.z * w2 + h4.w * w3); } }
#pragma unroll
            for (int r = 0; r < 8; ++r) part[(pt * 8 + r) * 32 + e] = acc[r];
        }
        __syncthreads();
        if (live) {
            const int e = lane & 31; float lg = p.b_router[e];
#pragma unroll
            for (int q = 0; q < 16; ++q) lg += part[(q * 8 + w) * 32 + e];
            float tv[TOPK]; int ti[TOPK];
#pragma unroll
            for (int k = 0; k < TOPK; ++k) { float bv = lg; int bi = e;
#pragma unroll
                for (int o = 1; o < 32; o <<= 1) { const float ov = __shfl_xor(bv, o); const int oi = __shfl_xor(bi, o); const bool take = (ov > bv) || (ov == bv && oi < bi); bv = take ? ov : bv; bi = take ? oi : bi; }
                tv[k] = bv; ti[k] = bi; if (e == bi) lg = -INFINITY; }
            if (lane == 0) {
                const float mx = tv[0]; float ex[TOPK], sum = 0.f;
#pragma unroll
                for (int k = 0; k < TOPK; ++k) { ex[k] = __expf(tv[k] - mx); sum += ex[k]; }
                const float inv = 1.0f / sum; const int br = buf * 8 + w;
                sel_t[br] = base + w;
#pragma unroll
                for (int k = 0; k < TOPK; ++k) { sel_e[br * 4 + k] = ti[k]; sel_g[br * 4 + k] = ex[k] * inv; }
            }
        }
        if (!live && lane == 0) sel_t[buf * 8 + w] = -1;
        if (buf == 7 || it == nit - 1) {
            const int nrow = (buf + 1) * 8;
            if (tid < NE) hist[tid] = 0;
            __syncthreads();
            int my_e = 0, my_t = -1;
            if (tid < nrow * 4) { my_t = sel_t[tid >> 2]; if (my_t >= 0) { my_e = sel_e[tid]; rank[tid] = __hip_atomic_fetch_add((int*)(hist + my_e), 1, __ATOMIC_RELAXED, __HIP_MEMORY_SCOPE_WORKGROUP); } }
            __syncthreads();
            if (tid < NE) gbase[tid] = atomicAdd(&cnt[tid], hist[tid]);
            __syncthreads();
            if (tid < nrow * 4 && my_t >= 0) { const int a = my_t * TOPK + (tid & 3), sl = gbase[my_e] + rank[tid];
                idx[a] = my_e; gate[a] = sel_g[tid]; slot[a] = sl; list[(size_t)my_e * S + sl] = a; }
        }
        __syncthreads();
    }
}

__device__ __forceinline__ void phase_final(const P& p, int bid, int Gn) {
    const int tid_ = otid(); const int lane = tid_ & 63, gw = bid * NWAVES + (tid_ >> 6), NGW = Gn * NWAVES;
    const int* cnt = (const int*)(p.ws + WS_CTL);
    const int* idx = (const int*)(p.ws + WS_IDX); const int* slot = (const int*)(p.ws + WS_SLOT);
    const float* mod = (const float*)(p.ws + WS_MOD);
    const bf16_t* X1 = (const bf16_t*)(p.ws + WS_X1);
    const bf16_t* YA = (const bf16_t*)(p.ws + WS_YA);
    int poff_l = 0;
    { int acc = 0; for (int j = 0; j < NE; ++j) { const int cj = (cnt[j] + 255) & ~255; if (lane == j) poff_l = acc; acc += cj; } }
    u32x2 ya[4][8], yan[4][8], xa[8], xan[8];
    int pr[TOPK], prn[TOPK];
#define FIN_IDS(PR, row_) do { _Pragma("unroll") for (int k = 0; k < TOPK; ++k) { const int e = idx[(row_) * TOPK + k]; PR[k] = __shfl(poff_l, e) + slot[(row_) * TOPK + k]; } } while (0)
#define FIN_LOAD(YAR, XAR, PR, row_) do { _Pragma("unroll") for (int j = 0; j < 8; ++j) { const int c0 = 4 * lane + 256 * j; \
        _Pragma("unroll") for (int k = 0; k < TOPK; ++k) YAR[k][j] = *(const u32x2*)(YA + (size_t)PR[k] * D + c0); \
        XAR[j] = *(const u32x2*)(X1 + (size_t)(row_) * D + c0); } } while (0)
    int row = gw;
    if (row < S) { FIN_IDS(pr, row); FIN_LOAD(ya, xa, pr, row); }
    if (row + NGW < S) FIN_IDS(prn, row + NGW);
    while (row < S) {
        const int nrow = row + NGW;
        if (nrow < S) FIN_LOAD(yan, xan, prn, nrow);
        if (nrow + NGW < S) FIN_IDS(pr, nrow + NGW);
        f32x4 v[8]; float ss = 0.f;
#pragma unroll
        for (int j = 0; j < 8; ++j) { const int c0 = 4 * lane + 256 * j; f32x4 m = (f32x4){0.f, 0.f, 0.f, 0.f};
#pragma unroll
            for (int k = 0; k < TOPK; ++k) m += bf4_to_f32(ya[k][j]);
            const f32x4 g2 = *(const f32x4*)(mod + 5 * D + c0);
            v[j] = bf4_to_f32(xa[j]) + g2 * m;
            ss += (v[j].x * v[j].x + v[j].y * v[j].y) + (v[j].z * v[j].z + v[j].w * v[j].w); }
        const float rs = 1.0f / sqrtf(wave_sum(ss) * (1.0f / D) + EPS);
#pragma unroll
        for (int j = 0; j < 8; ++j) { const int c0 = 4 * lane + 256 * j; const f32x4 fg = *(const f32x4*)(p.final_g + c0);
            *(f32x4*)(p.out + (size_t)row * D + c0) = v[j] * rs * fg; }
#pragma unroll
        for (int j = 0; j < 8; ++j) { xa[j] = xan[j];
#pragma unroll
            for (int k = 0; k < TOPK; ++k) ya[k][j] = yan[k][j]; }
#pragma unroll
        for (int k = 0; k < TOPK; ++k) { const int t = prn[k]; prn[k] = pr[k]; pr[k] = t; }
        row = nrow;
    }
#undef FIN_IDS
#undef FIN_LOAD
}

#define XB_TMO      128
#define XB_XCNT(j)  (256  + 64 * (j))
#define XB_XSUB(j)  (1280 + 64 * (j))
#define XB_XGEN(j)  (2304 + 64 * (j))
#define XB_TOP      3328
#define XB_TOPGEN   3392
#define XCD_BAR_WORDS 3456
#define XB_SPIN_CAP (1u << 18)

__device__ __forceinline__ unsigned xb_ld(unsigned* p)              { return __hip_atomic_load(p, __ATOMIC_RELAXED, __HIP_MEMORY_SCOPE_AGENT); }
__device__ __forceinline__ unsigned xb_add(unsigned* p, unsigned v) { return __hip_atomic_fetch_add(p, v, __ATOMIC_RELAXED, __HIP_MEMORY_SCOPE_AGENT); }
__device__ __forceinline__ unsigned xb_xcc_id() { return (unsigned)__builtin_amdgcn_s_getreg((3 << 11) | 20) & 0xFu; }
#define XB_SPIN(cond, bar) do { unsigned _sp = 0; while (cond) { __builtin_amdgcn_s_sleep(1); \
    if ((++_sp & 255u) == 0u) { if (xb_ld(&(bar)[XB_TMO])) break; if (_sp > XB_SPIN_CAP) { atomicAdd(&(bar)[XB_TMO], 1u); break; } } } } while (0)

struct XcdBarrier {
    unsigned* bar; unsigned x;
    volatile LAS unsigned* st;
};

__device__ __forceinline__ XcdBarrier xcd_barrier_post(unsigned* bar, volatile LAS unsigned* st) {
    XcdBarrier b; b.bar = bar; b.x = xb_xcc_id(); b.st = st;
    if (threadIdx.x == 0) (void)xb_add(&bar[XB_XCNT(b.x)], 1u);
    return b;
}
__device__ __forceinline__ void xcd_barrier_complete(unsigned* bar, unsigned x, unsigned& nloc, unsigned& nx) {
    const unsigned G = gridDim.x * gridDim.y * gridDim.z;
    unsigned sum, cnt, mine, sp = 0u;
    for (;;) {
        sum = 0u; cnt = 0u; mine = 0u;
#pragma unroll
        for (unsigned j = 0; j < 16; ++j) { const unsigned c = xb_ld(&bar[XB_XCNT(j)]); sum += c; cnt += (c > 0u) ? 1u : 0u; mine = (j == x) ? c : mine; }
        if (sum == G) break;
        __builtin_amdgcn_s_sleep(1);
        if ((++sp & 255u) == 0u) { if (xb_ld(&bar[XB_TMO])) break; if (sp > XB_SPIN_CAP) { atomicAdd(&bar[XB_TMO], 1u); break; } }
    }
    nloc = mine > 0u ? mine : 1u; nx = cnt > 0u ? cnt : 1u;
}

__device__ __forceinline__ void xcd_barrier(const XcdBarrier& b) {
    asm volatile("s_waitcnt vmcnt(0)" ::: "memory");
    __syncthreads();
    if (threadIdx.x == 0) {
        unsigned* bar = b.bar;
        __builtin_amdgcn_s_waitcnt(0);
        unsigned nloc = b.st[0], nx = b.st[1];
        if (nloc == 0u) { xcd_barrier_complete(bar, b.x, nloc, nx); b.st[0] = nloc; b.st[1] = nx; }
        const unsigned old = xb_add(&bar[XB_XSUB(b.x)], 1u);
        const unsigned gen = old / nloc;
        if (old + 1u == (gen + 1u) * nloc) {
            __builtin_amdgcn_fence(__ATOMIC_RELEASE, "agent");
            asm volatile("s_waitcnt vmcnt(0)" ::: "memory");
            const unsigned og = xb_add(&bar[XB_TOP], 1u);
            const unsigned tg = og / nx;
            if (og + 1u == (tg + 1u) * nx) xb_add(&bar[XB_TOPGEN], 1u);
            else XB_SPIN(xb_ld(&bar[XB_TOPGEN]) == tg, bar);
            __builtin_amdgcn_fence(__ATOMIC_ACQUIRE, "agent");
            xb_add(&bar[XB_XGEN(b.x)], 1u);
            asm volatile("s_waitcnt vmcnt(0)" ::: "memory");
        } else {
            XB_SPIN(xb_ld(&bar[XB_XGEN(b.x)]) == gen, bar);
            __builtin_amdgcn_fence(__ATOMIC_ACQUIRE, "agent");
            asm volatile("s_waitcnt vmcnt(0)" ::: "memory");
        }
    }
    __syncthreads();
}
constexpr int CW_BAR = 4096;
constexpr int MISC_OFF = 147456;

typedef __attribute__((address_space(4))) const Args CArgs;
__device__ __forceinline__ const Args* kargs() { CArgs* k = (CArgs*)__builtin_amdgcn_kernarg_segment_ptr(); asm volatile("" : "+s"(k)); return (const Args*)k; }
__device__ __forceinline__ const float* asg(const float* q) { return (const float*)(GAS const float*)q; }
__device__ __forceinline__ P globalize(const P& q) {
    P r;
#define GZ(m) r.m = asg(q.m)
    GZ(x); GZ(c); GZ(w_ada); GZ(b_ada); GZ(norm1_g); GZ(w_in); GZ(lam_re); GZ(lam_im); GZ(b_re); GZ(b_im); GZ(c_re); GZ(c_im); GZ(d_skip); GZ(log_dt);
    GZ(w_glu); GZ(b_glu); GZ(attn_g); GZ(ssm_g); GZ(w_out); GZ(norm2_g); GZ(w_router); GZ(b_router); GZ(w_gu); GZ(b_gu); GZ(w_down); GZ(b_down); GZ(final_g);
#undef GZ
    r.out = (float*)(GAS float*)q.out; r.ws = (unsigned char*)(GAS unsigned char*)q.ws;
    return r;
}
__global__ void __launch_bounds__(NWAVES * 64, 2) mk_fwd(Args args_unused) {
    extern __shared__ __attribute__((aligned(16))) unsigned char lds_raw[];
    LAS unsigned char* lds = (LAS unsigned char*)lds_raw;
    const int lo = kargs()->ph_lo, hi = kargs()->ph_hi;
    const int Gn = gridDim.x, bid = blockIdx.x;
    if (threadIdx.x == 0) *(LAS u32x4*)(lds + MISC_OFF) = (u32x4){0u, 0u, 0u, 0u};
    __syncthreads();
    XcdBarrier bar; bar.bar = nullptr; bar.x = 0; bar.st = nullptr;
    if (hi - lo > 1) { unsigned* bw = (unsigned*)((unsigned char*)(GAS unsigned char*)kargs()->p.ws + WS_CTL) + CW_BAR; bar = xcd_barrier_post(bw, (volatile LAS unsigned*)(lds + MISC_OFF)); }
#define SEAM(k) do { if (lo <= (k) && (k) + 1 < hi) xcd_barrier(bar); } while (0)
#ifndef PHMASK
#define PHMASK 0x1fff
#endif
#define IN(k) (((PHMASK >> (k)) & 1) && lo <= (k) && (k) < hi)
#ifndef REPMASK
#define REPMASK 0
#endif
#define REPS(k) for (int rep_ = 0; rep_ < ((((REPMASK) >> (k)) & 1) ? 2 : 1); ++rep_)
#define PHASE_P const P p = globalize(kargs()->p); unsigned char* ws = p.ws; (void)ws
    if (IN(0)) REPS(0) { __syncthreads(); PHASE_P; phase_prologue(p, lds, bid, Gn); }
    SEAM(0);
    if (IN(1)) REPS(1) { __syncthreads(); PHASE_P; phase_norm1(p, bid, Gn); }
    SEAM(1);
    if (IN(2)) REPS(2) { __syncthreads();
        PHASE_P;
        typedef pg8::DenseSched<WS_HB, WS_WIN, S, INW, D> Sch; Sch Sd; Sd.init(ws, Gn, bid);
        pg8::EpiProj E{(bf16_t*)(ws + WS_QKV), (bf16_t*)(ws + WS_UB2)};
        pg8::gemm_phase<pg8::EpiProj, Sch>(lds + RING_OFF, Sd, E);
    }
    SEAM(2);
    if (IN(3)) REPS(3) { __syncthreads();
        PHASE_P;
        {   typedef pg8::S5Sched<0> Sch; Sch Ss; Ss.init(ws, Gn, bid);
            pg8::EpiS5E E{(float*)(ws + WS_EF)};
            pg8::gemm_phase<pg8::EpiS5E, Sch>(lds + RING_OFF, Ss, E); }
        __syncthreads();
        phase_attn(p, lds, bid, Gn);
    }
    SEAM(3);
    if (IN(4)) REPS(4) { __syncthreads(); PHASE_P; phase_s5_carry(p, bid); }
    SEAM(4);
    if (IN(5)) REPS(5) { __syncthreads();
        PHASE_P;
        typedef pg8::S5Sched<1> Sch; Sch Ss; Ss.init(ws, Gn, bid);
        pg8::EpiS5Y E{(bf16_t*)(ws + WS_YGB)};
        pg8::gemm_phase<pg8::EpiS5Y, Sch>(lds + RING_OFF, Ss, E);
    }
    SEAM(5);
    if (IN(6)) REPS(6) { __syncthreads();
        PHASE_P;
        typedef pg8::DenseSched<WS_YGB, WS_WGLU, S, SW, SW> Sch; Sch Sd; Sd.init(ws, Gn, bid);
        pg8::EpiGlu E{(const bf16_t*)(ws + WS_YGB), p.b_glu, (bf16_t*)(ws + WS_Z)};
        pg8::gemm_phase<pg8::EpiGlu, Sch>(lds + RING_OFF, Sd, E);
    }
    SEAM(6);
    if (IN(7)) REPS(7) { __syncthreads(); PHASE_P; phase_mix(p, bid, Gn); }
    SEAM(7);
    if (IN(8)) REPS(8) { __syncthreads();
        PHASE_P;
        typedef pg8::DenseSched<WS_YMIXB, WS_WOUT, S, D, D> Sch; Sch Sd; Sd.init(ws, Gn, bid);
        pg8::EpiResid E{p.x, (const float*)(ws + WS_MOD) + 2 * D, (bf16_t*)(ws + WS_X1)};
        pg8::gemm_phase<pg8::EpiResid, Sch>(lds + RING_OFF, Sd, E);
    }
    SEAM(8);
    if (IN(9)) REPS(9) { __syncthreads(); PHASE_P; phase_norm2_router(p, lds, bid, Gn); }
    SEAM(9);
    if (IN(10)) REPS(10) { __syncthreads();
        PHASE_P;
        pg8::MoeSched<1> Sm; Sm.init(ws, Gn, bid);
        pg8::EpiMoe1 E{p.b_gu, ws + WS_ACT};
        pg8::gemm_phase<pg8::EpiMoe1, pg8::MoeSched<1>>(lds + RING_OFF, Sm, E);
    }
    SEAM(10);
    if (IN(11)) REPS(11) { __syncthreads();
        PHASE_P;
        pg8::MoeSched<2> Sm; Sm.init(ws, Gn, bid);
        pg8::EpiMoe2 E{p.b_down, ws};
        pg8::gemm_phase<pg8::EpiMoe2, pg8::MoeSched<2>>(lds + RING_OFF, Sm, E);
    }
    SEAM(11);
    if (IN(12)) REPS(12) { __syncthreads(); PHASE_P; phase_final(p, bid, Gn); }
#undef IN
#undef PHASE_P
#undef SEAM
}

extern "C" void kernel_launch(void* const* d_in, const int* in_sizes, int n_in, void* d_out, int out_size, void* d_ws, size_t ws_size, hipStream_t stream) {
    static int grid = 0;
    if (grid == 0) {
        if (n_in != 27 || ws_size < WS_END) { fprintf(stderr, "kernel_launch: unexpected n_in %d or ws_size %zu (< %zu)\n", n_in, ws_size, (size_t)WS_END); grid = -1; return; }
        int dev = 0, cus = 0;
        if (hipGetDevice(&dev) != hipSuccess || hipDeviceGetAttribute(&cus, hipDeviceAttributeMultiprocessorCount, dev) != hipSuccess) { grid = -1; return; }
        if (hipFuncSetAttribute((const void*)mk_fwd, hipFuncAttributeMaxDynamicSharedMemorySize, LDS_BYTES) != hipSuccess) { fprintf(stderr, "hipFuncSetAttribute failed\n"); grid = -1; return; }
        grid = cus;
    }
    if (grid < 0) return;
    Args a{};
    const float** f = (const float**)&a.p;
    for (int i = 0; i < 27; ++i) f[i] = (const float*)d_in[i];
    a.p.out = (float*)d_out; a.p.ws = (unsigned char*)d_ws;
    (void)hipMemsetAsync(a.p.ws + WS_CTL, 0, 1 * MiB, stream);
#ifndef MK_PER_PHASE
    a.ph_lo = 0; a.ph_hi = 13; hipLaunchKernelGGL(mk_fwd, dim3(grid), dim3(NWAVES * 64), LDS_BYTES, stream, a);
#else
    for (int ph = 0; ph < 13; ++ph) { a.ph_lo = ph; a.ph_hi = ph + 1; hipLaunchKernelGGL(mk_fwd, dim3(grid), dim3(NWAVES * 64), LDS_BYTES, stream, a); }
#endif
}
```
